# Optimizing an MI355X kernel written in HIP

```python
import jax, jax.numpy as jnp
from jax import lax
import numpy as np

D_MODEL = 1024
BATCH = 16
SEQ = 4096
DEPTH = 1

MIX_WIDTH = D_MODEL
M_HEADS = 4
M_WIDTH = MIX_WIDTH // 2
M_HEAD_DIM = M_WIDTH // M_HEADS
CHUNK = 64
R_HEADS = 4
R_WIDTH = MIX_WIDTH - M_WIDTH
R_BLOCK = R_WIDTH // R_HEADS
CONV_WIDTH = 4
LRU_C = 8.0
N_EXPERTS = 32
TOP_K = 4
D_FF = D_MODEL
SWIGLU_LIMIT = 7.0
SWIGLU_ALPHA = 1.702
MOE_BLOCK = 512
EPS = 1e-6

Q_OFF = 0
K_OFF = Q_OFF + M_WIDTH
V_OFF = K_OFF + M_WIDTH
G_OFF = V_OFF + M_WIDTH
O_OFF = G_OFF + 2 * M_HEADS
RX_OFF = O_OFF + M_WIDTH
RG_OFF = RX_OFF + R_WIDTH
IN_COLS = RG_OFF + R_WIDTH

kernel_name = "hymba_mlstm_rglru_moe_block"


def rms_norm(x, w):
    xf = x.astype(jnp.float32)
    y = xf * lax.rsqrt(jnp.mean(xf * xf, axis=-1, keepdims=True) + EPS)
    return (y * w.astype(jnp.float32)).astype(x.dtype)


def mlstm_chunkwise(q, k, v, ig, fg):
    B, S, H, d = q.shape
    nc = S // CHUNK
    q = q.astype(jnp.float32)
    k = k.astype(jnp.float32) * (d ** -0.5)
    v = v.astype(jnp.float32)
    ig = ig.astype(jnp.float32)
    lf = jax.nn.log_sigmoid(fg.astype(jnp.float32))

    def chunks4(t):
        return t.reshape(B, nc, CHUNK, H, d).transpose(1, 0, 3, 2, 4)

    def chunks3(t):
        return t.reshape(B, nc, CHUNK, H).transpose(1, 0, 3, 2)

    causal = jnp.tril(jnp.ones((CHUNK, CHUNK), dtype=bool))

    def body(carry, xs):
        C, n, m = carry
        qc, kc, vc, ic, fc = xs
        b = jnp.cumsum(fc, axis=-1)
        Dm = b[..., :, None] - b[..., None, :] + ic[..., None, :]
        Dm = jnp.where(causal, Dm, -jnp.inf)
        inter = b + m[..., None]
        m_t = jnp.maximum(jnp.max(Dm, axis=-1), inter)
        Sw = jnp.einsum('bhtd,bhsd->bhts', qc, kc) * jnp.exp(Dm - m_t[..., None])
        w_inter = jnp.exp(inter - m_t)
        num = jnp.einsum('bhts,bhse->bhte', Sw, vc) + w_inter[..., None] * jnp.einsum('bhtd,bhde->bhte', qc, C)
        den = jnp.sum(Sw, axis=-1) + w_inter * jnp.einsum('bhtd,bhd->bht', qc, n)
        h = num / jnp.maximum(jnp.abs(den), jnp.exp(-m_t))[..., None]
        bL = b[..., -1]
        g = bL[..., None] - b + ic
        m_new = jnp.maximum(bL + m, jnp.max(g, axis=-1))
        w = jnp.exp(g - m_new[..., None])
        decay = jnp.exp(bL + m - m_new)
        C_new = decay[..., None, None] * C + jnp.einsum('bhs,bhsd,bhse->bhde', w, kc, vc)
        n_new = decay[..., None] * n + jnp.einsum('bhs,bhsd->bhd', w, kc)
        return (C_new, n_new, m_new), h

    init = (jnp.zeros((B, H, d, d), jnp.float32), jnp.zeros((B, H, d), jnp.float32),
            jnp.zeros((B, H), jnp.float32))
    _, hs = lax.scan(body, init, (chunks4(q), chunks4(k), chunks4(v), chunks3(ig), chunks3(lf)))
    return hs.transpose(1, 0, 3, 2, 4).reshape(B, S, H, d)


def causal_depthwise_conv(x, w, b):
    S = x.shape[1]
    xp = jnp.pad(x, ((0, 0), (CONV_WIDTH - 1, 0), (0, 0)))
    y = sum(xp[:, j:j + S] * w[j] for j in range(CONV_WIDTH))
    return y + b


def rg_lru(x, wr, br, wi, bi, lam):
    B, S, R = x.shape
    xb = x.reshape(B, S, R_HEADS, R_BLOCK)
    r = jax.nn.sigmoid(jnp.einsum('bshi,hij->bshj', xb, wr.astype(jnp.float32)).reshape(B, S, R) + br)
    i = jax.nn.sigmoid(jnp.einsum('bshi,hij->bshj', xb, wi.astype(jnp.float32)).reshape(B, S, R) + bi)
    log_a = -LRU_C * r * jax.nn.softplus(-lam.astype(jnp.float32))
    a = jnp.exp(log_a)
    bterm = jnp.sqrt(-jnp.expm1(2.0 * log_a)) * (i * x)

    def combine(p, q):
        a1, b1 = p
        a2, b2 = q
        return a1 * a2, a2 * b1 + b2

    _, h = lax.associative_scan(combine, (a, bterm), axis=1)
    return h


def moe_ffn(x, router_w, router_b, w_gu, b_gu, w_down, b_down):
    B, S, D = x.shape
    T = B * S
    xt = x.reshape(T, D)
    logits = (xt @ router_w).astype(jnp.float32) + router_b.astype(jnp.float32)
    topv, topi = lax.top_k(logits, TOP_K)
    gates = jax.nn.softmax(topv, axis=-1)
    A = T * TOP_K
    e = topi.reshape(A)
    tok = jnp.arange(A, dtype=jnp.int32) // TOP_K
    g = gates.reshape(A)
    order = jnp.argsort(e)
    e_s, tok_s, g_s = e[order], tok[order], g[order]
    counts = jnp.zeros((N_EXPERTS,), jnp.int32).at[e].add(1)
    starts = jnp.cumsum(counts) - counts
    padded = ((counts + MOE_BLOCK - 1) // MOE_BLOCK) * MOE_BLOCK
    pends = jnp.cumsum(padded)
    pstarts = pends - padded
    dest = pstarts[e_s] + jnp.arange(A, dtype=jnp.int32) - starts[e_s]
    NB = -(-A // MOE_BLOCK) + N_EXPERTS
    P = NB * MOE_BLOCK
    src = jnp.zeros((P,), jnp.int32).at[dest].set(tok_s)
    wrow = jnp.zeros((P,), jnp.float32).at[dest].set(g_s)
    block_e = jnp.clip(jnp.searchsorted(pends, jnp.arange(NB, dtype=jnp.int32) * MOE_BLOCK, side='right'),
                       0, N_EXPERTS - 1)

    def body(acc, blk):
        be, bsrc, bw = blk
        xb = xt[bsrc]
        gu = xb @ w_gu[be] + b_gu[be]
        gate = jnp.minimum(gu[:, :D_FF], SWIGLU_LIMIT)
        up = jnp.clip(gu[:, D_FF:], -SWIGLU_LIMIT, SWIGLU_LIMIT)
        hdn = (up + 1.0) * gate * jax.nn.sigmoid(gate * SWIGLU_ALPHA)
        yb = hdn @ w_down[be] + b_down[be]
        acc = acc.at[bsrc].add((yb * bw[:, None]).astype(acc.dtype))
        return acc, None

    out, _ = lax.scan(body, jnp.zeros((T, D), x.dtype),
                      (block_e, src.reshape(NB, MOE_BLOCK), wrow.reshape(NB, MOE_BLOCK)))
    return out.reshape(B, S, D)


def setup_inputs(seed: int = 0) -> dict:
    key = jax.random.key(seed)
    ks = jax.random.split(key, 24)
    f32 = jnp.float32
    L, D, E = DEPTH, D_MODEL, N_EXPERTS

    def nrm(k, shape, scale):
        return jax.random.normal(k, shape, f32) * scale

    x = jax.random.normal(ks[0], (BATCH, SEQ, D), f32)
    norm1_w = 1.0 + nrm(ks[1], (L, D), 0.01)
    w_in = nrm(ks[2], (L, D, IN_COLS), D ** -0.5)
    i_bias = nrm(ks[3], (L, M_HEADS), 0.1)
    f_bias = jnp.linspace(3.0, 6.0, M_HEADS, dtype=f32)[None, :] + nrm(ks[4], (L, M_HEADS), 0.1)
    mlstm_gate_b = jnp.concatenate([i_bias, f_bias], axis=-1)
    mlstm_norm_w = 1.0 + nrm(ks[5], (L, M_WIDTH), 0.01)
    conv_w = nrm(ks[6], (L, CONV_WIDTH, R_WIDTH), CONV_WIDTH ** -0.5)
    conv_b = nrm(ks[7], (L, R_WIDTH), 0.01)
    lru_wr = nrm(ks[8], (L, R_HEADS, R_BLOCK, R_BLOCK), R_BLOCK ** -0.5)
    lru_br = nrm(ks[9], (L, R_WIDTH), 0.01)
    lru_wi = nrm(ks[10], (L, R_HEADS, R_BLOCK, R_BLOCK), R_BLOCK ** -0.5)
    lru_bi = nrm(ks[11], (L, R_WIDTH), 0.01)
    u = jax.random.uniform(ks[12], (L, R_WIDTH), f32, 0.9, 0.999)
    p = u ** (1.0 / LRU_C)
    lru_lambda = jnp.log(p) - jnp.log1p(-p)
    lru_norm_w = 1.0 + nrm(ks[13], (L, R_WIDTH), 0.01)
    w_out = nrm(ks[14], (L, MIX_WIDTH, D), MIX_WIDTH ** -0.5)
    norm2_w = 1.0 + nrm(ks[15], (L, D), 0.01)
    router_w = nrm(ks[16], (L, D, E), D ** -0.5)
    router_b = nrm(ks[17], (L, E), 0.01)
    moe_w_gu = nrm(ks[18], (L, E, D, 2 * D_FF), D ** -0.5)
    moe_b_gu = nrm(ks[19], (L, E, 2 * D_FF), 0.01)
    moe_w_down = nrm(ks[20], (L, E, D_FF, D), D_FF ** -0.5)
    moe_b_down = nrm(ks[21], (L, E, D), 0.01)
    final_norm_w = 1.0 + nrm(ks[22], (D,), 0.01)
    return {"x": x, "norm1_w": norm1_w, "w_in": w_in, "mlstm_gate_b": mlstm_gate_b,
            "mlstm_norm_w": mlstm_norm_w, "conv_w": conv_w, "conv_b": conv_b,
            "lru_wr": lru_wr, "lru_br": lru_br, "lru_wi": lru_wi, "lru_bi": lru_bi,
            "lru_lambda": lru_lambda, "lru_norm_w": lru_norm_w, "w_out": w_out,
            "norm2_w": norm2_w, "router_w": router_w, "router_b": router_b,
            "moe_w_gu": moe_w_gu, "moe_b_gu": moe_b_gu, "moe_w_down": moe_w_down,
            "moe_b_down": moe_b_down, "final_norm_w": final_norm_w}


def reference(x, norm1_w, w_in, mlstm_gate_b, mlstm_norm_w, conv_w, conv_b, lru_wr, lru_br, lru_wi,
              lru_bi, lru_lambda, lru_norm_w, w_out, norm2_w, router_w, router_b, moe_w_gu, moe_b_gu,
              moe_w_down, moe_b_down, final_norm_w):
    B, S, D = x.shape
    h = x
    for l in range(DEPTH):
        hn = rms_norm(h, norm1_w[l])
        proj = hn @ w_in[l]
        q = proj[..., Q_OFF:K_OFF].reshape(B, S, M_HEADS, M_HEAD_DIM)
        k = proj[..., K_OFF:V_OFF].reshape(B, S, M_HEADS, M_HEAD_DIM)
        v = proj[..., V_OFF:G_OFF].reshape(B, S, M_HEADS, M_HEAD_DIM)
        gts = proj[..., G_OFF:O_OFF].astype(jnp.float32) + mlstm_gate_b[l].astype(jnp.float32)
        h_m = mlstm_chunkwise(q, k, v, gts[..., :M_HEADS], gts[..., M_HEADS:])
        o = jax.nn.sigmoid(proj[..., O_OFF:RX_OFF].astype(jnp.float32)).reshape(B, S, M_HEADS, M_HEAD_DIM)
        h_m = rms_norm(o * h_m, mlstm_norm_w[l].reshape(M_HEADS, M_HEAD_DIM)).reshape(B, S, M_WIDTH)
        xr = proj[..., RX_OFF:RG_OFF].astype(jnp.float32)
        xr = causal_depthwise_conv(xr, conv_w[l].astype(jnp.float32), conv_b[l].astype(jnp.float32))
        h_r = rg_lru(xr, lru_wr[l], lru_br[l].astype(jnp.float32), lru_wi[l],
                     lru_bi[l].astype(jnp.float32), lru_lambda[l])
        gate_r = jax.nn.gelu(proj[..., RG_OFF:IN_COLS].astype(jnp.float32), approximate=True)
        h_r = rms_norm(gate_r * h_r, lru_norm_w[l])
        mix = jnp.concatenate([h_m, h_r], axis=-1).astype(h.dtype) @ w_out[l]
        h = h + mix
        h = h + moe_ffn(rms_norm(h, norm2_w[l]), router_w[l], router_b[l], moe_w_gu[l], moe_b_gu[l],
                        moe_w_down[l], moe_b_down[l])
    return rms_norm(h, final_norm_w)
```

```cpp
#include <hip/hip_runtime.h>
#include <cstdio>
#include <cstdint>

#define LAS __attribute__((address_space(3)))
typedef unsigned short bf16_t;
typedef short bf16x8 __attribute__((ext_vector_type(8)));
typedef float f32x4 __attribute__((ext_vector_type(4)));
typedef unsigned u32x4 __attribute__((ext_vector_type(4)));
typedef unsigned u32x2 __attribute__((ext_vector_type(2)));
typedef int i32x4 __attribute__((ext_vector_type(4)));

constexpr int T = 65536, D = 1024, SEQ = 4096, NB = 16;
constexpr int INC = 3080;
constexpr int NPROJ = 3072;
constexpr int NE = 32, TOPK = 4, DFF = 1024;
constexpr float EPS = 1e-6f;
constexpr int CAP_ROWS = 196608;

constexpr size_t MB = 1024 * 1024;
constexpr size_t WS_CTL  = 0;
constexpr size_t WS_GATES = 1 * MB;
constexpr size_t WS_SSQR = 3 * MB;
constexpr size_t WS_SUMM = 4 * MB;
constexpr size_t WS_WRI  = 5 * MB;
constexpr size_t WS_ENT  = 6 * MB;
constexpr size_t WS_WIN  = 38 * MB;
constexpr size_t WS_WOUT = 44 * MB;
constexpr size_t WS_WGU  = 46 * MB;
constexpr size_t WS_WDN  = 174 * MB;
constexpr size_t WS_R1   = 238 * MB;
constexpr size_t WS_R2   = 366 * MB;
constexpr size_t WS_Y23  = 750 * MB;
constexpr size_t WS_END  = 1006 * MB;

constexpr int CW_CNT = 0;
constexpr int CW_WORK = 64;

__device__ __forceinline__ unsigned pk2(float lo, float hi) { unsigned r; asm("v_cvt_pk_bf16_f32 %0, %1, %2" : "=v"(r) : "v"(lo), "v"(hi)); return r; }
__device__ __forceinline__ float bflo(unsigned u) { return __uint_as_float(u << 16); }
__device__ __forceinline__ float bfhi(unsigned u) { return __uint_as_float(u & 0xffff0000u); }
__device__ __forceinline__ float bf2f(bf16_t b) { return __uint_as_float(((unsigned)b) << 16); }
__device__ __forceinline__ float wave_sum(float v) {
#pragma unroll
    for (int o = 1; o < 64; o <<= 1) v += __shfl_xor(v, o);
    return v;
}
__device__ __forceinline__ float sigmoidf_(float x) { return 1.0f / (1.0f + __expf(-x)); }
__device__ __forceinline__ float gelu_tanh(float x) {
    const float u = 0.7978845608028654f * (x + 0.044715f * x * x * x);
    const float t = 1.0f - 2.0f / (1.0f + __expf(2.0f * u));
    return 0.5f * x * (1.0f + t);
}

struct Params {
    const float* in[22];
    float* out;
    unsigned char* ws;
    int pad0, pad1;
};
enum { I_X = 0, I_N1W, I_WIN, I_GB, I_MNW, I_CW, I_CB, I_WR, I_BR, I_WI, I_BI, I_LAM, I_LNW, I_WOUT, I_N2W, I_RW, I_RB, I_WGU, I_BGU, I_WDN, I_BDN, I_FNW };

__device__ __forceinline__ void tr_item(const float* __restrict__ W, int ldw, int col0, bf16_t* dst, int K, int k0, const float* sk, float mul, LAS float* scr, int lane) {
#pragma unroll 8
    for (int i = 0; i < 32; ++i) { const int kk = 2 * i + (lane >> 5); const float s = sk ? sk[k0 + kk] * mul : mul; scr[kk * 33 + (lane & 31)] = W[(size_t)(k0 + kk) * ldw + col0 + (lane & 31)] * s; }
    asm volatile("s_waitcnt lgkmcnt(0)" ::: "memory");
    const int c = lane & 7;
#pragma unroll
    for (int j = 0; j < 4; ++j) { const int n = (lane >> 3) + 8 * j; const LAS float* s = scr + (8 * c) * 33 + n;
        u32x4 o; o.x = pk2(s[0 * 33], s[1 * 33]); o.y = pk2(s[2 * 33], s[3 * 33]); o.z = pk2(s[4 * 33], s[5 * 33]); o.w = pk2(s[6 * 33], s[7 * 33]);
        *(u32x4*)(dst + (size_t)n * K + k0 + 8 * c) = o; }
    asm volatile("s_waitcnt lgkmcnt(0)" ::: "memory");
}
constexpr int IT_WIN = 16 * 96, IT_WOUT = 16 * 32, IT_WGU_E = 16 * 64, IT_WDN_E = 16 * 32;
__device__ __forceinline__ void conv_item_small(const Params& p, int it, LAS float* scr, int lane) {
    if (it < IT_WIN) {
        const int kb = it / 96, nb = it % 96, n0 = 32 * nb, sec = n0 >> 9;
        const int secoff = sec == 0 ? 0 : sec == 1 ? 512 : sec == 2 ? 1024 : sec == 3 ? 1544 : sec == 4 ? 2056 : 2568;
        const float mul = sec == 1 ? 0.08838834764831845f : 1.0f;
        tr_item(p.in[I_WIN], INC, secoff + (n0 & 511), (bf16_t*)(p.ws + WS_WIN) + (size_t)n0 * D, D, 64 * kb, nullptr, mul, scr, lane);
    } else {
        it -= IT_WIN; const int kb = it / 32, nb = it % 32, k0 = 64 * kb;
        const float* sk = k0 < 512 ? p.in[I_MNW] : p.in[I_LNW] - 512;
        tr_item(p.in[I_WOUT], D, 32 * nb, (bf16_t*)(p.ws + WS_WOUT) + (size_t)(32 * nb) * D, D, k0, sk, 1.0f, scr, lane);
    }
}
__device__ __forceinline__ void conv_item_moe(const Params& p, int it, LAS float* scr, int lane) {
    if (it < NE * IT_WGU_E) {
        const int e = it / IT_WGU_E, r = it % IT_WGU_E, kb = r / 64, nb = r % 64, n0 = 32 * nb, j = n0 >> 8, c0 = n0 & 255;
        const int srccol = c0 < 128 ? 128 * j + c0 : 1024 + 128 * j + (c0 - 128);
        tr_item(p.in[I_WGU] + (size_t)e * D * 2 * DFF, 2 * DFF, srccol, (bf16_t*)(p.ws + WS_WGU) + ((size_t)e * 2 * DFF + n0) * D, D, 64 * kb, p.in[I_N2W], 1.0f, scr, lane);
    } else {
        it -= NE * IT_WGU_E; const int e = it / IT_WDN_E, r = it % IT_WDN_E, kb = r / 32, nb = r % 32;
        tr_item(p.in[I_WDN] + (size_t)e * DFF * D, D, 32 * nb, (bf16_t*)(p.ws + WS_WDN) + ((size_t)e * D + 32 * nb) * DFF, DFF, 64 * kb, nullptr, 1.0f, scr, lane);
    }
}
__device__ __forceinline__ void xpass_rows(const Params& p, int gw, int ngw, int lane) {
    const float* wg = p.in[I_WIN] + 1536;
    float wr[16][8];
#pragma unroll
    for (int j = 0; j < 4; ++j)
#pragma unroll
        for (int c = 0; c < 4; ++c) { const int k = 256 * j + 4 * lane + c; const f32x4 a = *(const f32x4*)(wg + (size_t)k * INC), b = *(const f32x4*)(wg + (size_t)k * INC + 4);
            wr[j * 4 + c][0] = a.x; wr[j * 4 + c][1] = a.y; wr[j * 4 + c][2] = a.z; wr[j * 4 + c][3] = a.w; wr[j * 4 + c][4] = b.x; wr[j * 4 + c][5] = b.y; wr[j * 4 + c][6] = b.z; wr[j * 4 + c][7] = b.w; }
    f32x4 w1[4];
#pragma unroll
    for (int j = 0; j < 4; ++j) w1[j] = *(const f32x4*)(p.in[I_N1W] + 256 * j + 4 * lane);
    const float gb = lane < 8 ? p.in[I_GB][lane] : 0.f;
    bf16_t* XN = (bf16_t*)(p.ws + WS_R1); float* GATES = (float*)(p.ws + WS_GATES);
    for (int m = gw; m < T; m += ngw) {
        const f32x4* xr = (const f32x4*)(p.in[I_X] + (size_t)m * D) + lane;
        f32x4 v[4]; float s = 0.f;
#pragma unroll
        for (int j = 0; j < 4; ++j) { v[j] = xr[64 * j]; s += (v[j].x * v[j].x + v[j].y * v[j].y) + (v[j].z * v[j].z + v[j].w * v[j].w); }
        const float rstd = rsqrtf(wave_sum(s) * (1.0f / D) + EPS);
        float g[8];
#pragma unroll
        for (int q = 0; q < 8; ++q) g[q] = 0.f;
        unsigned long long* o8 = (unsigned long long*)(XN + (size_t)m * D) + lane;
#pragma unroll
        for (int j = 0; j < 4; ++j) { v[j] = v[j] * rstd * w1[j];
            o8[64 * j] = (unsigned long long)pk2(v[j].x, v[j].y) | ((unsigned long long)pk2(v[j].z, v[j].w) << 32);
#pragma unroll
            for (int q = 0; q < 8; ++q) g[q] += v[j].x * wr[j * 4 + 0][q] + v[j].y * wr[j * 4 + 1][q] + v[j].z * wr[j * 4 + 2][q] + v[j].w * wr[j * 4 + 3][q]; }
        float mine = 0.f;
#pragma unroll
        for (int q = 0; q < 8; ++q) { const float t = wave_sum(g[q]); if (lane == q) mine = t; }
        if (lane < 8) { float val = mine + gb; if (lane >= 4) val = -log1pf(__expf(-val)); GATES[(size_t)m * 8 + lane] = val; }
    }
}
__global__ void __launch_bounds__(512) k_prep(Params p) {
    extern __shared__ __attribute__((aligned(16))) unsigned char lds[];
    const int tid = threadIdx.x, lane = tid & 63, wave = tid >> 6, gw = blockIdx.x * 8 + wave, ngw = gridDim.x * 8;
    LAS float* scr = (LAS float*)((LAS unsigned char*)lds + wave * 8448);
    for (int it = gw; it < IT_WIN + IT_WOUT; it += ngw) conv_item_small(p, it, scr, lane);
    for (int it = gw; it < NE * (IT_WGU_E + IT_WDN_E); it += ngw) conv_item_moe(p, it, scr, lane);
    bf16_t* WRI = (bf16_t*)(p.ws + WS_WRI);
    for (int i = blockIdx.x * 512 + tid; i < 4 * 256 * 128; i += gridDim.x * 512) { const int h = i >> 15, n = (i >> 7) & 255, k = i & 127;
        const float v = n < 128 ? p.in[I_WR][(h * 128 + k) * 128 + n] : p.in[I_WI][(h * 128 + k) * 128 + n - 128]; WRI[i] = (bf16_t)(pk2(v, 0.f) & 0xffff); }
    float* SSQR = (float*)(p.ws + WS_SSQR);
    for (int i = blockIdx.x * 512 + tid; i < T; i += gridDim.x * 512) SSQR[i] = 0.f;
    xpass_rows(p, gw, ngw, lane);
}

template <class P> __device__ __forceinline__ void sgemm_block(const P& p, int unit) {
    const int tid = threadIdx.x, w = tid >> 6, lane = tid & 63, wr = w >> 1, wc = w & 1, fr = lane & 15, fq = lane >> 4;
    const bf16_t* ap[4]; const bf16_t* bp[4];
#pragma unroll
    for (int m = 0; m < 4; ++m) ap[m] = p.arow(unit, wr * 64 + m * 16 + fr) + fq * 8;
#pragma unroll
    for (int j = 0; j < 4; ++j) bp[j] = p.brow(unit, wc, j, fr) + fq * 8;
    f32x4 acc[4][4];
#pragma unroll
    for (int m = 0; m < 4; ++m)
#pragma unroll
        for (int j = 0; j < 4; ++j) acc[m][j] = (f32x4){0.f, 0.f, 0.f, 0.f};
    for (int k = 0; k < p.K; k += 32) {
        bf16x8 a[4], b[4];
#pragma unroll
        for (int m = 0; m < 4; ++m) a[m] = *(const bf16x8*)(ap[m] + k);
#pragma unroll
        for (int j = 0; j < 4; ++j) b[j] = *(const bf16x8*)(bp[j] + k);
#pragma unroll
        for (int m = 0; m < 4; ++m)
#pragma unroll
            for (int j = 0; j < 4; ++j) acc[m][j] = __builtin_amdgcn_mfma_f32_16x16x32_bf16(b[j], a[m], acc[m][j], 0, 0, 0);
    }
    p.epi(unit, wr, wc, fr, fq, acc);
}
template <class P> __global__ void __launch_bounds__(256) k_sgemm(P p) {
    const int n = p.nunits();
    for (int u = blockIdx.x; u < n; u += gridDim.x) sgemm_block(p, u);
}

struct InProjS {
    const bf16_t* XN; const bf16_t* W; bf16_t* PROJ; int K;
    __device__ int nunits() const { return (T / 128) * (NPROJ / 128); }
    __device__ const bf16_t* arow(int u, int r) const { return XN + (size_t)((u / 24) * 128 + r) * D; }
    __device__ const bf16_t* brow(int u, int wc, int j, int fr) const { return W + (size_t)((u % 24) * 128 + wc * 64 + j * 16 + fr) * D; }
    __device__ void epi(int u, int wr, int wc, int fr, int fq, const f32x4 (&acc)[4][4]) const {
        const int pm = u / 24, pn = u % 24, sec = pn >> 2;
#pragma unroll
        for (int m = 0; m < 4; ++m)
#pragma unroll
            for (int j = 0; j < 4; ++j) { f32x4 v = acc[m][j];
                if (sec == 3) { v.x = sigmoidf_(v.x); v.y = sigmoidf_(v.y); v.z = sigmoidf_(v.z); v.w = sigmoidf_(v.w); }
                if (sec == 5) { v.x = gelu_tanh(v.x); v.y = gelu_tanh(v.y); v.z = gelu_tanh(v.z); v.w = gelu_tanh(v.w); }
                const size_t row = (size_t)pm * 128 + wr * 64 + m * 16 + fr; const int col = pn * 128 + wc * 64 + j * 16 + 4 * fq;
                u32x2 o; o.x = pk2(v.x, v.y); o.y = pk2(v.z, v.w); *(u32x2*)(PROJ + row * NPROJ + col) = o; }
    }
};
struct OutProjS {
    const bf16_t* MIX; const bf16_t* W; const float* X; float* H; int K;
    __device__ int nunits() const { return (T / 128) * (D / 128); }
    __device__ const bf16_t* arow(int u, int r) const { return MIX + (size_t)((u / 8) * 128 + r) * D; }
    __device__ const bf16_t* brow(int u, int wc, int j, int fr) const { return W + (size_t)((u % 8) * 128 + wc * 64 + j * 16 + fr) * D; }
    __device__ void epi(int u, int wr, int wc, int fr, int fq, const f32x4 (&acc)[4][4]) const {
        const int pm = u / 8, pn = u % 8;
#pragma unroll
        for (int m = 0; m < 4; ++m)
#pragma unroll
            for (int j = 0; j < 4; ++j) { const size_t row = (size_t)pm * 128 + wr * 64 + m * 16 + fr; const int col = pn * 128 + wc * 64 + j * 16 + 4 * fq;
                const f32x4 x = *(const f32x4*)(X + row * D + col); *(f32x4*)(H + row * D + col) = x + acc[m][j]; }
    }
};

__global__ void __launch_bounds__(256) k_mlstm_naive(Params p) {
    __shared__ float qs[128], ks[128], red[4];
    const int tid = threadIdx.x, e = tid >> 1, half = tid & 1, b = blockIdx.x >> 2, h = blockIdx.x & 3, lane = tid & 63, w = tid >> 6;
    const bf16_t* PROJ = (const bf16_t*)(p.ws + WS_R2); const float* GATES = (const float*)(p.ws + WS_GATES); bf16_t* MIX = (bf16_t*)(p.ws + WS_R1);
    float C[64], n[64];
#pragma unroll
    for (int i = 0; i < 64; ++i) { C[i] = 0.f; n[i] = 0.f; }
    float mst = 0.f;
    for (int t = 0; t < SEQ; ++t) {
        const size_t row = (size_t)b * SEQ + t; const bf16_t* pr = PROJ + row * NPROJ + h * 128;
        if (tid < 128) qs[tid] = bf2f(pr[tid]); else ks[tid - 128] = bf2f(pr[512 + tid - 128]);
        const float ve = bf2f(pr[1024 + e]), oe = bf2f(pr[1536 + e]);
        const float ig = GATES[row * 8 + h], lf = GATES[row * 8 + 4 + h];
        __syncthreads();
        const float mn = fmaxf(lf + mst, ig), fp = __expf(lf + mst - mn), ip = __expf(ig - mn); mst = mn;
        float num = 0.f, den = 0.f;
#pragma unroll
        for (int i = 0; i < 64; ++i) { const float kd = ks[half * 64 + i], qd = qs[half * 64 + i];
            C[i] = fp * C[i] + ip * kd * ve; n[i] = fp * n[i] + ip * kd; num += qd * C[i]; den += qd * n[i]; }
        num += __shfl_xor(num, 1); den += __shfl_xor(den, 1);
        const float hv = num / fmaxf(fabsf(den), __expf(-mst)), x = oe * hv;
        float s = half == 0 ? x * x : 0.f; s = wave_sum(s);
        if (lane == 0) red[w] = s;
        __syncthreads();
        const float tot = red[0] + red[1] + red[2] + red[3];
        if (half == 0) MIX[row * D + h * 128 + e] = (bf16_t)(pk2(x * rsqrtf(tot * (1.0f / 128.f) + EPS), 0.f) & 0xffff);
        __syncthreads();
    }
}
__global__ void __launch_bounds__(256) k_rglru_naive(Params p) {
    extern __shared__ __attribute__((aligned(16))) unsigned char lds[];
    float* Wr = (float*)lds; float* Wi = Wr + 128 * 128; float* xcs = Wi + 128 * 128;
    const int tid = threadIdx.x, ch = tid >> 1, half = tid & 1, b = blockIdx.x >> 2, hd = blockIdx.x & 3, lane = tid & 63;
    for (int i = tid; i < 128 * 128; i += 256) { Wr[i] = p.in[I_WR][hd * 16384 + i]; Wi[i] = p.in[I_WI][hd * 16384 + i]; }
    const int c = hd * 128 + ch;
    const float cw0 = p.in[I_CW][0 * 512 + c], cw1 = p.in[I_CW][1 * 512 + c], cw2 = p.in[I_CW][2 * 512 + c], cw3 = p.in[I_CW][3 * 512 + c], cb = p.in[I_CB][c];
    const float br = p.in[I_BR][c], bi = p.in[I_BI][c], lam = p.in[I_LAM][c];
    const float sp = log1pf(__expf(-lam));
    const bf16_t* PROJ = (const bf16_t*)(p.ws + WS_R2); bf16_t* MIX = (bf16_t*)(p.ws + WS_R1); float* SSQR = (float*)(p.ws + WS_SSQR);
    float x0 = 0.f, x1 = 0.f, x2 = 0.f, hst = 0.f;
    __syncthreads();
    for (int t = 0; t < SEQ; ++t) {
        const size_t row = (size_t)b * SEQ + t;
        const float x3 = bf2f(PROJ[row * NPROJ + 2048 + c]), rg = bf2f(PROJ[row * NPROJ + 2560 + c]);
        const float xc = cb + cw0 * x0 + cw1 * x1 + cw2 * x2 + cw3 * x3; x0 = x1; x1 = x2; x2 = x3;
        if (half == 0) xcs[ch] = xc;
        __syncthreads();
        float rp = 0.f, ipre = 0.f;
        for (int i = 0; i < 64; ++i) { const float xv = xcs[half * 64 + i]; rp += xv * Wr[(half * 64 + i) * 128 + ch]; ipre += xv * Wi[(half * 64 + i) * 128 + ch]; }
        rp += __shfl_xor(rp, 1); ipre += __shfl_xor(ipre, 1);
        const float r = sigmoidf_(rp + br), ig = sigmoidf_(ipre + bi), la = -8.0f * r * sp, a = __expf(la), bt = sqrtf(fmaxf(1.0f - a * a, 0.f)) * (ig * xc);
        hst = a * hst + bt;
        const float g = rg * hst;
        float s = half == 0 ? g * g : 0.f; s = wave_sum(s);
        if (lane == 0) atomicAdd(SSQR + row, s);
        if (half == 0) MIX[row * D + 512 + c] = (bf16_t)(pk2(g, 0.f) & 0xffff);
        __syncthreads();
    }
}
__global__ void __launch_bounds__(256) k_rglru_norm(Params p) {
    bf16_t* MIX = (bf16_t*)(p.ws + WS_R1); const float* SSQR = (const float*)(p.ws + WS_SSQR);
    for (size_t i = (size_t)blockIdx.x * 256 + threadIdx.x; i < (size_t)T * 64; i += (size_t)gridDim.x * 256) {
        const size_t row = i >> 6; const int c8 = (int)(i & 63);
        const float rs = rsqrtf(SSQR[row] * (1.0f / 512.f) + EPS);
        u32x4* ptr = (u32x4*)(MIX + row * D + 512 + c8 * 8); u32x4 v = *ptr;
        v.x = pk2(bflo(v.x) * rs, bfhi(v.x) * rs); v.y = pk2(bflo(v.y) * rs, bfhi(v.y) * rs); v.z = pk2(bflo(v.z) * rs, bfhi(v.z) * rs); v.w = pk2(bflo(v.w) * rs, bfhi(v.w) * rs);
        *ptr = v;
    }
}

constexpr int RT_WR = 0, RT_SELE = 147456, RT_SELG = RT_SELE + 4096, RT_RSTD = RT_SELG + 4096, RT_HIST = RT_RSTD + 1024, RT_BASE = RT_HIST + 128, RT_LDS = RT_BASE + 128;
__device__ __forceinline__ void routing_block(const Params& p, LAS unsigned char* lds, int tb) {
    const int tid = threadIdx.x, lane = tid & 63, wave = tid >> 6;
    LAS float* WRl = (LAS float*)(lds + RT_WR); LAS int* selE = (LAS int*)(lds + RT_SELE); LAS float* selG = (LAS float*)(lds + RT_SELG);
    LAS float* rstds = (LAS float*)(lds + RT_RSTD); LAS int* hist = (LAS int*)(lds + RT_HIST); LAS int* base = (LAS int*)(lds + RT_BASE);
    for (int i = tid; i < 1024 * 8; i += 512) { const int k = i >> 3, q = i & 7; const float s = p.in[I_N2W][k];
        f32x4 v = *(const f32x4*)(p.in[I_RW] + (size_t)k * 32 + 4 * q); v = v * s;
        const int rho = ((k >> 8) * 4 + (k & 3)) * 64 + ((k >> 2) & 63); *(LAS f32x4*)(WRl + rho * 36 + 4 * q) = v; }
    if (tid < 32) hist[tid] = 0;
    __syncthreads();
    const float* H = p.out; bf16_t* HB = (bf16_t*)(p.ws + WS_R1);
    const float rb = p.in[I_RB][lane >> 1];
    for (int it = 0; it < 32; ++it) {
        const int tl = it * 8 + wave; const size_t tok = (size_t)tb * 256 + tl;
        const f32x4* hr = (const f32x4*)(H + tok * D) + lane;
        f32x4 v[4]; float s = 0.f;
#pragma unroll
        for (int j = 0; j < 4; ++j) { v[j] = hr[64 * j]; s += (v[j].x * v[j].x + v[j].y * v[j].y) + (v[j].z * v[j].z + v[j].w * v[j].w); }
        const float rstd = rsqrtf(wave_sum(s) * (1.0f / D) + EPS);
        unsigned long long* o8 = (unsigned long long*)(HB + tok * D) + lane;
#pragma unroll
        for (int j = 0; j < 4; ++j) o8[64 * j] = (unsigned long long)pk2(v[j].x, v[j].y) | ((unsigned long long)pk2(v[j].z, v[j].w) << 32);
        float acc[32];
#pragma unroll
        for (int q = 0; q < 32; ++q) acc[q] = 0.f;
#pragma unroll
        for (int j = 0; j < 4; ++j)
#pragma unroll
            for (int c = 0; c < 4; ++c) { const float hv = c == 0 ? v[j].x : c == 1 ? v[j].y : c == 2 ? v[j].z : v[j].w;
                const LAS f32x4* wrow = (const LAS f32x4*)(WRl + ((j * 4 + c) * 64 + lane) * 36);
#pragma unroll
                for (int q = 0; q < 8; ++q) { const f32x4 wv = wrow[q]; acc[4 * q + 0] += hv * wv.x; acc[4 * q + 1] += hv * wv.y; acc[4 * q + 2] += hv * wv.z; acc[4 * q + 3] += hv * wv.w; } }
#pragma unroll
        for (int q = 0; q < 16; ++q) { const bool up = (lane & 32) != 0; const float send = up ? acc[q] : acc[q + 16], keep = up ? acc[q + 16] : acc[q]; acc[q] = keep + __shfl_xor(send, 32); }
#pragma unroll
        for (int q = 0; q < 8; ++q) { const bool up = (lane & 16) != 0; const float send = up ? acc[q] : acc[q + 8], keep = up ? acc[q + 8] : acc[q]; acc[q] = keep + __shfl_xor(send, 16); }
#pragma unroll
        for (int q = 0; q < 4; ++q) { const bool up = (lane & 8) != 0; const float send = up ? acc[q] : acc[q + 4], keep = up ? acc[q + 4] : acc[q]; acc[q] = keep + __shfl_xor(send, 8); }
#pragma unroll
        for (int q = 0; q < 2; ++q) { const bool up = (lane & 4) != 0; const float send = up ? acc[q] : acc[q + 2], keep = up ? acc[q + 2] : acc[q]; acc[q] = keep + __shfl_xor(send, 4); }
        { const bool up = (lane & 2) != 0; const float send = up ? acc[0] : acc[1], keep = up ? acc[1] : acc[0]; acc[0] = keep + __shfl_xor(send, 2); }
        float logit = (acc[0] + __shfl_xor(acc[0], 1)) * rstd + rb;
        float tv[4]; int te[4];
#pragma unroll
        for (int k = 0; k < 4; ++k) {
            float mx = logit;
#pragma unroll
            for (int o = 2; o < 64; o <<= 1) mx = fmaxf(mx, __shfl_xor(mx, o));
            const unsigned long long bal = __ballot(logit == mx);
            const int src = __ffsll((long long)bal) - 1; te[k] = src >> 1; tv[k] = mx;
            if ((lane >> 1) == te[k]) logit = -INFINITY;
        }
        const float e1 = __expf(tv[1] - tv[0]), e2 = __expf(tv[2] - tv[0]), e3 = __expf(tv[3] - tv[0]), inv = 1.0f / (1.0f + e1 + e2 + e3);
        if (lane < 4) { const int ee = lane == 0 ? te[0] : lane == 1 ? te[1] : lane == 2 ? te[2] : te[3]; const float gg = (lane == 0 ? 1.0f : lane == 1 ? e1 : lane == 2 ? e2 : e3) * inv;
            selE[tl * 4 + lane] = ee; selG[tl * 4 + lane] = gg; }
        if (lane == 0) rstds[tl] = rstd;
    }
    __syncthreads();
    int myrank[2], mye[2];
#pragma unroll
    for (int q = 0; q < 2; ++q) { const int a = tid + 512 * q; mye[q] = selE[a]; myrank[q] = atomicAdd((int*)(hist + mye[q]), 1); }
    __syncthreads();
    unsigned* ctl = (unsigned*)(p.ws + WS_CTL);
    if (tid < 32) base[tid] = (int)atomicAdd(ctl + CW_CNT + tid, (unsigned)hist[tid]);
    __syncthreads();
    i32x4* ENT = (i32x4*)(p.ws + WS_ENT);
#pragma unroll
    for (int q = 0; q < 2; ++q) { const int a = tid + 512 * q, tl = a >> 2, k = a & 3; const int pos = base[mye[q]] + myrank[q];
        i32x4 en; en.x = tb * 256 + tl; en.y = __float_as_int(rstds[tl]); en.z = k; en.w = __float_as_int(selG[a]); ENT[(size_t)mye[q] * T + pos] = en; }
}
__global__ void __launch_bounds__(512) k_routing(Params p) {
    extern __shared__ __attribute__((aligned(16))) unsigned char lds[];
    for (int tb = blockIdx.x; tb < T / 256; tb += gridDim.x) { routing_block(p, (LAS unsigned char*)lds, tb); __syncthreads(); }
}

struct Rounds { int e0[3]; int nr; };
__device__ __forceinline__ int pad256(int c) { return (c + 255) & ~255; }
__device__ __forceinline__ Rounds make_rounds(const unsigned* cnt) {
    Rounds R; R.e0[0] = 0; int sum = 0, e = 0;
    for (; e < NE; ++e) { const int pc = pad256((int)cnt[e]); if (sum + pc > CAP_ROWS) break; sum += pc; }
    R.e0[1] = e; R.e0[2] = NE; R.nr = e < NE ? 2 : 1; return R;
}
struct MoeG1S {
    const bf16_t* HB; const bf16_t* W; bf16_t* HID; const i32x4* ENT; const unsigned* cnt; const float* bgu; int K; int round;
    __device__ int nunits() const { const Rounds R = make_rounds(cnt); if (round >= R.nr) return 0; int n = 0; for (int e = R.e0[round]; e < R.e0[round + 1]; ++e) n += ((int)cnt[e] + 127) / 128 * 16; return n; }
    __device__ void decode(int u, int& e, int& m, int& n, int& hb) const { const Rounds R = make_rounds(cnt); hb = 0; for (e = R.e0[round]; e < R.e0[round + 1]; ++e) { const int ue = ((int)cnt[e] + 127) / 128 * 16; if (u < ue) break; u -= ue; hb += pad256((int)cnt[e]); } m = u >> 4; n = u & 15; }
    __device__ const bf16_t* arow(int u, int r) const { int e, m, n, hb; decode(u, e, m, n, hb); const int pos = m * 128 + r; const int tok = pos < (int)cnt[e] ? ENT[(size_t)e * T + pos].x : 0; return HB + (size_t)tok * D; }
    __device__ const bf16_t* brow(int u, int wc, int j, int fr) const { int e, m, n, hb; decode(u, e, m, n, hb); const int hc = n * 64 + wc * 32 + (j & 1) * 16 + fr;
        const int np = 256 * (hc >> 7) + (hc & 127) + (j >= 2 ? 128 : 0); return W + ((size_t)e * 2 * DFF + np) * D; }
    __device__ void epi(int u, int wr, int wc, int fr, int fq, const f32x4 (&acc)[4][4]) const {
        int e, m, n, hb; decode(u, e, m, n, hb);
#pragma unroll
        for (int mm = 0; mm < 4; ++mm) { const int pos = m * 128 + wr * 64 + mm * 16 + fr; const bool valid = pos < (int)cnt[e];
            const float rstd = valid ? __int_as_float(ENT[(size_t)e * T + pos].y) : 0.f;
#pragma unroll
            for (int j = 0; j < 2; ++j) { const int hc = n * 64 + wc * 32 + j * 16 + 4 * fq;
                const f32x4 bg = *(const f32x4*)(bgu + (size_t)e * 2 * DFF + hc), bu = *(const f32x4*)(bgu + (size_t)e * 2 * DFF + DFF + hc);
                float hv[4];
#pragma unroll
                for (int q = 0; q < 4; ++q) { float g = acc[mm][j][q] * rstd + bg[q], up = acc[mm][j + 2][q] * rstd + bu[q];
                    g = fminf(g, 7.0f); up = fminf(fmaxf(up, -7.0f), 7.0f); hv[q] = (up + 1.0f) * g * sigmoidf_(1.702f * g); }
                u32x2 o; o.x = pk2(hv[0], hv[1]); o.y = pk2(hv[2], hv[3]); *(u32x2*)(HID + (size_t)(hb + pos) * DFF + hc) = o; } }
    }
};
struct MoeG2S {
    const bf16_t* HID; const bf16_t* W; float* OUT01; bf16_t* Y23; const i32x4* ENT; const unsigned* cnt; const float* bdn; int K; int round;
    __device__ int nunits() const { const Rounds R = make_rounds(cnt); if (round >= R.nr) return 0; int n = 0; for (int e = R.e0[round]; e < R.e0[round + 1]; ++e) n += ((int)cnt[e] + 127) / 128 * 8; return n; }
    __device__ void decode(int u, int& e, int& m, int& n, int& hb) const { const Rounds R = make_rounds(cnt); hb = 0; for (e = R.e0[round]; e < R.e0[round + 1]; ++e) { const int ue = ((int)cnt[e] + 127) / 128 * 8; if (u < ue) break; u -= ue; hb += pad256((int)cnt[e]); } m = u >> 3; n = u & 7; }
    __device__ const bf16_t* arow(int u, int r) const { int e, m, n, hb; decode(u, e, m, n, hb); return HID + (size_t)(hb + m * 128 + r) * DFF; }
    __device__ const bf16_t* brow(int u, int wc, int j, int fr) const { int e, m, n, hb; decode(u, e, m, n, hb); return W + ((size_t)e * D + n * 128 + wc * 64 + j * 16 + fr) * DFF; }
    __device__ void epi(int u, int wr, int wc, int fr, int fq, const f32x4 (&acc)[4][4]) const {
        int e, m, n, hb; decode(u, e, m, n, hb);
#pragma unroll
        for (int mm = 0; mm < 4; ++mm) { const int pos = m * 128 + wr * 64 + mm * 16 + fr; if (pos >= (int)cnt[e]) continue;
            const i32x4 en = ENT[(size_t)e * T + pos]; const float gate = __int_as_float(en.w);
            bf16_t* dst = (en.z < 2 ? (bf16_t*)OUT01 : Y23) + (size_t)en.x * 2048 + (en.z & 1) * 1024;
#pragma unroll
            for (int j = 0; j < 4; ++j) { const int col = n * 128 + wc * 64 + j * 16 + 4 * fq; const f32x4 bd = *(const f32x4*)(bdn + (size_t)e * D + col);
                const f32x4 y = (acc[mm][j] + bd) * gate; u32x2 o; o.x = pk2(y.x, y.y); o.y = pk2(y.z, y.w); *(u32x2*)(dst + col) = o; } }
    }
};

__device__ __forceinline__ void combine_rows(const Params& p, int gw, int ngw, int lane) {
    const bf16_t* HB = (const bf16_t*)(p.ws + WS_R1); const bf16_t* Y23 = (const bf16_t*)(p.ws + WS_Y23);
    f32x4 fw[4];
#pragma unroll
    for (int q = 0; q < 4; ++q) fw[q] = *(const f32x4*)(p.in[I_FNW] + 512 * (q >> 1) + 8 * lane + 4 * (q & 1));
    for (int m = gw; m < T; m += ngw) {
        float v[16];
        const u32x4 h0 = *(const u32x4*)(HB + (size_t)m * D + 8 * lane), h1 = *(const u32x4*)(HB + (size_t)m * D + 512 + 8 * lane);
        const unsigned hw[8] = {h0.x, h0.y, h0.z, h0.w, h1.x, h1.y, h1.z, h1.w};
#pragma unroll
        for (int q = 0; q < 8; ++q) { v[2 * q] = bflo(hw[q]); v[2 * q + 1] = bfhi(hw[q]); }
#pragma unroll
        for (int k = 0; k < 4; ++k) { const bf16_t* yb = (k < 2 ? (const bf16_t*)p.out : Y23) + (size_t)m * 2048 + (k & 1) * 1024;
            const u32x4 y0 = *(const u32x4*)(yb + 8 * lane), y1 = *(const u32x4*)(yb + 512 + 8 * lane);
            const unsigned yw[8] = {y0.x, y0.y, y0.z, y0.w, y1.x, y1.y, y1.z, y1.w};
#pragma unroll
            for (int q = 0; q < 8; ++q) { v[2 * q] += bflo(yw[q]); v[2 * q + 1] += bfhi(yw[q]); } }
        float s = 0.f;
#pragma unroll
        for (int q = 0; q < 16; ++q) s += v[q] * v[q];
        const float rstd = rsqrtf(wave_sum(s) * (1.0f / D) + EPS);
        float* o = p.out + (size_t)m * D;
#pragma unroll
        for (int q = 0; q < 4; ++q) { f32x4 r; r.x = v[4 * q] * rstd * fw[q].x; r.y = v[4 * q + 1] * rstd * fw[q].y; r.z = v[4 * q + 2] * rstd * fw[q].z; r.w = v[4 * q + 3] * rstd * fw[q].w;
            *(f32x4*)(o + 512 * (q >> 1) + 8 * lane + 4 * (q & 1)) = r; }
    }
}
__global__ void __launch_bounds__(512) k_combine(Params p) {
    const int tid = threadIdx.x; combine_rows(p, blockIdx.x * 8 + (tid >> 6), gridDim.x * 8, tid & 63);
}

extern "C" void kernel_launch(void* const* d_in, const int* in_sizes, int n_in, void* d_out, int out_size, void* d_ws, size_t ws_size, hipStream_t stream) {
    static int inited = 0;
    if (!inited) {
        if (n_in != 22 || ws_size < WS_END) { fprintf(stderr, "kernel_launch: unexpected n_in %d / ws_size %zu (need %zu)\n", n_in, ws_size, (size_t)WS_END); inited = -1; return; }
        hipFuncSetAttribute((const void*)k_prep, hipFuncAttributeMaxDynamicSharedMemorySize, 8 * 8448);
        hipFuncSetAttribute((const void*)k_rglru_naive, hipFuncAttributeMaxDynamicSharedMemorySize, 2 * 65536 + 512);
        hipFuncSetAttribute((const void*)k_routing, hipFuncAttributeMaxDynamicSharedMemorySize, RT_LDS);
        inited = 1;
    }
    if (inited < 0) return;
    Params p{};
    for (int i = 0; i < 22; ++i) p.in[i] = (const float*)d_in[i];
    p.out = (float*)d_out; p.ws = (unsigned char*)d_ws;
    unsigned char* ws = (unsigned char*)d_ws;
    hipMemsetAsync(ws + WS_CTL, 0, 65536, stream);
    hipLaunchKernelGGL(k_prep, dim3(1024), dim3(512), 8 * 8448, stream, p);
    { InProjS g{(const bf16_t*)(ws + WS_R1), (const bf16_t*)(ws + WS_WIN), (bf16_t*)(ws + WS_R2), D}; hipLaunchKernelGGL(k_sgemm<InProjS>, dim3(4096), dim3(256), 0, stream, g); }
    hipLaunchKernelGGL(k_mlstm_naive, dim3(64), dim3(256), 0, stream, p);
    hipLaunchKernelGGL(k_rglru_naive, dim3(64), dim3(256), 2 * 65536 + 512, stream, p);
    hipLaunchKernelGGL(k_rglru_norm, dim3(2048), dim3(256), 0, stream, p);
    { OutProjS g{(const bf16_t*)(ws + WS_R1), (const bf16_t*)(ws + WS_WOUT), (const float*)d_in[I_X], (float*)d_out, D}; hipLaunchKernelGGL(k_sgemm<OutProjS>, dim3(4096), dim3(256), 0, stream, g); }
    hipLaunchKernelGGL(k_routing, dim3(256), dim3(512), RT_LDS, stream, p);
    for (int r = 0; r < 2; ++r) {
        MoeG1S g1{(const bf16_t*)(ws + WS_R1), (const bf16_t*)(ws + WS_WGU), (bf16_t*)(ws + WS_R2), (const i32x4*)(ws + WS_ENT), (const unsigned*)(ws + WS_CTL) + CW_CNT, (const float*)d_in[I_BGU], D, r};
        hipLaunchKernelGGL(k_sgemm<MoeG1S>, dim3(4096), dim3(256), 0, stream, g1);
        MoeG2S g2{(const bf16_t*)(ws + WS_R2), (const bf16_t*)(ws + WS_WDN), (float*)d_out, (bf16_t*)(ws + WS_Y23), (const i32x4*)(ws + WS_ENT), (const unsigned*)(ws + WS_CTL) + CW_CNT, (const float*)d_in[I_BDN], DFF, r};
        hipLaunchKernelGGL(k_sgemm<MoeG2S>, dim3(4096), dim3(256), 0, stream, g2);
    }
    hipLaunchKernelGGL(k_combine, dim3(2048), dim3(512), 0, stream, p);
}
```

```cpp
#include <hip/hip_runtime.h>
#include <hip/hip_cooperative_groups.h>
#include <cstdio>
#include <cstdint>

namespace cg = cooperative_groups;
#define LAS __attribute__((address_space(3)))
typedef unsigned short bf16_t;
typedef short bf16x8 __attribute__((ext_vector_type(8)));
typedef float f32x4 __attribute__((ext_vector_type(4)));
typedef unsigned u32x4 __attribute__((ext_vector_type(4)));
typedef unsigned u32x2 __attribute__((ext_vector_type(2)));
typedef int i32x4 __attribute__((ext_vector_type(4)));

constexpr int T = 65536, D = 1024, SEQ = 4096, NB = 16;
constexpr int INC = 3080;
constexpr int NPROJ = 3072;
constexpr int NE = 32, TOPK = 4, DFF = 1024;
constexpr float EPS = 1e-6f;
constexpr int CAP_ROWS = 196608;

constexpr size_t MB = 1024 * 1024;
constexpr size_t WS_CTL  = 0;
constexpr size_t WS_GATES = 1 * MB;
constexpr size_t WS_SSQR = 3 * MB;
constexpr size_t WS_SUMM = 4 * MB;
constexpr size_t WS_WRI  = 5 * MB;
constexpr size_t WS_ENT  = 6 * MB;
constexpr size_t WS_WIN  = 38 * MB;
constexpr size_t WS_WOUT = 44 * MB;
constexpr size_t WS_WGU  = 46 * MB;
constexpr size_t WS_WDN  = 174 * MB;
constexpr size_t WS_R1   = 238 * MB;
constexpr size_t WS_R2   = 366 * MB;
constexpr size_t WS_Y23  = 750 * MB;
constexpr size_t WS_END  = 1006 * MB;

constexpr int CW_CNT = 0;
constexpr int CW_WORK = 64;

__device__ __forceinline__ unsigned pk2(float lo, float hi) { unsigned r; asm("v_cvt_pk_bf16_f32 %0, %1, %2" : "=v"(r) : "v"(lo), "v"(hi)); return r; }
__device__ __forceinline__ float bflo(unsigned u) { return __uint_as_float(u << 16); }
__device__ __forceinline__ float bfhi(unsigned u) { return __uint_as_float(u & 0xffff0000u); }
__device__ __forceinline__ float bf2f(bf16_t b) { return __uint_as_float(((unsigned)b) << 16); }
__device__ __forceinline__ float wave_sum(float v) {
#pragma unroll
    for (int o = 1; o < 64; o <<= 1) v += __shfl_xor(v, o);
    return v;
}
__device__ __forceinline__ float sigmoidf_(float x) { return 1.0f / (1.0f + __expf(-x)); }
__device__ __forceinline__ float gelu_tanh(float x) {
    const float u = 0.7978845608028654f * (x + 0.044715f * x * x * x);
    const float t = 1.0f - 2.0f / (1.0f + __expf(2.0f * u));
    return 0.5f * x * (1.0f + t);
}

struct Params {
    const float* in[22];
    float* out;
    unsigned char* ws;
    int pad0, pad1;
};
enum { I_X = 0, I_N1W, I_WIN, I_GB, I_MNW, I_CW, I_CB, I_WR, I_BR, I_WI, I_BI, I_LAM, I_LNW, I_WOUT, I_N2W, I_RW, I_RB, I_WGU, I_BGU, I_WDN, I_BDN, I_FNW };

__device__ __forceinline__ void tr_item(const float* __restrict__ W, int ldw, int col0, bf16_t* dst, int K, int k0, const float* sk, float mul, LAS float* scr, int lane) {
#pragma unroll 8
    for (int i = 0; i < 32; ++i) { const int kk = 2 * i + (lane >> 5); const float s = sk ? sk[k0 + kk] * mul : mul; scr[kk * 33 + (lane & 31)] = W[(size_t)(k0 + kk) * ldw + col0 + (lane & 31)] * s; }
    asm volatile("s_waitcnt lgkmcnt(0)" ::: "memory");
    const int c = lane & 7;
#pragma unroll
    for (int j = 0; j < 4; ++j) { const int n = (lane >> 3) + 8 * j; const LAS float* s = scr + (8 * c) * 33 + n;
        u32x4 o; o.x = pk2(s[0 * 33], s[1 * 33]); o.y = pk2(s[2 * 33], s[3 * 33]); o.z = pk2(s[4 * 33], s[5 * 33]); o.w = pk2(s[6 * 33], s[7 * 33]);
        *(u32x4*)(dst + (size_t)n * K + k0 + 8 * c) = o; }
    asm volatile("s_waitcnt lgkmcnt(0)" ::: "memory");
}
constexpr int IT_WIN = 16 * 96, IT_WOUT = 16 * 32, IT_WGU_E = 16 * 64, IT_WDN_E = 16 * 32;
__device__ __forceinline__ void conv_item_small(const Params& p, int it, LAS float* scr, int lane) {
    if (it < IT_WIN) {
        const int kb = it / 96, nb = it % 96, n0 = 32 * nb, sec = n0 >> 9;
        const int secoff = sec == 0 ? 0 : sec == 1 ? 512 : sec == 2 ? 1024 : sec == 3 ? 1544 : sec == 4 ? 2056 : 2568;
        const float mul = sec == 1 ? 0.08838834764831845f : 1.0f;
        tr_item(p.in[I_WIN], INC, secoff + (n0 & 511), (bf16_t*)(p.ws + WS_WIN) + (size_t)n0 * D, D, 64 * kb, nullptr, mul, scr, lane);
    } else {
        it -= IT_WIN; const int kb = it / 32, nb = it % 32, k0 = 64 * kb;
        const float* sk = k0 < 512 ? p.in[I_MNW] : p.in[I_LNW] - 512;
        tr_item(p.in[I_WOUT], D, 32 * nb, (bf16_t*)(p.ws + WS_WOUT) + (size_t)(32 * nb) * D, D, k0, sk, 1.0f, scr, lane);
    }
}
__device__ __forceinline__ void conv_item_moe(const Params& p, int it, LAS float* scr, int lane) {
    if (it < NE * IT_WGU_E) {
        const int e = it / IT_WGU_E, r = it % IT_WGU_E, kb = r / 64, nb = r % 64, n0 = 32 * nb, j = n0 >> 8, c0 = n0 & 255;
        const int srccol = c0 < 128 ? 128 * j + c0 : 1024 + 128 * j + (c0 - 128);
        tr_item(p.in[I_WGU] + (size_t)e * D * 2 * DFF, 2 * DFF, srccol, (bf16_t*)(p.ws + WS_WGU) + ((size_t)e * 2 * DFF + n0) * D, D, 64 * kb, p.in[I_N2W], 1.0f, scr, lane);
    } else {
        it -= NE * IT_WGU_E; const int e = it / IT_WDN_E, r = it % IT_WDN_E, kb = r / 32, nb = r % 32;
        tr_item(p.in[I_WDN] + (size_t)e * DFF * D, D, 32 * nb, (bf16_t*)(p.ws + WS_WDN) + ((size_t)e * D + 32 * nb) * DFF, DFF, 64 * kb, nullptr, 1.0f, scr, lane);
    }
}
__device__ __forceinline__ void xpass_rows(const Params& p, int gw, int ngw, int lane) {
    const float* wg = p.in[I_WIN] + 1536;
    float wr[16][8];
#pragma unroll
    for (int j = 0; j < 4; ++j)
#pragma unroll
        for (int c = 0; c < 4; ++c) { const int k = 256 * j + 4 * lane + c; const f32x4 a = *(const f32x4*)(wg + (size_t)k * INC), b = *(const f32x4*)(wg + (size_t)k * INC + 4);
            wr[j * 4 + c][0] = a.x; wr[j * 4 + c][1] = a.y; wr[j * 4 + c][2] = a.z; wr[j * 4 + c][3] = a.w; wr[j * 4 + c][4] = b.x; wr[j * 4 + c][5] = b.y; wr[j * 4 + c][6] = b.z; wr[j * 4 + c][7] = b.w; }
    f32x4 w1[4];
#pragma unroll
    for (int j = 0; j < 4; ++j) w1[j] = *(const f32x4*)(p.in[I_N1W] + 256 * j + 4 * lane);
    const float gb = lane < 8 ? p.in[I_GB][lane] : 0.f;
    bf16_t* XN = (bf16_t*)(p.ws + WS_R1); float* GATES = (float*)(p.ws + WS_GATES);
    for (int m = gw; m < T; m += ngw) {
        const f32x4* xr = (const f32x4*)(p.in[I_X] + (size_t)m * D) + lane;
        f32x4 v[4]; float s = 0.f;
#pragma unroll
        for (int j = 0; j < 4; ++j) { v[j] = xr[64 * j]; s += (v[j].x * v[j].x + v[j].y * v[j].y) + (v[j].z * v[j].z + v[j].w * v[j].w); }
        const float rstd = rsqrtf(wave_sum(s) * (1.0f / D) + EPS);
        float g[8];
#pragma unroll
        for (int q = 0; q < 8; ++q) g[q] = 0.f;
        unsigned long long* o8 = (unsigned long long*)(XN + (size_t)m * D) + lane;
#pragma unroll
        for (int j = 0; j < 4; ++j) { v[j] = v[j] * rstd * w1[j];
            o8[64 * j] = (unsigned long long)pk2(v[j].x, v[j].y) | ((unsigned long long)pk2(v[j].z, v[j].w) << 32);
#pragma unroll
            for (int q = 0; q < 8; ++q) g[q] += v[j].x * wr[j * 4 + 0][q] + v[j].y * wr[j * 4 + 1][q] + v[j].z * wr[j * 4 + 2][q] + v[j].w * wr[j * 4 + 3][q]; }
        float mine = 0.f;
#pragma unroll
        for (int q = 0; q < 8; ++q) { const float t = wave_sum(g[q]); if (lane == q) mine = t; }
        if (lane < 8) { float val = mine + gb; if (lane >= 4) val = -log1pf(__expf(-val)); GATES[(size_t)m * 8 + lane] = val; }
    }
}
__device__ __forceinline__ void prep_phase(const Params& p, LAS unsigned char* lds) {
    const int tid = threadIdx.x, lane = tid & 63, wave = tid >> 6, gw = blockIdx.x * 8 + wave, ngw = gridDim.x * 8;
    LAS float* scr = (LAS float*)(lds + wave * 8448);
    for (int it = gw; it < IT_WIN + IT_WOUT; it += ngw) conv_item_small(p, it, scr, lane);
    bf16_t* WRI = (bf16_t*)(p.ws + WS_WRI);
    for (int i = blockIdx.x * 512 + tid; i < 4 * 256 * 128; i += gridDim.x * 512) { const int h = i >> 15, n = (i >> 7) & 255, k = i & 127;
        const float v = n < 128 ? p.in[I_WR][(h * 128 + k) * 128 + n] : p.in[I_WI][(h * 128 + k) * 128 + n - 128]; WRI[i] = (bf16_t)(pk2(v, 0.f) & 0xffff); }
    float* SSQR = (float*)(p.ws + WS_SSQR);
    for (int i = blockIdx.x * 512 + tid; i < T; i += gridDim.x * 512) SSQR[i] = 0.f;
    xpass_rows(p, gw, ngw, lane);
}
__device__ __forceinline__ void moe_conv_phase(const Params& p, LAS unsigned char* lds, int b0) {
    const int tid = threadIdx.x, lane = tid & 63, wave = tid >> 6;
    if ((int)blockIdx.x < b0) return;
    const int gw = ((int)blockIdx.x - b0) * 8 + wave, ngw = ((int)gridDim.x - b0) * 8;
    LAS float* scr = (LAS float*)(lds + wave * 8448);
    for (int it = gw; it < NE * (IT_WGU_E + IT_WDN_E); it += ngw) conv_item_moe(p, it, scr, lane);
}

template <class P> __device__ __forceinline__ void sgemm_block(const P& p, int unit, int tid) {
    const int w = tid >> 6, lane = tid & 63, wr = w >> 1, wc = w & 1, fr = lane & 15, fq = lane >> 4;
    const bf16_t* ap[4]; const bf16_t* bp[4];
#pragma unroll
    for (int m = 0; m < 4; ++m) ap[m] = p.arow(unit, wr * 64 + m * 16 + fr) + fq * 8;
#pragma unroll
    for (int j = 0; j < 4; ++j) bp[j] = p.brow(unit, wc, j, fr) + fq * 8;
    f32x4 acc[4][4];
#pragma unroll
    for (int m = 0; m < 4; ++m)
#pragma unroll
        for (int j = 0; j < 4; ++j) acc[m][j] = (f32x4){0.f, 0.f, 0.f, 0.f};
    for (int k = 0; k < p.K; k += 32) {
        bf16x8 a[4], b[4];
#pragma unroll
        for (int m = 0; m < 4; ++m) a[m] = *(const bf16x8*)(ap[m] + k);
#pragma unroll
        for (int j = 0; j < 4; ++j) b[j] = *(const bf16x8*)(bp[j] + k);
#pragma unroll
        for (int m = 0; m < 4; ++m)
#pragma unroll
            for (int j = 0; j < 4; ++j) acc[m][j] = __builtin_amdgcn_mfma_f32_16x16x32_bf16(b[j], a[m], acc[m][j], 0, 0, 0);
    }
    p.epi(unit, wr, wc, fr, fq, acc);
}
template <class P> __device__ __forceinline__ void sgemm_phase(const P& p) {
    const int n = p.nunits(), tid = threadIdx.x;
    for (int u = blockIdx.x * 2 + (tid >> 8); u < n; u += gridDim.x * 2) sgemm_block(p, u, tid & 255);
}

struct InProjS {
    const bf16_t* XN; const bf16_t* W; bf16_t* PROJ; int K;
    __device__ int nunits() const { return (T / 128) * (NPROJ / 128); }
    __device__ const bf16_t* arow(int u, int r) const { return XN + (size_t)((u / 24) * 128 + r) * D; }
    __device__ const bf16_t* brow(int u, int wc, int j, int fr) const { return W + (size_t)((u % 24) * 128 + wc * 64 + j * 16 + fr) * D; }
    __device__ void epi(int u, int wr, int wc, int fr, int fq, const f32x4 (&acc)[4][4]) const {
        const int pm = u / 24, pn = u % 24, sec = pn >> 2;
#pragma unroll
        for (int m = 0; m < 4; ++m)
#pragma unroll
            for (int j = 0; j < 4; ++j) { f32x4 v = acc[m][j];
                if (sec == 3) { v.x = sigmoidf_(v.x); v.y = sigmoidf_(v.y); v.z = sigmoidf_(v.z); v.w = sigmoidf_(v.w); }
                if (sec == 5) { v.x = gelu_tanh(v.x); v.y = gelu_tanh(v.y); v.z = gelu_tanh(v.z); v.w = gelu_tanh(v.w); }
                const size_t row = (size_t)pm * 128 + wr * 64 + m * 16 + fr; const int col = pn * 128 + wc * 64 + j * 16 + 4 * fq;
                u32x2 o; o.x = pk2(v.x, v.y); o.y = pk2(v.z, v.w); *(u32x2*)(PROJ + row * NPROJ + col) = o; }
    }
};
struct OutProjS {
    const bf16_t* MIX; const bf16_t* W; const float* X; float* H; int K;
    __device__ int nunits() const { return (T / 128) * (D / 128); }
    __device__ const bf16_t* arow(int u, int r) const { return MIX + (size_t)((u / 8) * 128 + r) * D; }
    __device__ const bf16_t* brow(int u, int wc, int j, int fr) const { return W + (size_t)((u % 8) * 128 + wc * 64 + j * 16 + fr) * D; }
    __device__ void epi(int u, int wr, int wc, int fr, int fq, const f32x4 (&acc)[4][4]) const {
        const int pm = u / 8, pn = u % 8;
#pragma unroll
        for (int m = 0; m < 4; ++m)
#pragma unroll
            for (int j = 0; j < 4; ++j) { const size_t row = (size_t)pm * 128 + wr * 64 + m * 16 + fr; const int col = pn * 128 + wc * 64 + j * 16 + 4 * fq;
                const f32x4 x = *(const f32x4*)(X + row * D + col); *(f32x4*)(H + row * D + col) = x + acc[m][j]; }
    }
};

__device__ __forceinline__ void mlstm_naive_phase(const Params& p, LAS unsigned char* lds, int bh  ) {
    const int tid = threadIdx.x, sb = tid >> 8, t8 = tid & 255, e = t8 >> 1, half = t8 & 1, lane = tid & 63, w = (tid >> 6) & 3;
    LAS float* qs = (LAS float*)(lds + sb * 2048); LAS float* ks = qs + 128; LAS float* red = ks + 128;
    const int b = (bh + sb) >> 2, h = (bh + sb) & 3;
    const bf16_t* PROJ = (const bf16_t*)(p.ws + WS_R2); const float* GATES = (const float*)(p.ws + WS_GATES); bf16_t* MIX = (bf16_t*)(p.ws + WS_R1);
    float C[64], n[64];
#pragma unroll
    for (int i = 0; i < 64; ++i) { C[i] = 0.f; n[i] = 0.f; }
    float mst = 0.f;
    for (int t = 0; t < SEQ; ++t) {
        const size_t row = (size_t)b * SEQ + t; const bf16_t* pr = PROJ + row * NPROJ + h * 128;
        if (t8 < 128) qs[t8] = bf2f(pr[t8]); else ks[t8 - 128] = bf2f(pr[512 + t8 - 128]);
        const float ve = bf2f(pr[1024 + e]), oe = bf2f(pr[1536 + e]);
        const float ig = GATES[row * 8 + h], lf = GATES[row * 8 + 4 + h];
        __syncthreads();
        const float mn = fmaxf(lf + mst, ig), fp = __expf(lf + mst - mn), ip = __expf(ig - mn); mst = mn;
        float num = 0.f, den = 0.f;
#pragma unroll
        for (int i = 0; i < 64; ++i) { const float kd = ks[half * 64 + i], qd = qs[half * 64 + i];
            C[i] = fp * C[i] + ip * kd * ve; n[i] = fp * n[i] + ip * kd; num += qd * C[i]; den += qd * n[i]; }
        num += __shfl_xor(num, 1); den += __shfl_xor(den, 1);
        const float hv = num / fmaxf(fabsf(den), __expf(-mst)), x = oe * hv;
        float s = half == 0 ? x * x : 0.f; s = wave_sum(s);
        if (lane == 0) red[w] = s;
        __syncthreads();
        const float tot = red[0] + red[1] + red[2] + red[3];
        if (half == 0) MIX[row * D + h * 128 + e] = (bf16_t)(pk2(x * rsqrtf(tot * (1.0f / 128.f) + EPS), 0.f) & 0xffff);
        __syncthreads();
    }
}
__device__ __forceinline__ void rglru_naive_phase(const Params& p, LAS unsigned char* lds, int bhd) {
    LAS float* Wr = (LAS float*)lds; LAS float* Wi = Wr + 128 * 128; LAS float* xcs = Wi + 128 * 128;
    const int tid = threadIdx.x, ch = tid >> 2, qt = tid & 3, b = bhd >> 2, hd = bhd & 3, lane = tid & 63;
    for (int i = tid; i < 128 * 128; i += 512) { Wr[i] = p.in[I_WR][hd * 16384 + i]; Wi[i] = p.in[I_WI][hd * 16384 + i]; }
    const int c = hd * 128 + ch;
    const float cw0 = p.in[I_CW][0 * 512 + c], cw1 = p.in[I_CW][1 * 512 + c], cw2 = p.in[I_CW][2 * 512 + c], cw3 = p.in[I_CW][3 * 512 + c], cb = p.in[I_CB][c];
    const float br = p.in[I_BR][c], bi = p.in[I_BI][c], lam = p.in[I_LAM][c];
    const float sp = log1pf(__expf(-lam));
    const bf16_t* PROJ = (const bf16_t*)(p.ws + WS_R2); bf16_t* MIX = (bf16_t*)(p.ws + WS_R1); float* SSQR = (float*)(p.ws + WS_SSQR);
    float x0 = 0.f, x1 = 0.f, x2 = 0.f, hst = 0.f;
    __syncthreads();
    for (int t = 0; t < SEQ; ++t) {
        const size_t row = (size_t)b * SEQ + t;
        const float x3 = bf2f(PROJ[row * NPROJ + 2048 + c]), rg = bf2f(PROJ[row * NPROJ + 2560 + c]);
        const float xc = cb + cw0 * x0 + cw1 * x1 + cw2 * x2 + cw3 * x3; x0 = x1; x1 = x2; x2 = x3;
        if (qt == 0) xcs[ch] = xc;
        __syncthreads();
        float rp = 0.f, ipre = 0.f;
        for (int i = 0; i < 32; ++i) { const float xv = xcs[qt * 32 + i]; rp += xv * Wr[(qt * 32 + i) * 128 + ch]; ipre += xv * Wi[(qt * 32 + i) * 128 + ch]; }
        rp += __shfl_xor(rp, 1); ipre += __shfl_xor(ipre, 1); rp += __shfl_xor(rp, 2); ipre += __shfl_xor(ipre, 2);
        const float r = sigmoidf_(rp + br), ig = sigmoidf_(ipre + bi), la = -8.0f * r * sp, a = __expf(la), bt = sqrtf(fmaxf(1.0f - a * a, 0.f)) * (ig * xc);
        hst = a * hst + bt;
        const float g = rg * hst;
        float s = qt == 0 ? g * g : 0.f; s = wave_sum(s);
        if (lane == 0) atomicAdd(SSQR + row, s);
        if (qt == 0) MIX[row * D + 512 + c] = (bf16_t)(pk2(g, 0.f) & 0xffff);
        __syncthreads();
    }
}
__device__ __forceinline__ void rglru_norm_phase(const Params& p) {
    bf16_t* MIX = (bf16_t*)(p.ws + WS_R1); const float* SSQR = (const float*)(p.ws + WS_SSQR);
    for (size_t i = (size_t)blockIdx.x * 512 + threadIdx.x; i < (size_t)T * 64; i += (size_t)gridDim.x * 512) {
        const size_t row = i >> 6; const int c8 = (int)(i & 63);
        const float rs = rsqrtf(SSQR[row] * (1.0f / 512.f) + EPS);
        u32x4* ptr = (u32x4*)(MIX + row * D + 512 + c8 * 8); u32x4 v = *ptr;
        v.x = pk2(bflo(v.x) * rs, bfhi(v.x) * rs); v.y = pk2(bflo(v.y) * rs, bfhi(v.y) * rs); v.z = pk2(bflo(v.z) * rs, bfhi(v.z) * rs); v.w = pk2(bflo(v.w) * rs, bfhi(v.w) * rs);
        *ptr = v;
    }
}

constexpr int RT_WR = 0, RT_SELE = 147456, RT_SELG = RT_SELE + 4096, RT_RSTD = RT_SELG + 4096, RT_HIST = RT_RSTD + 1024, RT_BASE = RT_HIST + 128, RT_LDS = RT_BASE + 128;
__device__ __forceinline__ void routing_block(const Params& p, LAS unsigned char* lds, int tb) {
    const int tid = threadIdx.x, lane = tid & 63, wave = tid >> 6;
    LAS float* WRl = (LAS float*)(lds + RT_WR); LAS int* selE = (LAS int*)(lds + RT_SELE); LAS float* selG = (LAS float*)(lds + RT_SELG);
    LAS float* rstds = (LAS float*)(lds + RT_RSTD); LAS int* hist = (LAS int*)(lds + RT_HIST); LAS int* base = (LAS int*)(lds + RT_BASE);
    for (int i = tid; i < 1024 * 8; i += 512) { const int k = i >> 3, q = i & 7; const float s = p.in[I_N2W][k];
        f32x4 v = *(const f32x4*)(p.in[I_RW] + (size_t)k * 32 + 4 * q); v = v * s;
        const int rho = ((k >> 8) * 4 + (k & 3)) * 64 + ((k >> 2) & 63); *(LAS f32x4*)(WRl + rho * 36 + 4 * q) = v; }
    if (tid < 32) hist[tid] = 0;
    __syncthreads();
    const float* H = p.out; bf16_t* HB = (bf16_t*)(p.ws + WS_R1);
    const float rb = p.in[I_RB][lane >> 1];
    for (int it = 0; it < 32; ++it) {
        const int tl = it * 8 + wave; const size_t tok = (size_t)tb * 256 + tl;
        const f32x4* hr = (const f32x4*)(H + tok * D) + lane;
        f32x4 v[4]; float s = 0.f;
#pragma unroll
        for (int j = 0; j < 4; ++j) { v[j] = hr[64 * j]; s += (v[j].x * v[j].x + v[j].y * v[j].y) + (v[j].z * v[j].z + v[j].w * v[j].w); }
        const float rstd = rsqrtf(wave_sum(s) * (1.0f / D) + EPS);
        unsigned long long* o8 = (unsigned long long*)(HB + tok * D) + lane;
#pragma unroll
        for (int j = 0; j < 4; ++j) o8[64 * j] = (unsigned long long)pk2(v[j].x, v[j].y) | ((unsigned long long)pk2(v[j].z, v[j].w) << 32);
        float acc[32];
#pragma unroll
        for (int q = 0; q < 32; ++q) acc[q] = 0.f;
#pragma unroll
        for (int j = 0; j < 4; ++j)
#pragma unroll
            for (int c = 0; c < 4; ++c) { const float hv = c == 0 ? v[j].x : c == 1 ? v[j].y : c == 2 ? v[j].z : v[j].w;
                const LAS f32x4* wrow = (const LAS f32x4*)(WRl + ((j * 4 + c) * 64 + lane) * 36);
#pragma unroll
                for (int q = 0; q < 8; ++q) { const f32x4 wv = wrow[q]; acc[4 * q + 0] += hv * wv.x; acc[4 * q + 1] += hv * wv.y; acc[4 * q + 2] += hv * wv.z; acc[4 * q + 3] += hv * wv.w; } }
#pragma unroll
        for (int q = 0; q < 16; ++q) { const bool up = (lane & 32) != 0; const float send = up ? acc[q] : acc[q + 16], keep = up ? acc[q + 16] : acc[q]; acc[q] = keep + __shfl_xor(send, 32); }
#pragma unroll
        for (int q = 0; q < 8; ++q) { const bool up = (lane & 16) != 0; const float send = up ? acc[q] : acc[q + 8], keep = up ? acc[q + 8] : acc[q]; acc[q] = keep + __shfl_xor(send, 16); }
#pragma unroll
        for (int q = 0; q < 4; ++q) { const bool up = (lane & 8) != 0; const float send = up ? acc[q] : acc[q + 4], keep = up ? acc[q + 4] : acc[q]; acc[q] = keep + __shfl_xor(send, 8); }
#pragma unroll
        for (int q = 0; q < 2; ++q) { const bool up = (lane & 4) != 0; const float send = up ? acc[q] : acc[q + 2], keep = up ? acc[q + 2] : acc[q]; acc[q] = keep + __shfl_xor(send, 4); }
        { const bool up = (lane & 2) != 0; const float send = up ? acc[0] : acc[1], keep = up ? acc[1] : acc[0]; acc[0] = keep + __shfl_xor(send, 2); }
        float logit = (acc[0] + __shfl_xor(acc[0], 1)) * rstd + rb;
        float tv[4]; int te[4];
#pragma unroll
        for (int k = 0; k < 4; ++k) {
            float mx = logit;
#pragma unroll
            for (int o = 2; o < 64; o <<= 1) mx = fmaxf(mx, __shfl_xor(mx, o));
            const unsigned long long bal = __ballot(logit == mx);
            const int src = __ffsll((long long)bal) - 1; te[k] = src >> 1; tv[k] = mx;
            if ((lane >> 1) == te[k]) logit = -INFINITY;
        }
        const float e1 = __expf(tv[1] - tv[0]), e2 = __expf(tv[2] - tv[0]), e3 = __expf(tv[3] - tv[0]), inv = 1.0f / (1.0f + e1 + e2 + e3);
        if (lane < 4) { const int ee = lane == 0 ? te[0] : lane == 1 ? te[1] : lane == 2 ? te[2] : te[3]; const float gg = (lane == 0 ? 1.0f : lane == 1 ? e1 : lane == 2 ? e2 : e3) * inv;
            selE[tl * 4 + lane] = ee; selG[tl * 4 + lane] = gg; }
        if (lane == 0) rstds[tl] = rstd;
    }
    __syncthreads();
    int myrank[2], mye[2];
#pragma unroll
    for (int q = 0; q < 2; ++q) { const int a = tid + 512 * q; mye[q] = selE[a]; myrank[q] = atomicAdd((int*)(hist + mye[q]), 1); }
    __syncthreads();
    unsigned* ctl = (unsigned*)(p.ws + WS_CTL);
    if (tid < 32) base[tid] = (int)atomicAdd(ctl + CW_CNT + tid, (unsigned)hist[tid]);
    __syncthreads();
    i32x4* ENT = (i32x4*)(p.ws + WS_ENT);
#pragma unroll
    for (int q = 0; q < 2; ++q) { const int a = tid + 512 * q, tl = a >> 2, k = a & 3; const int pos = base[mye[q]] + myrank[q];
        i32x4 en; en.x = tb * 256 + tl; en.y = __float_as_int(rstds[tl]); en.z = k; en.w = __float_as_int(selG[a]); ENT[(size_t)mye[q] * T + pos] = en; }
}
__device__ __forceinline__ void routing_phase(const Params& p, LAS unsigned char* lds) {
    for (int tb = blockIdx.x; tb < T / 256; tb += gridDim.x) { routing_block(p, lds, tb); __syncthreads(); }
}

struct Rounds { int es; int nr; __device__ __forceinline__ int lo(int r) const { return r == 0 ? 0 : es; } __device__ __forceinline__ int hi(int r) const { return r == 0 ? es : NE; } };
__device__ __forceinline__ int pad256(int c) { return (c + 255) & ~255; }
__device__ __forceinline__ Rounds make_rounds(const unsigned* cnt) {
    Rounds R; int sum = 0, e = 0;
    for (; e < NE; ++e) { const int pc = pad256((int)cnt[e]); if (sum + pc > CAP_ROWS) break; sum += pc; }
    R.es = e; R.nr = e < NE ? 2 : 1; return R;
}
struct MoeG1S {
    const bf16_t* HB; const bf16_t* W; bf16_t* HID; const i32x4* ENT; const unsigned* cnt; const float* bgu; int K; int round;
    __device__ int nunits() const { const Rounds R = make_rounds(cnt); if (round >= R.nr) return 0; int n = 0; for (int e = R.lo(round); e < R.hi(round); ++e) n += ((int)cnt[e] + 127) / 128 * 16; return n; }
    __device__ void decode(int u, int& e, int& m, int& n, int& hb) const { const Rounds R = make_rounds(cnt); hb = 0; for (e = R.lo(round); e < R.hi(round); ++e) { const int ue = ((int)cnt[e] + 127) / 128 * 16; if (u < ue) break; u -= ue; hb += pad256((int)cnt[e]); } m = u >> 4; n = u & 15; }
    __device__ const bf16_t* arow(int u, int r) const { int e, m, n, hb; decode(u, e, m, n, hb); const int pos = m * 128 + r; const int tok = pos < (int)cnt[e] ? ENT[(size_t)e * T + pos].x : 0; return HB + (size_t)tok * D; }
    __device__ const bf16_t* brow(int u, int wc, int j, int fr) const { int e, m, n, hb; decode(u, e, m, n, hb); const int hc = n * 64 + wc * 32 + (j & 1) * 16 + fr;
        const int np = 256 * (hc >> 7) + (hc & 127) + (j >= 2 ? 128 : 0); return W + ((size_t)e * 2 * DFF + np) * D; }
    __device__ void epi(int u, int wr, int wc, int fr, int fq, const f32x4 (&acc)[4][4]) const {
        int e, m, n, hb; decode(u, e, m, n, hb);
#pragma unroll
        for (int mm = 0; mm < 4; ++mm) { const int pos = m * 128 + wr * 64 + mm * 16 + fr; const bool valid = pos < (int)cnt[e];
            const float rstd = valid ? __int_as_float(ENT[(size_t)e * T + pos].y) : 0.f;
#pragma unroll
            for (int j = 0; j < 2; ++j) { const int hc = n * 64 + wc * 32 + j * 16 + 4 * fq;
                const f32x4 bg = *(const f32x4*)(bgu + (size_t)e * 2 * DFF + hc), bu = *(const f32x4*)(bgu + (size_t)e * 2 * DFF + DFF + hc);
                float hv[4];
#pragma unroll
                for (int q = 0; q < 4; ++q) { float g = acc[mm][j][q] * rstd + bg[q], up = acc[mm][j + 2][q] * rstd + bu[q];
                    g = fminf(g, 7.0f); up = fminf(fmaxf(up, -7.0f), 7.0f); hv[q] = (up + 1.0f) * g * sigmoidf_(1.702f * g); }
                u32x2 o; o.x = pk2(hv[0], hv[1]); o.y = pk2(hv[2], hv[3]); *(u32x2*)(HID + (size_t)(hb + pos) * DFF + hc) = o; } }
    }
};
struct MoeG2S {
    const bf16_t* HID; const bf16_t* W; float* OUT01; bf16_t* Y23; const i32x4* ENT; const unsigned* cnt; const float* bdn; int K; int round;
    __device__ int nunits() const { const Rounds R = make_rounds(cnt); if (round >= R.nr) return 0; int n = 0; for (int e = R.lo(round); e < R.hi(round); ++e) n += ((int)cnt[e] + 127) / 128 * 8; return n; }
    __device__ void decode(int u, int& e, int& m, int& n, int& hb) const { const Rounds R = make_rounds(cnt); hb = 0; for (e = R.lo(round); e < R.hi(round); ++e) { const int ue = ((int)cnt[e] + 127) / 128 * 8; if (u < ue) break; u -= ue; hb += pad256((int)cnt[e]); } m = u >> 3; n = u & 7; }
    __device__ const bf16_t* arow(int u, int r) const { int e, m, n, hb; decode(u, e, m, n, hb); return HID + (size_t)(hb + m * 128 + r) * DFF; }
    __device__ const bf16_t* brow(int u, int wc, int j, int fr) const { int e, m, n, hb; decode(u, e, m, n, hb); return W + ((size_t)e * D + n * 128 + wc * 64 + j * 16 + fr) * DFF; }
    __device__ void epi(int u, int wr, int wc, int fr, int fq, const f32x4 (&acc)[4][4]) const {
        int e, m, n, hb; decode(u, e, m, n, hb);
#pragma unroll
        for (int mm = 0; mm < 4; ++mm) { const int pos = m * 128 + wr * 64 + mm * 16 + fr; if (pos >= (int)cnt[e]) continue;
            const i32x4 en = ENT[(size_t)e * T + pos]; const float gate = __int_as_float(en.w);
            bf16_t* dst = (en.z < 2 ? (bf16_t*)OUT01 : Y23) + (size_t)en.x * 2048 + (en.z & 1) * 1024;
#pragma unroll
            for (int j = 0; j < 4; ++j) { const int col = n * 128 + wc * 64 + j * 16 + 4 * fq; const f32x4 bd = *(const f32x4*)(bdn + (size_t)e * D + col);
                const f32x4 y = (acc[mm][j] + bd) * gate; u32x2 o; o.x = pk2(y.x, y.y); o.y = pk2(y.z, y.w); *(u32x2*)(dst + col) = o; } }
    }
};

__device__ __forceinline__ void combine_rows(const Params& p, int gw, int ngw, int lane) {
    const bf16_t* HB = (const bf16_t*)(p.ws + WS_R1); const bf16_t* Y23 = (const bf16_t*)(p.ws + WS_Y23);
    f32x4 fw[4];
#pragma unroll
    for (int q = 0; q < 4; ++q) fw[q] = *(const f32x4*)(p.in[I_FNW] + 512 * (q >> 1) + 8 * lane + 4 * (q & 1));
    for (int m = gw; m < T; m += ngw) {
        float v[16];
        const u32x4 h0 = *(const u32x4*)(HB + (size_t)m * D + 8 * lane), h1 = *(const u32x4*)(HB + (size_t)m * D + 512 + 8 * lane);
        const unsigned hw[8] = {h0.x, h0.y, h0.z, h0.w, h1.x, h1.y, h1.z, h1.w};
#pragma unroll
        for (int q = 0; q < 8; ++q) { v[2 * q] = bflo(hw[q]); v[2 * q + 1] = bfhi(hw[q]); }
#pragma unroll
        for (int k = 0; k < 4; ++k) { const bf16_t* yb = (k < 2 ? (const bf16_t*)p.out : Y23) + (size_t)m * 2048 + (k & 1) * 1024;
            const u32x4 y0 = *(const u32x4*)(yb + 8 * lane), y1 = *(const u32x4*)(yb + 512 + 8 * lane);
            const unsigned yw[8] = {y0.x, y0.y, y0.z, y0.w, y1.x, y1.y, y1.z, y1.w};
#pragma unroll
            for (int q = 0; q < 8; ++q) { v[2 * q] += bflo(yw[q]); v[2 * q + 1] += bfhi(yw[q]); } }
        float s = 0.f;
#pragma unroll
        for (int q = 0; q < 16; ++q) s += v[q] * v[q];
        const float rstd = rsqrtf(wave_sum(s) * (1.0f / D) + EPS);
        float* o = p.out + (size_t)m * D;
#pragma unroll
        for (int q = 0; q < 4; ++q) { f32x4 r; r.x = v[4 * q] * rstd * fw[q].x; r.y = v[4 * q + 1] * rstd * fw[q].y; r.z = v[4 * q + 2] * rstd * fw[q].z; r.w = v[4 * q + 3] * rstd * fw[q].w;
            *(f32x4*)(o + 512 * (q >> 1) + 8 * lane + 4 * (q & 1)) = r; }
    }
}
constexpr int LDS_BYTES = 159744;
__global__ void __launch_bounds__(512, 2) fwd(Params p) {
    extern __shared__ __attribute__((aligned(16))) unsigned char lds_[];
    LAS unsigned char* lds = (LAS unsigned char*)lds_;
    cg::grid_group grid = cg::this_grid();
    unsigned char* ws = p.ws;
    const int tid = threadIdx.x;
    prep_phase(p, lds);
    grid.sync();
    { InProjS g{(const bf16_t*)(ws + WS_R1), (const bf16_t*)(ws + WS_WIN), (bf16_t*)(ws + WS_R2), D}; sgemm_phase(g); }
    grid.sync();
    if (blockIdx.x < 32) mlstm_naive_phase(p, lds, 2 * blockIdx.x);
    else if (blockIdx.x < 96) rglru_naive_phase(p, lds, blockIdx.x - 32);
    else moe_conv_phase(p, lds, 96);
    grid.sync();
    rglru_norm_phase(p);
    grid.sync();
    { OutProjS g{(const bf16_t*)(ws + WS_R1), (const bf16_t*)(ws + WS_WOUT), p.in[I_X], p.out, D}; sgemm_phase(g); }
    grid.sync();
    routing_phase(p, lds);
    grid.sync();
    const unsigned* cnt = (const unsigned*)(ws + WS_CTL) + CW_CNT;
    const int nr = make_rounds(cnt).nr;
    for (int r = 0; r < nr; ++r) {
        { MoeG1S g1{(const bf16_t*)(ws + WS_R1), (const bf16_t*)(ws + WS_WGU), (bf16_t*)(ws + WS_R2), (const i32x4*)(ws + WS_ENT), cnt, p.in[I_BGU], D, r}; sgemm_phase(g1); }
        grid.sync();
        { MoeG2S g2{(const bf16_t*)(ws + WS_R2), (const bf16_t*)(ws + WS_WDN), p.out, (bf16_t*)(ws + WS_Y23), (const i32x4*)(ws + WS_ENT), cnt, p.in[I_BDN], DFF, r}; sgemm_phase(g2); }
        grid.sync();
    }
    combine_rows(p, blockIdx.x * 8 + (tid >> 6), gridDim.x * 8, tid & 63);
}

extern "C" void kernel_launch(void* const* d_in, const int* in_sizes, int n_in, void* d_out, int out_size, void* d_ws, size_t ws_size, hipStream_t stream) {
    static int grid = 0;
    if (grid == 0) {
        if (n_in != 22 || ws_size < WS_END) { fprintf(stderr, "kernel_launch: unexpected n_in %d / ws_size %zu (need %zu)\n", n_in, ws_size, (size_t)WS_END); grid = -1; return; }
        int dev = 0, cus = 0, per_cu = 0;
        (void)hipGetDevice(&dev); (void)hipDeviceGetAttribute(&cus, hipDeviceAttributeMultiprocessorCount, dev);
        (void)hipFuncSetAttribute((const void*)fwd, hipFuncAttributeMaxDynamicSharedMemorySize, LDS_BYTES);
        (void)hipOccupancyMaxActiveBlocksPerMultiprocessor(&per_cu, (const void*)fwd, 512, LDS_BYTES);
        if (per_cu < 1) { fprintf(stderr, "kernel_launch: occupancy query says %d blocks/CU\n", per_cu); per_cu = 1; }
        grid = cus * per_cu;
        fprintf(stderr, "kernel_launch: grid %d (cus %d x %d)\n", grid, cus, per_cu);
    }
    if (grid < 0) return;
    Params p{};
    for (int i = 0; i < 22; ++i) p.in[i] = (const float*)d_in[i];
    p.out = (float*)d_out; p.ws = (unsigned char*)d_ws;
    (void)hipMemsetAsync((unsigned char*)d_ws + WS_CTL, 0, 65536, stream);
    void* args[] = {&p};
    hipError_t e = hipLaunchCooperativeKernel((const void*)fwd, dim3(grid), dim3(512), args, LDS_BYTES, stream);
    if (e != hipSuccess) fprintf(stderr, "kernel_launch: cooperative launch failed: %s (grid %d)\n", hipGetErrorString(e), grid);
}
```

```cpp
#include <hip/hip_runtime.h>
#include <hip/hip_cooperative_groups.h>
#include <cstdio>
#include <cstdint>

namespace cg = cooperative_groups;
#define LAS __attribute__((address_space(3)))
typedef unsigned short bf16_t;
typedef short bf16x8 __attribute__((ext_vector_type(8)));
typedef float f32x4 __attribute__((ext_vector_type(4)));
typedef unsigned u32x4 __attribute__((ext_vector_type(4)));
typedef unsigned u32x2 __attribute__((ext_vector_type(2)));
typedef int i32x4 __attribute__((ext_vector_type(4)));

constexpr int T = 65536, D = 1024, SEQ = 4096, NB = 16;
constexpr int INC = 3080;
constexpr int NPROJ = 3072;
constexpr int NE = 32, TOPK = 4, DFF = 1024;
constexpr float EPS = 1e-6f;
constexpr int CAP_ROWS = 196608;

constexpr size_t MB = 1024 * 1024;
constexpr size_t WS_CTL  = 0;
constexpr size_t WS_GATES = 1 * MB;
constexpr size_t WS_SSQR = 3 * MB;
constexpr size_t WS_SUMM = 4 * MB;
constexpr size_t WS_WRI  = 5 * MB;
constexpr size_t WS_ENT  = 6 * MB;
constexpr size_t WS_WIN  = 38 * MB;
constexpr size_t WS_WOUT = 44 * MB;
constexpr size_t WS_WGU  = 46 * MB;
constexpr size_t WS_WDN  = 174 * MB;
constexpr size_t WS_R1   = 238 * MB;
constexpr size_t WS_R2   = 366 * MB;
constexpr size_t WS_Y23  = 750 * MB;
constexpr size_t WS_END  = 1006 * MB;

constexpr int CW_CNT = 0;
constexpr int CW_WORK = 64;
constexpr int CW_BAR = 1024;

__device__ __forceinline__ unsigned pk2(float lo, float hi) { unsigned r; asm("v_cvt_pk_bf16_f32 %0, %1, %2" : "=v"(r) : "v"(lo), "v"(hi)); return r; }
__device__ __forceinline__ float bflo(unsigned u) { return __uint_as_float(u << 16); }
__device__ __forceinline__ float bfhi(unsigned u) { return __uint_as_float(u & 0xffff0000u); }
__device__ __forceinline__ float bf2f(bf16_t b) { return __uint_as_float(((unsigned)b) << 16); }
__device__ __forceinline__ float wave_sum(float v) {
#pragma unroll
    for (int o = 1; o < 64; o <<= 1) v += __shfl_xor(v, o);
    return v;
}
__device__ __forceinline__ float sigmoidf_(float x) { return 1.0f / (1.0f + __expf(-x)); }
__device__ __forceinline__ float gelu_tanh(float x) {
    const float u = 0.7978845608028654f * (x + 0.044715f * x * x * x);
    const float t = 1.0f - 2.0f / (1.0f + __expf(2.0f * u));
    return 0.5f * x * (1.0f + t);
}

struct Params {
    const float* in[22];
    float* out;
    unsigned char* ws;
    int pad0, pad1;
};
enum { I_X = 0, I_N1W, I_WIN, I_GB, I_MNW, I_CW, I_CB, I_WR, I_BR, I_WI, I_BI, I_LAM, I_LNW, I_WOUT, I_N2W, I_RW, I_RB, I_WGU, I_BGU, I_WDN, I_BDN, I_FNW };


constexpr int LDS_BYTES = 159744, LDS_TAB = LDS_BYTES - 512, LDS_BARST = LDS_BYTES - 16;
__device__ __forceinline__ int get_tid(LAS unsigned char* lds) {
    const unsigned slot = (unsigned)__builtin_amdgcn_s_getreg(((6 - 1) << 11) | 4);
    const int w = __builtin_amdgcn_readfirstlane(*(volatile LAS int*)(lds + LDS_TAB + 4 * slot));
    int lane; asm volatile("v_mbcnt_lo_u32_b32 %0, -1, 0\n\tv_mbcnt_hi_u32_b32 %0, -1, %0" : "=v"(lane));
    return w * 64 + lane;
}
#define XB_TMO      128
#define XB_XCNT(j)  (256  + 64 * (j))
#define XB_XSUB(j)  (1280 + 64 * (j))
#define XB_XGEN(j)  (2304 + 64 * (j))
#define XB_TOP      3328
#define XB_TOPGEN   3392
#define XCD_BAR_WORDS 3456
#define XB_SPIN_CAP (1u << 22)
__device__ __forceinline__ unsigned xb_ld(unsigned* p)              { return __hip_atomic_load(p, __ATOMIC_RELAXED, __HIP_MEMORY_SCOPE_AGENT); }
__device__ __forceinline__ unsigned xb_add(unsigned* p, unsigned v) { return __hip_atomic_fetch_add(p, v, __ATOMIC_RELAXED, __HIP_MEMORY_SCOPE_AGENT); }
__device__ __forceinline__ unsigned xb_xcc_id() { return (unsigned)__builtin_amdgcn_s_getreg((3 << 11) | 20) & 0xFu; }
#define XB_SPIN(cond, bar) do { unsigned _sp = 0; while (cond) { __builtin_amdgcn_s_sleep(1); \
    if ((++_sp & 255u) == 0u) { if (xb_ld(&(bar)[XB_TMO])) break; if (_sp > XB_SPIN_CAP) { atomicAdd(&(bar)[XB_TMO], 1u); break; } } } } while (0)
__device__ __forceinline__ void xcd_barrier_complete(unsigned* bar, unsigned x, unsigned G, unsigned& nloc, unsigned& nx) {
    unsigned sum, cnt, mine, sp = 0u;
    for (;;) {
        sum = 0u; cnt = 0u; mine = 0u;
#pragma unroll
        for (unsigned j = 0; j < 16; ++j) { const unsigned c = xb_ld(&bar[XB_XCNT(j)]); sum += c; cnt += (c > 0u) ? 1u : 0u; mine = (j == x) ? c : mine; }
        if (sum == G) break;
        __builtin_amdgcn_s_sleep(1);
        if ((++sp & 255u) == 0u) { if (xb_ld(&bar[XB_TMO])) break; if (sp > XB_SPIN_CAP) { atomicAdd(&bar[XB_TMO], 1u); break; } }
    }
    nloc = mine > 0u ? mine : 1u; nx = cnt > 0u ? cnt : 1u;
}
__device__ __forceinline__ void grid_barrier(unsigned* bar, LAS unsigned char* lds) {
    asm volatile("s_waitcnt vmcnt(0)" ::: "memory");
    __syncthreads();
    if (get_tid(lds) == 0) {
        volatile LAS unsigned* st = (volatile LAS unsigned*)(lds + LDS_BARST);
        const unsigned x = xb_xcc_id();
        __builtin_amdgcn_s_waitcnt(0);
        unsigned nloc = st[0], nx = st[1];
        if (nloc == 0u) { xcd_barrier_complete(bar, x, gridDim.x, nloc, nx); st[0] = nloc; st[1] = nx; }
        const unsigned old = xb_add(&bar[XB_XSUB(x)], 1u);
        const unsigned gen = old / nloc;
        if (old + 1u == (gen + 1u) * nloc) {
            __builtin_amdgcn_fence(__ATOMIC_RELEASE, "agent");
            asm volatile("s_waitcnt vmcnt(0)" ::: "memory");
            const unsigned og = xb_add(&bar[XB_TOP], 1u);
            const unsigned tg = og / nx;
            if (og + 1u == (tg + 1u) * nx) xb_add(&bar[XB_TOPGEN], 1u);
            else XB_SPIN(xb_ld(&bar[XB_TOPGEN]) == tg, bar);
            __builtin_amdgcn_fence(__ATOMIC_ACQUIRE, "agent");
            xb_add(&bar[XB_XGEN(x)], 1u);
            asm volatile("s_waitcnt vmcnt(0)" ::: "memory");
        } else {
            XB_SPIN(xb_ld(&bar[XB_XGEN(x)]) == gen, bar);
            __builtin_amdgcn_fence(__ATOMIC_ACQUIRE, "agent");
            asm volatile("s_waitcnt vmcnt(0)" ::: "memory");
        }
    }
    __syncthreads();
}

__device__ __forceinline__ void tr_item(const float* __restrict__ W, int ldw, int col0, bf16_t* dst, int K, int k0, const float* sk, float mul, LAS float* scr, int lane) {
#pragma unroll 8
    for (int i = 0; i < 32; ++i) { const int kk = 2 * i + (lane >> 5); const float s = sk ? sk[k0 + kk] * mul : mul; scr[kk * 33 + (lane & 31)] = W[(size_t)(k0 + kk) * ldw + col0 + (lane & 31)] * s; }
    asm volatile("s_waitcnt lgkmcnt(0)" ::: "memory");
    const int c = lane & 7;
#pragma unroll
    for (int j = 0; j < 4; ++j) { const int n = (lane >> 3) + 8 * j; const LAS float* s = scr + (8 * c) * 33 + n;
        u32x4 o; o.x = pk2(s[0 * 33], s[1 * 33]); o.y = pk2(s[2 * 33], s[3 * 33]); o.z = pk2(s[4 * 33], s[5 * 33]); o.w = pk2(s[6 * 33], s[7 * 33]);
        *(u32x4*)(dst + (size_t)n * K + k0 + 8 * c) = o; }
    asm volatile("s_waitcnt lgkmcnt(0)" ::: "memory");
}
constexpr int IT_WIN = 16 * 96, IT_WOUT = 16 * 32, IT_WGU_E = 16 * 64, IT_WDN_E = 16 * 32;
__device__ __forceinline__ void conv_item_small(const Params& p, int it, LAS float* scr, int lane) {
    if (it < IT_WIN) {
        const int kb = it / 96, nb = it % 96, n0 = 32 * nb, sec = n0 >> 9;
        const int secoff = sec == 0 ? 0 : sec == 1 ? 512 : sec == 2 ? 1024 : sec == 3 ? 1544 : sec == 4 ? 2056 : 2568;
        const float mul = sec == 1 ? 0.08838834764831845f : 1.0f;
        tr_item(p.in[I_WIN], INC, secoff + (n0 & 511), (bf16_t*)(p.ws + WS_WIN) + (size_t)n0 * D, D, 64 * kb, nullptr, mul, scr, lane);
    } else {
        it -= IT_WIN; const int kb = it / 32, nb = it % 32, k0 = 64 * kb;
        const float* sk = k0 < 512 ? p.in[I_MNW] : p.in[I_LNW] - 512;
        tr_item(p.in[I_WOUT], D, 32 * nb, (bf16_t*)(p.ws + WS_WOUT) + (size_t)(32 * nb) * D, D, k0, sk, 1.0f, scr, lane);
    }
}
__device__ __forceinline__ void conv_item_moe(const Params& p, int it, LAS float* scr, int lane) {
    if (it < NE * IT_WGU_E) {
        const int e = it / IT_WGU_E, r = it % IT_WGU_E, kb = r / 64, nb = r % 64, n0 = 32 * nb, j = n0 >> 8, c0 = n0 & 255;
        const int srccol = c0 < 128 ? 128 * j + c0 : 1024 + 128 * j + (c0 - 128);
        tr_item(p.in[I_WGU] + (size_t)e * D * 2 * DFF, 2 * DFF, srccol, (bf16_t*)(p.ws + WS_WGU) + ((size_t)e * 2 * DFF + n0) * D, D, 64 * kb, p.in[I_N2W], 1.0f, scr, lane);
    } else {
        it -= NE * IT_WGU_E; const int e = it / IT_WDN_E, r = it % IT_WDN_E, kb = r / 32, nb = r % 32;
        tr_item(p.in[I_WDN] + (size_t)e * DFF * D, D, 32 * nb, (bf16_t*)(p.ws + WS_WDN) + ((size_t)e * D + 32 * nb) * DFF, DFF, 64 * kb, nullptr, 1.0f, scr, lane);
    }
}
__device__ __forceinline__ void xpass_rows(const Params& p, LAS unsigned char* lds, int gw, int ngw, int lane) {
    LAS float* WG = (LAS float*)(lds + 69632);
    { const float* wg = p.in[I_WIN] + 1536;
      for (int i = get_tid(lds); i < 2048; i += 512) { const int k = i >> 1, q = i & 1; const f32x4 a = *(const f32x4*)(wg + (size_t)k * INC + 4 * q);
          const int rho = ((k >> 8) * 4 + (k & 3)) * 64 + ((k >> 2) & 63); *(LAS f32x4*)(WG + rho * 12 + 4 * q) = a; } }
    __syncthreads();
    f32x4 w1[4];
#pragma unroll
    for (int j = 0; j < 4; ++j) w1[j] = *(const f32x4*)(p.in[I_N1W] + 256 * j + 4 * lane);
    const float gb = lane < 8 ? p.in[I_GB][lane] : 0.f;
    bf16_t* XN = (bf16_t*)(p.ws + WS_R1); float* GATES = (float*)(p.ws + WS_GATES);
    for (int m = gw; m < T; m += ngw) {
        const f32x4* xr = (const f32x4*)(p.in[I_X] + (size_t)m * D) + lane;
        f32x4 v[4]; float s = 0.f;
#pragma unroll
        for (int j = 0; j < 4; ++j) { v[j] = xr[64 * j]; s += (v[j].x * v[j].x + v[j].y * v[j].y) + (v[j].z * v[j].z + v[j].w * v[j].w); }
        const float rstd = rsqrtf(wave_sum(s) * (1.0f / D) + EPS);
        float g[8];
#pragma unroll
        for (int q = 0; q < 8; ++q) g[q] = 0.f;
        unsigned long long* o8 = (unsigned long long*)(XN + (size_t)m * D) + lane;
#pragma unroll
        for (int j = 0; j < 4; ++j) { v[j] = v[j] * rstd * w1[j];
            o8[64 * j] = (unsigned long long)pk2(v[j].x, v[j].y) | ((unsigned long long)pk2(v[j].z, v[j].w) << 32);
#pragma unroll
            for (int c = 0; c < 4; ++c) { const float xv = v[j][c]; const LAS f32x4* wrow = (const LAS f32x4*)(WG + ((j * 4 + c) * 64 + lane) * 12); const f32x4 wa = wrow[0], wb = wrow[1];
                g[0] += xv * wa.x; g[1] += xv * wa.y; g[2] += xv * wa.z; g[3] += xv * wa.w; g[4] += xv * wb.x; g[5] += xv * wb.y; g[6] += xv * wb.z; g[7] += xv * wb.w; } }
        float mine = 0.f;
#pragma unroll
        for (int q = 0; q < 8; ++q) { const float t = wave_sum(g[q]); if (lane == q) mine = t; }
        if (lane < 8) { float val = mine + gb; if (lane >= 4) val = -log1pf(__expf(-val)); GATES[(size_t)m * 8 + lane] = val; }
    }
}
__device__ __forceinline__ void prep_phase(const Params& p, LAS unsigned char* lds) {
    const int tid = get_tid(lds), lane = tid & 63, wave = tid >> 6, gw = blockIdx.x * 8 + wave, ngw = gridDim.x * 8;
    LAS float* scr = (LAS float*)(lds + wave * 8448);
    for (int it = gw; it < IT_WIN + IT_WOUT; it += ngw) conv_item_small(p, it, scr, lane);
    bf16_t* WRI = (bf16_t*)(p.ws + WS_WRI);
    for (int i = blockIdx.x * 512 + tid; i < 4 * 256 * 128; i += gridDim.x * 512) { const int h = i >> 15, n = (i >> 7) & 255, k = i & 127;
        const float v = n < 128 ? p.in[I_WR][(h * 128 + k) * 128 + n] : p.in[I_WI][(h * 128 + k) * 128 + n - 128]; WRI[i] = (bf16_t)(pk2(v, 0.f) & 0xffff); }
    float* SSQR = (float*)(p.ws + WS_SSQR);
    for (int i = blockIdx.x * 512 + tid; i < T; i += gridDim.x * 512) SSQR[i] = 0.f;
    xpass_rows(p, lds, gw, ngw, lane);
}
__device__ __forceinline__ void moe_conv_phase(const Params& p, LAS unsigned char* lds, int b0) {
    const int tid = get_tid(lds), lane = tid & 63, wave = tid >> 6;
    if ((int)blockIdx.x < b0) return;
    const int gw = ((int)blockIdx.x - b0) * 8 + wave, ngw = ((int)gridDim.x - b0) * 8;
    LAS float* scr = (LAS float*)(lds + wave * 8448);
    for (int it = gw; it < NE * (IT_WGU_E + IT_WDN_E); it += ngw) conv_item_moe(p, it, scr, lane);
}

namespace pg8 {
constexpr int BM = 256, BK = 64, HALF = 128, HTB = HALF * BK * 2, STAGE_BYTES = 8 * HTB;
__device__ __forceinline__ int lds_byte(int r, int c) { const int st = (r >> 4) * 2 + (c >> 5), rr = r & 15, cc = c & 31, ob = rr * 64 + cc * 2; return st * 1024 + (ob ^ (((ob >> 9) & 1) << 5)); }
__device__ __forceinline__ void stage_rc(int b, int& R, int& C) { const int st = b / 1024, sb = b % 1024, swz = sb ^ (((sb >> 9) & 1) << 5); R = (st >> 1) * 16 + swz / 64; C = (st & 1) * 32 + (swz % 64) / 2; }
__device__ __forceinline__ int perm32(int rho) { const int n = rho >> 4, i = rho & 15; return 8 * (i >> 2) + 4 * n + (i & 3); }
struct Unit { const char* b; int i0, i1, i2, i3; };
template <class Epi, class Sched>
__device__ __forceinline__ void gemm_phase(LAS unsigned char* lds, const char* Abase, int K, const Sched& S, const Epi& E) {
    const int tid = get_tid(lds);
    const int wid = __builtin_amdgcn_readfirstlane(tid >> 6), lane = tid & 63, wr = wid >> 2, wc = wid & 3, fr = lane & 15, fq = lane >> 4;
    const int nt = K / BK;
    unsigned voffB[2];
    { int R0, C0, R1, C1; stage_rc(tid * 16, R0, C0); stage_rc(tid * 16 + 8192, R1, C1);
      const int Rb0 = Epi::PERM ? ((R0 & ~31) + perm32(R0 & 31)) : R0, Rb1 = Epi::PERM ? ((R1 & ~31) + perm32(R1 & 31)) : R1;
      voffB[0] = (unsigned)(Rb0 * K + C0) * 2u; voffB[1] = (unsigned)(Rb1 * K + C1) * 2u; }
    const size_t kstep = (size_t)(BK * 2), hstep = (size_t)HALF * K * 2;
    const unsigned ldsw = (unsigned)wid * 1024u;
    const int aoff = lds_byte(wr * 64 + fr, fq * 8), boff = lds_byte(wc * 32 + fr, fq * 8);
#define PG8_SA(b, h) (((b) * 2 + (h)) * HTB)
#define PG8_SB(b, h) ((4 + (b) * 2 + (h)) * HTB)
#define PG8_STAGE2(bufoff, gbase, v0, v1) do { \
        __builtin_amdgcn_global_load_lds((const unsigned*)((const char*)(gbase) + (v0)), (LAS unsigned*)(lds + (bufoff) + ldsw), 16, 0, 0); \
        __builtin_amdgcn_global_load_lds((const unsigned*)((const char*)(gbase) + (v1)), (LAS unsigned*)(lds + (bufoff) + ldsw + 8192), 16, 0, 0); } while (0)
#define PG8_STAGEB(bufoff, gbase) PG8_STAGE2(bufoff, gbase, voffB[0], voffB[1])
#define PG8_LDA(dst, b, h) do { _Pragma("unroll") for (int m = 0; m < 4; ++m) _Pragma("unroll") for (int k = 0; k < 2; ++k) dst[m][k] = *(const LAS bf16x8*)(lds + PG8_SA(b, h) + aoff + m * 2048 + k * 1024); } while (0)
#define PG8_LDB(dst, b, h) do { _Pragma("unroll") for (int n = 0; n < 2; ++n) _Pragma("unroll") for (int k = 0; k < 2; ++k) dst[n][k] = *(const LAS bf16x8*)(lds + PG8_SB(b, h) + boff + n * 2048 + k * 1024); } while (0)
#define PG8_MMA(ai, bj, At, Bt) do { __builtin_amdgcn_s_setprio(1); _Pragma("unroll") for (int m = 0; m < 4; ++m) _Pragma("unroll") for (int n = 0; n < 2; ++n) _Pragma("unroll") for (int k = 0; k < 2; ++k) \
        acc[ai][bj][m][n] = __builtin_amdgcn_mfma_f32_16x16x32_bf16(Bt[n][k], At[m][k], acc[ai][bj][m][n], 0, 0, 0); __builtin_amdgcn_s_setprio(0); } while (0)
#define PG8_WAIT_V(n) asm volatile("s_waitcnt vmcnt(" #n ")" ::: "memory")
#define PG8_WAIT_L(n) asm volatile("s_waitcnt lgkmcnt(" #n ")" ::: "memory")
#define PG8_BAR __builtin_amdgcn_s_barrier()
#define PG8_SCHED __builtin_amdgcn_sched_barrier(0)
    Unit cur, nxt; int ui = 0;
    if (!S.next(0, cur)) return;
    f32x4 acc[2][2][4][2];
#pragma unroll
    for (int a = 0; a < 2; ++a)
#pragma unroll
        for (int b = 0; b < 2; ++b)
#pragma unroll
            for (int m = 0; m < 4; ++m)
#pragma unroll
                for (int n = 0; n < 2; ++n) acc[a][b][m][n] = (f32x4){0.f, 0.f, 0.f, 0.f};
    bf16x8 At[4][2], B0[2][2], B1[2][2];
    unsigned c0, c1, c2, c3;
    S.aoffs(cur, tid, c0, c1, c2, c3);
    const char* cB = cur.b;
    PG8_STAGEB(PG8_SB(0, 0), cB); PG8_STAGEB(PG8_SB(0, 1), cB + hstep); PG8_STAGE2(PG8_SA(0, 0), Abase, c0, c1); PG8_STAGE2(PG8_SA(0, 1), Abase, c2, c3);
    if (wr == 1) PG8_BAR;
    PG8_WAIT_V(2); PG8_BAR;
    PG8_STAGEB(PG8_SB(1, 0), cB + kstep); PG8_STAGE2(PG8_SA(1, 0), Abase + kstep, c0, c1); PG8_STAGEB(PG8_SB(1, 1), cB + hstep + kstep);
    PG8_WAIT_V(6); PG8_BAR;
    for (;;) {
        const bool has_next = S.next(ui + 1, nxt);
        const char* nB = has_next ? nxt.b : cB;
        for (int t = 0; t < nt; t += 2) {
            const bool last = (t == nt - 2);
            const char* a1 = Abase + (size_t)(t + 1) * kstep;
            const char* a2 = last ? Abase : Abase + (size_t)(t + 2) * kstep; const char* b2 = last ? nB : cB + (size_t)(t + 2) * kstep;
            const char* a3 = a2 + kstep; const char* b3 = b2 + kstep;
            unsigned n2 = c2, n3 = c3;
            if (last && has_next) S.aoffs(nxt, tid, c0, c1, n2, n3);
            PG8_LDB(B0, 0, 0); PG8_LDB(B1, 0, 1); PG8_SCHED; PG8_LDA(At, 0, 0); PG8_STAGE2(PG8_SA(1, 1), a1, c2, c3);
            c2 = n2; c3 = n3;
            PG8_WAIT_V(8); PG8_WAIT_L(0); PG8_BAR; PG8_MMA(0, 0, At, B0); PG8_MMA(0, 1, At, B1); PG8_BAR; PG8_SCHED;
            PG8_LDA(At, 0, 1); PG8_STAGEB(PG8_SB(0, 0), b2); PG8_STAGEB(PG8_SB(0, 1), b2 + hstep); PG8_STAGE2(PG8_SA(0, 0), a2, c0, c1);
            PG8_WAIT_V(8); PG8_WAIT_L(0); PG8_BAR; PG8_MMA(1, 0, At, B0); PG8_MMA(1, 1, At, B1); PG8_BAR; PG8_SCHED;
            PG8_LDB(B0, 1, 0); PG8_LDB(B1, 1, 1); PG8_SCHED; PG8_LDA(At, 1, 0); PG8_STAGE2(PG8_SA(0, 1), a2, c2, c3);
            PG8_WAIT_V(8); PG8_WAIT_L(0); PG8_BAR; PG8_MMA(0, 0, At, B0); PG8_MMA(0, 1, At, B1); PG8_BAR; PG8_SCHED;
            PG8_LDA(At, 1, 1); PG8_STAGEB(PG8_SB(1, 0), b3); PG8_STAGEB(PG8_SB(1, 1), b3 + hstep); PG8_STAGE2(PG8_SA(1, 0), a3, c0, c1);
            PG8_WAIT_V(8); PG8_WAIT_L(0); PG8_BAR; PG8_MMA(1, 0, At, B0); PG8_MMA(1, 1, At, B1); PG8_BAR; PG8_SCHED;
        }
        if (wr == 0) PG8_BAR;
        E(acc, cur, wr, wc, fr, fq);
        if (!has_next) break;
#pragma unroll
        for (int a = 0; a < 2; ++a)
#pragma unroll
            for (int b = 0; b < 2; ++b)
#pragma unroll
                for (int m = 0; m < 4; ++m)
#pragma unroll
                    for (int n = 0; n < 2; ++n) acc[a][b][m][n] = (f32x4){0.f, 0.f, 0.f, 0.f};
        cur = nxt; cB = nB; ++ui;
        if (wr == 1) PG8_BAR;
    }
    PG8_WAIT_V(0);
    PG8_BAR;
#undef PG8_SA
#undef PG8_SB
#undef PG8_STAGE2
#undef PG8_STAGEB
#undef PG8_LDA
#undef PG8_LDB
#undef PG8_MMA
#undef PG8_WAIT_V
#undef PG8_WAIT_L
#undef PG8_BAR
#undef PG8_SCHED
}
struct TileOrder {
    int nM, nN, nwg, G, c;
    __device__ __forceinline__ void init(int nM_, int nN_, int G_, int c_) { nM = nM_; nN = nN_; nwg = nM * nN; G = G_; c = c_; }
    __device__ __forceinline__ bool tile(int i, int& pm, int& pn) const {
        const long L = (long)i * G + c; if (L >= nwg) return false;
        int wgid = (int)L; { const int q = nwg / 8, r = nwg % 8, xcd = wgid % 8, off = wgid / 8; wgid = (xcd < r ? xcd * (q + 1) : r * (q + 1) + (xcd - r) * q) + off; }
        const int nig = 8 * nN, gid = wgid / nig, fm = gid * 8, gsz = (nM - fm) < 8 ? (nM - fm) : 8;
        pm = fm + ((wgid % nig) % gsz); pn = (wgid % nig) / gsz; return true;
    }
};
}

struct DenseSched {
    pg8::TileOrder o; const char* Bt; int K;
    __device__ __forceinline__ bool next(int i, pg8::Unit& u) const { int pm, pn; if (!o.tile(i, pm, pn)) return false; u.i0 = pm; u.i1 = pn; u.i2 = 0; u.i3 = 0; u.b = Bt + (size_t)pn * 256 * K * 2; return true; }
    __device__ __forceinline__ void aoffs(const pg8::Unit& u, int tid, unsigned& a0, unsigned& a1, unsigned& a2, unsigned& a3) const {
        int R0, C0, R1, C1; pg8::stage_rc(tid * 16, R0, C0); pg8::stage_rc(tid * 16 + 8192, R1, C1);
        const unsigned rb = (unsigned)u.i0 * 256u;
        a0 = ((rb + R0) * (unsigned)K + C0) * 2u; a1 = ((rb + R1) * (unsigned)K + C1) * 2u; a2 = ((rb + 128 + R0) * (unsigned)K + C0) * 2u; a3 = ((rb + 128 + R1) * (unsigned)K + C1) * 2u;
    }
};
struct EpiInProj {
    static constexpr bool PERM = true;
    bf16_t* PROJ;
    __device__ __forceinline__ void operator()(const f32x4 (&acc)[2][2][4][2], const pg8::Unit& u, int wr, int wc, int fr, int fq) const {
        const int row0 = u.i0 * 256 + wr * 64 + fr, col0 = u.i1 * 256 + wc * 32 + 8 * fq;
#pragma unroll
        for (int ai = 0; ai < 2; ++ai)
#pragma unroll
            for (int m = 0; m < 4; ++m) { bf16_t* rowp = PROJ + (size_t)(row0 + ai * 128 + m * 16) * NPROJ + col0;
#pragma unroll
                for (int bj = 0; bj < 2; ++bj) { const f32x4 v0 = acc[ai][bj][m][0], v1 = acc[ai][bj][m][1];
                    u32x4 w; w.x = pk2(v0[0], v0[1]); w.y = pk2(v0[2], v0[3]); w.z = pk2(v1[0], v1[1]); w.w = pk2(v1[2], v1[3]);
                    *(u32x4*)(rowp + bj * 128) = w; } }
    }
};
struct EpiOutProj {
    static constexpr bool PERM = false;
    const float* X; float* H;
    __device__ __forceinline__ void operator()(const f32x4 (&acc)[2][2][4][2], const pg8::Unit& u, int wr, int wc, int fr, int fq) const {
        const int row0 = u.i0 * 256 + wr * 64 + fr, col0 = u.i1 * 256 + wc * 32 + 4 * fq;
#pragma unroll
        for (int ai = 0; ai < 2; ++ai)
#pragma unroll
            for (int m = 0; m < 4; ++m) { const size_t off = (size_t)(row0 + ai * 128 + m * 16) * D + col0;
#pragma unroll
                for (int bj = 0; bj < 2; ++bj)
#pragma unroll
                    for (int n = 0; n < 2; ++n) { const f32x4 x = *(const f32x4*)(X + off + bj * 128 + n * 16); *(f32x4*)(H + off + bj * 128 + n * 16) = x + acc[ai][bj][m][n]; }
                asm volatile("" ::: "memory"); }
    }
};


struct MoeSched {
    const unsigned* cnt; const i32x4* ENT; const char* Bt; int lo, hi, NT  , NROWS  , K, G, c; bool gather;
    __device__ __forceinline__ bool next(int i, pg8::Unit& u) const {
        int L = i * G + c, hb = 0, e = lo;
        for (; e < hi; ++e) { const int te = ((int)cnt[e] + 255) >> 8, ue = te * NT; if (L < ue) { u.i0 = e; u.i1 = L % te; u.i2 = L / te; u.i3 = hb; u.b = Bt + ((size_t)e * NROWS + (size_t)u.i2 * 256) * K * 2; return true; } L -= ue; hb += te * 256; }
        return false;
    }
    __device__ __forceinline__ void aoffs(const pg8::Unit& u, int tid, unsigned& a0, unsigned& a1, unsigned& a2, unsigned& a3) const {
        int R0, C0, R1, C1; pg8::stage_rc(tid * 16, R0, C0); pg8::stage_rc(tid * 16 + 8192, R1, C1);
        if (gather) {
            const int ce = (int)cnt[u.i0], p0 = u.i1 * 256; const i32x4* en = ENT + (size_t)u.i0 * T;
            const int t0 = p0 + R0 < ce ? en[p0 + R0].x : 0, t1 = p0 + R1 < ce ? en[p0 + R1].x : 0, t2 = p0 + 128 + R0 < ce ? en[p0 + 128 + R0].x : 0, t3 = p0 + 128 + R1 < ce ? en[p0 + 128 + R1].x : 0;
            a0 = ((unsigned)t0 * 1024u + C0) * 2u; a1 = ((unsigned)t1 * 1024u + C1) * 2u; a2 = ((unsigned)t2 * 1024u + C0) * 2u; a3 = ((unsigned)t3 * 1024u + C1) * 2u;
        } else {
            const unsigned rb = (unsigned)(u.i3 + u.i1 * 256);
            a0 = ((rb + R0) * 1024u + C0) * 2u; a1 = ((rb + R1) * 1024u + C1) * 2u; a2 = ((rb + 128 + R0) * 1024u + C0) * 2u; a3 = ((rb + 128 + R1) * 1024u + C1) * 2u;
        }
    }
};
struct EpiG1 {
    static constexpr bool PERM = true;
    bf16_t* HID; const i32x4* ENT; const unsigned* cnt; const float* bgu;
    __device__ __forceinline__ void operator()(const f32x4 (&acc)[2][2][4][2], const pg8::Unit& u, int wr, int wc, int fr, int fq) const {
        const int e = u.i0, ce = (int)cnt[e], hc = u.i2 * 128 + wc * 32 + 8 * fq; const i32x4* en = ENT + (size_t)e * T;
        const float* bg = bgu + (size_t)e * 2 * DFF + hc;
        const f32x4 bg0 = *(const f32x4*)bg, bg1 = *(const f32x4*)(bg + 4), bu0 = *(const f32x4*)(bg + DFF), bu1 = *(const f32x4*)(bg + DFF + 4);
#pragma unroll
        for (int ai = 0; ai < 2; ++ai)
#pragma unroll
            for (int m = 0; m < 4; ++m) { const int pos = u.i1 * 256 + ai * 128 + wr * 64 + m * 16 + fr;
                const float rstd = pos < ce ? __int_as_float(en[pos].y) : 0.f;
                float hv[8];
#pragma unroll
                for (int q = 0; q < 8; ++q) { const int n = q >> 2, j = q & 3; float g = acc[ai][0][m][n][j] * rstd + (n ? bg1[j] : bg0[j]), up = acc[ai][1][m][n][j] * rstd + (n ? bu1[j] : bu0[j]);
                    g = fminf(g, 7.0f); up = fminf(fmaxf(up, -7.0f), 7.0f); hv[q] = (up + 1.0f) * g * sigmoidf_(1.702f * g); }
                u32x4 w; w.x = pk2(hv[0], hv[1]); w.y = pk2(hv[2], hv[3]); w.z = pk2(hv[4], hv[5]); w.w = pk2(hv[6], hv[7]);
                *(u32x4*)(HID + (size_t)(u.i3 + pos) * DFF + hc) = w;
                asm volatile("" ::: "memory"); }
    }
};
struct EpiG2 {
    static constexpr bool PERM = true;
    bf16_t* OUT01; bf16_t* Y23; const i32x4* ENT; const unsigned* cnt; const float* bdn;
    __device__ __forceinline__ void operator()(const f32x4 (&acc)[2][2][4][2], const pg8::Unit& u, int wr, int wc, int fr, int fq) const {
        const int e = u.i0, ce = (int)cnt[e], col0 = u.i2 * 256 + wc * 32 + 8 * fq; const i32x4* en = ENT + (size_t)e * T;
        const float* bd = bdn + (size_t)e * D + col0;
        f32x4 b[2][2];
#pragma unroll
        for (int bj = 0; bj < 2; ++bj) { b[bj][0] = *(const f32x4*)(bd + bj * 128); b[bj][1] = *(const f32x4*)(bd + bj * 128 + 4); }
#pragma unroll
        for (int ai = 0; ai < 2; ++ai)
#pragma unroll
            for (int m = 0; m < 4; ++m) { const int pos = u.i1 * 256 + ai * 128 + wr * 64 + m * 16 + fr;
                if (pos < ce) { const i32x4 en4 = en[pos]; const float gate = __int_as_float(en4.w);
                    bf16_t* dst = (en4.z < 2 ? OUT01 : Y23) + (size_t)en4.x * 2048 + (en4.z & 1) * 1024 + col0;
#pragma unroll
                    for (int bj = 0; bj < 2; ++bj) { const f32x4 y0 = (acc[ai][bj][m][0] + b[bj][0]) * gate, y1 = (acc[ai][bj][m][1] + b[bj][1]) * gate;
                        u32x4 w; w.x = pk2(y0[0], y0[1]); w.y = pk2(y0[2], y0[3]); w.z = pk2(y1[0], y1[1]); w.w = pk2(y1[2], y1[3]);
                        *(u32x4*)(dst + bj * 128) = w; } }
                asm volatile("" ::: "memory"); }
    }
};


constexpr int ML_QS = 0, ML_KS = 17408, ML_VS = 34816, ML_PS = 52224, ML_CT = 61440, ML_DENP = 96256, ML_DI = 96768, ML_SSQP = 97024, ML_NARR = 99072, ML_END = 99584;
__device__ __forceinline__ bf16x8 tr_pair(unsigned a0, unsigned a1) {
    u32x2 lo, hi; asm volatile("ds_read_b64_tr_b16 %0, %2\n\tds_read_b64_tr_b16 %1, %3\n\ts_waitcnt lgkmcnt(0)" : "=&v"(lo), "=&v"(hi) : "v"(a0), "v"(a1) : "memory");
    u32x4 r; r.x = lo.x; r.y = lo.y; r.z = hi.x; r.w = hi.y; return __builtin_bit_cast(bf16x8, r);
}
__device__ __forceinline__ void unpack16(const u32x4& a, const u32x4& b, float (&f)[16]) {
    const unsigned w[8] = {a.x, a.y, a.z, a.w, b.x, b.y, b.z, b.w};
#pragma unroll
    for (int i = 0; i < 8; ++i) { f[2 * i] = bflo(w[i]); f[2 * i + 1] = bfhi(w[i]); }
}
__device__ __forceinline__ void mlstm_phase(const Params& p, LAS unsigned char* lds, int bh) {
    const int tid = get_tid(lds);
    const int lane = tid & 63, w = __builtin_amdgcn_readfirstlane(tid >> 6), fr = lane & 15, fq = lane >> 4, tq = (lane & 15) >> 2, tp = lane & 3;
    const int b = bh >> 2, h = bh & 3, srow = tid >> 3, sseg = tid & 7;
    const bf16_t* PROJ = (const bf16_t*)(p.ws + WS_R2); const float* GATES = (const float*)(p.ws + WS_GATES); bf16_t* MIX = (bf16_t*)(p.ws + WS_R1);
    LAS float* DENP = (LAS float*)(lds + ML_DENP); LAS float* DI = (LAS float*)(lds + ML_DI); LAS float* SSQP = (LAS float*)(lds + ML_SSQP); LAS float* NARR = (LAS float*)(lds + ML_NARR);
    const unsigned ldsb = (unsigned)(size_t)lds;
    for (int i = tid; i < 34816 / 16; i += 512) *(LAS u32x4*)(lds + ML_CT + 16 * i) = (u32x4){0u, 0u, 0u, 0u};
    if (tid < 128) NARR[tid] = 0.f;
    f32x4 c3[8];
#pragma unroll
    for (int i = 0; i < 8; ++i) c3[i] = (f32x4){0.f, 0.f, 0.f, 0.f};
    float nst = 0.f, mprev = 0.f;
    u32x4 rq0, rq1, rk0, rk1, rv0, rv1;
    { const bf16_t* pr = PROJ + ((size_t)b * SEQ + srow) * NPROJ + h * 128 + 16 * sseg;
      rq0 = *(const u32x4*)pr; rq1 = *(const u32x4*)(pr + 8); rk0 = *(const u32x4*)(pr + 512); rk1 = *(const u32x4*)(pr + 520); rv0 = *(const u32x4*)(pr + 1024); rv1 = *(const u32x4*)(pr + 1032); }
    __syncthreads();
    for (int c = 0; c < SEQ / 64; ++c) {
        const size_t row0 = (size_t)b * SEQ + (size_t)c * 64;
        const float ig = GATES[(row0 + lane) * 8 + h], lf = GATES[(row0 + lane) * 8 + 4 + h];
        float bc = lf;
#pragma unroll
        for (int o = 1; o < 64; o <<= 1) { const float t = __shfl_up(bc, o); if (lane >= o) bc += t; }
        const float u = ig - bc; float cm = u;
#pragma unroll
        for (int o = 1; o < 64; o <<= 1) { const float t = __shfl_up(cm, o); if (lane >= o) cm = fmaxf(cm, t); }
        const float Mt = fmaxf(cm, mprev), M63 = __shfl(Mt, 63), bL = __shfl(bc, 63);
        const float sq = __expf(M63 - Mt), sk = __expf(u - M63), fl = __expf(-bc - Mt), decay = __expf(mprev - M63);
        mprev = bL + M63;
        { const float sqv = __shfl(sq, srow), skv = __shfl(sk, srow);
          float f[16]; unpack16(rq0, rq1, f);
          float part = 0.f;
#pragma unroll
          for (int j = 0; j < 16; ++j) { f[j] *= sqv; part += f[j] * NARR[16 * sseg + j]; }
          part += __shfl_xor(part, 1); part += __shfl_xor(part, 2); part += __shfl_xor(part, 4);
          if (sseg == 0) DI[srow] = decay * part;
          u32x4 o0, o1; o0.x = pk2(f[0], f[1]); o0.y = pk2(f[2], f[3]); o0.z = pk2(f[4], f[5]); o0.w = pk2(f[6], f[7]); o1.x = pk2(f[8], f[9]); o1.y = pk2(f[10], f[11]); o1.z = pk2(f[12], f[13]); o1.w = pk2(f[14], f[15]);
          *(LAS u32x4*)(lds + ML_QS + srow * 272 + sseg * 32) = o0; *(LAS u32x4*)(lds + ML_QS + srow * 272 + sseg * 32 + 16) = o1;
          unpack16(rk0, rk1, f);
#pragma unroll
          for (int j = 0; j < 16; ++j) f[j] *= skv;
          o0.x = pk2(f[0], f[1]); o0.y = pk2(f[2], f[3]); o0.z = pk2(f[4], f[5]); o0.w = pk2(f[6], f[7]); o1.x = pk2(f[8], f[9]); o1.y = pk2(f[10], f[11]); o1.z = pk2(f[12], f[13]); o1.w = pk2(f[14], f[15]);
          *(LAS u32x4*)(lds + ML_KS + srow * 272 + sseg * 32) = o0; *(LAS u32x4*)(lds + ML_KS + srow * 272 + sseg * 32 + 16) = o1;
          *(LAS u32x4*)(lds + ML_VS + srow * 272 + sseg * 32) = rv0; *(LAS u32x4*)(lds + ML_VS + srow * 272 + sseg * 32 + 16) = rv1; }
        if (c + 1 < SEQ / 64) { const bf16_t* pr = PROJ + (row0 + 64 + srow) * NPROJ + h * 128 + 16 * sseg;
          rq0 = *(const u32x4*)pr; rq1 = *(const u32x4*)(pr + 8); rk0 = *(const u32x4*)(pr + 512); rk1 = *(const u32x4*)(pr + 520); rv0 = *(const u32x4*)(pr + 1024); rv1 = *(const u32x4*)(pr + 1032); }
        u32x2 og[4];
#pragma unroll
        for (int ti = 0; ti < 4; ++ti) og[ti] = *(const u32x2*)(PROJ + (row0 + 16 * ti + fr) * NPROJ + 1536 + h * 128 + 16 * w + 4 * fq);
        __syncthreads();
        if (tid < 128) { float s = 0.f;
#pragma unroll 16
            for (int ss = 0; ss < 64; ++ss) s += bf2f(*(const LAS bf16_t*)(lds + ML_KS + ss * 272 + tid * 2));
            nst = decay * nst + s; NARR[tid] = nst; }
        { const int ti = w >> 1; float dsum = 0.f;
#pragma unroll
          for (int jj = 0; jj < 2; ++jj) { const int sj = 2 * (w & 1) + jj;
            f32x4 a = (f32x4){0.f, 0.f, 0.f, 0.f};
            if (sj <= ti) {
#pragma unroll
                for (int ks = 0; ks < 4; ++ks) { const bf16x8 ka = *(const LAS bf16x8*)(lds + ML_KS + (16 * sj + fr) * 272 + (32 * ks + 8 * fq) * 2), qb = *(const LAS bf16x8*)(lds + ML_QS + (16 * ti + fr) * 272 + (32 * ks + 8 * fq) * 2);
                    a = __builtin_amdgcn_mfma_f32_16x16x32_bf16(ka, qb, a, 0, 0, 0); }
                const int t = 16 * ti + fr, s0 = 16 * sj + 4 * fq;
#pragma unroll
                for (int r = 0; r < 4; ++r) { if (s0 + r > t) a[r] = 0.f; dsum += a[r]; }
            }
            u32x2 pw; pw.x = pk2(a[0], a[1]); pw.y = pk2(a[2], a[3]);
            *(LAS u32x2*)(lds + ML_PS + (16 * ti + fr) * 144 + (16 * sj + 4 * fq) * 2) = pw; }
          dsum += __shfl_xor(dsum, 16); dsum += __shfl_xor(dsum, 32);
          if (fq == 0) DENP[(w & 1) * 64 + 16 * ti + fr] = dsum; }
        __syncthreads();
        bf16x8 av[2];
#pragma unroll
        for (int ks = 0; ks < 2; ++ks) { const unsigned a0 = ldsb + ML_VS + (32 * ks + 8 * fq + tq) * 272 + (16 * w + 4 * tp) * 2; av[ks] = tr_pair(a0, a0 + 4 * 272); }
        bf16x8 ac[4];
#pragma unroll
        for (int ks = 0; ks < 4; ++ks) ac[ks] = *(const LAS bf16x8*)(lds + ML_CT + (16 * w + fr) * 272 + (32 * ks + 8 * fq) * 2);
        float xs[4][4];
#pragma unroll
        for (int ti = 0; ti < 4; ++ti) { f32x4 a = (f32x4){0.f, 0.f, 0.f, 0.f}, a2 = (f32x4){0.f, 0.f, 0.f, 0.f};
#pragma unroll
            for (int ks = 0; ks < 2; ++ks) { const bf16x8 pb = *(const LAS bf16x8*)(lds + ML_PS + (16 * ti + fr) * 144 + (32 * ks + 8 * fq) * 2); a = __builtin_amdgcn_mfma_f32_16x16x32_bf16(av[ks], pb, a, 0, 0, 0); }
#pragma unroll
            for (int ks = 0; ks < 4; ++ks) { const bf16x8 qb = *(const LAS bf16x8*)(lds + ML_QS + (16 * ti + fr) * 272 + (32 * ks + 8 * fq) * 2); a2 = __builtin_amdgcn_mfma_f32_16x16x32_bf16(ac[ks], qb, a2, 0, 0, 0); }
            a = a + a2 * decay;
            const int t = 16 * ti + fr; const float den = DENP[t] + DENP[64 + t] + DI[t], flt = __shfl(fl, t), inv = 1.0f / fmaxf(fabsf(den), flt);
            xs[ti][0] = sigmoidf_(bflo(og[ti].x)) * a[0] * inv; xs[ti][1] = sigmoidf_(bfhi(og[ti].x)) * a[1] * inv; xs[ti][2] = sigmoidf_(bflo(og[ti].y)) * a[2] * inv; xs[ti][3] = sigmoidf_(bfhi(og[ti].y)) * a[3] * inv;
            float ss = xs[ti][0] * xs[ti][0] + xs[ti][1] * xs[ti][1] + xs[ti][2] * xs[ti][2] + xs[ti][3] * xs[ti][3];
            ss += __shfl_xor(ss, 16); ss += __shfl_xor(ss, 32);
            if (fq == 0) SSQP[w * 64 + t] = ss; }
#pragma unroll
        for (int i = 0; i < 8; ++i) { c3[i] = c3[i] * decay;
#pragma unroll
            for (int ks = 0; ks < 2; ++ks) { const unsigned a0 = ldsb + ML_KS + (32 * ks + 8 * fq + tq) * 272 + (16 * i + 4 * tp) * 2; const bf16x8 ka = tr_pair(a0, a0 + 4 * 272);
                c3[i] = __builtin_amdgcn_mfma_f32_16x16x32_bf16(ka, av[ks], c3[i], 0, 0, 0); } }
        __syncthreads();
#pragma unroll
        for (int ti = 0; ti < 4; ++ti) { const int t = 16 * ti + fr; float s = 0.f;
#pragma unroll
            for (int ww = 0; ww < 8; ++ww) s += SSQP[ww * 64 + t];
            const float rs = rsqrtf(s * (1.0f / 128.f) + EPS);
            u32x2 o; o.x = pk2(xs[ti][0] * rs, xs[ti][1] * rs); o.y = pk2(xs[ti][2] * rs, xs[ti][3] * rs);
            *(u32x2*)(MIX + (row0 + t) * D + h * 128 + 16 * w + 4 * fq) = o; }
#pragma unroll
        for (int i = 0; i < 8; ++i) { u32x2 cw; cw.x = pk2(c3[i][0], c3[i][1]); cw.y = pk2(c3[i][2], c3[i][3]);
            *(LAS u32x2*)(lds + ML_CT + (16 * w + fr) * 272 + (16 * i + 4 * fq) * 2) = cw; }
    }
    __syncthreads();
}


constexpr int RL_XC = 0, RL_RG = 34816, RL_OUT = 69632, RL_CW = 104448, RL_CARRY = 114688, RL_SSQP = 116736, RL_END = 124928;
template <bool FINAL>
__device__ __forceinline__ void rglru_item(const Params& p, LAS unsigned char* lds, int item) {
    const int tid = get_tid(lds);
    const int lane = tid & 63, w = __builtin_amdgcn_readfirstlane(tid >> 6), fr = lane & 15, fq = lane >> 4, srow = tid >> 3, sseg = tid & 7;
    const int b = item >> 4, chunk = item & 15;
    const bf16_t* PROJ = (const bf16_t*)(p.ws + WS_R2); bf16_t* MIX = (bf16_t*)(p.ws + WS_R1); float* SUMM = (float*)(p.ws + WS_SUMM); const bf16_t* WRI = (const bf16_t*)(p.ws + WS_WRI);
    LAS float* CW = (LAS float*)(lds + RL_CW); LAS float* CARRY = (LAS float*)(lds + RL_CARRY); LAS float* SSQP = (LAS float*)(lds + RL_SSQP);
    const size_t tok0 = (size_t)b * SEQ + (size_t)chunk * 256;
    for (int i = tid; i < 2560; i += 512) CW[i] = i < 2048 ? p.in[I_CW][i] : p.in[I_CB][i - 2048];
    if (FINAL) {
        float carry = 0.f;
        for (int cc = 0; cc < chunk; ++cc) { const float2 ab = *(const float2*)(SUMM + ((size_t)(b * 16 + cc) * 512 + tid) * 2); carry = ab.x * carry + ab.y; }
        CARRY[tid] = carry;
        for (int i = tid; i < 2048; i += 512) SSQP[i] = 0.f;
    }
    u32x4 rx[8], rgr[2];
    auto prefetch = [&](int sidx) {
        const int hd = sidx >> 2, step = sidx & 3; const int tl = step * 64 + srow; const size_t tok = tok0 + tl; const int tseq = chunk * 256 + tl;
        const bf16_t* px = PROJ + tok * NPROJ + 2048 + hd * 128 + 16 * sseg;
#pragma unroll
        for (int j = 0; j < 4; ++j) { if (tseq - 3 + j >= 0) { rx[2 * j] = *(const u32x4*)(px + (ptrdiff_t)(j - 3) * NPROJ); rx[2 * j + 1] = *(const u32x4*)(px + (ptrdiff_t)(j - 3) * NPROJ + 8); } else { rx[2 * j] = (u32x4){0u, 0u, 0u, 0u}; rx[2 * j + 1] = (u32x4){0u, 0u, 0u, 0u}; } }
        if (FINAL) { rgr[0] = *(const u32x4*)(px + 512); rgr[1] = *(const u32x4*)(px + 520); }
    };
    prefetch(0);
    __syncthreads();
    float hc = 0.f, ptot = 1.f;
    bf16x8 br[4], bi[4], bid; float brv = 0.f, biv = 0.f, spv = 0.f;
    for (int sidx = 0; sidx < 16; ++sidx) {
        const int hd = sidx >> 2, step = sidx & 3, buf = sidx & 1;
        if (step == 0) {
            const int ch = hd * 128 + 16 * w + fr;
#pragma unroll
            for (int ks = 0; ks < 4; ++ks) { br[ks] = *(const bf16x8*)(WRI + ((size_t)(hd * 256 + 16 * w + fr) * 128 + 32 * ks + 8 * fq)); bi[ks] = *(const bf16x8*)(WRI + ((size_t)(hd * 256 + 128 + 16 * w + fr) * 128 + 32 * ks + 8 * fq)); }
#pragma unroll
            for (int jj = 0; jj < 8; ++jj) bid[jj] = (8 * fq + jj == 16 * (w & 1) + fr) ? (short)0x3F80 : (short)0;
            brv = p.in[I_BR][ch]; biv = p.in[I_BI][ch]; spv = log1pf(__expf(-p.in[I_LAM][ch]));
            if (FINAL) hc = CARRY[ch]; else { hc = 0.f; ptot = 1.f; }
        }
        { float xc[16];
          const LAS f32x4* cb4 = (const LAS f32x4*)(CW + 2048 + hd * 128 + 16 * sseg);
#pragma unroll
          for (int q = 0; q < 4; ++q) { const f32x4 v = cb4[q]; xc[4 * q] = v.x; xc[4 * q + 1] = v.y; xc[4 * q + 2] = v.z; xc[4 * q + 3] = v.w; }
#pragma unroll
          for (int j = 0; j < 4; ++j) { float xf[16]; unpack16(rx[2 * j], rx[2 * j + 1], xf); const LAS f32x4* cw4 = (const LAS f32x4*)(CW + j * 512 + hd * 128 + 16 * sseg);
#pragma unroll
              for (int q = 0; q < 4; ++q) { const f32x4 v = cw4[q]; xc[4 * q] += v.x * xf[4 * q]; xc[4 * q + 1] += v.y * xf[4 * q + 1]; xc[4 * q + 2] += v.z * xf[4 * q + 2]; xc[4 * q + 3] += v.w * xf[4 * q + 3]; } }
          u32x4 o0, o1; o0.x = pk2(xc[0], xc[1]); o0.y = pk2(xc[2], xc[3]); o0.z = pk2(xc[4], xc[5]); o0.w = pk2(xc[6], xc[7]); o1.x = pk2(xc[8], xc[9]); o1.y = pk2(xc[10], xc[11]); o1.z = pk2(xc[12], xc[13]); o1.w = pk2(xc[14], xc[15]);
          *(LAS u32x4*)(lds + RL_XC + buf * 17408 + srow * 272 + sseg * 32) = o0; *(LAS u32x4*)(lds + RL_XC + buf * 17408 + srow * 272 + sseg * 32 + 16) = o1;
          if (FINAL) { *(LAS u32x4*)(lds + RL_RG + buf * 17408 + srow * 272 + sseg * 32) = rgr[0]; *(LAS u32x4*)(lds + RL_RG + buf * 17408 + srow * 272 + sseg * 32 + 16) = rgr[1]; } }
        if (sidx + 1 < 16) prefetch(sidx + 1);
        __syncthreads();
        if (FINAL && sidx > 0) { const int ps = sidx - 1, phd = ps >> 2, pstep = ps & 3, pbuf = ps & 1;
            const u32x4 v0 = *(const LAS u32x4*)(lds + RL_OUT + pbuf * 17408 + srow * 272 + sseg * 32), v1 = *(const LAS u32x4*)(lds + RL_OUT + pbuf * 17408 + srow * 272 + sseg * 32 + 16);
            bf16_t* dst = MIX + (tok0 + pstep * 64 + srow) * D + 512 + phd * 128 + 16 * sseg; *(u32x4*)dst = v0; *(u32x4*)(dst + 8) = v1; }
        const int ksx = w >> 1;
#pragma unroll
        for (int m = 0; m < 4; ++m) {
            f32x4 ar = (f32x4){0.f, 0.f, 0.f, 0.f}, ai = ar, ax = ar, ag = ar;
#pragma unroll
            for (int ks = 0; ks < 4; ++ks) { const bf16x8 a = *(const LAS bf16x8*)(lds + RL_XC + buf * 17408 + (16 * m + fr) * 272 + (32 * ks + 8 * fq) * 2);
                ar = __builtin_amdgcn_mfma_f32_16x16x32_bf16(a, br[ks], ar, 0, 0, 0); ai = __builtin_amdgcn_mfma_f32_16x16x32_bf16(a, bi[ks], ai, 0, 0, 0); }
            { const bf16x8 a = *(const LAS bf16x8*)(lds + RL_XC + buf * 17408 + (16 * m + fr) * 272 + (32 * ksx + 8 * fq) * 2); ax = __builtin_amdgcn_mfma_f32_16x16x32_bf16(a, bid, ax, 0, 0, 0); }
            if (FINAL) { const bf16x8 a = *(const LAS bf16x8*)(lds + RL_RG + buf * 17408 + (16 * m + fr) * 272 + (32 * ksx + 8 * fq) * 2); ag = __builtin_amdgcn_mfma_f32_16x16x32_bf16(a, bid, ag, 0, 0, 0); }
            float hl[4], pl[4]; float P = 1.f, H = 0.f;
#pragma unroll
            for (int r = 0; r < 4; ++r) { const float rr = sigmoidf_(ar[r] + brv), ii = sigmoidf_(ai[r] + biv), a = __expf(-8.0f * rr * spv), bt = sqrtf(fmaxf(1.0f - a * a, 0.f)) * (ii * ax[r]);
                H = a * H + bt; P = P * a; hl[r] = H; pl[r] = P; }
            { const float Pp = __shfl_up(P, 16), Hp = __shfl_up(H, 16); if (fq >= 1) { H = P * Hp + H; P = P * Pp; } }
            { const float Pp = __shfl_up(P, 32), Hp = __shfl_up(H, 32); if (fq >= 2) { H = P * Hp + H; P = P * Pp; } }
            float Pe = __shfl_up(P, 16), He = __shfl_up(H, 16); if (fq == 0) { Pe = 1.f; He = 0.f; }
            const float cin = Pe * hc + He;
            const float tend = P * hc + H;
            if (FINAL) {
                float ss[4];
#pragma unroll
                for (int r = 0; r < 4; ++r) { const float hv = hl[r] + pl[r] * cin, g = gelu_tanh(ag[r]) * hv; ss[r] = g * g;
                    *(LAS bf16_t*)(lds + RL_OUT + buf * 17408 + (16 * m + 4 * fq + r) * 272 + (16 * w + fr) * 2) = (bf16_t)(pk2(g, 0.f) & 0xffff); }
#pragma unroll
                for (int r = 0; r < 4; ++r) { float s = ss[r]; s += __shfl_xor(s, 1); s += __shfl_xor(s, 2); s += __shfl_xor(s, 4); s += __shfl_xor(s, 8);
                    if (fr == 0) SSQP[w * 256 + step * 64 + 16 * m + 4 * fq + r] += s; }
            } else ptot *= __shfl(P, 48 + fr);
            hc = __shfl(tend, 48 + fr);
        }
        if (!FINAL && step == 3 && fq == 0) { *(float2*)(SUMM + ((size_t)(b * 16 + chunk) * 512 + hd * 128 + 16 * w + fr) * 2) = make_float2(ptot, hc); }
    }
    if (FINAL) {
        __syncthreads();
        { const int ps = 15, phd = 3, pstep = 3, pbuf = ps & 1;
          const u32x4 v0 = *(const LAS u32x4*)(lds + RL_OUT + pbuf * 17408 + srow * 272 + sseg * 32), v1 = *(const LAS u32x4*)(lds + RL_OUT + pbuf * 17408 + srow * 272 + sseg * 32 + 16);
          bf16_t* dst = MIX + (tok0 + pstep * 64 + srow) * D + 512 + phd * 128 + 16 * sseg; *(u32x4*)dst = v0; *(u32x4*)(dst + 8) = v1; }
        asm volatile("s_waitcnt vmcnt(0)" ::: "memory");
        __syncthreads();
        for (int i = tid; i < 256 * 64; i += 512) { const int tl = i >> 6, c8 = i & 63; float s = 0.f;
#pragma unroll
            for (int ww = 0; ww < 8; ++ww) s += SSQP[ww * 256 + tl];
            const float rs = rsqrtf(s * (1.0f / 512.f) + EPS);
            u32x4* ptr = (u32x4*)(MIX + (tok0 + tl) * D + 512 + c8 * 8); u32x4 v = *ptr;
            v.x = pk2(bflo(v.x) * rs, bfhi(v.x) * rs); v.y = pk2(bflo(v.y) * rs, bfhi(v.y) * rs); v.z = pk2(bflo(v.z) * rs, bfhi(v.z) * rs); v.w = pk2(bflo(v.w) * rs, bfhi(v.w) * rs);
            *ptr = v; }
    }
    __syncthreads();
}

constexpr int RT_WR = 0, RT_SELE = 147456, RT_SELG = RT_SELE + 4096, RT_RSTD = RT_SELG + 4096, RT_HIST = RT_RSTD + 1024, RT_BASE = RT_HIST + 128, RT_LDS = RT_BASE + 128;
__device__ __forceinline__ void routing_block(const Params& p, LAS unsigned char* lds, int tb) {
    const int tid = get_tid(lds), lane = tid & 63, wave = tid >> 6;
    LAS float* WRl = (LAS float*)(lds + RT_WR); LAS int* selE = (LAS int*)(lds + RT_SELE); LAS float* selG = (LAS float*)(lds + RT_SELG);
    LAS float* rstds = (LAS float*)(lds + RT_RSTD); LAS int* hist = (LAS int*)(lds + RT_HIST); LAS int* base = (LAS int*)(lds + RT_BASE);
    for (int i = tid; i < 1024 * 8; i += 512) { const int k = i >> 3, q = i & 7; const float s = p.in[I_N2W][k];
        f32x4 v = *(const f32x4*)(p.in[I_RW] + (size_t)k * 32 + 4 * q); v = v * s;
        const int rho = ((k >> 8) * 4 + (k & 3)) * 64 + ((k >> 2) & 63); *(LAS f32x4*)(WRl + rho * 36 + 4 * q) = v; }
    if (tid < 32) hist[tid] = 0;
    __syncthreads();
    const float* H = p.out; bf16_t* HB = (bf16_t*)(p.ws + WS_R1);
    const float rb = p.in[I_RB][lane >> 1];
    for (int it = 0; it < 32; ++it) {
        const int tl = it * 8 + wave; const size_t tok = (size_t)tb * 256 + tl;
        const f32x4* hr = (const f32x4*)(H + tok * D) + lane;
        f32x4 v[4]; float s = 0.f;
#pragma unroll
        for (int j = 0; j < 4; ++j) { v[j] = hr[64 * j]; s += (v[j].x * v[j].x + v[j].y * v[j].y) + (v[j].z * v[j].z + v[j].w * v[j].w); }
        const float rstd = rsqrtf(wave_sum(s) * (1.0f / D) + EPS);
        unsigned long long* o8 = (unsigned long long*)(HB + tok * D) + lane;
#pragma unroll
        for (int j = 0; j < 4; ++j) o8[64 * j] = (unsigned long long)pk2(v[j].x, v[j].y) | ((unsigned long long)pk2(v[j].z, v[j].w) << 32);
        float acc[32];
#pragma unroll
        for (int q = 0; q < 32; ++q) acc[q] = 0.f;
#pragma unroll
        for (int j = 0; j < 4; ++j)
#pragma unroll
            for (int c = 0; c < 4; ++c) { const float hv = c == 0 ? v[j].x : c == 1 ? v[j].y : c == 2 ? v[j].z : v[j].w;
                const LAS f32x4* wrow = (const LAS f32x4*)(WRl + ((j * 4 + c) * 64 + lane) * 36);
#pragma unroll
                for (int q = 0; q < 8; ++q) { const f32x4 wv = wrow[q]; acc[4 * q + 0] += hv * wv.x; acc[4 * q + 1] += hv * wv.y; acc[4 * q + 2] += hv * wv.z; acc[4 * q + 3] += hv * wv.w; } }
#pragma unroll
        for (int q = 0; q < 16; ++q) { const bool up = (lane & 32) != 0; const float send = up ? acc[q] : acc[q + 16], keep = up ? acc[q + 16] : acc[q]; acc[q] = keep + __shfl_xor(send, 32); }
#pragma unroll
        for (int q = 0; q < 8; ++q) { const bool up = (lane & 16) != 0; const float send = up ? acc[q] : acc[q + 8], keep = up ? acc[q + 8] : acc[q]; acc[q] = keep + __shfl_xor(send, 16); }
#pragma unroll
        for (int q = 0; q < 4; ++q) { const bool up = (lane & 8) != 0; const float send = up ? acc[q] : acc[q + 4], keep = up ? acc[q + 4] : acc[q]; acc[q] = keep + __shfl_xor(send, 8); }
#pragma unroll
        for (int q = 0; q < 2; ++q) { const bool up = (lane & 4) != 0; const float send = up ? acc[q] : acc[q + 2], keep = up ? acc[q + 2] : acc[q]; acc[q] = keep + __shfl_xor(send, 4); }
        { const bool up = (lane & 2) != 0; const float send = up ? acc[0] : acc[1], keep = up ? acc[1] : acc[0]; acc[0] = keep + __shfl_xor(send, 2); }
        float logit = (acc[0] + __shfl_xor(acc[0], 1)) * rstd + rb;
        float tv[4]; int te[4];
#pragma unroll
        for (int k = 0; k < 4; ++k) {
            float mx = logit;
#pragma unroll
            for (int o = 2; o < 64; o <<= 1) mx = fmaxf(mx, __shfl_xor(mx, o));
            const unsigned long long bal = __ballot(logit == mx);
            const int src = __ffsll((long long)bal) - 1; te[k] = src >> 1; tv[k] = mx;
            if ((lane >> 1) == te[k]) logit = -INFINITY;
        }
        const float e1 = __expf(tv[1] - tv[0]), e2 = __expf(tv[2] - tv[0]), e3 = __expf(tv[3] - tv[0]), inv = 1.0f / (1.0f + e1 + e2 + e3);
        if (lane < 4) { const int ee = lane == 0 ? te[0] : lane == 1 ? te[1] : lane == 2 ? te[2] : te[3]; const float gg = (lane == 0 ? 1.0f : lane == 1 ? e1 : lane == 2 ? e2 : e3) * inv;
            selE[tl * 4 + lane] = ee; selG[tl * 4 + lane] = gg; }
        if (lane == 0) rstds[tl] = rstd;
    }
    __syncthreads();
    int myrank[2], mye[2];
#pragma unroll
    for (int q = 0; q < 2; ++q) { const int a = tid + 512 * q; mye[q] = selE[a]; myrank[q] = atomicAdd((int*)(hist + mye[q]), 1); }
    __syncthreads();
    unsigned* ctl = (unsigned*)(p.ws + WS_CTL);
    if (tid < 32) base[tid] = (int)atomicAdd(ctl + CW_CNT + tid, (unsigned)hist[tid]);
    __syncthreads();
    i32x4* ENT = (i32x4*)(p.ws + WS_ENT);
#pragma unroll
    for (int q = 0; q < 2; ++q) { const int a = tid + 512 * q, tl = a >> 2, k = a & 3; const int pos = base[mye[q]] + myrank[q];
        i32x4 en; en.x = tb * 256 + tl; en.y = __float_as_int(rstds[tl]); en.z = k; en.w = __float_as_int(selG[a]); ENT[(size_t)mye[q] * T + pos] = en; }
}
__device__ __forceinline__ void routing_phase(const Params& p, LAS unsigned char* lds) {
    for (int tb = blockIdx.x; tb < T / 256; tb += gridDim.x) { routing_block(p, lds, tb); __syncthreads(); }
}

struct Rounds { int es; int nr; __device__ __forceinline__ int lo(int r) const { return r == 0 ? 0 : es; } __device__ __forceinline__ int hi(int r) const { return r == 0 ? es : NE; } };
__device__ __forceinline__ int pad256(int c) { return (c + 255) & ~255; }
__device__ __forceinline__ Rounds make_rounds(const unsigned* cnt) {
    Rounds R; int sum = 0, e = 0;
    for (; e < NE; ++e) { const int pc = pad256((int)cnt[e]); if (sum + pc > CAP_ROWS) break; sum += pc; }
    R.es = e; R.nr = e < NE ? 2 : 1; return R;
}
__device__ __forceinline__ void combine_rows(const Params& p, int gw, int ngw, int lane) {
    const bf16_t* HB = (const bf16_t*)(p.ws + WS_R1); const bf16_t* Y23 = (const bf16_t*)(p.ws + WS_Y23);
    f32x4 fw[4];
#pragma unroll
    for (int q = 0; q < 4; ++q) fw[q] = *(const f32x4*)(p.in[I_FNW] + 512 * (q >> 1) + 8 * lane + 4 * (q & 1));
    for (int m = gw; m < T; m += ngw) {
        float v[16];
        const u32x4 h0 = *(const u32x4*)(HB + (size_t)m * D + 8 * lane), h1 = *(const u32x4*)(HB + (size_t)m * D + 512 + 8 * lane);
        const unsigned hw[8] = {h0.x, h0.y, h0.z, h0.w, h1.x, h1.y, h1.z, h1.w};
#pragma unroll
        for (int q = 0; q < 8; ++q) { v[2 * q] = bflo(hw[q]); v[2 * q + 1] = bfhi(hw[q]); }
#pragma unroll
        for (int k = 0; k < 4; ++k) { const bf16_t* yb = (k < 2 ? (const bf16_t*)p.out : Y23) + (size_t)m * 2048 + (k & 1) * 1024;
            const u32x4 y0 = *(const u32x4*)(yb + 8 * lane), y1 = *(const u32x4*)(yb + 512 + 8 * lane);
            const unsigned yw[8] = {y0.x, y0.y, y0.z, y0.w, y1.x, y1.y, y1.z, y1.w};
#pragma unroll
            for (int q = 0; q < 8; ++q) { v[2 * q] += bflo(yw[q]); v[2 * q + 1] += bfhi(yw[q]); } }
        float s = 0.f;
#pragma unroll
        for (int q = 0; q < 16; ++q) s += v[q] * v[q];
        const float rstd = rsqrtf(wave_sum(s) * (1.0f / D) + EPS);
        float* o = p.out + (size_t)m * D;
#pragma unroll
        for (int q = 0; q < 4; ++q) { f32x4 r; r.x = v[4 * q] * rstd * fw[q].x; r.y = v[4 * q + 1] * rstd * fw[q].y; r.z = v[4 * q + 2] * rstd * fw[q].z; r.w = v[4 * q + 3] * rstd * fw[q].w;
            *(f32x4*)(o + 512 * (q >> 1) + 8 * lane + 4 * (q & 1)) = r; }
    }
}
__global__ void __launch_bounds__(512, 2) fwd(Params p) {
    extern __shared__ __attribute__((aligned(16))) unsigned char lds_[];
    LAS unsigned char* lds = (LAS unsigned char*)lds_;
    unsigned char* ws = p.ws;
    unsigned* bar = (unsigned*)(ws + WS_CTL) + CW_BAR;
    {
        const int t0 = threadIdx.x;
        const unsigned slot = (unsigned)__builtin_amdgcn_s_getreg(((6 - 1) << 11) | 4);
        if ((t0 & 63) == 0) *(volatile LAS int*)(lds + LDS_TAB + 4 * slot) = t0 >> 6;
        if (t0 == 0) { *(volatile LAS unsigned*)(lds + LDS_BARST) = 0u; *(volatile LAS unsigned*)(lds + LDS_BARST + 4) = 0u; (void)xb_add(&bar[XB_XCNT(xb_xcc_id())], 1u); }
        __syncthreads();
    }
#define GRID_BAR() grid_barrier(bar, lds)
    prep_phase(p, lds);
    cg::this_grid().sync();
#ifndef SKIP_IP
    { DenseSched S; S.o.init(T / 256, NPROJ / 256, gridDim.x, blockIdx.x); S.Bt = (const char*)(ws + WS_WIN); S.K = D; EpiInProj E{(bf16_t*)(ws + WS_R2)};
      pg8::gemm_phase(lds, (const char*)(ws + WS_R1), D, S, E); }
#endif
    GRID_BAR();
#ifndef SKIP_ML
    if (blockIdx.x < 64) mlstm_phase(p, lds, blockIdx.x);
    else
#endif
    {
#ifndef SKIP_RA
        for (int it = blockIdx.x - 64; it < 256; it += gridDim.x - 64) rglru_item<false>(p, lds, it);
#endif
        moe_conv_phase(p, lds, 64); }
    GRID_BAR();
#ifndef SKIP_RC
    for (int it = blockIdx.x; it < 256; it += gridDim.x) rglru_item<true>(p, lds, it);
#endif
    GRID_BAR();
#ifndef SKIP_OP
    { DenseSched S; S.o.init(T / 256, D / 256, gridDim.x, blockIdx.x); S.Bt = (const char*)(ws + WS_WOUT); S.K = D; EpiOutProj E{p.in[I_X], p.out};
      pg8::gemm_phase(lds, (const char*)(ws + WS_R1), D, S, E); }
#endif
    GRID_BAR();
    routing_phase(p, lds);
    GRID_BAR();
    const unsigned* cnt = (const unsigned*)(ws + WS_CTL) + CW_CNT;
    const Rounds RR = make_rounds(cnt);
    for (int r = 0; r < RR.nr; ++r) {
#ifndef SKIP_G1
        { MoeSched S{cnt, (const i32x4*)(ws + WS_ENT), (const char*)(ws + WS_WGU), RR.lo(r), RR.hi(r), 8, 2 * DFF, D, (int)gridDim.x, (int)blockIdx.x, true};
          EpiG1 E{(bf16_t*)(ws + WS_R2), (const i32x4*)(ws + WS_ENT), cnt, p.in[I_BGU]};
          pg8::gemm_phase(lds, (const char*)(ws + WS_R1), D, S, E); }
#endif
        GRID_BAR();
#ifndef SKIP_G2
        { MoeSched S{cnt, (const i32x4*)(ws + WS_ENT), (const char*)(ws + WS_WDN), RR.lo(r), RR.hi(r), 4, D, DFF, (int)gridDim.x, (int)blockIdx.x, false};
          EpiG2 E{(bf16_t*)p.out, (bf16_t*)(ws + WS_Y23), (const i32x4*)(ws + WS_ENT), cnt, p.in[I_BDN]};
          pg8::gemm_phase(lds, (const char*)(ws + WS_R2), DFF, S, E); }
#endif
        GRID_BAR();
    }
    { const int tid = get_tid(lds); combine_rows(p, blockIdx.x * 8 + (tid >> 6), gridDim.x * 8, tid & 63); }
}

extern "C" void kernel_launch(void* const* d_in, const int* in_sizes, int n_in, void* d_out, int out_size, void* d_ws, size_t ws_size, hipStream_t stream) {
    static int grid = 0;
    if (grid == 0) {
        if (n_in != 22 || ws_size < WS_END) { fprintf(stderr, "kernel_launch: unexpected n_in %d / ws_size %zu (need %zu)\n", n_in, ws_size, (size_t)WS_END); grid = -1; return; }
        int dev = 0, cus = 0, per_cu = 0;
        (void)hipGetDevice(&dev); (void)hipDeviceGetAttribute(&cus, hipDeviceAttributeMultiprocessorCount, dev);
        (void)hipFuncSetAttribute((const void*)fwd, hipFuncAttributeMaxDynamicSharedMemorySize, LDS_BYTES);
        (void)hipOccupancyMaxActiveBlocksPerMultiprocessor(&per_cu, (const void*)fwd, 512, LDS_BYTES);
        if (per_cu < 1) { fprintf(stderr, "kernel_launch: occupancy query says %d blocks/CU\n", per_cu); per_cu = 1; }
        grid = cus * per_cu;
        fprintf(stderr, "kernel_launch: grid %d (cus %d x %d)\n", grid, cus, per_cu);
    }
    if (grid < 0) return;
    Params p{};
    for (int i = 0; i < 22; ++i) p.in[i] = (const float*)d_in[i];
    p.out = (float*)d_out; p.ws = (unsigned char*)d_ws;
    (void)hipMemsetAsync((unsigned char*)d_ws + WS_CTL, 0, 65536, stream);
    void* args[] = {&p};
    hipError_t e = hipLaunchCooperativeKernel((const void*)fwd, dim3(grid), dim3(512), args, LDS_BYTES, stream);
    if (e != hipSuccess) fprintf(stderr, "kernel_launch: cooperative launch failed: %s (grid %d)\n", hipGetErrorString(e), grid);
}
```

```cpp
#include <hip/hip_runtime.h>
#include <hip/hip_cooperative_groups.h>
#include <cstdio>
#include <cstdint>

namespace cg = cooperative_groups;
#define LAS __attribute__((address_space(3)))
typedef unsigned short bf16_t;
typedef short bf16x8 __attribute__((ext_vector_type(8)));
typedef float f32x4 __attribute__((ext_vector_type(4)));
typedef unsigned u32x4 __attribute__((ext_vector_type(4)));
typedef unsigned u32x2 __attribute__((ext_vector_type(2)));
typedef int i32x4 __attribute__((ext_vector_type(4)));

constexpr int T = 65536, D = 1024, SEQ = 4096, NB = 16;
constexpr int INC = 3080;
constexpr int NPROJ = 3072;
constexpr int NE = 32, TOPK = 4, DFF = 1024;
constexpr float EPS = 1e-6f;
constexpr int CAP_ROWS = 196608;

constexpr size_t MB = 1024 * 1024;
constexpr size_t WS_CTL  = 0;
constexpr size_t WS_GATES = 1 * MB;
constexpr size_t WS_SSQR = 3 * MB;
constexpr size_t WS_SUMM = 4 * MB;
constexpr size_t WS_WRI  = 5 * MB;
constexpr size_t WS_ENT  = 6 * MB;
constexpr size_t WS_WIN  = 38 * MB;
constexpr size_t WS_WOUT = 44 * MB;
constexpr size_t WS_WGU  = 46 * MB;
constexpr size_t WS_WDN  = 174 * MB;
constexpr size_t WS_R1   = 238 * MB;
constexpr size_t WS_R2   = 366 * MB;
constexpr size_t WS_Y23  = 750 * MB;
constexpr size_t WS_END  = 1006 * MB;

constexpr int CW_CNT = 0;
constexpr int CW_WORK = 64;
constexpr int CW_BAR = 1024;

__device__ __forceinline__ unsigned pk2(float lo, float hi) { unsigned r; asm("v_cvt_pk_bf16_f32 %0, %1, %2" : "=v"(r) : "v"(lo), "v"(hi)); return r; }
__device__ __forceinline__ float bflo(unsigned u) { return __uint_as_float(u << 16); }
__device__ __forceinline__ float bfhi(unsigned u) { return __uint_as_float(u & 0xffff0000u); }
__device__ __forceinline__ float bf2f(bf16_t b) { return __uint_as_float(((unsigned)b) << 16); }
__device__ __forceinline__ float wave_sum(float v) {
#pragma unroll
    for (int o = 1; o < 64; o <<= 1) v += __shfl_xor(v, o);
    return v;
}
__device__ __forceinline__ float fexp(float x) { return __builtin_amdgcn_exp2f(x * 1.4426950408889634f); }
__device__ __forceinline__ float frcp(float x) { return __builtin_amdgcn_rcpf(x); }
__device__ __forceinline__ float fsqrt(float x) { return __builtin_amdgcn_sqrtf(x); }
__device__ __forceinline__ float frsq(float x) { return __builtin_amdgcn_rsqf(x); }
__device__ __forceinline__ float sigmoidf_(float x) { return frcp(1.0f + __builtin_amdgcn_exp2f(x * -1.4426950408889634f)); }
__device__ __forceinline__ float gelu_tanh(float x) {
    const float u2 = 1.5957691216057308f * (x + 0.044715f * x * x * x);
    return x * sigmoidf_(u2);
}

struct Params {
    const float* in[22];
    float* out;
    unsigned char* ws;
    int pad0, pad1;
};
enum { I_X = 0, I_N1W, I_WIN, I_GB, I_MNW, I_CW, I_CB, I_WR, I_BR, I_WI, I_BI, I_LAM, I_LNW, I_WOUT, I_N2W, I_RW, I_RB, I_WGU, I_BGU, I_WDN, I_BDN, I_FNW };


constexpr int LDS_BYTES = 159744, LDS_TAB = LDS_BYTES - 512, LDS_BARST = LDS_BYTES - 16;
__device__ __forceinline__ int get_tid(LAS unsigned char* lds) {
    const unsigned slot = (unsigned)__builtin_amdgcn_s_getreg(((6 - 1) << 11) | 4);
    const int w = __builtin_amdgcn_readfirstlane(*(volatile LAS int*)(lds + LDS_TAB + 4 * slot));
    int lane; asm volatile("v_mbcnt_lo_u32_b32 %0, -1, 0\n\tv_mbcnt_hi_u32_b32 %0, -1, %0" : "=v"(lane));
    return w * 64 + lane;
}
#define XB_TMO      128
#define XB_XCNT(j)  (256  + 64 * (j))
#define XB_XSUB(j)  (1280 + 64 * (j))
#define XB_XGEN(j)  (2304 + 64 * (j))
#define XB_TOP      3328
#define XB_TOPGEN   3392
#define XCD_BAR_WORDS 3456
#define XB_SPIN_CAP (1u << 22)
__device__ __forceinline__ unsigned xb_ld(unsigned* p)              { return __hip_atomic_load(p, __ATOMIC_RELAXED, __HIP_MEMORY_SCOPE_AGENT); }
__device__ __forceinline__ unsigned xb_add(unsigned* p, unsigned v) { return __hip_atomic_fetch_add(p, v, __ATOMIC_RELAXED, __HIP_MEMORY_SCOPE_AGENT); }
__device__ __forceinline__ unsigned xb_xcc_id() { return (unsigned)__builtin_amdgcn_s_getreg((3 << 11) | 20) & 0xFu; }
#define XB_SPIN(cond, bar) do { unsigned _sp = 0; while (cond) { __builtin_amdgcn_s_sleep(1); \
    if ((++_sp & 255u) == 0u) { if (xb_ld(&(bar)[XB_TMO])) break; if (_sp > XB_SPIN_CAP) { atomicAdd(&(bar)[XB_TMO], 1u); break; } } } } while (0)
__device__ __forceinline__ void xcd_barrier_complete(unsigned* bar, unsigned x, unsigned G, unsigned& nloc, unsigned& nx) {
    unsigned sum, cnt, mine, sp = 0u;
    for (;;) {
        sum = 0u; cnt = 0u; mine = 0u;
#pragma unroll
        for (unsigned j = 0; j < 16; ++j) { const unsigned c = xb_ld(&bar[XB_XCNT(j)]); sum += c; cnt += (c > 0u) ? 1u : 0u; mine = (j == x) ? c : mine; }
        if (sum == G) break;
        __builtin_amdgcn_s_sleep(1);
        if ((++sp & 255u) == 0u) { if (xb_ld(&bar[XB_TMO])) break; if (sp > XB_SPIN_CAP) { atomicAdd(&bar[XB_TMO], 1u); break; } }
    }
    nloc = mine > 0u ? mine : 1u; nx = cnt > 0u ? cnt : 1u;
}
__device__ __forceinline__ void grid_barrier(unsigned* bar, LAS unsigned char* lds) {
    asm volatile("s_waitcnt vmcnt(0)" ::: "memory");
    __syncthreads();
    if (get_tid(lds) == 0) {
        volatile LAS unsigned* st = (volatile LAS unsigned*)(lds + LDS_BARST);
        const unsigned x = xb_xcc_id();
        __builtin_amdgcn_s_waitcnt(0);
        unsigned nloc = st[0], nx = st[1];
        if (nloc == 0u) { xcd_barrier_complete(bar, x, gridDim.x, nloc, nx); st[0] = nloc; st[1] = nx; }
        const unsigned old = xb_add(&bar[XB_XSUB(x)], 1u);
        const unsigned gen = old / nloc;
        if (old + 1u == (gen + 1u) * nloc) {
            __builtin_amdgcn_fence(__ATOMIC_RELEASE, "agent");
            asm volatile("s_waitcnt vmcnt(0)" ::: "memory");
            const unsigned og = xb_add(&bar[XB_TOP], 1u);
            const unsigned tg = og / nx;
            if (og + 1u == (tg + 1u) * nx) xb_add(&bar[XB_TOPGEN], 1u);
            else XB_SPIN(xb_ld(&bar[XB_TOPGEN]) == tg, bar);
            __builtin_amdgcn_fence(__ATOMIC_ACQUIRE, "agent");
            xb_add(&bar[XB_XGEN(x)], 1u);
            asm volatile("s_waitcnt vmcnt(0)" ::: "memory");
        } else {
            XB_SPIN(xb_ld(&bar[XB_XGEN(x)]) == gen, bar);
            __builtin_amdgcn_fence(__ATOMIC_ACQUIRE, "agent");
            asm volatile("s_waitcnt vmcnt(0)" ::: "memory");
        }
    }
    __syncthreads();
}

#ifdef PROBE_G
#define GSTAMP(ws_, tid_, i_) do { if (blockIdx.x == PROBE_BLK && (tid_) == 0) ((volatile unsigned long long*)((ws_) + WS_CTL + 40960))[i_] = __builtin_amdgcn_s_memrealtime(); } while (0)
#else
#define GSTAMP(ws_, tid_, i_) do { } while (0)
#endif
__device__ __forceinline__ void tr_item(const float* __restrict__ W, int ldw, int col0, bf16_t* dst, int K, int k0, const float* sk, float mul, LAS float* scr, int lane) {
    float v[32];
    const float* src = W + (size_t)(k0 + (lane >> 5)) * ldw + col0 + (lane & 31);
#pragma unroll
    for (int i = 0; i < 32; ++i) v[i] = __builtin_nontemporal_load(src + (size_t)(2 * i) * ldw);
#pragma unroll
    for (int i = 0; i < 32; ++i) { const int kk = 2 * i + (lane >> 5); const float s = sk ? sk[k0 + kk] * mul : mul; scr[kk * 33 + (lane & 31)] = v[i] * s; }
    asm volatile("s_waitcnt lgkmcnt(0)" ::: "memory");
    const int c = lane & 7;
#pragma unroll
    for (int j = 0; j < 4; ++j) { const int n = (lane >> 3) + 8 * j; const LAS float* s = scr + (8 * c) * 33 + n;
        u32x4 o; o.x = pk2(s[0 * 33], s[1 * 33]); o.y = pk2(s[2 * 33], s[3 * 33]); o.z = pk2(s[4 * 33], s[5 * 33]); o.w = pk2(s[6 * 33], s[7 * 33]);
        *(u32x4*)(dst + (size_t)n * K + k0 + 8 * c) = o; }
    asm volatile("s_waitcnt lgkmcnt(0)" ::: "memory");
}
constexpr int IT_WIN = 16 * 96, IT_WOUT = 16 * 32, IT_WGU_E = 16 * 64, IT_WDN_E = 16 * 32;
__device__ __forceinline__ void conv_item_small(const Params& p, int it, LAS float* scr, int lane) {
    if (it < IT_WIN) {
        const int kb = it / 96, nb = it % 96, n0 = 32 * nb, sec = n0 >> 9;
        const int secoff = sec == 0 ? 0 : sec == 1 ? 512 : sec == 2 ? 1024 : sec == 3 ? 1544 : sec == 4 ? 2056 : 2568;
        const float mul = sec == 1 ? 0.08838834764831845f : 1.0f;
        tr_item(p.in[I_WIN], INC, secoff + (n0 & 511), (bf16_t*)(p.ws + WS_WIN) + (size_t)n0 * D, D, 64 * kb, nullptr, mul, scr, lane);
    } else {
        it -= IT_WIN; const int kb = it / 32, nb = it % 32, k0 = 64 * kb;
        const float* sk = k0 < 512 ? p.in[I_MNW] : p.in[I_LNW] - 512;
        tr_item(p.in[I_WOUT], D, 32 * nb, (bf16_t*)(p.ws + WS_WOUT) + (size_t)(32 * nb) * D, D, k0, sk, 1.0f, scr, lane);
    }
}
__device__ __forceinline__ void conv_item_moe(const Params& p, int it, LAS float* scr, int lane) {
    if (it < NE * IT_WGU_E) {
        const int e = it / IT_WGU_E, r = it % IT_WGU_E, kb = r / 64, nb = r % 64, n0 = 32 * nb, j = n0 >> 8, c0 = n0 & 255;
        const int srccol = c0 < 128 ? 128 * j + c0 : 1024 + 128 * j + (c0 - 128);
        tr_item(p.in[I_WGU] + (size_t)e * D * 2 * DFF, 2 * DFF, srccol, (bf16_t*)(p.ws + WS_WGU) + ((size_t)e * 2 * DFF + n0) * D, D, 64 * kb, p.in[I_N2W], 1.0f, scr, lane);
    } else {
        it -= NE * IT_WGU_E; const int e = it / IT_WDN_E, r = it % IT_WDN_E, kb = r / 32, nb = r % 32;
        tr_item(p.in[I_WDN] + (size_t)e * DFF * D, D, 32 * nb, (bf16_t*)(p.ws + WS_WDN) + ((size_t)e * D + 32 * nb) * DFF, DFF, 64 * kb, nullptr, 1.0f, scr, lane);
    }
}
__device__ __forceinline__ void xpass_rows(const Params& p, LAS unsigned char* lds, int gw, int ngw, int lane) {
    LAS float* WG = (LAS float*)(lds + 69632);
    { const float* wg = p.in[I_WIN] + 1536;
      for (int i = get_tid(lds); i < 2048; i += 512) { const int k = i >> 1, q = i & 1; const f32x4 a = *(const f32x4*)(wg + (size_t)k * INC + 4 * q);
          const int rho = ((k >> 8) * 4 + (k & 3)) * 64 + ((k >> 2) & 63); *(LAS f32x4*)(WG + rho * 12 + 4 * q) = a; } }
    __syncthreads();
    f32x4 w1[4];
#pragma unroll
    for (int j = 0; j < 4; ++j) w1[j] = *(const f32x4*)(p.in[I_N1W] + 256 * j + 4 * lane);
    const float gb = lane < 8 ? p.in[I_GB][lane] : 0.f;
    bf16_t* XN = (bf16_t*)(p.ws + WS_R1); float* GATES = (float*)(p.ws + WS_GATES);
    for (int m = gw; m < T; m += ngw) {
        const f32x4* xr = (const f32x4*)(p.in[I_X] + (size_t)m * D) + lane;
        f32x4 v[4]; float s = 0.f;
#pragma unroll
        for (int j = 0; j < 4; ++j) { v[j] = xr[64 * j]; s += (v[j].x * v[j].x + v[j].y * v[j].y) + (v[j].z * v[j].z + v[j].w * v[j].w); }
        const float rstd = frsq(wave_sum(s) * (1.0f / D) + EPS);
        float g[8];
#pragma unroll
        for (int q = 0; q < 8; ++q) g[q] = 0.f;
        unsigned long long* o8 = (unsigned long long*)(XN + (size_t)m * D) + lane;
#pragma unroll
        for (int j = 0; j < 4; ++j) { v[j] = v[j] * rstd * w1[j];
            o8[64 * j] = (unsigned long long)pk2(v[j].x, v[j].y) | ((unsigned long long)pk2(v[j].z, v[j].w) << 32);
#pragma unroll
            for (int c = 0; c < 4; ++c) { const float xv = v[j][c]; const LAS f32x4* wrow = (const LAS f32x4*)(WG + ((j * 4 + c) * 64 + lane) * 12); const f32x4 wa = wrow[0], wb = wrow[1];
                g[0] += xv * wa.x; g[1] += xv * wa.y; g[2] += xv * wa.z; g[3] += xv * wa.w; g[4] += xv * wb.x; g[5] += xv * wb.y; g[6] += xv * wb.z; g[7] += xv * wb.w; } }
        float mine = 0.f;
#pragma unroll
        for (int q = 0; q < 8; ++q) { const float t = wave_sum(g[q]); if (lane == q) mine = t; }
        if (lane < 8) { float val = mine + gb; if (lane >= 4) val = -log1pf(fexp(-val)); GATES[(size_t)m * 8 + lane] = val; }
    }
}
__device__ __forceinline__ void prep_phase(const Params& p, LAS unsigned char* lds) {
    const int tid = get_tid(lds), lane = tid & 63, wave = tid >> 6, gw = blockIdx.x * 8 + wave, ngw = gridDim.x * 8;
    LAS float* scr = (LAS float*)(lds + wave * 8448);
    for (int it = gw; it < IT_WIN + IT_WOUT; it += ngw) conv_item_small(p, it, scr, lane);
    bf16_t* WRI = (bf16_t*)(p.ws + WS_WRI);
    for (int i = blockIdx.x * 512 + tid; i < 4 * 256 * 128; i += gridDim.x * 512) { const int h = i >> 15, n = (i >> 7) & 255, k = i & 127;
        const float v = n < 128 ? p.in[I_WR][(h * 128 + k) * 128 + n] : p.in[I_WI][(h * 128 + k) * 128 + n - 128]; WRI[i] = (bf16_t)(pk2(v, 0.f) & 0xffff); }
    float* SSQR = (float*)(p.ws + WS_SSQR);
    for (int i = blockIdx.x * 512 + tid; i < T; i += gridDim.x * 512) SSQR[i] = 0.f;
    xpass_rows(p, lds, gw, ngw, lane);
}
__device__ __forceinline__ void moe_conv_phase(const Params& p, LAS unsigned char* lds, int b0) {
    const int tid = get_tid(lds), lane = tid & 63, wave = tid >> 6;
    if ((int)blockIdx.x < b0) return;
    const int gw = ((int)blockIdx.x - b0) * 8 + wave, ngw = ((int)gridDim.x - b0) * 8;
    LAS float* scr = (LAS float*)(lds + wave * 8448);
    for (int it = gw; it < NE * (IT_WGU_E + IT_WDN_E); it += ngw) conv_item_moe(p, it, scr, lane);
}

namespace pg8 {
constexpr int BM = 256, BK = 64, HALF = 128, HTB = HALF * BK * 2, STAGE_BYTES = 8 * HTB;
__device__ __forceinline__ int lds_byte(int r, int c) { const int st = (r >> 4) * 2 + (c >> 5), rr = r & 15, cc = c & 31, ob = rr * 64 + cc * 2; return st * 1024 + (ob ^ (((ob >> 9) & 1) << 5)); }
__device__ __forceinline__ void stage_rc(int b, int& R, int& C) { const int st = b / 1024, sb = b % 1024, swz = sb ^ (((sb >> 9) & 1) << 5); R = (st >> 1) * 16 + swz / 64; C = (st & 1) * 32 + (swz % 64) / 2; }
__device__ __forceinline__ int perm32(int rho) { const int n = rho >> 4, i = rho & 15; return 8 * (i >> 2) + 4 * n + (i & 3); }
struct Unit { const char* b; int i0, i1, i2, i3; };
template <class Epi, class Sched>
__device__ __forceinline__ void gemm_phase(LAS unsigned char* lds, const char* Abase, int K, const Sched& S, const Epi& E) {
    const int tid = get_tid(lds);
    const int wid = __builtin_amdgcn_readfirstlane(tid >> 6), lane = tid & 63, wr = wid >> 2, wc = wid & 3, fr = lane & 15, fq = lane >> 4;
    const int nt = K / BK;
    unsigned voffB[2];
    { int R0, C0, R1, C1; stage_rc(tid * 16, R0, C0); stage_rc(tid * 16 + 8192, R1, C1);
      const int Rb0 = Epi::PERM ? ((R0 & ~31) + perm32(R0 & 31)) : R0, Rb1 = Epi::PERM ? ((R1 & ~31) + perm32(R1 & 31)) : R1;
      voffB[0] = (unsigned)(Rb0 * K + C0) * 2u; voffB[1] = (unsigned)(Rb1 * K + C1) * 2u; }
    const size_t kstep = (size_t)(BK * 2), hstep = (size_t)HALF * K * 2;
    const unsigned ldsw = (unsigned)wid * 1024u;
    const int aoff = lds_byte(wr * 64 + fr, fq * 8), boff = lds_byte(wc * 32 + fr, fq * 8);
#define PG8_SA(b, h) (((b) * 2 + (h)) * HTB)
#define PG8_SB(b, h) ((4 + (b) * 2 + (h)) * HTB)
#define PG8_STAGE2(bufoff, gbase, v0, v1) do { \
        __builtin_amdgcn_global_load_lds((const unsigned*)((const char*)(gbase) + (v0)), (LAS unsigned*)(lds + (bufoff) + ldsw), 16, 0, 0); \
        __builtin_amdgcn_global_load_lds((const unsigned*)((const char*)(gbase) + (v1)), (LAS unsigned*)(lds + (bufoff) + ldsw + 8192), 16, 0, 0); } while (0)
#define PG8_STAGEB(bufoff, gbase) PG8_STAGE2(bufoff, gbase, voffB[0], voffB[1])
#define PG8_LDA(dst, b, h) do { _Pragma("unroll") for (int m = 0; m < 4; ++m) _Pragma("unroll") for (int k = 0; k < 2; ++k) dst[m][k] = *(const LAS bf16x8*)(lds + PG8_SA(b, h) + aoff + m * 2048 + k * 1024); } while (0)
#define PG8_LDB(dst, b, h) do { _Pragma("unroll") for (int n = 0; n < 2; ++n) _Pragma("unroll") for (int k = 0; k < 2; ++k) dst[n][k] = *(const LAS bf16x8*)(lds + PG8_SB(b, h) + boff + n * 2048 + k * 1024); } while (0)
#define PG8_MMA(ai, bj, At, Bt) do { __builtin_amdgcn_s_setprio(1); _Pragma("unroll") for (int m = 0; m < 4; ++m) _Pragma("unroll") for (int n = 0; n < 2; ++n) _Pragma("unroll") for (int k = 0; k < 2; ++k) \
        acc[ai][bj][m][n] = __builtin_amdgcn_mfma_f32_16x16x32_bf16(Bt[n][k], At[m][k], acc[ai][bj][m][n], 0, 0, 0); __builtin_amdgcn_s_setprio(0); } while (0)
#define PG8_WAIT_V(n) asm volatile("s_waitcnt vmcnt(" #n ")" ::: "memory")
#define PG8_WAIT_L(n) asm volatile("s_waitcnt lgkmcnt(" #n ")" ::: "memory")
#define PG8_BAR __builtin_amdgcn_s_barrier()
#define PG8_SCHED __builtin_amdgcn_sched_barrier(0)
    Unit cur, nxt; int ui = 0;
    if (!S.next(0, cur)) return;
    f32x4 acc[2][2][4][2];
#pragma unroll
    for (int a = 0; a < 2; ++a)
#pragma unroll
        for (int b = 0; b < 2; ++b)
#pragma unroll
            for (int m = 0; m < 4; ++m)
#pragma unroll
                for (int n = 0; n < 2; ++n) acc[a][b][m][n] = (f32x4){0.f, 0.f, 0.f, 0.f};
    bf16x8 At[4][2], B0[2][2], B1[2][2];
    unsigned c0, c1, c2, c3;
    S.aoffs(cur, tid, c0, c1, c2, c3);
    const char* cB = cur.b;
    PG8_STAGEB(PG8_SB(0, 0), cB); PG8_STAGEB(PG8_SB(0, 1), cB + hstep); PG8_STAGE2(PG8_SA(0, 0), Abase, c0, c1); PG8_STAGE2(PG8_SA(0, 1), Abase, c2, c3);
    if (wr == 1) PG8_BAR;
    PG8_WAIT_V(2); PG8_BAR;
    PG8_STAGEB(PG8_SB(1, 0), cB + kstep); PG8_STAGE2(PG8_SA(1, 0), Abase + kstep, c0, c1); PG8_STAGEB(PG8_SB(1, 1), cB + hstep + kstep);
    PG8_WAIT_V(6); PG8_BAR;
#ifdef PROBE_T
    unsigned long long pr0 = 0, pr1 = 0, pr2 = 0, pc0 = 0, pc1 = 0, pc2 = 0;
#endif
    for (;;) {
        const bool has_next = S.next(ui + 1, nxt);
        const char* nB = has_next ? nxt.b : cB;
#ifdef PROBE_T
        if (ui == 1) { pr0 = __builtin_amdgcn_s_memrealtime(); pc0 = __builtin_amdgcn_s_memtime(); }
#endif
        for (int t = 0; t < nt; t += 2) {
            const bool last = (t == nt - 2);
            const char* a1 = Abase + (size_t)(t + 1) * kstep;
            const char* a2 = last ? Abase : Abase + (size_t)(t + 2) * kstep; const char* b2 = last ? nB : cB + (size_t)(t + 2) * kstep;
            const char* a3 = a2 + kstep; const char* b3 = b2 + kstep;
            unsigned n2 = c2, n3 = c3;
            if (last && has_next) S.aoffs(nxt, tid, c0, c1, n2, n3);
            PG8_LDB(B0, 0, 0); PG8_LDB(B1, 0, 1); PG8_SCHED; PG8_LDA(At, 0, 0); PG8_STAGE2(PG8_SA(1, 1), a1, c2, c3);
            c2 = n2; c3 = n3;
            PG8_WAIT_V(8); PG8_WAIT_L(0); PG8_BAR; PG8_MMA(0, 0, At, B0); PG8_MMA(0, 1, At, B1); PG8_BAR; PG8_SCHED;
            PG8_LDA(At, 0, 1); PG8_STAGEB(PG8_SB(0, 0), b2); PG8_STAGEB(PG8_SB(0, 1), b2 + hstep); PG8_STAGE2(PG8_SA(0, 0), a2, c0, c1);
            PG8_WAIT_V(8); PG8_WAIT_L(0); PG8_BAR; PG8_MMA(1, 0, At, B0); PG8_MMA(1, 1, At, B1); PG8_BAR; PG8_SCHED;
            PG8_LDB(B0, 1, 0); PG8_LDB(B1, 1, 1); PG8_SCHED; PG8_LDA(At, 1, 0); PG8_STAGE2(PG8_SA(0, 1), a2, c2, c3);
            PG8_WAIT_V(8); PG8_WAIT_L(0); PG8_BAR; PG8_MMA(0, 0, At, B0); PG8_MMA(0, 1, At, B1); PG8_BAR; PG8_SCHED;
            PG8_LDA(At, 1, 1); PG8_STAGEB(PG8_SB(1, 0), b3); PG8_STAGEB(PG8_SB(1, 1), b3 + hstep); PG8_STAGE2(PG8_SA(1, 0), a3, c0, c1);
            PG8_WAIT_V(8); PG8_WAIT_L(0); PG8_BAR; PG8_MMA(1, 0, At, B0); PG8_MMA(1, 1, At, B1); PG8_BAR; PG8_SCHED;
        }
#ifdef PROBE_T
        if (ui == 1) { pr1 = __builtin_amdgcn_s_memrealtime(); pc1 = __builtin_amdgcn_s_memtime(); }
#endif
        if (wr == 0) PG8_BAR;
        E(acc, cur, wr, wc, fr, fq);
#ifdef PROBE_T
        if (ui == 1) { asm volatile("s_waitcnt vmcnt(0)" ::: "memory"); pr2 = __builtin_amdgcn_s_memrealtime(); pc2 = __builtin_amdgcn_s_memtime();
            if (tid == 0 && S.probe_slot() >= 0) { unsigned long long* pw = S.probe_ptr() + 8 * S.probe_slot(); pw[0] = pr1 - pr0; pw[1] = pr2 - pr1; pw[2] = pc1 - pc0; pw[3] = pc2 - pc1; } }
#endif
        if (!has_next) break;
#pragma unroll
        for (int a = 0; a < 2; ++a)
#pragma unroll
            for (int b = 0; b < 2; ++b)
#pragma unroll
                for (int m = 0; m < 4; ++m)
#pragma unroll
                    for (int n = 0; n < 2; ++n) acc[a][b][m][n] = (f32x4){0.f, 0.f, 0.f, 0.f};
        cur = nxt; cB = nB; ++ui;
        if (wr == 1) PG8_BAR;
    }
    PG8_WAIT_V(0);
    PG8_BAR;
#undef PG8_SA
#undef PG8_SB
#undef PG8_STAGE2
#undef PG8_STAGEB
#undef PG8_LDA
#undef PG8_LDB
#undef PG8_MMA
#undef PG8_WAIT_V
#undef PG8_WAIT_L
#undef PG8_BAR
#undef PG8_SCHED
}
struct TileOrder {
    int nM, nN, nwg, G, c;
    __device__ __forceinline__ void init(int nM_, int nN_, int G_, int c_) { nM = nM_; nN = nN_; nwg = nM * nN; G = G_; c = c_; }
    __device__ __forceinline__ bool tile(int i, int& pm, int& pn) const {
        const long L = (long)i * G + c; if (L >= nwg) return false;
        int wgid = (int)L; { const int q = nwg / 8, r = nwg % 8, xcd = wgid % 8, off = wgid / 8; wgid = (xcd < r ? xcd * (q + 1) : r * (q + 1) + (xcd - r) * q) + off; }
        const int nig = 8 * nN, gid = wgid / nig, fm = gid * 8, gsz = (nM - fm) < 8 ? (nM - fm) : 8;
        pm = fm + ((wgid % nig) % gsz); pn = (wgid % nig) / gsz; return true;
    }
};
}

struct DenseSched {
    pg8::TileOrder o; const char* Bt; int K; unsigned long long* pp; int ps;
    __device__ __forceinline__ int probe_slot() const { return o.c == 0 ? ps : -1; }
    __device__ __forceinline__ unsigned long long* probe_ptr() const { return pp; }
    __device__ __forceinline__ bool next(int i, pg8::Unit& u) const { int pm, pn; if (!o.tile(i, pm, pn)) return false; u.i0 = pm; u.i1 = pn; u.i2 = 0; u.i3 = 0; u.b = Bt + (size_t)pn * 256 * K * 2; return true; }
    __device__ __forceinline__ void aoffs(const pg8::Unit& u, int tid, unsigned& a0, unsigned& a1, unsigned& a2, unsigned& a3) const {
        int R0, C0, R1, C1; pg8::stage_rc(tid * 16, R0, C0); pg8::stage_rc(tid * 16 + 8192, R1, C1);
        const unsigned rb = (unsigned)u.i0 * 256u;
        a0 = ((rb + R0) * (unsigned)K + C0) * 2u; a1 = ((rb + R1) * (unsigned)K + C1) * 2u; a2 = ((rb + 128 + R0) * (unsigned)K + C0) * 2u; a3 = ((rb + 128 + R1) * (unsigned)K + C1) * 2u;
    }
};
struct EpiInProj {
    static constexpr bool PERM = true;
    bf16_t* PROJ;
    __device__ __forceinline__ void operator()(const f32x4 (&acc)[2][2][4][2], const pg8::Unit& u, int wr, int wc, int fr, int fq) const {
        const int row0 = u.i0 * 256 + wr * 64 + fr, col0 = u.i1 * 256 + wc * 32 + 8 * fq;
#pragma unroll
        for (int ai = 0; ai < 2; ++ai)
#pragma unroll
            for (int m = 0; m < 4; ++m) { bf16_t* rowp = PROJ + (size_t)(row0 + ai * 128 + m * 16) * NPROJ + col0;
#pragma unroll
                for (int bj = 0; bj < 2; ++bj) { const f32x4 v0 = acc[ai][bj][m][0], v1 = acc[ai][bj][m][1];
                    u32x4 w; w.x = pk2(v0[0], v0[1]); w.y = pk2(v0[2], v0[3]); w.z = pk2(v1[0], v1[1]); w.w = pk2(v1[2], v1[3]);
                    *(u32x4*)(rowp + bj * 128) = w; } }
    }
};
struct EpiOutProj {
    static constexpr bool PERM = false;
    const float* X; float* H;
    __device__ __forceinline__ void operator()(const f32x4 (&acc)[2][2][4][2], const pg8::Unit& u, int wr, int wc, int fr, int fq) const {
        const int row0 = u.i0 * 256 + wr * 64 + fr, col0 = u.i1 * 256 + wc * 32 + 4 * fq;
#pragma unroll
        for (int ai = 0; ai < 2; ++ai)
#pragma unroll
            for (int m = 0; m < 4; ++m) { const size_t off = (size_t)(row0 + ai * 128 + m * 16) * D + col0;
#pragma unroll
                for (int bj = 0; bj < 2; ++bj)
#pragma unroll
                    for (int n = 0; n < 2; ++n) { const f32x4 x = *(const f32x4*)(X + off + bj * 128 + n * 16); *(f32x4*)(H + off + bj * 128 + n * 16) = x + acc[ai][bj][m][n]; }
                asm volatile("" ::: "memory"); }
    }
};


struct MoeSched {
    const unsigned* cnt; const i32x4* ENT; const char* Bt; int lo, hi, NT  , NROWS  , K, G, c; bool gather; unsigned long long* pp; int ps;
    __device__ __forceinline__ int probe_slot() const { return c == 0 ? ps : -1; }
    __device__ __forceinline__ unsigned long long* probe_ptr() const { return pp; }
    int tot;
    __device__ __forceinline__ void init_tot() { int t = 0; for (int e = lo; e < hi; ++e) t += (((int)cnt[e] + 255) >> 8) * NT; tot = t; }
    __device__ __forceinline__ bool next(int i, pg8::Unit& u) const {
        const int L = i * G + c; if (L >= tot) return false;
        int W; { const int q = tot / 8, r = tot % 8, xcd = L % 8, off = L / 8; W = (xcd < r ? xcd * (q + 1) : r * (q + 1) + (xcd - r) * q) + off; }
        int hb = 0;
        for (int e = lo; e < hi; ++e) { const int te = ((int)cnt[e] + 255) >> 8, ue = te * NT;
            if (W < ue) { const int nig = 8 * NT, gid = W / nig, fm = gid * 8, gsz = (te - fm) < 8 ? (te - fm) : 8, j = W % nig;
                u.i0 = e; u.i1 = fm + j % gsz; u.i2 = j / gsz; u.i3 = hb; u.b = Bt + ((size_t)e * NROWS + (size_t)u.i2 * 256) * K * 2; return true; }
            W -= ue; hb += te * 256; }
        return false;
    }
    __device__ __forceinline__ void aoffs(const pg8::Unit& u, int tid, unsigned& a0, unsigned& a1, unsigned& a2, unsigned& a3) const {
        int R0, C0, R1, C1; pg8::stage_rc(tid * 16, R0, C0); pg8::stage_rc(tid * 16 + 8192, R1, C1);
        if (gather) {
            const int ce = (int)cnt[u.i0], p0 = u.i1 * 256; const i32x4* en = ENT + (size_t)u.i0 * T;
            const int t0 = p0 + R0 < ce ? en[p0 + R0].x : 0, t1 = p0 + R1 < ce ? en[p0 + R1].x : 0, t2 = p0 + 128 + R0 < ce ? en[p0 + 128 + R0].x : 0, t3 = p0 + 128 + R1 < ce ? en[p0 + 128 + R1].x : 0;
            a0 = ((unsigned)t0 * 1024u + C0) * 2u; a1 = ((unsigned)t1 * 1024u + C1) * 2u; a2 = ((unsigned)t2 * 1024u + C0) * 2u; a3 = ((unsigned)t3 * 1024u + C1) * 2u;
        } else {
            const unsigned rb = (unsigned)(u.i3 + u.i1 * 256);
            a0 = ((rb + R0) * 1024u + C0) * 2u; a1 = ((rb + R1) * 1024u + C1) * 2u; a2 = ((rb + 128 + R0) * 1024u + C0) * 2u; a3 = ((rb + 128 + R1) * 1024u + C1) * 2u;
        }
    }
};
struct EpiG1 {
    static constexpr bool PERM = true;
    bf16_t* HID; const i32x4* ENT; const unsigned* cnt; const float* bgu;
    __device__ __forceinline__ void operator()(const f32x4 (&acc)[2][2][4][2], const pg8::Unit& u, int wr, int wc, int fr, int fq) const {
        const int e = u.i0, ce = (int)cnt[e], hc = u.i2 * 128 + wc * 32 + 8 * fq; const i32x4* en = ENT + (size_t)e * T;
        float rs[8];
#pragma unroll
        for (int q = 0; q < 8; ++q) { const int pos = u.i1 * 256 + (q >> 2) * 128 + wr * 64 + (q & 3) * 16 + fr; rs[q] = pos < ce ? __int_as_float(en[pos].y) : 0.f; }
        const float* bg = bgu + (size_t)e * 2 * DFF + hc;
        const f32x4 bg0 = *(const f32x4*)bg, bg1 = *(const f32x4*)(bg + 4), bu0 = *(const f32x4*)(bg + DFF), bu1 = *(const f32x4*)(bg + DFF + 4);
#pragma unroll
        for (int ai = 0; ai < 2; ++ai)
#pragma unroll
            for (int m = 0; m < 4; ++m) { const int pos = u.i1 * 256 + ai * 128 + wr * 64 + m * 16 + fr;
                const float rstd = rs[ai * 4 + m];
                float hv[8];
#pragma unroll
                for (int q = 0; q < 8; ++q) { const int n = q >> 2, j = q & 3; float g = acc[ai][0][m][n][j] * rstd + (n ? bg1[j] : bg0[j]), up = acc[ai][1][m][n][j] * rstd + (n ? bu1[j] : bu0[j]);
                    g = fminf(g, 7.0f); up = fminf(fmaxf(up, -7.0f), 7.0f); hv[q] = (up + 1.0f) * g * sigmoidf_(1.702f * g); }
                u32x4 w; w.x = pk2(hv[0], hv[1]); w.y = pk2(hv[2], hv[3]); w.z = pk2(hv[4], hv[5]); w.w = pk2(hv[6], hv[7]);
                *(u32x4*)(HID + (size_t)(u.i3 + pos) * DFF + hc) = w; }
    }
};
struct EpiG2 {
    static constexpr bool PERM = true;
    bf16_t* OUT01; bf16_t* Y23; const i32x4* ENT; const unsigned* cnt; const float* bdn;
    __device__ __forceinline__ void operator()(const f32x4 (&acc)[2][2][4][2], const pg8::Unit& u, int wr, int wc, int fr, int fq) const {
        const int e = u.i0, ce = (int)cnt[e], col0 = u.i2 * 256 + wc * 32 + 8 * fq; const i32x4* en = ENT + (size_t)e * T;
        int tk[8], kk[8]; float gt[8];
#pragma unroll
        for (int q = 0; q < 8; ++q) { const int pos = u.i1 * 256 + (q >> 2) * 128 + wr * 64 + (q & 3) * 16 + fr; const i32x4 v = pos < ce ? en[pos] : (i32x4){-1, 0, 0, 0}; tk[q] = v.x; kk[q] = v.z; gt[q] = __int_as_float(v.w); }
        const float* bd = bdn + (size_t)e * D + col0;
        f32x4 b[2][2];
#pragma unroll
        for (int bj = 0; bj < 2; ++bj) { b[bj][0] = *(const f32x4*)(bd + bj * 128); b[bj][1] = *(const f32x4*)(bd + bj * 128 + 4); }
#pragma unroll
        for (int ai = 0; ai < 2; ++ai)
#pragma unroll
            for (int m = 0; m < 4; ++m) { const int q = ai * 4 + m;
                if (tk[q] >= 0) { const float gate = gt[q];
                    bf16_t* dst = (kk[q] < 2 ? OUT01 : Y23) + (size_t)tk[q] * 2048 + (kk[q] & 1) * 1024 + col0;
#pragma unroll
                    for (int bj = 0; bj < 2; ++bj) { const f32x4 y0 = (acc[ai][bj][m][0] + b[bj][0]) * gate, y1 = (acc[ai][bj][m][1] + b[bj][1]) * gate;
                        u32x4 w; w.x = pk2(y0[0], y0[1]); w.y = pk2(y0[2], y0[3]); w.z = pk2(y1[0], y1[1]); w.w = pk2(y1[2], y1[3]);
                        *(u32x4*)(dst + bj * 128) = w; } } }
    }
};

constexpr int ML_QS = 0, ML_KS = 17408, ML_VS = 34816, ML_PS = 52224, ML_CT = 61440, ML_DENP = 96256, ML_DI = 96768, ML_SSQP = 97024, ML_NARR = 99072, ML_END = 99584;
__device__ __forceinline__ bf16x8 tr_pair(unsigned a0, unsigned a1) {
    u32x2 lo, hi; asm volatile("ds_read_b64_tr_b16 %0, %2\n\tds_read_b64_tr_b16 %1, %3\n\ts_waitcnt lgkmcnt(0)" : "=&v"(lo), "=&v"(hi) : "v"(a0), "v"(a1) : "memory");
    u32x4 r; r.x = lo.x; r.y = lo.y; r.z = hi.x; r.w = hi.y; return __builtin_bit_cast(bf16x8, r);
}
#define TR8(dst, base, OFF0, STEP) do { u32x2 _l[8], _h[8]; \
    asm volatile("ds_read_b64_tr_b16 %0, %16 offset:%17\n\tds_read_b64_tr_b16 %1, %16 offset:%17+1088\n\tds_read_b64_tr_b16 %2, %16 offset:%17+%18\n\tds_read_b64_tr_b16 %3, %16 offset:%17+%18+1088\n\t" \
                 "ds_read_b64_tr_b16 %4, %16 offset:%17+2*%18\n\tds_read_b64_tr_b16 %5, %16 offset:%17+2*%18+1088\n\tds_read_b64_tr_b16 %6, %16 offset:%17+3*%18\n\tds_read_b64_tr_b16 %7, %16 offset:%17+3*%18+1088\n\t" \
                 "ds_read_b64_tr_b16 %8, %16 offset:%17+4*%18\n\tds_read_b64_tr_b16 %9, %16 offset:%17+4*%18+1088\n\tds_read_b64_tr_b16 %10, %16 offset:%17+5*%18\n\tds_read_b64_tr_b16 %11, %16 offset:%17+5*%18+1088\n\t" \
                 "ds_read_b64_tr_b16 %12, %16 offset:%17+6*%18\n\tds_read_b64_tr_b16 %13, %16 offset:%17+6*%18+1088\n\tds_read_b64_tr_b16 %14, %16 offset:%17+7*%18\n\tds_read_b64_tr_b16 %15, %16 offset:%17+7*%18+1088\n\ts_waitcnt lgkmcnt(0)" \
                 : "=&v"(_l[0]), "=&v"(_h[0]), "=&v"(_l[1]), "=&v"(_h[1]), "=&v"(_l[2]), "=&v"(_h[2]), "=&v"(_l[3]), "=&v"(_h[3]), "=&v"(_l[4]), "=&v"(_h[4]), "=&v"(_l[5]), "=&v"(_h[5]), "=&v"(_l[6]), "=&v"(_h[6]), "=&v"(_l[7]), "=&v"(_h[7]) \
                 : "v"(base), "i"(OFF0), "i"(STEP) : "memory"); \
    _Pragma("unroll") for (int _p = 0; _p < 8; ++_p) { u32x4 _r; _r.x = _l[_p].x; _r.y = _l[_p].y; _r.z = _h[_p].x; _r.w = _h[_p].y; dst[_p] = __builtin_bit_cast(bf16x8, _r); } } while (0)
template <int CTRL, int RM> __device__ __forceinline__ float dpp_x(float v, float ident) {
    return __builtin_bit_cast(float, __builtin_amdgcn_update_dpp(__builtin_bit_cast(int, ident), __builtin_bit_cast(int, v), CTRL, RM, 0xf, false));
}
__device__ __forceinline__ float wave_scan_add(float s) {
    s += dpp_x<0x111, 0xf>(s, 0.f); s += dpp_x<0x112, 0xf>(s, 0.f); s += dpp_x<0x114, 0xf>(s, 0.f); s += dpp_x<0x118, 0xf>(s, 0.f);
    s += dpp_x<0x142, 0xa>(s, 0.f); s += dpp_x<0x143, 0xc>(s, 0.f); return s;
}
__device__ __forceinline__ float wave_scan_max(float s) {
    const float ni = -INFINITY;
    s = fmaxf(s, dpp_x<0x111, 0xf>(s, ni)); s = fmaxf(s, dpp_x<0x112, 0xf>(s, ni)); s = fmaxf(s, dpp_x<0x114, 0xf>(s, ni)); s = fmaxf(s, dpp_x<0x118, 0xf>(s, ni));
    s = fmaxf(s, dpp_x<0x142, 0xa>(s, ni)); s = fmaxf(s, dpp_x<0x143, 0xc>(s, ni)); return s;
}
__device__ __forceinline__ void unpack16(const u32x4& a, const u32x4& b, float (&f)[16]) {
    const unsigned w[8] = {a.x, a.y, a.z, a.w, b.x, b.y, b.z, b.w};
#pragma unroll
    for (int i = 0; i < 8; ++i) { f[2 * i] = bflo(w[i]); f[2 * i + 1] = bfhi(w[i]); }
}
__device__ __forceinline__ void mlstm_phase(const Params& p, LAS unsigned char* lds, int bh) {
    const int tid = get_tid(lds);
    const int lane = tid & 63, w = __builtin_amdgcn_readfirstlane(tid >> 6), fr = lane & 15, fq = lane >> 4, tq = (lane & 15) >> 2, tp = lane & 3;
    const int b = bh >> 2, h = bh & 3, srow = tid >> 3, sseg = tid & 7;
    const bf16_t* PROJ = (const bf16_t*)(p.ws + WS_R2); const float* GATES = (const float*)(p.ws + WS_GATES); bf16_t* MIX = (bf16_t*)(p.ws + WS_R1);
    LAS float* DENP = (LAS float*)(lds + ML_DENP); LAS float* DI = (LAS float*)(lds + ML_DI); LAS float* SSQP = (LAS float*)(lds + ML_SSQP); LAS float* NARR = (LAS float*)(lds + ML_NARR);
    const unsigned ldsb = (unsigned)(size_t)lds;
    for (int i = tid; i < 34816 / 16; i += 512) *(LAS u32x4*)(lds + ML_CT + 16 * i) = (u32x4){0u, 0u, 0u, 0u};
    if (tid < 128) NARR[tid] = 0.f;
    f32x4 c3[8];
#pragma unroll
    for (int i = 0; i < 8; ++i) c3[i] = (f32x4){0.f, 0.f, 0.f, 0.f};
    f32x4 nacc = (f32x4){0.f, 0.f, 0.f, 0.f}; float mprev = 0.f;
    bf16x8 ones;
#pragma unroll
    for (int jj = 0; jj < 8; ++jj) ones[jj] = (short)0x3F80;
    float ig = GATES[((size_t)b * SEQ + lane) * 8 + h], lf = GATES[((size_t)b * SEQ + lane) * 8 + 4 + h];
    u32x4 rq0, rq1, rk0, rk1, rv0, rv1;
    { const bf16_t* pr = PROJ + ((size_t)b * SEQ + srow) * NPROJ + h * 128 + 16 * sseg;
      rq0 = *(const u32x4*)pr; rq1 = *(const u32x4*)(pr + 8); rk0 = *(const u32x4*)(pr + 512); rk1 = *(const u32x4*)(pr + 520); rv0 = *(const u32x4*)(pr + 1024); rv1 = *(const u32x4*)(pr + 1032); }
    __syncthreads();
    for (int c = 0; c < SEQ / 64; ++c) {
        const size_t row0 = (size_t)b * SEQ + (size_t)c * 64;
        const float bc = wave_scan_add(lf), u = ig - bc, cm = wave_scan_max(u);
        const float Mt = fmaxf(cm, mprev), M63 = __builtin_bit_cast(float, __builtin_amdgcn_readlane(__builtin_bit_cast(int, Mt), 63)), bL = __builtin_bit_cast(float, __builtin_amdgcn_readlane(__builtin_bit_cast(int, bc), 63));
        if (c + 1 < SEQ / 64) { ig = GATES[(row0 + 64 + lane) * 8 + h]; lf = GATES[(row0 + 64 + lane) * 8 + 4 + h]; }
        const float sq = fexp(M63 - Mt), sk = fexp(u - M63), fl = fexp(-bc - Mt), decay = fexp(mprev - M63);
        mprev = bL + M63;
        { const float sqv = __shfl(sq, srow), skv = __shfl(sk, srow);
          float f[16]; unpack16(rq0, rq1, f);
          float part = 0.f;
#pragma unroll
          for (int j = 0; j < 16; ++j) { f[j] *= sqv; part += f[j] * NARR[16 * sseg + j]; }
          part += __shfl_xor(part, 1); part += __shfl_xor(part, 2); part += __shfl_xor(part, 4);
          if (sseg == 0) DI[srow] = decay * part;
          u32x4 o0, o1; o0.x = pk2(f[0], f[1]); o0.y = pk2(f[2], f[3]); o0.z = pk2(f[4], f[5]); o0.w = pk2(f[6], f[7]); o1.x = pk2(f[8], f[9]); o1.y = pk2(f[10], f[11]); o1.z = pk2(f[12], f[13]); o1.w = pk2(f[14], f[15]);
          *(LAS u32x4*)(lds + ML_QS + srow * 272 + sseg * 32) = o0; *(LAS u32x4*)(lds + ML_QS + srow * 272 + sseg * 32 + 16) = o1;
          unpack16(rk0, rk1, f);
#pragma unroll
          for (int j = 0; j < 16; ++j) f[j] *= skv;
          o0.x = pk2(f[0], f[1]); o0.y = pk2(f[2], f[3]); o0.z = pk2(f[4], f[5]); o0.w = pk2(f[6], f[7]); o1.x = pk2(f[8], f[9]); o1.y = pk2(f[10], f[11]); o1.z = pk2(f[12], f[13]); o1.w = pk2(f[14], f[15]);
          *(LAS u32x4*)(lds + ML_KS + srow * 272 + sseg * 32) = o0; *(LAS u32x4*)(lds + ML_KS + srow * 272 + sseg * 32 + 16) = o1;
          *(LAS u32x4*)(lds + ML_VS + srow * 272 + sseg * 32) = rv0; *(LAS u32x4*)(lds + ML_VS + srow * 272 + sseg * 32 + 16) = rv1; }
        if (c + 1 < SEQ / 64) { const bf16_t* pr = PROJ + (row0 + 64 + srow) * NPROJ + h * 128 + 16 * sseg;
          rq0 = *(const u32x4*)pr; rq1 = *(const u32x4*)(pr + 8); rk0 = *(const u32x4*)(pr + 512); rk1 = *(const u32x4*)(pr + 520); rv0 = *(const u32x4*)(pr + 1024); rv1 = *(const u32x4*)(pr + 1032); }
        u32x2 og[4];
#pragma unroll
        for (int ti = 0; ti < 4; ++ti) og[ti] = *(const u32x2*)(PROJ + (row0 + 16 * ti + fr) * NPROJ + 1536 + h * 128 + 16 * w + 4 * fq);
        __syncthreads();
        { const int ti = w >> 1; float dsum = 0.f;
#pragma unroll
          for (int jj = 0; jj < 2; ++jj) { const int sj = 2 * (w & 1) + jj;
            f32x4 a = (f32x4){0.f, 0.f, 0.f, 0.f};
            if (sj <= ti) {
#pragma unroll
                for (int ks = 0; ks < 4; ++ks) { const bf16x8 ka = *(const LAS bf16x8*)(lds + ML_KS + (16 * sj + fr) * 272 + (32 * ks + 8 * fq) * 2), qb = *(const LAS bf16x8*)(lds + ML_QS + (16 * ti + fr) * 272 + (32 * ks + 8 * fq) * 2);
                    a = __builtin_amdgcn_mfma_f32_16x16x32_bf16(ka, qb, a, 0, 0, 0); }
                const int t = 16 * ti + fr, s0 = 16 * sj + 4 * fq;
#pragma unroll
                for (int r = 0; r < 4; ++r) { if (s0 + r > t) a[r] = 0.f; dsum += a[r]; }
            }
            u32x2 pw; pw.x = pk2(a[0], a[1]); pw.y = pk2(a[2], a[3]);
            *(LAS u32x2*)(lds + ML_PS + (16 * ti + fr) * 144 + (16 * sj + 4 * fq) * 2) = pw; }
          dsum += __shfl_xor(dsum, 16); dsum += __shfl_xor(dsum, 32);
          if (fq == 0) DENP[(w & 1) * 64 + 16 * ti + fr] = dsum; }
        __syncthreads();
        bf16x8 av[2];
        { u32x2 l0, h0, l1, h1; const unsigned a0 = ldsb + ML_VS + (8 * fq + tq) * 272 + (16 * w + 4 * tp) * 2;
          asm volatile("ds_read_b64_tr_b16 %0, %4\n\tds_read_b64_tr_b16 %1, %4 offset:1088\n\tds_read_b64_tr_b16 %2, %4 offset:8704\n\tds_read_b64_tr_b16 %3, %4 offset:9792\n\ts_waitcnt lgkmcnt(0)"
                       : "=&v"(l0), "=&v"(h0), "=&v"(l1), "=&v"(h1) : "v"(a0) : "memory");
          u32x4 r; r.x = l0.x; r.y = l0.y; r.z = h0.x; r.w = h0.y; av[0] = __builtin_bit_cast(bf16x8, r); r.x = l1.x; r.y = l1.y; r.z = h1.x; r.w = h1.y; av[1] = __builtin_bit_cast(bf16x8, r); }
        bf16x8 ac[4];
#pragma unroll
        for (int ks = 0; ks < 4; ++ks) ac[ks] = *(const LAS bf16x8*)(lds + ML_CT + (16 * w + fr) * 272 + (32 * ks + 8 * fq) * 2);
        float xs[4][4];
#pragma unroll
        for (int ti = 0; ti < 4; ++ti) { f32x4 a = (f32x4){0.f, 0.f, 0.f, 0.f}, a2 = (f32x4){0.f, 0.f, 0.f, 0.f};
#pragma unroll
            for (int ks = 0; ks < 2; ++ks) { const bf16x8 pb = *(const LAS bf16x8*)(lds + ML_PS + (16 * ti + fr) * 144 + (32 * ks + 8 * fq) * 2); a = __builtin_amdgcn_mfma_f32_16x16x32_bf16(av[ks], pb, a, 0, 0, 0); }
#pragma unroll
            for (int ks = 0; ks < 4; ++ks) { const bf16x8 qb = *(const LAS bf16x8*)(lds + ML_QS + (16 * ti + fr) * 272 + (32 * ks + 8 * fq) * 2); a2 = __builtin_amdgcn_mfma_f32_16x16x32_bf16(ac[ks], qb, a2, 0, 0, 0); }
            a = a + a2 * decay;
            const int t = 16 * ti + fr; const float den = DENP[t] + DENP[64 + t] + DI[t], flt = __shfl(fl, t), inv = frcp(fmaxf(fabsf(den), flt));
            xs[ti][0] = sigmoidf_(bflo(og[ti].x)) * a[0] * inv; xs[ti][1] = sigmoidf_(bfhi(og[ti].x)) * a[1] * inv; xs[ti][2] = sigmoidf_(bflo(og[ti].y)) * a[2] * inv; xs[ti][3] = sigmoidf_(bfhi(og[ti].y)) * a[3] * inv;
            float ss = xs[ti][0] * xs[ti][0] + xs[ti][1] * xs[ti][1] + xs[ti][2] * xs[ti][2] + xs[ti][3] * xs[ti][3];
            ss += __shfl_xor(ss, 16); ss += __shfl_xor(ss, 32);
            if (fq == 0) SSQP[w * 64 + t] = ss; }
        { const unsigned kb = ldsb + ML_KS + (8 * fq + tq) * 272 + 4 * tp * 2;
          bf16x8 k0[8], k1[8];
          TR8(k0, kb, 0, 32); TR8(k1, kb, 8704, 32);
#pragma unroll
          for (int i = 0; i < 8; ++i) { c3[i] = c3[i] * decay;
              c3[i] = __builtin_amdgcn_mfma_f32_16x16x32_bf16(k0[i], av[0], c3[i], 0, 0, 0); c3[i] = __builtin_amdgcn_mfma_f32_16x16x32_bf16(k1[i], av[1], c3[i], 0, 0, 0);
              if (i == w) { nacc = nacc * decay; nacc = __builtin_amdgcn_mfma_f32_16x16x32_bf16(k0[i], ones, nacc, 0, 0, 0); nacc = __builtin_amdgcn_mfma_f32_16x16x32_bf16(k1[i], ones, nacc, 0, 0, 0); } }
          if (fr == 0) *(LAS f32x4*)(NARR + 16 * w + 4 * fq) = nacc; }
        __syncthreads();
#pragma unroll
        for (int ti = 0; ti < 4; ++ti) { const int t = 16 * ti + fr; float s = 0.f;
#pragma unroll
            for (int ww = 0; ww < 8; ++ww) s += SSQP[ww * 64 + t];
            const float rs = frsq(s * (1.0f / 128.f) + EPS);
            u32x2 o; o.x = pk2(xs[ti][0] * rs, xs[ti][1] * rs); o.y = pk2(xs[ti][2] * rs, xs[ti][3] * rs);
            *(u32x2*)(MIX + (row0 + t) * D + h * 128 + 16 * w + 4 * fq) = o; }
#pragma unroll
        for (int i = 0; i < 8; ++i) { u32x2 cw; cw.x = pk2(c3[i][0], c3[i][1]); cw.y = pk2(c3[i][2], c3[i][3]);
            *(LAS u32x2*)(lds + ML_CT + (16 * w + fr) * 272 + (16 * i + 4 * fq) * 2) = cw; }
    }
    __syncthreads();
}


constexpr int RL_XC = 0, RL_RG = 34816, RL_OUT = 69632, RL_CW = 104448, RL_CARRY = 114688, RL_SSQP = 116736, RL_END = 124928;
template <int S> __device__ __forceinline__ float dpp_shr(float v, float ident) {
    return __builtin_bit_cast(float, __builtin_amdgcn_update_dpp(__builtin_bit_cast(int, ident), __builtin_bit_cast(int, v), 0x110 + S, 0xf, 0xf, false));
}
__device__ __forceinline__ float row_last(float v) { return __builtin_bit_cast(float, __builtin_amdgcn_ds_swizzle(__builtin_bit_cast(int, v), 0x1F0)); }
template <bool FINAL>
__device__ __forceinline__ void rglru_item(const Params& p, LAS unsigned char* lds, int item) {
    const int tid = get_tid(lds);
    const int lane = tid & 63, w = __builtin_amdgcn_readfirstlane(tid >> 6), fr = lane & 15, fq = lane >> 4, srow = tid >> 3, sseg = tid & 7;
    const int b = item >> 4, chunk = item & 15;
    const bf16_t* PROJ = (const bf16_t*)(p.ws + WS_R2); bf16_t* MIX = (bf16_t*)(p.ws + WS_R1); float* SUMM = (float*)(p.ws + WS_SUMM); const bf16_t* WRI = (const bf16_t*)(p.ws + WS_WRI);
    LAS float* CW = (LAS float*)(lds + RL_CW); LAS float* CARRY = (LAS float*)(lds + RL_CARRY); LAS float* SSQP = (LAS float*)(lds + RL_SSQP);
    const size_t tok0 = (size_t)b * SEQ + (size_t)chunk * 256;
    if (FINAL) GSTAMP(p.ws, tid, 0);
    for (int i = tid; i < 2560; i += 512) CW[i] = i < 2048 ? p.in[I_CW][i] : p.in[I_CB][i - 2048];
    if (FINAL) {
        float carry = 0.f;
        for (int cc = 0; cc < chunk; ++cc) { const float2 ab = *(const float2*)(SUMM + ((size_t)(b * 16 + cc) * 512 + tid) * 2); carry = ab.x * carry + ab.y; }
        CARRY[tid] = carry;
        for (int i = tid; i < 2048; i += 512) SSQP[i] = 0.f;
    }
    u32x4 rx[8], rgr[2];
    auto prefetch = [&](int sidx) {
        const int hd = sidx >> 2, step = sidx & 3; const int tl = step * 64 + srow; const size_t tok = tok0 + tl; const int tseq = chunk * 256 + tl;
        const bf16_t* px = PROJ + tok * NPROJ + 2048 + hd * 128 + 16 * sseg;
#pragma unroll
        for (int j = 0; j < 4; ++j) { if (tseq - 3 + j >= 0) { rx[2 * j] = *(const u32x4*)(px + (ptrdiff_t)(j - 3) * NPROJ); rx[2 * j + 1] = *(const u32x4*)(px + (ptrdiff_t)(j - 3) * NPROJ + 8); } else { rx[2 * j] = (u32x4){0u, 0u, 0u, 0u}; rx[2 * j + 1] = (u32x4){0u, 0u, 0u, 0u}; } }
        if (FINAL) { rgr[0] = *(const u32x4*)(px + 512); rgr[1] = *(const u32x4*)(px + 520); }
    };
    prefetch(0);
    __syncthreads();
    if (FINAL) GSTAMP(p.ws, tid, 1);
    float hc[4], ptot[4], brv[4], biv[4], spv[4];
    bf16x8 br[4], bi[4], bid;
    for (int sidx = 0; sidx < 16; ++sidx) {
        const int hd = sidx >> 2, step = sidx & 3, buf = sidx & 1;
        if (step == 0) {
#pragma unroll
            for (int ks = 0; ks < 4; ++ks) { br[ks] = *(const bf16x8*)(WRI + ((size_t)(hd * 256 + 16 * w + fr) * 128 + 32 * ks + 8 * fq)); bi[ks] = *(const bf16x8*)(WRI + ((size_t)(hd * 256 + 128 + 16 * w + fr) * 128 + 32 * ks + 8 * fq)); }
#pragma unroll
            for (int jj = 0; jj < 8; ++jj) bid[jj] = (8 * fq + jj == 16 * (w & 1) + fr) ? (short)0x3F80 : (short)0;
#pragma unroll
            for (int r = 0; r < 4; ++r) { const int ch = hd * 128 + 16 * w + 4 * fq + r; brv[r] = p.in[I_BR][ch]; biv[r] = p.in[I_BI][ch]; spv[r] = log1pf(fexp(-p.in[I_LAM][ch]));
                hc[r] = FINAL ? CARRY[ch] : 0.f; ptot[r] = 1.f; }
        }
        { float xc[16];
          const LAS f32x4* cb4 = (const LAS f32x4*)(CW + 2048 + hd * 128 + 16 * sseg);
#pragma unroll
          for (int q = 0; q < 4; ++q) { const f32x4 v = cb4[q]; xc[4 * q] = v.x; xc[4 * q + 1] = v.y; xc[4 * q + 2] = v.z; xc[4 * q + 3] = v.w; }
#pragma unroll
          for (int j = 0; j < 4; ++j) { float xf[16]; unpack16(rx[2 * j], rx[2 * j + 1], xf); const LAS f32x4* cw4 = (const LAS f32x4*)(CW + j * 512 + hd * 128 + 16 * sseg);
#pragma unroll
              for (int q = 0; q < 4; ++q) { const f32x4 v = cw4[q]; xc[4 * q] += v.x * xf[4 * q]; xc[4 * q + 1] += v.y * xf[4 * q + 1]; xc[4 * q + 2] += v.z * xf[4 * q + 2]; xc[4 * q + 3] += v.w * xf[4 * q + 3]; } }
          u32x4 o0, o1; o0.x = pk2(xc[0], xc[1]); o0.y = pk2(xc[2], xc[3]); o0.z = pk2(xc[4], xc[5]); o0.w = pk2(xc[6], xc[7]); o1.x = pk2(xc[8], xc[9]); o1.y = pk2(xc[10], xc[11]); o1.z = pk2(xc[12], xc[13]); o1.w = pk2(xc[14], xc[15]);
          *(LAS u32x4*)(lds + RL_XC + buf * 17408 + srow * 272 + sseg * 32) = o0; *(LAS u32x4*)(lds + RL_XC + buf * 17408 + srow * 272 + sseg * 32 + 16) = o1;
          if (FINAL) { *(LAS u32x4*)(lds + RL_RG + buf * 17408 + srow * 272 + sseg * 32) = rgr[0]; *(LAS u32x4*)(lds + RL_RG + buf * 17408 + srow * 272 + sseg * 32 + 16) = rgr[1]; } }
        if (sidx + 1 < 16) prefetch(sidx + 1);
        __syncthreads();
        if (FINAL && sidx > 0) { const int ps = sidx - 1, phd = ps >> 2, pstep = ps & 3, pbuf = ps & 1;
            const u32x4 v0 = *(const LAS u32x4*)(lds + RL_OUT + pbuf * 17408 + srow * 272 + sseg * 32), v1 = *(const LAS u32x4*)(lds + RL_OUT + pbuf * 17408 + srow * 272 + sseg * 32 + 16);
            bf16_t* dst = MIX + (tok0 + pstep * 64 + srow) * D + 512 + phd * 128 + 16 * sseg; *(u32x4*)dst = v0; *(u32x4*)(dst + 8) = v1; }
        const int ksx = w >> 1;
#pragma unroll
        for (int m = 0; m < 4; ++m) {
            f32x4 ar = (f32x4){0.f, 0.f, 0.f, 0.f}, ai = ar, ax = ar, ag = ar;
#pragma unroll
            for (int ks = 0; ks < 4; ++ks) { const bf16x8 a = *(const LAS bf16x8*)(lds + RL_XC + buf * 17408 + (16 * m + fr) * 272 + (32 * ks + 8 * fq) * 2);
                ar = __builtin_amdgcn_mfma_f32_16x16x32_bf16(br[ks], a, ar, 0, 0, 0); ai = __builtin_amdgcn_mfma_f32_16x16x32_bf16(bi[ks], a, ai, 0, 0, 0); }
            { const bf16x8 a = *(const LAS bf16x8*)(lds + RL_XC + buf * 17408 + (16 * m + fr) * 272 + (32 * ksx + 8 * fq) * 2); ax = __builtin_amdgcn_mfma_f32_16x16x32_bf16(bid, a, ax, 0, 0, 0); }
            if (FINAL) { const bf16x8 a = *(const LAS bf16x8*)(lds + RL_RG + buf * 17408 + (16 * m + fr) * 272 + (32 * ksx + 8 * fq) * 2); ag = __builtin_amdgcn_mfma_f32_16x16x32_bf16(bid, a, ag, 0, 0, 0); }
            float P[4], H[4];
#pragma unroll
            for (int r = 0; r < 4; ++r) { const float rr = sigmoidf_(ar[r] + brv[r]), ii = sigmoidf_(ai[r] + biv[r]), a = fexp(-8.0f * rr * spv[r]);
                P[r] = a; H[r] = fsqrt(fmaxf(1.0f - a * a, 0.f)) * (ii * ax[r]); }
#pragma unroll
            for (int r = 0; r < 4; ++r) { { const float Pp = dpp_shr<1>(P[r], 1.f), Hp = dpp_shr<1>(H[r], 0.f); H[r] = P[r] * Hp + H[r]; P[r] = P[r] * Pp; }
                { const float Pp = dpp_shr<2>(P[r], 1.f), Hp = dpp_shr<2>(H[r], 0.f); H[r] = P[r] * Hp + H[r]; P[r] = P[r] * Pp; }
                { const float Pp = dpp_shr<4>(P[r], 1.f), Hp = dpp_shr<4>(H[r], 0.f); H[r] = P[r] * Hp + H[r]; P[r] = P[r] * Pp; }
                { const float Pp = dpp_shr<8>(P[r], 1.f), Hp = dpp_shr<8>(H[r], 0.f); H[r] = P[r] * Hp + H[r]; P[r] = P[r] * Pp; } }
            float gq[4]; float ss = 0.f;
#pragma unroll
            for (int r = 0; r < 4; ++r) { const float hv = H[r] + P[r] * hc[r];
                if (FINAL) { gq[r] = gelu_tanh(ag[r]) * hv; ss += gq[r] * gq[r]; } else ptot[r] *= row_last(P[r]);
                hc[r] = row_last(hv); }
            if (FINAL) {
                u32x2 ow; ow.x = pk2(gq[0], gq[1]); ow.y = pk2(gq[2], gq[3]);
                *(LAS u32x2*)(lds + RL_OUT + buf * 17408 + (16 * m + fr) * 272 + (16 * w + 4 * fq) * 2) = ow;
                ss += __shfl_xor(ss, 16); ss += __shfl_xor(ss, 32);
                if (fq == 0) SSQP[w * 256 + step * 64 + 16 * m + fr] += ss;
            }
        }
        if (!FINAL && step == 3 && fr == 0) {
#pragma unroll
            for (int r = 0; r < 4; ++r) *(float2*)(SUMM + ((size_t)(b * 16 + chunk) * 512 + hd * 128 + 16 * w + 4 * fq + r) * 2) = make_float2(ptot[r], hc[r]); }
    }
    if (FINAL) {
        __syncthreads();
        GSTAMP(p.ws, tid, 2);
        { const int ps = 15, phd = 3, pstep = 3, pbuf = ps & 1;
          const u32x4 v0 = *(const LAS u32x4*)(lds + RL_OUT + pbuf * 17408 + srow * 272 + sseg * 32), v1 = *(const LAS u32x4*)(lds + RL_OUT + pbuf * 17408 + srow * 272 + sseg * 32 + 16);
          bf16_t* dst = MIX + (tok0 + pstep * 64 + srow) * D + 512 + phd * 128 + 16 * sseg; *(u32x4*)dst = v0; *(u32x4*)(dst + 8) = v1; }
        asm volatile("s_waitcnt vmcnt(0)" ::: "memory");
        __syncthreads();
        for (int i = tid; i < 256 * 64; i += 512) { const int tl = i >> 6, c8 = i & 63; float s = 0.f;
#pragma unroll
            for (int ww = 0; ww < 8; ++ww) s += SSQP[ww * 256 + tl];
            const float rs = frsq(s * (1.0f / 512.f) + EPS);
            u32x4* ptr = (u32x4*)(MIX + (tok0 + tl) * D + 512 + c8 * 8); u32x4 v = *ptr;
            v.x = pk2(bflo(v.x) * rs, bfhi(v.x) * rs); v.y = pk2(bflo(v.y) * rs, bfhi(v.y) * rs); v.z = pk2(bflo(v.z) * rs, bfhi(v.z) * rs); v.w = pk2(bflo(v.w) * rs, bfhi(v.w) * rs);
            *ptr = v; }
    }
    __syncthreads();
    if (FINAL) GSTAMP(p.ws, tid, 3);
}

constexpr int RT_WR = 0, RT_SELE = 147456, RT_SELG = RT_SELE + 4096, RT_RSTD = RT_SELG + 4096, RT_HIST = RT_RSTD + 1024, RT_BASE = RT_HIST + 128, RT_LDS = RT_BASE + 128;
__device__ __forceinline__ void routing_block(const Params& p, LAS unsigned char* lds, int tb) {
    const int tid = get_tid(lds), lane = tid & 63, wave = tid >> 6;
    LAS float* WRl = (LAS float*)(lds + RT_WR); LAS int* selE = (LAS int*)(lds + RT_SELE); LAS float* selG = (LAS float*)(lds + RT_SELG);
    LAS float* rstds = (LAS float*)(lds + RT_RSTD); LAS int* hist = (LAS int*)(lds + RT_HIST); LAS int* base = (LAS int*)(lds + RT_BASE);
    for (int i = tid; i < 1024 * 8; i += 512) { const int k = i >> 3, q = i & 7; const float s = p.in[I_N2W][k];
        f32x4 v = *(const f32x4*)(p.in[I_RW] + (size_t)k * 32 + 4 * q); v = v * s;
        const int rho = ((k >> 8) * 4 + (k & 3)) * 64 + ((k >> 2) & 63); *(LAS f32x4*)(WRl + rho * 36 + 4 * q) = v; }
    if (tid < 32) hist[tid] = 0;
    __syncthreads();
    const float* H = p.out; bf16_t* HB = (bf16_t*)(p.ws + WS_R1);
    const float rb = p.in[I_RB][lane >> 1];
    for (int it = 0; it < 32; ++it) {
        const int tl = it * 8 + wave; const size_t tok = (size_t)tb * 256 + tl;
        const f32x4* hr = (const f32x4*)(H + tok * D) + lane;
        f32x4 v[4]; float s = 0.f;
#pragma unroll
        for (int j = 0; j < 4; ++j) { v[j] = hr[64 * j]; s += (v[j].x * v[j].x + v[j].y * v[j].y) + (v[j].z * v[j].z + v[j].w * v[j].w); }
        const float rstd = frsq(wave_sum(s) * (1.0f / D) + EPS);
        unsigned long long* o8 = (unsigned long long*)(HB + tok * D) + lane;
#pragma unroll
        for (int j = 0; j < 4; ++j) o8[64 * j] = (unsigned long long)pk2(v[j].x, v[j].y) | ((unsigned long long)pk2(v[j].z, v[j].w) << 32);
        float acc[32];
#pragma unroll
        for (int q = 0; q < 32; ++q) acc[q] = 0.f;
#pragma unroll
        for (int j = 0; j < 4; ++j)
#pragma unroll
            for (int c = 0; c < 4; ++c) { const float hv = c == 0 ? v[j].x : c == 1 ? v[j].y : c == 2 ? v[j].z : v[j].w;
                const LAS f32x4* wrow = (const LAS f32x4*)(WRl + ((j * 4 + c) * 64 + lane) * 36);
#pragma unroll
                for (int q = 0; q < 8; ++q) { const f32x4 wv = wrow[q]; acc[4 * q + 0] += hv * wv.x; acc[4 * q + 1] += hv * wv.y; acc[4 * q + 2] += hv * wv.z; acc[4 * q + 3] += hv * wv.w; } }
#pragma unroll
        for (int q = 0; q < 16; ++q) { const bool up = (lane & 32) != 0; const float send = up ? acc[q] : acc[q + 16], keep = up ? acc[q + 16] : acc[q]; acc[q] = keep + __shfl_xor(send, 32); }
#pragma unroll
        for (int q = 0; q < 8; ++q) { const bool up = (lane & 16) != 0; const float send = up ? acc[q] : acc[q + 8], keep = up ? acc[q + 8] : acc[q]; acc[q] = keep + __shfl_xor(send, 16); }
#pragma unroll
        for (int q = 0; q < 4; ++q) { const bool up = (lane & 8) != 0; const float send = up ? acc[q] : acc[q + 4], keep = up ? acc[q + 4] : acc[q]; acc[q] = keep + __shfl_xor(send, 8); }
#pragma unroll
        for (int q = 0; q < 2; ++q) { const bool up = (lane & 4) != 0; const float send = up ? acc[q] : acc[q + 2], keep = up ? acc[q + 2] : acc[q]; acc[q] = keep + __shfl_xor(send, 4); }
        { const bool up = (lane & 2) != 0; const float send = up ? acc[0] : acc[1], keep = up ? acc[1] : acc[0]; acc[0] = keep + __shfl_xor(send, 2); }
        float logit = (acc[0] + __shfl_xor(acc[0], 1)) * rstd + rb;
        float tv[4]; int te[4];
#pragma unroll
        for (int k = 0; k < 4; ++k) {
            float mx = logit;
#pragma unroll
            for (int o = 2; o < 64; o <<= 1) mx = fmaxf(mx, __shfl_xor(mx, o));
            const unsigned long long bal = __ballot(logit == mx);
            const int src = __ffsll((long long)bal) - 1; te[k] = src >> 1; tv[k] = mx;
            if ((lane >> 1) == te[k]) logit = -INFINITY;
        }
        const float e1 = fexp(tv[1] - tv[0]), e2 = fexp(tv[2] - tv[0]), e3 = fexp(tv[3] - tv[0]), inv = 1.0f / (1.0f + e1 + e2 + e3);
        if (lane < 4) { const int ee = lane == 0 ? te[0] : lane == 1 ? te[1] : lane == 2 ? te[2] : te[3]; const float gg = (lane == 0 ? 1.0f : lane == 1 ? e1 : lane == 2 ? e2 : e3) * inv;
            selE[tl * 4 + lane] = ee; selG[tl * 4 + lane] = gg; }
        if (lane == 0) rstds[tl] = rstd;
    }
    __syncthreads();
    int myrank[2], mye[2];
#pragma unroll
    for (int q = 0; q < 2; ++q) { const int a = tid + 512 * q; mye[q] = selE[a]; myrank[q] = atomicAdd((int*)(hist + mye[q]), 1); }
    __syncthreads();
    unsigned* ctl = (unsigned*)(p.ws + WS_CTL);
    if (tid < 32) base[tid] = (int)atomicAdd(ctl + CW_CNT + tid, (unsigned)hist[tid]);
    __syncthreads();
    i32x4* ENT = (i32x4*)(p.ws + WS_ENT);
#pragma unroll
    for (int q = 0; q < 2; ++q) { const int a = tid + 512 * q, tl = a >> 2, k = a & 3; const int pos = base[mye[q]] + myrank[q];
        i32x4 en; en.x = tb * 256 + tl; en.y = __float_as_int(rstds[tl]); en.z = k; en.w = __float_as_int(selG[a]); ENT[(size_t)mye[q] * T + pos] = en; }
}
__device__ __forceinline__ void routing_phase(const Params& p, LAS unsigned char* lds) {
    for (int tb = blockIdx.x; tb < T / 256; tb += gridDim.x) { routing_block(p, lds, tb); __syncthreads(); }
}

struct Rounds { int es; int nr; __device__ __forceinline__ int lo(int r) const { return r == 0 ? 0 : es; } __device__ __forceinline__ int hi(int r) const { return r == 0 ? es : NE; } };
__device__ __forceinline__ int pad256(int c) { return (c + 255) & ~255; }
__device__ __forceinline__ Rounds make_rounds(const unsigned* cnt) {
    Rounds R; int sum = 0, e = 0;
    for (; e < NE; ++e) { const int pc = pad256((int)cnt[e]); if (sum + pc > CAP_ROWS) break; sum += pc; }
    R.es = e; R.nr = e < NE ? 2 : 1; return R;
}
__device__ __forceinline__ void combine_rows(const Params& p, int gw, int ngw, int lane) {
    const bf16_t* HB = (const bf16_t*)(p.ws + WS_R1); const bf16_t* Y23 = (const bf16_t*)(p.ws + WS_Y23);
    f32x4 fw[4];
#pragma unroll
    for (int q = 0; q < 4; ++q) fw[q] = *(const f32x4*)(p.in[I_FNW] + 512 * (q >> 1) + 8 * lane + 4 * (q & 1));
    for (int m = gw; m < T; m += ngw) {
        float v[16];
        const u32x4 h0 = *(const u32x4*)(HB + (size_t)m * D + 8 * lane), h1 = *(const u32x4*)(HB + (size_t)m * D + 512 + 8 * lane);
        const unsigned hw[8] = {h0.x, h0.y, h0.z, h0.w, h1.x, h1.y, h1.z, h1.w};
#pragma unroll
        for (int q = 0; q < 8; ++q) { v[2 * q] = bflo(hw[q]); v[2 * q + 1] = bfhi(hw[q]); }
#pragma unroll
        for (int k = 0; k < 4; ++k) { const bf16_t* yb = (k < 2 ? (const bf16_t*)p.out : Y23) + (size_t)m * 2048 + (k & 1) * 1024;
            const u32x4 y0 = *(const u32x4*)(yb + 8 * lane), y1 = *(const u32x4*)(yb + 512 + 8 * lane);
            const unsigned yw[8] = {y0.x, y0.y, y0.z, y0.w, y1.x, y1.y, y1.z, y1.w};
#pragma unroll
            for (int q = 0; q < 8; ++q) { v[2 * q] += bflo(yw[q]); v[2 * q + 1] += bfhi(yw[q]); } }
        float s = 0.f;
#pragma unroll
        for (int q = 0; q < 16; ++q) s += v[q] * v[q];
        const float rstd = frsq(wave_sum(s) * (1.0f / D) + EPS);
        float* o = p.out + (size_t)m * D;
#pragma unroll
        for (int q = 0; q < 4; ++q) { f32x4 r; r.x = v[4 * q] * rstd * fw[q].x; r.y = v[4 * q + 1] * rstd * fw[q].y; r.z = v[4 * q + 2] * rstd * fw[q].z; r.w = v[4 * q + 3] * rstd * fw[q].w;
            *(f32x4*)(o + 512 * (q >> 1) + 8 * lane + 4 * (q & 1)) = r; }
    }
}
#ifndef REP_P0
#define REP_P0 1
#endif
#ifndef REP_P1
#define REP_P1 1
#endif
#ifndef REP_P2
#define REP_P2 1
#endif
#ifndef REP_P3
#define REP_P3 1
#endif
#ifndef REP_P4
#define REP_P4 1
#endif
#ifndef REP_G1
#define REP_G1 1
#endif
#ifndef REP_G2
#define REP_G2 1
#endif
__global__ void __launch_bounds__(512, 2) fwd(Params p) {
    extern __shared__ __attribute__((aligned(16))) unsigned char lds_[];
    LAS unsigned char* lds = (LAS unsigned char*)lds_;
    unsigned char* ws = p.ws;
    unsigned* bar = (unsigned*)(ws + WS_CTL) + CW_BAR;
    {
        const int t0 = threadIdx.x;
        const unsigned slot = (unsigned)__builtin_amdgcn_s_getreg(((6 - 1) << 11) | 4);
        if ((t0 & 63) == 0) *(volatile LAS int*)(lds + LDS_TAB + 4 * slot) = t0 >> 6;
        if (t0 == 0) { *(volatile LAS unsigned*)(lds + LDS_BARST) = 0u; *(volatile LAS unsigned*)(lds + LDS_BARST + 4) = 0u;
            const unsigned x = xb_xcc_id(), rank = xb_add(&bar[XB_XCNT(x)], 1u);
            *(volatile LAS unsigned*)(lds + LDS_BARST + 8) = rank * 8u + x; }
        __syncthreads();
    }
#ifdef PROBE_PH
    volatile LAS unsigned long long* phs = (volatile LAS unsigned long long*)(lds + LDS_TAB - 256); int nph = 0;
#define PH_STAMP() do { if (get_tid(lds) == 0) phs[nph] = __builtin_amdgcn_s_memrealtime(); ++nph; } while (0)
    PH_STAMP();
#define GRID_BAR() do { grid_barrier(bar, lds); PH_STAMP(); } while (0)
#else
#define PH_STAMP() do { } while (0)
#define GRID_BAR() grid_barrier(bar, lds)
#endif
    for (int rep = 0; rep < REP_P0; ++rep) { prep_phase(p, lds);
    cg::this_grid().sync(); PH_STAMP(); }
    int vcu = (int)blockIdx.x;
    { bool even = (gridDim.x % 8u) == 0u;
      for (unsigned j = 0; j < 16; ++j) { const unsigned c = xb_ld(&bar[XB_XCNT(j)]); if (c != (j < 8 ? gridDim.x / 8u : 0u)) even = false; }
      if (even) vcu = (int)*(volatile LAS unsigned*)(lds + LDS_BARST + 8);
      vcu = __builtin_amdgcn_readfirstlane(vcu); }
    for (int rep = 0; rep < REP_P1; ++rep) {
    { DenseSched S; S.o.init(T / 256, NPROJ / 256, gridDim.x, vcu); S.Bt = (const char*)(ws + WS_WIN); S.K = D; S.pp = (unsigned long long*)(ws + WS_CTL + 32768); S.ps = 0; EpiInProj E{(bf16_t*)(ws + WS_R2)};
      pg8::gemm_phase(lds, (const char*)(ws + WS_R1), D, S, E); }
    GRID_BAR(); }
    for (int rep = 0; rep < REP_P2; ++rep) {
    GSTAMP(ws, get_tid(lds), 4);
    if (blockIdx.x < 64) mlstm_phase(p, lds, blockIdx.x);
    else {
        for (int it = blockIdx.x - 64; it < 256; it += gridDim.x - 64) rglru_item<false>(p, lds, it);
        GSTAMP(ws, get_tid(lds), 5);
        moe_conv_phase(p, lds, 64); }
    GSTAMP(ws, get_tid(lds), 6);
    GRID_BAR(); }
    for (int rep = 0; rep < REP_P3; ++rep) {
    for (int it = blockIdx.x; it < 256; it += gridDim.x) rglru_item<true>(p, lds, it);
    GRID_BAR(); }
    for (int rep = 0; rep < REP_P4; ++rep) {
    { DenseSched S; S.o.init(T / 256, D / 256, gridDim.x, vcu); S.Bt = (const char*)(ws + WS_WOUT); S.K = D; S.pp = (unsigned long long*)(ws + WS_CTL + 32768); S.ps = 1; EpiOutProj E{p.in[I_X], p.out};
      pg8::gemm_phase(lds, (const char*)(ws + WS_R1), D, S, E); }
    GRID_BAR(); }
    routing_phase(p, lds);
    GRID_BAR();
    const unsigned* cnt = (const unsigned*)(ws + WS_CTL) + CW_CNT;
    const Rounds RR = make_rounds(cnt);
    for (int r = 0; r < RR.nr; ++r) {
        for (int rep = 0; rep < REP_G1; ++rep) {
        { MoeSched S{cnt, (const i32x4*)(ws + WS_ENT), (const char*)(ws + WS_WGU), RR.lo(r), RR.hi(r), 8, 2 * DFF, D, (int)gridDim.x, vcu, true, (unsigned long long*)(ws + WS_CTL + 32768), 2, 0}; S.init_tot();
          EpiG1 E{(bf16_t*)(ws + WS_R2), (const i32x4*)(ws + WS_ENT), cnt, p.in[I_BGU]};
          pg8::gemm_phase(lds, (const char*)(ws + WS_R1), D, S, E); }
        GRID_BAR(); }
        for (int rep = 0; rep < REP_G2; ++rep) {
        { MoeSched S{cnt, (const i32x4*)(ws + WS_ENT), (const char*)(ws + WS_WDN), RR.lo(r), RR.hi(r), 4, D, DFF, (int)gridDim.x, vcu, false, (unsigned long long*)(ws + WS_CTL + 32768), 3, 0}; S.init_tot();
          EpiG2 E{(bf16_t*)p.out, (bf16_t*)(ws + WS_Y23), (const i32x4*)(ws + WS_ENT), cnt, p.in[I_BDN]};
          pg8::gemm_phase(lds, (const char*)(ws + WS_R2), DFF, S, E); }
        GRID_BAR(); }
    }
    { const int tid = get_tid(lds); combine_rows(p, blockIdx.x * 8 + (tid >> 6), gridDim.x * 8, tid & 63); }
#ifdef PROBE_G
    if (blockIdx.x == PROBE_BLK && get_tid(lds) == 0) {
        const volatile unsigned long long* st = (const volatile unsigned long long*)(ws + WS_CTL + 40960);
        const unsigned long long ticks = (st[PROBE_I + 1] - st[PROBE_I]) * PROBE_MUL;
        const unsigned long long t0 = __builtin_amdgcn_s_memrealtime();
        while (__builtin_amdgcn_s_memrealtime() - t0 < ticks) __builtin_amdgcn_s_sleep(8);
    }
#endif
#ifdef PROBE_PH
    PH_STAMP();
    if (vcu == 0 && get_tid(lds) == 0) {
        const unsigned long long ticks = (phs[PROBE_PH + 1] - phs[PROBE_PH]) * PROBE_MUL;
        const unsigned long long t0 = __builtin_amdgcn_s_memrealtime();
        while (__builtin_amdgcn_s_memrealtime() - t0 < ticks) __builtin_amdgcn_s_sleep(8);
    }
#endif
#ifdef PROBE_T
    if (vcu == 0 && get_tid(lds) == 0) {
        const unsigned long long q = ((const volatile unsigned long long*)(ws + WS_CTL + 32768))[8 * PROBE_SLOT + PROBE_WORD];
        const unsigned long long ticks = (PROBE_WORD >= 2 ? q / 24ull : q) * PROBE_MUL;
        const unsigned long long t0 = __builtin_amdgcn_s_memrealtime();
        while (__builtin_amdgcn_s_memrealtime() - t0 < ticks) __builtin_amdgcn_s_sleep(8);
    }
#endif
}

extern "C" void kernel_launch(void* const* d_in, const int* in_sizes, int n_in, void* d_out, int out_size, void* d_ws, size_t ws_size, hipStream_t stream) {
    static int grid = 0;
    if (grid == 0) {
        if (n_in != 22 || ws_size < WS_END) { fprintf(stderr, "kernel_launch: unexpected n_in %d / ws_size %zu (need %zu)\n", n_in, ws_size, (size_t)WS_END); grid = -1; return; }
        int dev = 0, cus = 0, per_cu = 0;
        (void)hipGetDevice(&dev); (void)hipDeviceGetAttribute(&cus, hipDeviceAttributeMultiprocessorCount, dev);
        (void)hipFuncSetAttribute((const void*)fwd, hipFuncAttributeMaxDynamicSharedMemorySize, LDS_BYTES);
        (void)hipOccupancyMaxActiveBlocksPerMultiprocessor(&per_cu, (const void*)fwd, 512, LDS_BYTES);
        if (per_cu < 1) { fprintf(stderr, "kernel_launch: occupancy query says %d blocks/CU\n", per_cu); per_cu = 1; }
        grid = cus * per_cu;
        fprintf(stderr, "kernel_launch: grid %d (cus %d x %d)\n", grid, cus, per_cu);
    }
    if (grid < 0) return;
    Params p{};
    for (int i = 0; i < 22; ++i) p.in[i] = (const float*)d_in[i];
    p.out = (float*)d_out; p.ws = (unsigned char*)d_ws;
    (void)hipMemsetAsync((unsigned char*)d_ws + WS_CTL, 0, 65536, stream);
    void* args[] = {&p};
    hipError_t e = hipLaunchCooperativeKernel((const void*)fwd, dim3(grid), dim3(512), args, LDS_BYTES, stream);
    if (e != hipSuccess) fprintf(stderr, "kernel_launch: cooperative launch failed: %s (grid %d)\n", hipGetErrorString(e), grid);
}
```

```cpp
#include <hip/hip_runtime.h>
#include <hip/hip_cooperative_groups.h>
#include <cstdio>
#include <cstdint>

namespace cg = cooperative_groups;
#define LAS __attribute__((address_space(3)))
typedef unsigned short bf16_t;
typedef short bf16x8 __attribute__((ext_vector_type(8)));
typedef float f32x4 __attribute__((ext_vector_type(4)));
typedef unsigned u32x4 __attribute__((ext_vector_type(4)));
typedef unsigned u32x2 __attribute__((ext_vector_type(2)));
typedef int i32x4 __attribute__((ext_vector_type(4)));

constexpr int T = 65536, D = 1024, SEQ = 4096, NB = 16;
constexpr int INC = 3080;
constexpr int NPROJ = 3072;
constexpr int NE = 32, TOPK = 4, DFF = 1024;
constexpr float EPS = 1e-6f;
constexpr int CAP_ROWS = 270336;
constexpr float SC_H = 8.0f, SC_W = 64.0f, SC_HID = 4.0f;

constexpr size_t MB = 1024 * 1024;
constexpr size_t WS_CTL  = 0;
constexpr size_t WS_GATES = 1 * MB;
constexpr size_t WS_SSQR = 3 * MB;
constexpr size_t WS_SUMM = 4 * MB;
constexpr size_t WS_WRI  = 5 * MB;
constexpr size_t WS_ENT  = 6 * MB;
constexpr size_t WS_WIN  = 38 * MB;
constexpr size_t WS_WOUT = 44 * MB;
constexpr size_t WS_WGU  = 46 * MB;
constexpr size_t WS_WDN  = 110 * MB;
constexpr size_t WS_HB8  = 142 * MB;
constexpr size_t WS_R1   = 238 * MB;
constexpr size_t WS_R2   = 366 * MB;
constexpr size_t WS_Y23  = 750 * MB;
constexpr size_t WS_END  = 1006 * MB;

constexpr int CW_CNT = 0;
constexpr int CW_WORK = 64;
constexpr int CW_BAR = 1024;

__device__ __forceinline__ unsigned pk2(float lo, float hi) { unsigned r; asm("v_cvt_pk_bf16_f32 %0, %1, %2" : "=v"(r) : "v"(lo), "v"(hi)); return r; }
__device__ __forceinline__ float bflo(unsigned u) { return __uint_as_float(u << 16); }
__device__ __forceinline__ float bfhi(unsigned u) { return __uint_as_float(u & 0xffff0000u); }
__device__ __forceinline__ float bf2f(bf16_t b) { return __uint_as_float(((unsigned)b) << 16); }
__device__ __forceinline__ float wave_sum(float v) {
#pragma unroll
    for (int o = 1; o < 64; o <<= 1) v += __shfl_xor(v, o);
    return v;
}
__device__ __forceinline__ float fexp(float x) { return __builtin_amdgcn_exp2f(x * 1.4426950408889634f); }
__device__ __forceinline__ float frcp(float x) { return __builtin_amdgcn_rcpf(x); }
__device__ __forceinline__ float fsqrt(float x) { return __builtin_amdgcn_sqrtf(x); }
__device__ __forceinline__ float frsq(float x) { return __builtin_amdgcn_rsqf(x); }
__device__ __forceinline__ float sigmoidf_(float x) { return frcp(1.0f + __builtin_amdgcn_exp2f(x * -1.4426950408889634f)); }
__device__ __forceinline__ float gelu_tanh(float x) {
    const float u2 = 1.5957691216057308f * (x + 0.044715f * x * x * x);
    return x * sigmoidf_(u2);
}

typedef int i32x8 __attribute__((ext_vector_type(8)));
__device__ __forceinline__ unsigned pk4_fp8(float a, float b, float c, float d) {
    int r = __builtin_amdgcn_cvt_pk_fp8_f32(a, b, 0, false); r = __builtin_amdgcn_cvt_pk_fp8_f32(c, d, r, true); return (unsigned)r;
}
__device__ __forceinline__ float clamp448(float x) { return fminf(fmaxf(x, -448.f), 448.f); }

struct Params {
    const float* in[22];
    float* out;
    unsigned char* ws;
    int pad0, pad1;
};
constexpr int LDS_PTAB_OFF = 159744 - 512 - 256 - 256;
struct PV {
    LAS unsigned char* l;
    __device__ __forceinline__ unsigned long long ptr(int i) const { const u32x2 v = *(volatile LAS u32x2*)(l + LDS_PTAB_OFF + 8 * i);
        return ((unsigned long long)(unsigned)__builtin_amdgcn_readfirstlane((int)v.y) << 32) | (unsigned)__builtin_amdgcn_readfirstlane((int)v.x); }
    __device__ __forceinline__ const float* in(int i) const { return (const float*)(size_t)ptr(i); }
    __device__ __forceinline__ float* out() const { return (float*)(size_t)ptr(22); }
    __device__ __forceinline__ unsigned char* ws() const { return (unsigned char*)(size_t)ptr(23); }
};
enum { I_X = 0, I_N1W, I_WIN, I_GB, I_MNW, I_CW, I_CB, I_WR, I_BR, I_WI, I_BI, I_LAM, I_LNW, I_WOUT, I_N2W, I_RW, I_RB, I_WGU, I_BGU, I_WDN, I_BDN, I_FNW };


constexpr int LDS_BYTES = 159744, LDS_TAB = LDS_BYTES - 512, LDS_BARST = LDS_BYTES - 16;
__device__ __forceinline__ int get_tid(LAS unsigned char* lds) {
    const unsigned slot = (unsigned)__builtin_amdgcn_s_getreg(((6 - 1) << 11) | 4);
    const int w = __builtin_amdgcn_readfirstlane(*(volatile LAS int*)(lds + LDS_TAB + 4 * slot));
    int lane; asm volatile("v_mbcnt_lo_u32_b32 %0, -1, 0\n\tv_mbcnt_hi_u32_b32 %0, -1, %0" : "=v"(lane));
    return w * 64 + lane;
}
#define XB_TMO      128
#define XB_XCNT(j)  (256  + 64 * (j))
#define XB_XSUB(j)  (1280 + 64 * (j))
#define XB_XGEN(j)  (2304 + 64 * (j))
#define XB_TOP      3328
#define XB_TOPGEN   3392
#define XCD_BAR_WORDS 3456
#define XB_SPIN_CAP (1u << 22)
__device__ __forceinline__ unsigned xb_ld(unsigned* p)              { return __hip_atomic_load(p, __ATOMIC_RELAXED, __HIP_MEMORY_SCOPE_AGENT); }
__device__ __forceinline__ unsigned xb_add(unsigned* p, unsigned v) { return __hip_atomic_fetch_add(p, v, __ATOMIC_RELAXED, __HIP_MEMORY_SCOPE_AGENT); }
__device__ __forceinline__ unsigned xb_xcc_id() { return (unsigned)__builtin_amdgcn_s_getreg((3 << 11) | 20) & 0xFu; }
#define XB_SPIN(cond, bar) do { unsigned _sp = 0; while (cond) { __builtin_amdgcn_s_sleep(1); \
    if ((++_sp & 255u) == 0u) { if (xb_ld(&(bar)[XB_TMO])) break; if (_sp > XB_SPIN_CAP) { atomicAdd(&(bar)[XB_TMO], 1u); break; } } } } while (0)
__device__ __forceinline__ void xcd_barrier_complete(unsigned* bar, unsigned x, unsigned G, unsigned& nloc, unsigned& nx) {
    unsigned sum, cnt, mine, sp = 0u;
    for (;;) {
        sum = 0u; cnt = 0u; mine = 0u;
#pragma unroll
        for (unsigned j = 0; j < 16; ++j) { const unsigned c = xb_ld(&bar[XB_XCNT(j)]); sum += c; cnt += (c > 0u) ? 1u : 0u; mine = (j == x) ? c : mine; }
        if (sum == G) break;
        __builtin_amdgcn_s_sleep(1);
        if ((++sp & 255u) == 0u) { if (xb_ld(&bar[XB_TMO])) break; if (sp > XB_SPIN_CAP) { atomicAdd(&bar[XB_TMO], 1u); break; } }
    }
    nloc = mine > 0u ? mine : 1u; nx = cnt > 0u ? cnt : 1u;
}
__device__ __forceinline__ void grid_barrier(unsigned* bar, LAS unsigned char* lds) {
    asm volatile("s_waitcnt vmcnt(0)" ::: "memory");
    __syncthreads();
    if (get_tid(lds) == 0) {
        volatile LAS unsigned* st = (volatile LAS unsigned*)(lds + LDS_BARST);
        const unsigned x = xb_xcc_id();
        __builtin_amdgcn_s_waitcnt(0);
        unsigned nloc = st[0], nx = st[1];
        if (nloc == 0u) { xcd_barrier_complete(bar, x, gridDim.x, nloc, nx); st[0] = nloc; st[1] = nx; }
        const unsigned old = xb_add(&bar[XB_XSUB(x)], 1u);
        const unsigned gen = old / nloc;
        if (old + 1u == (gen + 1u) * nloc) {
            __builtin_amdgcn_fence(__ATOMIC_RELEASE, "agent");
            asm volatile("s_waitcnt vmcnt(0)" ::: "memory");
            const unsigned og = xb_add(&bar[XB_TOP], 1u);
            const unsigned tg = og / nx;
            if (og + 1u == (tg + 1u) * nx) xb_add(&bar[XB_TOPGEN], 1u);
            else XB_SPIN(xb_ld(&bar[XB_TOPGEN]) == tg, bar);
            __builtin_amdgcn_fence(__ATOMIC_ACQUIRE, "agent");
            xb_add(&bar[XB_XGEN(x)], 1u);
            asm volatile("s_waitcnt vmcnt(0)" ::: "memory");
        } else {
            XB_SPIN(xb_ld(&bar[XB_XGEN(x)]) == gen, bar);
            __builtin_amdgcn_fence(__ATOMIC_ACQUIRE, "agent");
            asm volatile("s_waitcnt vmcnt(0)" ::: "memory");
        }
    }
    __syncthreads();
}

#ifdef PROBE_G
#define GSTAMP(ws_, tid_, i_) do { if (blockIdx.x == PROBE_BLK && (tid_) == 0) ((volatile unsigned long long*)((ws_) + WS_CTL + 40960))[i_] = __builtin_amdgcn_s_memrealtime(); } while (0)
#else
#define GSTAMP(ws_, tid_, i_) do { } while (0)
#endif
__device__ __forceinline__ void tr_item(const float* __restrict__ W, int ldw, int col0, bf16_t* dst, int K, int k0, const float* sk, float mul, LAS float* scr, int lane) {
    float v[32];
    const float* src = W + (size_t)(k0 + (lane >> 5)) * ldw + col0 + (lane & 31);
#pragma unroll
    for (int i = 0; i < 32; ++i) v[i] = __builtin_nontemporal_load(src + (size_t)(2 * i) * ldw);
#pragma unroll
    for (int i = 0; i < 32; ++i) { const int kk = 2 * i + (lane >> 5); const float s = sk ? sk[k0 + kk] * mul : mul; scr[kk * 33 + (lane & 31)] = v[i] * s; }
    asm volatile("s_waitcnt lgkmcnt(0)" ::: "memory");
    const int c = lane & 7;
#pragma unroll
    for (int j = 0; j < 4; ++j) { const int n = (lane >> 3) + 8 * j; const LAS float* s = scr + (8 * c) * 33 + n;
        u32x4 o; o.x = pk2(s[0 * 33], s[1 * 33]); o.y = pk2(s[2 * 33], s[3 * 33]); o.z = pk2(s[4 * 33], s[5 * 33]); o.w = pk2(s[6 * 33], s[7 * 33]);
        *(u32x4*)(dst + (size_t)n * K + k0 + 8 * c) = o; }
    asm volatile("s_waitcnt lgkmcnt(0)" ::: "memory");
}
__device__ __forceinline__ void tr_item_f8(const float* __restrict__ W, int ldw, int col0, unsigned char* dst, int K, int k0, const float* sk, float mul, LAS float* scr, int lane) {
    float v[32];
    const float* src = W + (size_t)(k0 + (lane >> 5)) * ldw + col0 + (lane & 31);
#pragma unroll
    for (int i = 0; i < 32; ++i) v[i] = __builtin_nontemporal_load(src + (size_t)(2 * i) * ldw);
#pragma unroll
    for (int i = 0; i < 32; ++i) { const int kk = 2 * i + (lane >> 5); const float s = sk ? sk[k0 + kk] * mul : mul; scr[kk * 33 + (lane & 31)] = clamp448(v[i] * s); }
    asm volatile("s_waitcnt lgkmcnt(0)" ::: "memory");
    const int c = lane & 3;
#pragma unroll
    for (int j = 0; j < 2; ++j) { const int n = (lane >> 2) + 16 * j; const LAS float* s = scr + (16 * c) * 33 + n;
        u32x4 o; o.x = pk4_fp8(s[0 * 33], s[1 * 33], s[2 * 33], s[3 * 33]); o.y = pk4_fp8(s[4 * 33], s[5 * 33], s[6 * 33], s[7 * 33]);
        o.z = pk4_fp8(s[8 * 33], s[9 * 33], s[10 * 33], s[11 * 33]); o.w = pk4_fp8(s[12 * 33], s[13 * 33], s[14 * 33], s[15 * 33]);
        *(u32x4*)(dst + (size_t)n * K + k0 + 16 * c) = o; }
    asm volatile("s_waitcnt lgkmcnt(0)" ::: "memory");
}
constexpr int IT_WIN = 16 * 96, IT_WOUT = 16 * 32, IT_WGU_E = 16 * 64, IT_WDN_E = 16 * 32;
__device__ __forceinline__ void conv_item_small(const PV& p, int it, LAS float* scr, int lane) {
    if (it < IT_WIN) {
        const int kb = it / 96, nb = it % 96, n0 = 32 * nb, sec = n0 >> 9;
        const int secoff = sec == 0 ? 0 : sec == 1 ? 512 : sec == 2 ? 1024 : sec == 3 ? 1544 : sec == 4 ? 2056 : 2568;
        const float mul = sec == 1 ? 0.08838834764831845f : 1.0f;
        tr_item(p.in(I_WIN), INC, secoff + (n0 & 511), (bf16_t*)(p.ws() + WS_WIN) + (size_t)n0 * D, D, 64 * kb, nullptr, mul, scr, lane);
    } else {
        it -= IT_WIN; const int kb = it / 32, nb = it % 32, k0 = 64 * kb;
        const float* sk = k0 < 512 ? p.in(I_MNW) : p.in(I_LNW) - 512;
        tr_item(p.in(I_WOUT), D, 32 * nb, (bf16_t*)(p.ws() + WS_WOUT) + (size_t)(32 * nb) * D, D, k0, sk, 1.0f, scr, lane);
    }
}
__device__ __forceinline__ void conv_item_moe(const PV& p, int it, LAS float* scr, int lane) {
    if (it < NE * IT_WGU_E) {
        const int e = it / IT_WGU_E, r = it % IT_WGU_E, kb = r / 64, nb = r % 64, n0 = 32 * nb, j = n0 >> 8, c0 = n0 & 255;
        const int srccol = c0 < 128 ? 128 * j + c0 : 1024 + 128 * j + (c0 - 128);
        tr_item_f8(p.in(I_WGU) + (size_t)e * D * 2 * DFF, 2 * DFF, srccol, (unsigned char*)(p.ws() + WS_WGU) + ((size_t)e * 2 * DFF + n0) * D, D, 64 * kb, p.in(I_N2W), SC_W, scr, lane);
    } else {
        it -= NE * IT_WGU_E; const int e = it / IT_WDN_E, r = it % IT_WDN_E, kb = r / 32, nb = r % 32;
        tr_item_f8(p.in(I_WDN) + (size_t)e * DFF * D, D, 32 * nb, (unsigned char*)(p.ws() + WS_WDN) + ((size_t)e * D + 32 * nb) * DFF, DFF, 64 * kb, nullptr, SC_W, scr, lane);
    }
}
__device__ __forceinline__ void xpass_rows(const PV& p, LAS unsigned char* lds, int gw, int ngw, int lane) {
    LAS float* WG = (LAS float*)(lds + 69632);
    { const float* wg = p.in(I_WIN) + 1536;
      for (int i = get_tid(lds); i < 2048; i += 512) { const int k = i >> 1, q = i & 1; const f32x4 a = *(const f32x4*)(wg + (size_t)k * INC + 4 * q);
          const int rho = ((k >> 8) * 4 + (k & 3)) * 64 + ((k >> 2) & 63); *(LAS f32x4*)(WG + rho * 12 + 4 * q) = a; } }
    __syncthreads();
    f32x4 w1[4];
#pragma unroll
    for (int j = 0; j < 4; ++j) w1[j] = *(const f32x4*)(p.in(I_N1W) + 256 * j + 4 * lane);
    const float gb = lane < 8 ? p.in(I_GB)[lane] : 0.f;
    bf16_t* XN = (bf16_t*)(p.ws() + WS_R1); float* GATES = (float*)(p.ws() + WS_GATES);
    for (int m = gw; m < T; m += ngw) {
        const f32x4* xr = (const f32x4*)(p.in(I_X) + (size_t)m * D) + lane;
        f32x4 v[4]; float s = 0.f;
#pragma unroll
        for (int j = 0; j < 4; ++j) { v[j] = xr[64 * j]; s += (v[j].x * v[j].x + v[j].y * v[j].y) + (v[j].z * v[j].z + v[j].w * v[j].w); }
        const float rstd = frsq(wave_sum(s) * (1.0f / D) + EPS);
        float g[8];
#pragma unroll
        for (int q = 0; q < 8; ++q) g[q] = 0.f;
        unsigned long long* o8 = (unsigned long long*)(XN + (size_t)m * D) + lane;
#pragma unroll
        for (int j = 0; j < 4; ++j) { v[j] = v[j] * rstd * w1[j];
            o8[64 * j] = (unsigned long long)pk2(v[j].x, v[j].y) | ((unsigned long long)pk2(v[j].z, v[j].w) << 32);
#pragma unroll
            for (int c = 0; c < 4; ++c) { const float xv = v[j][c]; const LAS f32x4* wrow = (const LAS f32x4*)(WG + ((j * 4 + c) * 64 + lane) * 12); const f32x4 wa = wrow[0], wb = wrow[1];
                g[0] += xv * wa.x; g[1] += xv * wa.y; g[2] += xv * wa.z; g[3] += xv * wa.w; g[4] += xv * wb.x; g[5] += xv * wb.y; g[6] += xv * wb.z; g[7] += xv * wb.w; } }
        float mine = 0.f;
#pragma unroll
        for (int q = 0; q < 8; ++q) { const float t = wave_sum(g[q]); if (lane == q) mine = t; }
        if (lane < 8) { float val = mine + gb; if (lane >= 4) val = -log1pf(fexp(-val)); GATES[(size_t)m * 8 + lane] = val; }
    }
}
__device__ __forceinline__ void prep_phase(const PV& p, LAS unsigned char* lds) {
    const int tid = get_tid(lds), lane = tid & 63, wave = tid >> 6, gw = blockIdx.x * 8 + wave, ngw = gridDim.x * 8;
    LAS float* scr = (LAS float*)(lds + wave * 8448);
    for (int it = gw; it < IT_WIN + IT_WOUT; it += ngw) conv_item_small(p, it, scr, lane);
    bf16_t* WRI = (bf16_t*)(p.ws() + WS_WRI);
    for (int i = blockIdx.x * 512 + tid; i < 4 * 256 * 128; i += gridDim.x * 512) { const int h = i >> 15, n = (i >> 7) & 255, k = i & 127;
        const float v = n < 128 ? p.in(I_WR)[(h * 128 + k) * 128 + n] : p.in(I_WI)[(h * 128 + k) * 128 + n - 128]; WRI[i] = (bf16_t)(pk2(v, 0.f) & 0xffff); }
    float* SSQR = (float*)(p.ws() + WS_SSQR);
    for (int i = blockIdx.x * 512 + tid; i < T; i += gridDim.x * 512) SSQR[i] = 0.f;
    xpass_rows(p, lds, gw, ngw, lane);
}
__device__ __forceinline__ void moe_conv_phase(const PV& p, LAS unsigned char* lds, int b0) {
    const int tid = get_tid(lds), lane = tid & 63, wave = tid >> 6;
    if ((int)blockIdx.x < b0) return;
    const int gw = ((int)blockIdx.x - b0) * 8 + wave, ngw = ((int)gridDim.x - b0) * 8;
    LAS float* scr = (LAS float*)(lds + wave * 8448);
    for (int it = gw; it < NE * (IT_WGU_E + IT_WDN_E); it += ngw) conv_item_moe(p, it, scr, lane);
}

namespace pg8 {
constexpr int BM = 256, BK = 64, HALF = 128, HTB = HALF * BK * 2, STAGE_BYTES = 8 * HTB;
__device__ __forceinline__ int lds_byte(int r, int c) { const int st = (r >> 4) * 2 + (c >> 5), rr = r & 15, cc = c & 31, ob = rr * 64 + cc * 2; return st * 1024 + (ob ^ (((ob >> 9) & 1) << 5)); }
__device__ __forceinline__ void stage_rc(int b, int& R, int& C) { const int st = b / 1024, sb = b % 1024, swz = sb ^ (((sb >> 9) & 1) << 5); R = (st >> 1) * 16 + swz / 64; C = (st & 1) * 32 + (swz % 64) / 2; }
__device__ __forceinline__ int perm32(int rho) { const int n = rho >> 4, i = rho & 15; return 8 * (i >> 2) + 4 * n + (i & 3); }
struct Unit { const char* b; const char* a; int i0, i1, i2, i3; };
#define PG8_GLDS2(ldsa, s0, v0, s1, v1) do { unsigned _keep; \
        asm volatile("s_mov_b32 %0, m0\n\ts_mov_b32 m0, %5\n\ts_nop 0\n\tglobal_load_lds_dwordx4 %1, %2\n\ts_mov_b32 m0, %6\n\ts_nop 0\n\tglobal_load_lds_dwordx4 %3, %4\n\ts_mov_b32 m0, %0" \
                     : "=&s"(_keep) : "v"(v0), "s"((const char*)(s0)), "v"(v1), "s"((const char*)(s1)), "s"(ldsa), "s"((ldsa) + 8192u) : "memory"); } while (0)
template <bool F8, bool GATHER, class Epi, class Sched>
__device__ __forceinline__ void gemm_phase(LAS unsigned char* lds, const char* Abase, int pitch, const Sched& S, const Epi& E) {
    const int tid = get_tid(lds);
    const int wid = __builtin_amdgcn_readfirstlane(tid >> 6), lane = tid & 63, wr = wid >> 2, wc = wid & 3, fr = lane & 15, fq = lane >> 4;
    const int nt = pitch / 128;
    unsigned vA, vB;
    { int R0, C0; stage_rc(tid * 16, R0, C0); const int Rb0 = Epi::PERM ? ((R0 & ~31) + perm32(R0 & 31)) : R0;
      vA = (unsigned)(R0 * pitch + 2 * C0); vB = (unsigned)(Rb0 * pitch + 2 * C0); }
    const size_t kstep = 128, hstep = (size_t)HALF * pitch, q64 = (size_t)64 * pitch;
    const unsigned ldsb0 = (unsigned)__builtin_amdgcn_readfirstlane((int)((unsigned)(size_t)lds + (unsigned)wid * 1024u));
    const int aoff = F8 ? lds_byte(wr * 64 + fr, fq * 16) : lds_byte(wr * 64 + fr, fq * 8), boff = F8 ? lds_byte(wc * 32 + fr, fq * 16) : lds_byte(wc * 32 + fr, fq * 8);
    constexpr int HOFF = F8 ? 16 : 1024;
#define PG8_SA(b, h) (((b) * 2 + (h)) * HTB)
#define PG8_SB(b, h) ((4 + (b) * 2 + (h)) * HTB)
#define PG8_STAGEB(bufoff, gbase) PG8_GLDS2(ldsb0 + (unsigned)(bufoff), (gbase), vB, (gbase) + q64, vB)
#define PG8_STAGEA(bufoff, kp, h) do { if constexpr (GATHER) { if ((h) == 0) PG8_GLDS2(ldsb0 + (unsigned)(bufoff), (kp), g0, (kp), g1); else PG8_GLDS2(ldsb0 + (unsigned)(bufoff), (kp), g2, (kp), g3); } \
        else PG8_GLDS2(ldsb0 + (unsigned)(bufoff), (kp) + (h) * hstep, vA, (kp) + (h) * hstep + q64, vA); } while (0)
#define PG8_RD(p) (*(const LAS u32x4*)(p))
#define PG8_LDA(dst, b, h) do { _Pragma("unroll") for (int m = 0; m < 4; ++m) { dst[m][0] = PG8_RD(lds + PG8_SA(b, h) + aoff + m * 2048); dst[m][1] = PG8_RD(lds + PG8_SA(b, h) + aoff + m * 2048 + HOFF); } } while (0)
#define PG8_LDB(dst, b, h) do { _Pragma("unroll") for (int n = 0; n < 2; ++n) { dst[n][0] = PG8_RD(lds + PG8_SB(b, h) + boff + n * 2048); dst[n][1] = PG8_RD(lds + PG8_SB(b, h) + boff + n * 2048 + HOFF); } } while (0)
#define PG8_CAT(v) __builtin_bit_cast(i32x8, __builtin_shufflevector((v)[0], (v)[1], 0, 1, 2, 3, 4, 5, 6, 7))
#define PG8_MMA(ai, bj, At, Bt) do { __builtin_amdgcn_s_setprio(1); _Pragma("unroll") for (int m = 0; m < 4; ++m) _Pragma("unroll") for (int n = 0; n < 2; ++n) { \
        if constexpr (F8) acc[ai][bj][m][n] = __builtin_amdgcn_mfma_scale_f32_16x16x128_f8f6f4(PG8_CAT(Bt[n]), PG8_CAT(At[m]), acc[ai][bj][m][n], 0, 0, 0, 0x7F7F7F7F, 0, 0x7F7F7F7F); \
        else { acc[ai][bj][m][n] = __builtin_amdgcn_mfma_f32_16x16x32_bf16(__builtin_bit_cast(bf16x8, Bt[n][0]), __builtin_bit_cast(bf16x8, At[m][0]), acc[ai][bj][m][n], 0, 0, 0); \
               acc[ai][bj][m][n] = __builtin_amdgcn_mfma_f32_16x16x32_bf16(__builtin_bit_cast(bf16x8, Bt[n][1]), __builtin_bit_cast(bf16x8, At[m][1]), acc[ai][bj][m][n], 0, 0, 0); } } \
        __builtin_amdgcn_s_setprio(0); } while (0)
#define PG8_WAIT_V(n) asm volatile("s_waitcnt vmcnt(" #n ")" ::: "memory")
#define PG8_WAIT_L(n) asm volatile("s_waitcnt lgkmcnt(" #n ")" ::: "memory")
#define PG8_BAR __builtin_amdgcn_s_barrier()
#define PG8_SCHED __builtin_amdgcn_sched_barrier(0)
    Unit cur, nxt; int ui = 0;
    if (!S.next(0, cur)) return;
    f32x4 acc[2][2][4][2];
#pragma unroll
    for (int a = 0; a < 2; ++a)
#pragma unroll
        for (int b = 0; b < 2; ++b)
#pragma unroll
            for (int m = 0; m < 4; ++m)
#pragma unroll
                for (int n = 0; n < 2; ++n) acc[a][b][m][n] = (f32x4){0.f, 0.f, 0.f, 0.f};
    u32x4 At[4][2], B0[2][2], B1[2][2];
    unsigned g0 = 0, g1 = 0, g2 = 0, g3 = 0;
    if constexpr (GATHER) { S.goffs(cur, tid, 0, g0, g1); S.goffs(cur, tid, 1, g2, g3); }
    const char* cA = GATHER ? Abase : cur.a; const char* cB = cur.b;
    PG8_STAGEB(PG8_SB(0, 0), cB); PG8_STAGEB(PG8_SB(0, 1), cB + hstep); PG8_STAGEA(PG8_SA(0, 0), cA, 0); PG8_STAGEA(PG8_SA(0, 1), cA, 1);
    if (wr == 1) PG8_BAR;
    PG8_WAIT_V(2); PG8_BAR;
    PG8_STAGEB(PG8_SB(1, 0), cB + kstep); PG8_STAGEA(PG8_SA(1, 0), cA + kstep, 0); PG8_STAGEB(PG8_SB(1, 1), cB + hstep + kstep);
    PG8_WAIT_V(6); PG8_BAR;
    for (;;) {
        const bool has_next = S.next(ui + 1, nxt);
        const char* nB = has_next ? nxt.b : cB; const char* nA = GATHER ? Abase : (has_next ? nxt.a : cA);
#pragma unroll 1
        for (int t = 0; t < nt; t += 2) {
            const bool last = (t == nt - 2);
            const char* a1 = cA + (size_t)(t + 1) * kstep;
            const char* a2 = last ? nA : cA + (size_t)(t + 2) * kstep; const char* b2 = last ? nB : cB + (size_t)(t + 2) * kstep;
            const char* a3 = a2 + kstep; const char* b3 = b2 + kstep;
            PG8_LDB(B0, 0, 0); PG8_LDB(B1, 0, 1); PG8_SCHED; PG8_LDA(At, 0, 0); PG8_STAGEA(PG8_SA(1, 1), a1, 1);
            if constexpr (GATHER) { if (last && has_next) { S.goffs(nxt, tid, 0, g0, g1); S.goffs(nxt, tid, 1, g2, g3); } }
            PG8_WAIT_V(8); PG8_WAIT_L(0); PG8_BAR; PG8_MMA(0, 0, At, B0); PG8_MMA(0, 1, At, B1); PG8_BAR; PG8_SCHED;
            PG8_LDA(At, 0, 1); PG8_STAGEB(PG8_SB(0, 0), b2); PG8_STAGEB(PG8_SB(0, 1), b2 + hstep); PG8_STAGEA(PG8_SA(0, 0), a2, 0);
            PG8_WAIT_V(8); PG8_WAIT_L(0); PG8_BAR; PG8_MMA(1, 0, At, B0); PG8_MMA(1, 1, At, B1); PG8_BAR; PG8_SCHED;
            PG8_LDB(B0, 1, 0); PG8_LDB(B1, 1, 1); PG8_SCHED; PG8_LDA(At, 1, 0); PG8_STAGEA(PG8_SA(0, 1), a2, 1);
            PG8_WAIT_V(8); PG8_WAIT_L(0); PG8_BAR; PG8_MMA(0, 0, At, B0); PG8_MMA(0, 1, At, B1); PG8_BAR; PG8_SCHED;
            PG8_LDA(At, 1, 1); PG8_STAGEB(PG8_SB(1, 0), b3); PG8_STAGEB(PG8_SB(1, 1), b3 + hstep); PG8_STAGEA(PG8_SA(1, 0), a3, 0);
            PG8_WAIT_V(8); PG8_WAIT_L(0); PG8_BAR; PG8_MMA(1, 0, At, B0); PG8_MMA(1, 1, At, B1); PG8_BAR; PG8_SCHED;
        }
        if (wr == 0) PG8_BAR;
        { int efr = fr, efq = fq; asm volatile("" : "+v"(efr), "+v"(efq));
          E(acc, cur, wr, wc, efr, efq); }
        if (!has_next) break;
#pragma unroll
        for (int a = 0; a < 2; ++a)
#pragma unroll
            for (int b = 0; b < 2; ++b)
#pragma unroll
                for (int m = 0; m < 4; ++m)
#pragma unroll
                    for (int n = 0; n < 2; ++n) acc[a][b][m][n] = (f32x4){0.f, 0.f, 0.f, 0.f};
        cur = nxt; cB = nB; cA = nA; ++ui;
        if (wr == 1) PG8_BAR;
    }
    PG8_WAIT_V(0);
    PG8_BAR;
#undef PG8_SA
#undef PG8_SB
#undef PG8_STAGEA
#undef PG8_STAGEB
#undef PG8_RD
#undef PG8_CAT
#undef PG8_LDA
#undef PG8_LDB
#undef PG8_MMA
#undef PG8_WAIT_V
#undef PG8_WAIT_L
#undef PG8_BAR
#undef PG8_SCHED
}
struct TileOrder {
    int nM, nN, nwg, G, c;
    __device__ __forceinline__ void init(int nM_, int nN_, int G_, int c_) { nM = nM_; nN = nN_; nwg = nM * nN; G = G_; c = c_; }
    __device__ __forceinline__ bool tile(int i, int& pm, int& pn) const {
        const long L = (long)i * G + c; if (L >= nwg) return false;
        int wgid = (int)L; { const int q = nwg / 8, r = nwg % 8, xcd = wgid % 8, off = wgid / 8; wgid = (xcd < r ? xcd * (q + 1) : r * (q + 1) + (xcd - r) * q) + off; }
        const int nig = 8 * nN, gid = wgid / nig, fm = gid * 8, gsz = (nM - fm) < 8 ? (nM - fm) : 8;
        pm = fm + ((wgid % nig) % gsz); pn = (wgid % nig) / gsz; return true;
    }
};
}

struct DenseSched {
    pg8::TileOrder o; const char* A; const char* Bt; int pitch;
    __device__ __forceinline__ bool next(int i, pg8::Unit& u) const { int pm, pn; if (!o.tile(i, pm, pn)) return false; u.i0 = pm; u.i1 = pn; u.i2 = 0; u.i3 = 0;
        u.a = A + (size_t)pm * 256 * pitch; u.b = Bt + (size_t)pn * 256 * pitch; return true; }
    __device__ __forceinline__ void goffs(const pg8::Unit&, int, int, unsigned&, unsigned&) const {}
};
struct EpiInProj {
    static constexpr bool PERM = true;
    bf16_t* PROJ;
    __device__ __forceinline__ void operator()(const f32x4 (&acc)[2][2][4][2], const pg8::Unit& u, int wr, int wc, int fr, int fq) const {
        const int row0 = u.i0 * 256 + wr * 64 + fr, col0 = u.i1 * 256 + wc * 32 + 8 * fq;
#pragma unroll
        for (int ai = 0; ai < 2; ++ai)
#pragma unroll
            for (int m = 0; m < 4; ++m) { bf16_t* rowp = PROJ + (size_t)(row0 + ai * 128 + m * 16) * NPROJ + col0;
#pragma unroll
                for (int bj = 0; bj < 2; ++bj) { const f32x4 v0 = acc[ai][bj][m][0], v1 = acc[ai][bj][m][1];
                    u32x4 w; w.x = pk2(v0[0], v0[1]); w.y = pk2(v0[2], v0[3]); w.z = pk2(v1[0], v1[1]); w.w = pk2(v1[2], v1[3]);
                    *(u32x4*)(rowp + bj * 128) = w; } }
    }
};
struct EpiOutProj {
    static constexpr bool PERM = false;
    const float* X; float* H;
    __device__ __forceinline__ void operator()(const f32x4 (&acc)[2][2][4][2], const pg8::Unit& u, int wr, int wc, int fr, int fq) const {
        const int row0 = u.i0 * 256 + wr * 64 + fr, col0 = u.i1 * 256 + wc * 32 + 4 * fq;
#pragma unroll
        for (int ai = 0; ai < 2; ++ai)
#pragma unroll
            for (int m = 0; m < 4; ++m) { const size_t off = (size_t)(row0 + ai * 128 + m * 16) * D + col0;
#pragma unroll
                for (int bj = 0; bj < 2; ++bj)
#pragma unroll
                    for (int n = 0; n < 2; ++n) { const f32x4 x = *(const f32x4*)(X + off + bj * 128 + n * 16); *(f32x4*)(H + off + bj * 128 + n * 16) = x + acc[ai][bj][m][n]; }
                asm volatile("" ::: "memory"); }
    }
};


template <bool GATHER, int NT  , int NROWS  >
struct MoeSched {
    const unsigned* cnt; const i32x4* ENT; const char* A; const char* Bt; int lo, hi, G, c, tot;
    __device__ __forceinline__ int cnt_s(int e) const { return __builtin_amdgcn_readfirstlane((int)cnt[e]); }
    __device__ __forceinline__ void init_tot() { int t = 0; for (int e = lo; e < hi; ++e) t += ((cnt_s(e) + 255) >> 8) * NT; tot = t; }
    __device__ __forceinline__ bool next(int i, pg8::Unit& u) const {
        const int L = i * G + c; if (L >= tot) return false;
        int W; { const int q = tot / 8, r = tot % 8, xcd = L % 8, off = L / 8; W = (xcd < r ? xcd * (q + 1) : r * (q + 1) + (xcd - r) * q) + off; }
        int hb = 0;
        for (int e = lo; e < hi; ++e) { const int te = (cnt_s(e) + 255) >> 8, ue = te * NT;
            if (W < ue) { constexpr int nig = 8 * NT; const int gid = W / nig, fm = gid * 8, gsz = (te - fm) < 8 ? (te - fm) : 8; int j = W - gid * nig, n = 0;
                while (j >= gsz) { j -= gsz; ++n; }
                u.i0 = __builtin_amdgcn_readfirstlane(e); u.i1 = __builtin_amdgcn_readfirstlane(fm + j); u.i2 = __builtin_amdgcn_readfirstlane(n); u.i3 = __builtin_amdgcn_readfirstlane(hb);
                u.b = Bt + ((size_t)u.i0 * NROWS + (size_t)u.i2 * 256) * 1024; u.a = A + (size_t)(u.i3 + u.i1 * 256) * 1024;
                return true; }
            W -= ue; hb += te * 256; }
        return false;
    }
    __device__ __forceinline__ void goffs(const pg8::Unit& u, int tid, int h, unsigned& o0, unsigned& o1) const {
        if constexpr (GATHER) { int R0, C0; pg8::stage_rc(tid * 16, R0, C0);
            const int ce = cnt_s(u.i0), p0 = u.i1 * 256 + h * 128 + R0; const i32x4* en = ENT + (size_t)u.i0 * T;
            const int t0 = p0 < ce ? en[p0].x : 0, t1 = p0 + 64 < ce ? en[p0 + 64].x : 0;
            o0 = (unsigned)t0 * 1024u + 2u * C0; o1 = (unsigned)t1 * 1024u + 2u * C0; }
    }
};
struct EpiG1 {
    static constexpr bool PERM = true;
    unsigned char* HID; const i32x4* ENT; const unsigned* cnt; const float* bgu;
    __device__ __forceinline__ void operator()(const f32x4 (&acc)[2][2][4][2], const pg8::Unit& u, int wr, int wc, int fr, int fq) const {
        const int e = u.i0, ce = __builtin_amdgcn_readfirstlane((int)cnt[e]), hc = u.i2 * 128 + wc * 32 + 8 * fq; const i32x4* en = ENT + (size_t)e * T;
        float rs[8];
#pragma unroll
        for (int q = 0; q < 8; ++q) { const int pos = u.i1 * 256 + (q >> 2) * 128 + wr * 64 + (q & 3) * 16 + fr; rs[q] = pos < ce ? __int_as_float(en[pos].y) * (1.0f / (SC_H * SC_W)) : 0.f; }
        const float* bg = bgu + (size_t)e * 2 * DFF + hc;
        const f32x4 bg0 = *(const f32x4*)bg, bg1 = *(const f32x4*)(bg + 4), bu0 = *(const f32x4*)(bg + DFF), bu1 = *(const f32x4*)(bg + DFF + 4);
#pragma unroll
        for (int ai = 0; ai < 2; ++ai)
#pragma unroll
            for (int m = 0; m < 4; ++m) { const int pos = u.i1 * 256 + ai * 128 + wr * 64 + m * 16 + fr;
                const float rstd = rs[ai * 4 + m];
                float hv[8];
#pragma unroll
                for (int q = 0; q < 8; ++q) { const int n = q >> 2, j = q & 3; float g = acc[ai][0][m][n][j] * rstd + (n ? bg1[j] : bg0[j]), up = acc[ai][1][m][n][j] * rstd + (n ? bu1[j] : bu0[j]);
                    g = fminf(g, 7.0f); up = fminf(fmaxf(up, -7.0f), 7.0f); hv[q] = (up + 1.0f) * g * sigmoidf_(1.702f * g) * SC_HID; }
                u32x2 w; w.x = pk4_fp8(hv[0], hv[1], hv[2], hv[3]); w.y = pk4_fp8(hv[4], hv[5], hv[6], hv[7]);
                *(u32x2*)(HID + (size_t)(u.i3 + pos) * DFF + hc) = w; }
    }
};
struct EpiG2 {
    static constexpr bool PERM = true;
    bf16_t* OUT01; bf16_t* Y23; const i32x4* ENT; const unsigned* cnt; const float* bdn;
    __device__ __forceinline__ void operator()(const f32x4 (&acc)[2][2][4][2], const pg8::Unit& u, int wr, int wc, int fr, int fq) const {
        const int e = u.i0, ce = __builtin_amdgcn_readfirstlane((int)cnt[e]), col0 = u.i2 * 256 + wc * 32 + 8 * fq; const i32x4* en = ENT + (size_t)e * T;
        int tk[8], kk[8]; float gt[8];
#pragma unroll
        for (int q = 0; q < 8; ++q) { const int pos = u.i1 * 256 + (q >> 2) * 128 + wr * 64 + (q & 3) * 16 + fr; const i32x4 v = pos < ce ? en[pos] : (i32x4){-1, 0, 0, 0}; tk[q] = v.x; kk[q] = v.z; gt[q] = __int_as_float(v.w); }
        const float* bd = bdn + (size_t)e * D + col0;
        f32x4 b[2][2];
#pragma unroll
        for (int bj = 0; bj < 2; ++bj) { b[bj][0] = *(const f32x4*)(bd + bj * 128); b[bj][1] = *(const f32x4*)(bd + bj * 128 + 4); }
#pragma unroll
        for (int ai = 0; ai < 2; ++ai)
#pragma unroll
            for (int m = 0; m < 4; ++m) { const int q = ai * 4 + m;
                if (tk[q] >= 0) { const float gate = gt[q];
                    bf16_t* dst = (kk[q] < 2 ? OUT01 : Y23) + (size_t)tk[q] * 2048 + (kk[q] & 1) * 1024 + col0;
#pragma unroll
                    for (int bj = 0; bj < 2; ++bj) { const f32x4 y0 = (acc[ai][bj][m][0] * (1.0f / (SC_HID * SC_W)) + b[bj][0]) * gate, y1 = (acc[ai][bj][m][1] * (1.0f / (SC_HID * SC_W)) + b[bj][1]) * gate;
                        u32x4 w; w.x = pk2(y0[0], y0[1]); w.y = pk2(y0[2], y0[3]); w.z = pk2(y1[0], y1[1]); w.w = pk2(y1[2], y1[3]);
                        *(u32x4*)(dst + bj * 128) = w; } } }
    }
};

constexpr int ML_QS = 0, ML_KS = 17408, ML_VS = 34816, ML_PS = 52224, ML_CT = 61440, ML_DENP = 96256, ML_DI = 96768, ML_SSQP = 97024, ML_NARR = 99072, ML_END = 99584;
__device__ __forceinline__ bf16x8 tr_pair(unsigned a0, unsigned a1) {
    u32x2 lo, hi; asm volatile("ds_read_b64_tr_b16 %0, %2\n\tds_read_b64_tr_b16 %1, %3\n\ts_waitcnt lgkmcnt(0)" : "=&v"(lo), "=&v"(hi) : "v"(a0), "v"(a1) : "memory");
    u32x4 r; r.x = lo.x; r.y = lo.y; r.z = hi.x; r.w = hi.y; return __builtin_bit_cast(bf16x8, r);
}
#define TR8(dst, base, OFF0, STEP) do { u32x2 _l[8], _h[8]; \
    asm volatile("ds_read_b64_tr_b16 %0, %16 offset:%17\n\tds_read_b64_tr_b16 %1, %16 offset:%17+1088\n\tds_read_b64_tr_b16 %2, %16 offset:%17+%18\n\tds_read_b64_tr_b16 %3, %16 offset:%17+%18+1088\n\t" \
                 "ds_read_b64_tr_b16 %4, %16 offset:%17+2*%18\n\tds_read_b64_tr_b16 %5, %16 offset:%17+2*%18+1088\n\tds_read_b64_tr_b16 %6, %16 offset:%17+3*%18\n\tds_read_b64_tr_b16 %7, %16 offset:%17+3*%18+1088\n\t" \
                 "ds_read_b64_tr_b16 %8, %16 offset:%17+4*%18\n\tds_read_b64_tr_b16 %9, %16 offset:%17+4*%18+1088\n\tds_read_b64_tr_b16 %10, %16 offset:%17+5*%18\n\tds_read_b64_tr_b16 %11, %16 offset:%17+5*%18+1088\n\t" \
                 "ds_read_b64_tr_b16 %12, %16 offset:%17+6*%18\n\tds_read_b64_tr_b16 %13, %16 offset:%17+6*%18+1088\n\tds_read_b64_tr_b16 %14, %16 offset:%17+7*%18\n\tds_read_b64_tr_b16 %15, %16 offset:%17+7*%18+1088\n\ts_waitcnt lgkmcnt(0)" \
                 : "=&v"(_l[0]), "=&v"(_h[0]), "=&v"(_l[1]), "=&v"(_h[1]), "=&v"(_l[2]), "=&v"(_h[2]), "=&v"(_l[3]), "=&v"(_h[3]), "=&v"(_l[4]), "=&v"(_h[4]), "=&v"(_l[5]), "=&v"(_h[5]), "=&v"(_l[6]), "=&v"(_h[6]), "=&v"(_l[7]), "=&v"(_h[7]) \
                 : "v"(base), "i"(OFF0), "i"(STEP) : "memory"); \
    _Pragma("unroll") for (int _p = 0; _p < 8; ++_p) { u32x4 _r; _r.x = _l[_p].x; _r.y = _l[_p].y; _r.z = _h[_p].x; _r.w = _h[_p].y; dst[_p] = __builtin_bit_cast(bf16x8, _r); } } while (0)
template <int CTRL, int RM> __device__ __forceinline__ float dpp_x(float v, float ident) {
    return __builtin_bit_cast(float, __builtin_amdgcn_update_dpp(__builtin_bit_cast(int, ident), __builtin_bit_cast(int, v), CTRL, RM, 0xf, false));
}
__device__ __forceinline__ float wave_scan_add(float s) {
    s += dpp_x<0x111, 0xf>(s, 0.f); s += dpp_x<0x112, 0xf>(s, 0.f); s += dpp_x<0x114, 0xf>(s, 0.f); s += dpp_x<0x118, 0xf>(s, 0.f);
    s += dpp_x<0x142, 0xa>(s, 0.f); s += dpp_x<0x143, 0xc>(s, 0.f); return s;
}
__device__ __forceinline__ float wave_scan_max(float s) {
    const float ni = -INFINITY;
    s = fmaxf(s, dpp_x<0x111, 0xf>(s, ni)); s = fmaxf(s, dpp_x<0x112, 0xf>(s, ni)); s = fmaxf(s, dpp_x<0x114, 0xf>(s, ni)); s = fmaxf(s, dpp_x<0x118, 0xf>(s, ni));
    s = fmaxf(s, dpp_x<0x142, 0xa>(s, ni)); s = fmaxf(s, dpp_x<0x143, 0xc>(s, ni)); return s;
}
__device__ __forceinline__ void unpack16(const u32x4& a, const u32x4& b, float (&f)[16]) {
    const unsigned w[8] = {a.x, a.y, a.z, a.w, b.x, b.y, b.z, b.w};
#pragma unroll
    for (int i = 0; i < 8; ++i) { f[2 * i] = bflo(w[i]); f[2 * i + 1] = bfhi(w[i]); }
}
__device__ __forceinline__ void mlstm_phase(const PV& p, LAS unsigned char* lds, int bh) {
    const int tid = get_tid(lds);
    const int lane = tid & 63, w = __builtin_amdgcn_readfirstlane(tid >> 6), fr = lane & 15, fq = lane >> 4, tq = (lane & 15) >> 2, tp = lane & 3;
    const int b = bh >> 2, h = bh & 3, srow = tid >> 3, sseg = tid & 7;
    const bf16_t* PROJ = (const bf16_t*)(p.ws() + WS_R2); const float* GATES = (const float*)(p.ws() + WS_GATES); bf16_t* MIX = (bf16_t*)(p.ws() + WS_R1);
    LAS float* DENP = (LAS float*)(lds + ML_DENP); LAS float* DI = (LAS float*)(lds + ML_DI); LAS float* SSQP = (LAS float*)(lds + ML_SSQP); LAS float* NARR = (LAS float*)(lds + ML_NARR);
    const unsigned ldsb = (unsigned)(size_t)lds;
    for (int i = tid; i < 34816 / 16; i += 512) *(LAS u32x4*)(lds + ML_CT + 16 * i) = (u32x4){0u, 0u, 0u, 0u};
    if (tid < 128) NARR[tid] = 0.f;
    f32x4 c3[8];
#pragma unroll
    for (int i = 0; i < 8; ++i) c3[i] = (f32x4){0.f, 0.f, 0.f, 0.f};
    f32x4 nacc = (f32x4){0.f, 0.f, 0.f, 0.f}; float mprev = 0.f;
    bf16x8 ones;
#pragma unroll
    for (int jj = 0; jj < 8; ++jj) ones[jj] = (short)0x3F80;
    float ig = GATES[((size_t)b * SEQ + lane) * 8 + h], lf = GATES[((size_t)b * SEQ + lane) * 8 + 4 + h];
    u32x4 rq0, rq1, rk0, rk1, rv0, rv1;
    { const bf16_t* pr = PROJ + ((size_t)b * SEQ + srow) * NPROJ + h * 128 + 16 * sseg;
      rq0 = *(const u32x4*)pr; rq1 = *(const u32x4*)(pr + 8); rk0 = *(const u32x4*)(pr + 512); rk1 = *(const u32x4*)(pr + 520); rv0 = *(const u32x4*)(pr + 1024); rv1 = *(const u32x4*)(pr + 1032); }
    __syncthreads();
    for (int c = 0; c < SEQ / 64; ++c) {
        const size_t row0 = (size_t)b * SEQ + (size_t)c * 64;
        const float bc = wave_scan_add(lf), u = ig - bc, cm = wave_scan_max(u);
        const float Mt = fmaxf(cm, mprev), M63 = __builtin_bit_cast(float, __builtin_amdgcn_readlane(__builtin_bit_cast(int, Mt), 63)), bL = __builtin_bit_cast(float, __builtin_amdgcn_readlane(__builtin_bit_cast(int, bc), 63));
        if (c + 1 < SEQ / 64) { ig = GATES[(row0 + 64 + lane) * 8 + h]; lf = GATES[(row0 + 64 + lane) * 8 + 4 + h]; }
        const float sq = fexp(M63 - Mt), sk = fexp(u - M63), fl = fexp(-bc - Mt), decay = fexp(mprev - M63);
        mprev = bL + M63;
        { const float sqv = __shfl(sq, srow), skv = __shfl(sk, srow);
          float f[16]; unpack16(rq0, rq1, f);
          float part = 0.f;
#pragma unroll
          for (int j = 0; j < 16; ++j) { f[j] *= sqv; part += f[j] * NARR[16 * sseg + j]; }
          part += __shfl_xor(part, 1); part += __shfl_xor(part, 2); part += __shfl_xor(part, 4);
          if (sseg == 0) DI[srow] = decay * part;
          u32x4 o0, o1; o0.x = pk2(f[0], f[1]); o0.y = pk2(f[2], f[3]); o0.z = pk2(f[4], f[5]); o0.w = pk2(f[6], f[7]); o1.x = pk2(f[8], f[9]); o1.y = pk2(f[10], f[11]); o1.z = pk2(f[12], f[13]); o1.w = pk2(f[14], f[15]);
          *(LAS u32x4*)(lds + ML_QS + srow * 272 + sseg * 32) = o0; *(LAS u32x4*)(lds + ML_QS + srow * 272 + sseg * 32 + 16) = o1;
          unpack16(rk0, rk1, f);
#pragma unroll
          for (int j = 0; j < 16; ++j) f[j] *= skv;
          o0.x = pk2(f[0], f[1]); o0.y = pk2(f[2], f[3]); o0.z = pk2(f[4], f[5]); o0.w = pk2(f[6], f[7]); o1.x = pk2(f[8], f[9]); o1.y = pk2(f[10], f[11]); o1.z = pk2(f[12], f[13]); o1.w = pk2(f[14], f[15]);
          *(LAS u32x4*)(lds + ML_KS + srow * 272 + sseg * 32) = o0; *(LAS u32x4*)(lds + ML_KS + srow * 272 + sseg * 32 + 16) = o1;
          *(LAS u32x4*)(lds + ML_VS + srow * 272 + sseg * 32) = rv0; *(LAS u32x4*)(lds + ML_VS + srow * 272 + sseg * 32 + 16) = rv1; }
        if (c + 1 < SEQ / 64) { const bf16_t* pr = PROJ + (row0 + 64 + srow) * NPROJ + h * 128 + 16 * sseg;
          rq0 = *(const u32x4*)pr; rq1 = *(const u32x4*)(pr + 8); rk0 = *(const u32x4*)(pr + 512); rk1 = *(const u32x4*)(pr + 520); rv0 = *(const u32x4*)(pr + 1024); rv1 = *(const u32x4*)(pr + 1032); }
        u32x2 og[4];
#pragma unroll
        for (int ti = 0; ti < 4; ++ti) og[ti] = *(const u32x2*)(PROJ + (row0 + 16 * ti + fr) * NPROJ + 1536 + h * 128 + 16 * w + 4 * fq);
        __syncthreads();
        { const int ti = w >> 1; float dsum = 0.f;
#pragma unroll
          for (int jj = 0; jj < 2; ++jj) { const int sj = 2 * (w & 1) + jj;
            f32x4 a = (f32x4){0.f, 0.f, 0.f, 0.f};
            if (sj <= ti) {
#pragma unroll
                for (int ks = 0; ks < 4; ++ks) { const bf16x8 ka = *(const LAS bf16x8*)(lds + ML_KS + (16 * sj + fr) * 272 + (32 * ks + 8 * fq) * 2), qb = *(const LAS bf16x8*)(lds + ML_QS + (16 * ti + fr) * 272 + (32 * ks + 8 * fq) * 2);
                    a = __builtin_amdgcn_mfma_f32_16x16x32_bf16(ka, qb, a, 0, 0, 0); }
                const int t = 16 * ti + fr, s0 = 16 * sj + 4 * fq;
#pragma unroll
                for (int r = 0; r < 4; ++r) { if (s0 + r > t) a[r] = 0.f; dsum += a[r]; }
            }
            u32x2 pw; pw.x = pk2(a[0], a[1]); pw.y = pk2(a[2], a[3]);
            *(LAS u32x2*)(lds + ML_PS + (16 * ti + fr) * 144 + (16 * sj + 4 * fq) * 2) = pw; }
          dsum += __shfl_xor(dsum, 16); dsum += __shfl_xor(dsum, 32);
          if (fq == 0) DENP[(w & 1) * 64 + 16 * ti + fr] = dsum; }
        __syncthreads();
        bf16x8 av[2];
        { u32x2 l0, h0, l1, h1; const unsigned a0 = ldsb + ML_VS + (8 * fq + tq) * 272 + (16 * w + 4 * tp) * 2;
          asm volatile("ds_read_b64_tr_b16 %0, %4\n\tds_read_b64_tr_b16 %1, %4 offset:1088\n\tds_read_b64_tr_b16 %2, %4 offset:8704\n\tds_read_b64_tr_b16 %3, %4 offset:9792\n\ts_waitcnt lgkmcnt(0)"
                       : "=&v"(l0), "=&v"(h0), "=&v"(l1), "=&v"(h1) : "v"(a0) : "memory");
          u32x4 r; r.x = l0.x; r.y = l0.y; r.z = h0.x; r.w = h0.y; av[0] = __builtin_bit_cast(bf16x8, r); r.x = l1.x; r.y = l1.y; r.z = h1.x; r.w = h1.y; av[1] = __builtin_bit_cast(bf16x8, r); }
        bf16x8 ac[4];
#pragma unroll
        for (int ks = 0; ks < 4; ++ks) ac[ks] = *(const LAS bf16x8*)(lds + ML_CT + (16 * w + fr) * 272 + (32 * ks + 8 * fq) * 2);
        float xs[4][4];
#pragma unroll
        for (int ti = 0; ti < 4; ++ti) { f32x4 a = (f32x4){0.f, 0.f, 0.f, 0.f}, a2 = (f32x4){0.f, 0.f, 0.f, 0.f};
#pragma unroll
            for (int ks = 0; ks < 2; ++ks) { const bf16x8 pb = *(const LAS bf16x8*)(lds + ML_PS + (16 * ti + fr) * 144 + (32 * ks + 8 * fq) * 2); a = __builtin_amdgcn_mfma_f32_16x16x32_bf16(av[ks], pb, a, 0, 0, 0); }
#pragma unroll
            for (int ks = 0; ks < 4; ++ks) { const bf16x8 qb = *(const LAS bf16x8*)(lds + ML_QS + (16 * ti + fr) * 272 + (32 * ks + 8 * fq) * 2); a2 = __builtin_amdgcn_mfma_f32_16x16x32_bf16(ac[ks], qb, a2, 0, 0, 0); }
            a = a + a2 * decay;
            const int t = 16 * ti + fr; const float den = DENP[t] + DENP[64 + t] + DI[t], flt = __shfl(fl, t), inv = frcp(fmaxf(fabsf(den), flt));
            xs[ti][0] = sigmoidf_(bflo(og[ti].x)) * a[0] * inv; xs[ti][1] = sigmoidf_(bfhi(og[ti].x)) * a[1] * inv; xs[ti][2] = sigmoidf_(bflo(og[ti].y)) * a[2] * inv; xs[ti][3] = sigmoidf_(bfhi(og[ti].y)) * a[3] * inv;
            float ss = xs[ti][0] * xs[ti][0] + xs[ti][1] * xs[ti][1] + xs[ti][2] * xs[ti][2] + xs[ti][3] * xs[ti][3];
            ss += __shfl_xor(ss, 16); ss += __shfl_xor(ss, 32);
            if (fq == 0) SSQP[w * 64 + t] = ss; }
        { const unsigned kb = ldsb + ML_KS + (8 * fq + tq) * 272 + 4 * tp * 2;
          bf16x8 k0[8], k1[8];
          TR8(k0, kb, 0, 32); TR8(k1, kb, 8704, 32);
#pragma unroll
          for (int i = 0; i < 8; ++i) { c3[i] = c3[i] * decay;
              c3[i] = __builtin_amdgcn_mfma_f32_16x16x32_bf16(k0[i], av[0], c3[i], 0, 0, 0); c3[i] = __builtin_amdgcn_mfma_f32_16x16x32_bf16(k1[i], av[1], c3[i], 0, 0, 0);
              if (i == w) { nacc = nacc * decay; nacc = __builtin_amdgcn_mfma_f32_16x16x32_bf16(k0[i], ones, nacc, 0, 0, 0); nacc = __builtin_amdgcn_mfma_f32_16x16x32_bf16(k1[i], ones, nacc, 0, 0, 0); } }
          if (fr == 0) *(LAS f32x4*)(NARR + 16 * w + 4 * fq) = nacc; }
        __syncthreads();
#pragma unroll
        for (int ti = 0; ti < 4; ++ti) { const int t = 16 * ti + fr; float s = 0.f;
#pragma unroll
            for (int ww = 0; ww < 8; ++ww) s += SSQP[ww * 64 + t];
            const float rs = frsq(s * (1.0f / 128.f) + EPS);
            u32x2 o; o.x = pk2(xs[ti][0] * rs, xs[ti][1] * rs); o.y = pk2(xs[ti][2] * rs, xs[ti][3] * rs);
            *(u32x2*)(MIX + (row0 + t) * D + h * 128 + 16 * w + 4 * fq) = o; }
#pragma unroll
        for (int i = 0; i < 8; ++i) { u32x2 cw; cw.x = pk2(c3[i][0], c3[i][1]); cw.y = pk2(c3[i][2], c3[i][3]);
            *(LAS u32x2*)(lds + ML_CT + (16 * w + fr) * 272 + (16 * i + 4 * fq) * 2) = cw; }
    }
    __syncthreads();
}


constexpr int RL_XC = 0, RL_RG = 34816, RL_OUT = 69632, RL_CW = 104448, RL_CARRY = 114688, RL_SSQP = 116736, RL_END = 124928;
template <int S> __device__ __forceinline__ float dpp_shr(float v, float ident) {
    return __builtin_bit_cast(float, __builtin_amdgcn_update_dpp(__builtin_bit_cast(int, ident), __builtin_bit_cast(int, v), 0x110 + S, 0xf, 0xf, false));
}
__device__ __forceinline__ float row_last(float v) { return __builtin_bit_cast(float, __builtin_amdgcn_ds_swizzle(__builtin_bit_cast(int, v), 0x1F0)); }
template <bool FINAL>
__device__ __forceinline__ void rglru_item(const PV& p, LAS unsigned char* lds, int item) {
    const int tid = get_tid(lds);
    const int lane = tid & 63, w = __builtin_amdgcn_readfirstlane(tid >> 6), fr = lane & 15, fq = lane >> 4, srow = tid >> 3, sseg = tid & 7;
    const int b = item >> 4, chunk = item & 15;
    const bf16_t* PROJ = (const bf16_t*)(p.ws() + WS_R2); bf16_t* MIX = (bf16_t*)(p.ws() + WS_R1); float* SUMM = (float*)(p.ws() + WS_SUMM); const bf16_t* WRI = (const bf16_t*)(p.ws() + WS_WRI);
    LAS float* CW = (LAS float*)(lds + RL_CW); LAS float* CARRY = (LAS float*)(lds + RL_CARRY); LAS float* SSQP = (LAS float*)(lds + RL_SSQP);
    const size_t tok0 = (size_t)b * SEQ + (size_t)chunk * 256;
    if (FINAL) GSTAMP(p.ws(), tid, 0);
    for (int i = tid; i < 2560; i += 512) CW[i] = i < 2048 ? p.in(I_CW)[i] : p.in(I_CB)[i - 2048];
    if (FINAL) {
        float carry = 0.f;
        for (int cc = 0; cc < chunk; ++cc) { const float2 ab = *(const float2*)(SUMM + ((size_t)(b * 16 + cc) * 512 + tid) * 2); carry = ab.x * carry + ab.y; }
        CARRY[tid] = carry;
        for (int i = tid; i < 2048; i += 512) SSQP[i] = 0.f;
    }
    u32x4 rx[8], rgr[2];
    auto prefetch = [&](int sidx) {
        const int hd = sidx >> 2, step = sidx & 3; const int tl = step * 64 + srow; const size_t tok = tok0 + tl; const int tseq = chunk * 256 + tl;
        const bf16_t* px = PROJ + tok * NPROJ + 2048 + hd * 128 + 16 * sseg;
#pragma unroll
        for (int j = 0; j < 4; ++j) { if (tseq - 3 + j >= 0) { rx[2 * j] = *(const u32x4*)(px + (ptrdiff_t)(j - 3) * NPROJ); rx[2 * j + 1] = *(const u32x4*)(px + (ptrdiff_t)(j - 3) * NPROJ + 8); } else { rx[2 * j] = (u32x4){0u, 0u, 0u, 0u}; rx[2 * j + 1] = (u32x4){0u, 0u, 0u, 0u}; } }
        if (FINAL) { rgr[0] = *(const u32x4*)(px + 512); rgr[1] = *(const u32x4*)(px + 520); }
    };
    prefetch(0);
    __syncthreads();
    if (FINAL) GSTAMP(p.ws(), tid, 1);
    float hc[4], ptot[4], brv[4], biv[4], spv[4];
    bf16x8 br[4], bi[4], bid;
    for (int sidx = 0; sidx < 16; ++sidx) {
        const int hd = sidx >> 2, step = sidx & 3, buf = sidx & 1;
        if (step == 0) {
#pragma unroll
            for (int ks = 0; ks < 4; ++ks) { br[ks] = *(const bf16x8*)(WRI + ((size_t)(hd * 256 + 16 * w + fr) * 128 + 32 * ks + 8 * fq)); bi[ks] = *(const bf16x8*)(WRI + ((size_t)(hd * 256 + 128 + 16 * w + fr) * 128 + 32 * ks + 8 * fq)); }
#pragma unroll
            for (int jj = 0; jj < 8; ++jj) bid[jj] = (8 * fq + jj == 16 * (w & 1) + fr) ? (short)0x3F80 : (short)0;
#pragma unroll
            for (int r = 0; r < 4; ++r) { const int ch = hd * 128 + 16 * w + 4 * fq + r; brv[r] = p.in(I_BR)[ch]; biv[r] = p.in(I_BI)[ch]; spv[r] = log1pf(fexp(-p.in(I_LAM)[ch]));
                hc[r] = FINAL ? CARRY[ch] : 0.f; ptot[r] = 1.f; }
        }
        { float xc[16];
          const LAS f32x4* cb4 = (const LAS f32x4*)(CW + 2048 + hd * 128 + 16 * sseg);
#pragma unroll
          for (int q = 0; q < 4; ++q) { const f32x4 v = cb4[q]; xc[4 * q] = v.x; xc[4 * q + 1] = v.y; xc[4 * q + 2] = v.z; xc[4 * q + 3] = v.w; }
#pragma unroll
          for (int j = 0; j < 4; ++j) { float xf[16]; unpack16(rx[2 * j], rx[2 * j + 1], xf); const LAS f32x4* cw4 = (const LAS f32x4*)(CW + j * 512 + hd * 128 + 16 * sseg);
#pragma unroll
              for (int q = 0; q < 4; ++q) { const f32x4 v = cw4[q]; xc[4 * q] += v.x * xf[4 * q]; xc[4 * q + 1] += v.y * xf[4 * q + 1]; xc[4 * q + 2] += v.z * xf[4 * q + 2]; xc[4 * q + 3] += v.w * xf[4 * q + 3]; } }
          u32x4 o0, o1; o0.x = pk2(xc[0], xc[1]); o0.y = pk2(xc[2], xc[3]); o0.z = pk2(xc[4], xc[5]); o0.w = pk2(xc[6], xc[7]); o1.x = pk2(xc[8], xc[9]); o1.y = pk2(xc[10], xc[11]); o1.z = pk2(xc[12], xc[13]); o1.w = pk2(xc[14], xc[15]);
          *(LAS u32x4*)(lds + RL_XC + buf * 17408 + srow * 272 + sseg * 32) = o0; *(LAS u32x4*)(lds + RL_XC + buf * 17408 + srow * 272 + sseg * 32 + 16) = o1;
          if (FINAL) { *(LAS u32x4*)(lds + RL_RG + buf * 17408 + srow * 272 + sseg * 32) = rgr[0]; *(LAS u32x4*)(lds + RL_RG + buf * 17408 + srow * 272 + sseg * 32 + 16) = rgr[1]; } }
        if (sidx + 1 < 16) prefetch(sidx + 1);
        __syncthreads();
        if (FINAL && sidx > 0) { const int ps = sidx - 1, phd = ps >> 2, pstep = ps & 3, pbuf = ps & 1;
            const u32x4 v0 = *(const LAS u32x4*)(lds + RL_OUT + pbuf * 17408 + srow * 272 + sseg * 32), v1 = *(const LAS u32x4*)(lds + RL_OUT + pbuf * 17408 + srow * 272 + sseg * 32 + 16);
            bf16_t* dst = MIX + (tok0 + pstep * 64 + srow) * D + 512 + phd * 128 + 16 * sseg; *(u32x4*)dst = v0; *(u32x4*)(dst + 8) = v1; }
        const int ksx = w >> 1;
#pragma unroll
        for (int m = 0; m < 4; ++m) {
            f32x4 ar = (f32x4){0.f, 0.f, 0.f, 0.f}, ai = ar, ax = ar, ag = ar;
#pragma unroll
            for (int ks = 0; ks < 4; ++ks) { const bf16x8 a = *(const LAS bf16x8*)(lds + RL_XC + buf * 17408 + (16 * m + fr) * 272 + (32 * ks + 8 * fq) * 2);
                ar = __builtin_amdgcn_mfma_f32_16x16x32_bf16(br[ks], a, ar, 0, 0, 0); ai = __builtin_amdgcn_mfma_f32_16x16x32_bf16(bi[ks], a, ai, 0, 0, 0); }
            { const bf16x8 a = *(const LAS bf16x8*)(lds + RL_XC + buf * 17408 + (16 * m + fr) * 272 + (32 * ksx + 8 * fq) * 2); ax = __builtin_amdgcn_mfma_f32_16x16x32_bf16(bid, a, ax, 0, 0, 0); }
            if (FINAL) { const bf16x8 a = *(const LAS bf16x8*)(lds + RL_RG + buf * 17408 + (16 * m + fr) * 272 + (32 * ksx + 8 * fq) * 2); ag = __builtin_amdgcn_mfma_f32_16x16x32_bf16(bid, a, ag, 0, 0, 0); }
            float P[4], H[4];
#pragma unroll
            for (int r = 0; r < 4; ++r) { const float rr = sigmoidf_(ar[r] + brv[r]), ii = sigmoidf_(ai[r] + biv[r]), a = fexp(-8.0f * rr * spv[r]);
                P[r] = a; H[r] = fsqrt(fmaxf(1.0f - a * a, 0.f)) * (ii * ax[r]); }
#pragma unroll
            for (int r = 0; r < 4; ++r) { { const float Pp = dpp_shr<1>(P[r], 1.f), Hp = dpp_shr<1>(H[r], 0.f); H[r] = P[r] * Hp + H[r]; P[r] = P[r] * Pp; }
                { const float Pp = dpp_shr<2>(P[r], 1.f), Hp = dpp_shr<2>(H[r], 0.f); H[r] = P[r] * Hp + H[r]; P[r] = P[r] * Pp; }
                { const float Pp = dpp_shr<4>(P[r], 1.f), Hp = dpp_shr<4>(H[r], 0.f); H[r] = P[r] * Hp + H[r]; P[r] = P[r] * Pp; }
                { const float Pp = dpp_shr<8>(P[r], 1.f), Hp = dpp_shr<8>(H[r], 0.f); H[r] = P[r] * Hp + H[r]; P[r] = P[r] * Pp; } }
            float gq[4]; float ss = 0.f;
#pragma unroll
            for (int r = 0; r < 4; ++r) { const float hv = H[r] + P[r] * hc[r];
                if (FINAL) { gq[r] = gelu_tanh(ag[r]) * hv; ss += gq[r] * gq[r]; } else ptot[r] *= row_last(P[r]);
                hc[r] = row_last(hv); }
            if (FINAL) {
                u32x2 ow; ow.x = pk2(gq[0], gq[1]); ow.y = pk2(gq[2], gq[3]);
                *(LAS u32x2*)(lds + RL_OUT + buf * 17408 + (16 * m + fr) * 272 + (16 * w + 4 * fq) * 2) = ow;
                ss += __shfl_xor(ss, 16); ss += __shfl_xor(ss, 32);
                if (fq == 0) SSQP[w * 256 + step * 64 + 16 * m + fr] += ss;
            }
        }
        if (!FINAL && step == 3 && fr == 0) {
#pragma unroll
            for (int r = 0; r < 4; ++r) *(float2*)(SUMM + ((size_t)(b * 16 + chunk) * 512 + hd * 128 + 16 * w + 4 * fq + r) * 2) = make_float2(ptot[r], hc[r]); }
    }
    if (FINAL) {
        __syncthreads();
        GSTAMP(p.ws(), tid, 2);
        { const int ps = 15, phd = 3, pstep = 3, pbuf = ps & 1;
          const u32x4 v0 = *(const LAS u32x4*)(lds + RL_OUT + pbuf * 17408 + srow * 272 + sseg * 32), v1 = *(const LAS u32x4*)(lds + RL_OUT + pbuf * 17408 + srow * 272 + sseg * 32 + 16);
          bf16_t* dst = MIX + (tok0 + pstep * 64 + srow) * D + 512 + phd * 128 + 16 * sseg; *(u32x4*)dst = v0; *(u32x4*)(dst + 8) = v1; }
        asm volatile("s_waitcnt vmcnt(0)" ::: "memory");
        __syncthreads();
        for (int i = tid; i < 256 * 64; i += 512) { const int tl = i >> 6, c8 = i & 63; float s = 0.f;
#pragma unroll
            for (int ww = 0; ww < 8; ++ww) s += SSQP[ww * 256 + tl];
            const float rs = frsq(s * (1.0f / 512.f) + EPS);
            u32x4* ptr = (u32x4*)(MIX + (tok0 + tl) * D + 512 + c8 * 8); u32x4 v = *ptr;
            v.x = pk2(bflo(v.x) * rs, bfhi(v.x) * rs); v.y = pk2(bflo(v.y) * rs, bfhi(v.y) * rs); v.z = pk2(bflo(v.z) * rs, bfhi(v.z) * rs); v.w = pk2(bflo(v.w) * rs, bfhi(v.w) * rs);
            *ptr = v; }
    }
    __syncthreads();
    if (FINAL) GSTAMP(p.ws(), tid, 3);
}

constexpr int RT_WR = 0, RT_SELE = 147456, RT_SELG = RT_SELE + 4096, RT_RSTD = RT_SELG + 4096, RT_HIST = RT_RSTD + 1024, RT_BASE = RT_HIST + 128, RT_LDS = RT_BASE + 128;
__device__ __forceinline__ void routing_block(const PV& p, LAS unsigned char* lds, int tb) {
    const int tid = get_tid(lds), lane = tid & 63, wave = tid >> 6;
    LAS float* WRl = (LAS float*)(lds + RT_WR); LAS int* selE = (LAS int*)(lds + RT_SELE); LAS float* selG = (LAS float*)(lds + RT_SELG);
    LAS float* rstds = (LAS float*)(lds + RT_RSTD); LAS int* hist = (LAS int*)(lds + RT_HIST); LAS int* base = (LAS int*)(lds + RT_BASE);
    for (int i = tid; i < 1024 * 8; i += 512) { const int k = i >> 3, q = i & 7; const float s = p.in(I_N2W)[k];
        f32x4 v = *(const f32x4*)(p.in(I_RW) + (size_t)k * 32 + 4 * q); v = v * s;
        const int rho = ((k >> 8) * 4 + (k & 3)) * 64 + ((k >> 2) & 63); *(LAS f32x4*)(WRl + rho * 36 + 4 * q) = v; }
    if (tid < 32) hist[tid] = 0;
    __syncthreads();
    const float* H = p.out(); bf16_t* HB = (bf16_t*)(p.ws() + WS_R1);
    const float rb = p.in(I_RB)[lane >> 1];
    for (int it = 0; it < 32; ++it) {
        const int tl = it * 8 + wave; const size_t tok = (size_t)tb * 256 + tl;
        const f32x4* hr = (const f32x4*)(H + tok * D) + lane;
        f32x4 v[4]; float s = 0.f;
#pragma unroll
        for (int j = 0; j < 4; ++j) { v[j] = hr[64 * j]; s += (v[j].x * v[j].x + v[j].y * v[j].y) + (v[j].z * v[j].z + v[j].w * v[j].w); }
        const float rstd = frsq(wave_sum(s) * (1.0f / D) + EPS);
        unsigned long long* o8 = (unsigned long long*)(HB + tok * D) + lane;
#pragma unroll
        for (int j = 0; j < 4; ++j) o8[64 * j] = (unsigned long long)pk2(v[j].x, v[j].y) | ((unsigned long long)pk2(v[j].z, v[j].w) << 32);
        { unsigned* o4 = (unsigned*)((unsigned char*)(p.ws() + WS_HB8) + tok * D) + lane;
#pragma unroll
          for (int j = 0; j < 4; ++j) o4[64 * j] = pk4_fp8(clamp448(v[j].x * SC_H), clamp448(v[j].y * SC_H), clamp448(v[j].z * SC_H), clamp448(v[j].w * SC_H)); }
        float acc[32];
#pragma unroll
        for (int q = 0; q < 32; ++q) acc[q] = 0.f;
#pragma unroll
        for (int j = 0; j < 4; ++j)
#pragma unroll
            for (int c = 0; c < 4; ++c) { const float hv = c == 0 ? v[j].x : c == 1 ? v[j].y : c == 2 ? v[j].z : v[j].w;
                const LAS f32x4* wrow = (const LAS f32x4*)(WRl + ((j * 4 + c) * 64 + lane) * 36);
#pragma unroll
                for (int q = 0; q < 8; ++q) { const f32x4 wv = wrow[q]; acc[4 * q + 0] += hv * wv.x; acc[4 * q + 1] += hv * wv.y; acc[4 * q + 2] += hv * wv.z; acc[4 * q + 3] += hv * wv.w; } }
#pragma unroll
        for (int q = 0; q < 16; ++q) { const bool up = (lane & 32) != 0; const float send = up ? acc[q] : acc[q + 16], keep = up ? acc[q + 16] : acc[q]; acc[q] = keep + __shfl_xor(send, 32); }
#pragma unroll
        for (int q = 0; q < 8; ++q) { const bool up = (lane & 16) != 0; const float send = up ? acc[q] : acc[q + 8], keep = up ? acc[q + 8] : acc[q]; acc[q] = keep + __shfl_xor(send, 16); }
#pragma unroll
        for (int q = 0; q < 4; ++q) { const bool up = (lane & 8) != 0; const float send = up ? acc[q] : acc[q + 4], keep = up ? acc[q + 4] : acc[q]; acc[q] = keep + __shfl_xor(send, 8); }
#pragma unroll
        for (int q = 0; q < 2; ++q) { const bool up = (lane & 4) != 0; const float send = up ? acc[q] : acc[q + 2], keep = up ? acc[q + 2] : acc[q]; acc[q] = keep + __shfl_xor(send, 4); }
        { const bool up = (lane & 2) != 0; const float send = up ? acc[0] : acc[1], keep = up ? acc[1] : acc[0]; acc[0] = keep + __shfl_xor(send, 2); }
        float logit = (acc[0] + __shfl_xor(acc[0], 1)) * rstd + rb;
        float tv[4]; int te[4];
#pragma unroll
        for (int k = 0; k < 4; ++k) {
            float mx = logit;
#pragma unroll
            for (int o = 2; o < 64; o <<= 1) mx = fmaxf(mx, __shfl_xor(mx, o));
            const unsigned long long bal = __ballot(logit == mx);
            const int src = __ffsll((long long)bal) - 1; te[k] = src >> 1; tv[k] = mx;
            if ((lane >> 1) == te[k]) logit = -INFINITY;
        }
        const float e1 = fexp(tv[1] - tv[0]), e2 = fexp(tv[2] - tv[0]), e3 = fexp(tv[3] - tv[0]), inv = 1.0f / (1.0f + e1 + e2 + e3);
        if (lane < 4) { const int ee = lane == 0 ? te[0] : lane == 1 ? te[1] : lane == 2 ? te[2] : te[3]; const float gg = (lane == 0 ? 1.0f : lane == 1 ? e1 : lane == 2 ? e2 : e3) * inv;
            selE[tl * 4 + lane] = ee; selG[tl * 4 + lane] = gg; }
        if (lane == 0) rstds[tl] = rstd;
    }
    __syncthreads();
    int myrank[2], mye[2];
#pragma unroll
    for (int q = 0; q < 2; ++q) { const int a = tid + 512 * q; mye[q] = selE[a]; myrank[q] = atomicAdd((int*)(hist + mye[q]), 1); }
    __syncthreads();
    unsigned* ctl = (unsigned*)(p.ws() + WS_CTL);
    if (tid < 32) base[tid] = (int)atomicAdd(ctl + CW_CNT + tid, (unsigned)hist[tid]);
    __syncthreads();
    i32x4* ENT = (i32x4*)(p.ws() + WS_ENT);
#pragma unroll
    for (int q = 0; q < 2; ++q) { const int a = tid + 512 * q, tl = a >> 2, k = a & 3; const int pos = base[mye[q]] + myrank[q];
        i32x4 en; en.x = tb * 256 + tl; en.y = __float_as_int(rstds[tl]); en.z = k; en.w = __float_as_int(selG[a]); ENT[(size_t)mye[q] * T + pos] = en; }
}
__device__ __forceinline__ void routing_phase(const PV& p, LAS unsigned char* lds) {
    for (int tb = blockIdx.x; tb < T / 256; tb += gridDim.x) { routing_block(p, lds, tb); __syncthreads(); }
}

struct Rounds { int es; int nr; __device__ __forceinline__ int lo(int r) const { return r == 0 ? 0 : es; } __device__ __forceinline__ int hi(int r) const { return r == 0 ? es : NE; } };
__device__ __forceinline__ int pad256(int c) { return (c + 255) & ~255; }
__device__ __forceinline__ Rounds make_rounds(const unsigned* cnt) {
    Rounds R; int sum = 0, e = 0;
    for (; e < NE; ++e) { const int pc = pad256((int)cnt[e]); if (sum + pc > CAP_ROWS) break; sum += pc; }
    R.es = e; R.nr = e < NE ? 2 : 1; return R;
}
__device__ __forceinline__ void combine_rows(const PV& p, int gw, int ngw, int lane) {
    const bf16_t* HB = (const bf16_t*)(p.ws() + WS_R1); const bf16_t* Y23 = (const bf16_t*)(p.ws() + WS_Y23);
    f32x4 fw[4];
#pragma unroll
    for (int q = 0; q < 4; ++q) fw[q] = *(const f32x4*)(p.in(I_FNW) + 512 * (q >> 1) + 8 * lane + 4 * (q & 1));
    for (int m = gw; m < T; m += ngw) {
        float v[16];
        const u32x4 h0 = *(const u32x4*)(HB + (size_t)m * D + 8 * lane), h1 = *(const u32x4*)(HB + (size_t)m * D + 512 + 8 * lane);
        const unsigned hw[8] = {h0.x, h0.y, h0.z, h0.w, h1.x, h1.y, h1.z, h1.w};
#pragma unroll
        for (int q = 0; q < 8; ++q) { v[2 * q] = bflo(hw[q]); v[2 * q + 1] = bfhi(hw[q]); }
#pragma unroll
        for (int k = 0; k < 4; ++k) { const bf16_t* yb = (k < 2 ? (const bf16_t*)p.out() : Y23) + (size_t)m * 2048 + (k & 1) * 1024;
            const u32x4 y0 = *(const u32x4*)(yb + 8 * lane), y1 = *(const u32x4*)(yb + 512 + 8 * lane);
            const unsigned yw[8] = {y0.x, y0.y, y0.z, y0.w, y1.x, y1.y, y1.z, y1.w};
#pragma unroll
            for (int q = 0; q < 8; ++q) { v[2 * q] += bflo(yw[q]); v[2 * q + 1] += bfhi(yw[q]); } }
        float s = 0.f;
#pragma unroll
        for (int q = 0; q < 16; ++q) s += v[q] * v[q];
        const float rstd = frsq(wave_sum(s) * (1.0f / D) + EPS);
        float* o = p.out() + (size_t)m * D;
#pragma unroll
        for (int q = 0; q < 4; ++q) { f32x4 r; r.x = v[4 * q] * rstd * fw[q].x; r.y = v[4 * q + 1] * rstd * fw[q].y; r.z = v[4 * q + 2] * rstd * fw[q].z; r.w = v[4 * q + 3] * rstd * fw[q].w;
            *(f32x4*)(o + 512 * (q >> 1) + 8 * lane + 4 * (q & 1)) = r; }
    }
}
#ifndef REP_P0
#define REP_P0 1
#endif
#ifndef REP_P1
#define REP_P1 1
#endif
#ifndef REP_P2
#define REP_P2 1
#endif
#ifndef REP_P3
#define REP_P3 1
#endif
#ifndef REP_P4
#define REP_P4 1
#endif
#ifndef REP_G1
#define REP_G1 1
#endif
#ifndef REP_G2
#define REP_G2 1
#endif
__global__ void __launch_bounds__(512, 2) fwd(Params kp) {
    extern __shared__ __attribute__((aligned(16))) unsigned char lds_[];
    LAS unsigned char* lds = (LAS unsigned char*)lds_;
    {
        const int t0 = threadIdx.x;
        if (t0 < 22) *(volatile LAS unsigned long long*)(lds + LDS_PTAB_OFF + 8 * t0) = (unsigned long long)(size_t)kp.in[t0];
        if (t0 == 22) *(volatile LAS unsigned long long*)(lds + LDS_PTAB_OFF + 8 * 22) = (unsigned long long)(size_t)kp.out;
        if (t0 == 23) *(volatile LAS unsigned long long*)(lds + LDS_PTAB_OFF + 8 * 23) = (unsigned long long)(size_t)kp.ws;
    }
    unsigned char* ws = kp.ws;
    unsigned* bar = (unsigned*)(ws + WS_CTL) + CW_BAR;
    const PV p{lds};
    {
        const int t0 = threadIdx.x;
        const unsigned slot = (unsigned)__builtin_amdgcn_s_getreg(((6 - 1) << 11) | 4);
        if ((t0 & 63) == 0) *(volatile LAS int*)(lds + LDS_TAB + 4 * slot) = t0 >> 6;
        if (t0 == 0) { *(volatile LAS unsigned*)(lds + LDS_BARST) = 0u; *(volatile LAS unsigned*)(lds + LDS_BARST + 4) = 0u;
            const unsigned x = xb_xcc_id(), rank = xb_add(&bar[XB_XCNT(x)], 1u);
            *(volatile LAS unsigned*)(lds + LDS_BARST + 8) = rank * 8u + x; }
        __syncthreads();
    }
#ifdef PROBE_PH
    volatile LAS unsigned long long* phs = (volatile LAS unsigned long long*)(lds + LDS_TAB - 256); int nph = 0;
#define PH_STAMP() do { if (get_tid(lds) == 0) phs[nph] = __builtin_amdgcn_s_memrealtime(); ++nph; } while (0)
    PH_STAMP();
#define GRID_BAR() do { grid_barrier(bar, lds); PH_STAMP(); } while (0)
#else
#define PH_STAMP() do { } while (0)
#define GRID_BAR() grid_barrier(bar, lds)
#endif
    for (int rep = 0; rep < REP_P0; ++rep) { prep_phase(p, lds);
    cg::this_grid().sync(); PH_STAMP(); }
    int vcu = (int)blockIdx.x;
    { bool even = (gridDim.x % 8u) == 0u;
      for (unsigned j = 0; j < 16; ++j) { const unsigned c = xb_ld(&bar[XB_XCNT(j)]); if (c != (j < 8 ? gridDim.x / 8u : 0u)) even = false; }
      if (even) vcu = (int)*(volatile LAS unsigned*)(lds + LDS_BARST + 8);
      vcu = __builtin_amdgcn_readfirstlane(vcu); }
    for (int rep = 0; rep < REP_P1; ++rep) {
    { DenseSched S; S.o.init(T / 256, NPROJ / 256, gridDim.x, vcu); S.A = (const char*)(ws + WS_R1); S.Bt = (const char*)(ws + WS_WIN); S.pitch = 2 * D; EpiInProj E{(bf16_t*)(ws + WS_R2)};
      pg8::gemm_phase<false, false>(lds, (const char*)(ws + WS_R1), 2 * D, S, E); }
    GRID_BAR(); }
    for (int rep = 0; rep < REP_P2; ++rep) {
    GSTAMP(ws, get_tid(lds), 4);
    if (blockIdx.x < 64) mlstm_phase(p, lds, blockIdx.x);
    else {
        for (int it = blockIdx.x - 64; it < 256; it += gridDim.x - 64) rglru_item<false>(p, lds, it);
        GSTAMP(ws, get_tid(lds), 5);
        moe_conv_phase(p, lds, 64); }
    GSTAMP(ws, get_tid(lds), 6);
    GRID_BAR(); }
    for (int rep = 0; rep < REP_P3; ++rep) {
    for (int it = blockIdx.x; it < 256; it += gridDim.x) rglru_item<true>(p, lds, it);
    GRID_BAR(); }
    for (int rep = 0; rep < REP_P4; ++rep) {
    { DenseSched S; S.o.init(T / 256, D / 256, gridDim.x, vcu); S.A = (const char*)(ws + WS_R1); S.Bt = (const char*)(ws + WS_WOUT); S.pitch = 2 * D; EpiOutProj E{p.in(I_X), p.out()};
      pg8::gemm_phase<false, false>(lds, (const char*)(ws + WS_R1), 2 * D, S, E); }
    GRID_BAR(); }
    routing_phase(p, lds);
    GRID_BAR();
    const unsigned* cnt = (const unsigned*)(ws + WS_CTL) + CW_CNT;
    const Rounds RR = make_rounds(cnt);
    for (int r = 0; r < RR.nr; ++r) {
        for (int rep = 0; rep < REP_G1; ++rep) {
        { MoeSched<true, 8, 2 * DFF> S{cnt, (const i32x4*)(ws + WS_ENT), (const char*)(ws + WS_HB8), (const char*)(ws + WS_WGU), RR.lo(r), RR.hi(r), (int)gridDim.x, vcu, 0}; S.init_tot();
          EpiG1 E{(unsigned char*)(ws + WS_R2), (const i32x4*)(ws + WS_ENT), cnt, p.in(I_BGU)};
          pg8::gemm_phase<true, true>(lds, (const char*)(ws + WS_HB8), D, S, E); }
        GRID_BAR(); }
        for (int rep = 0; rep < REP_G2; ++rep) {
        { MoeSched<false, 4, D> S{cnt, (const i32x4*)(ws + WS_ENT), (const char*)(ws + WS_R2), (const char*)(ws + WS_WDN), RR.lo(r), RR.hi(r), (int)gridDim.x, vcu, 0}; S.init_tot();
          EpiG2 E{(bf16_t*)p.out(), (bf16_t*)(ws + WS_Y23), (const i32x4*)(ws + WS_ENT), cnt, p.in(I_BDN)};
          pg8::gemm_phase<true, false>(lds, (const char*)(ws + WS_R2), DFF, S, E); }
        GRID_BAR(); }
    }
    { const int tid = get_tid(lds); combine_rows(p, blockIdx.x * 8 + (tid >> 6), gridDim.x * 8, tid & 63); }
#ifdef PROBE_G
    if (blockIdx.x == PROBE_BLK && get_tid(lds) == 0) {
        const volatile unsigned long long* st = (const volatile unsigned long long*)(ws + WS_CTL + 40960);
        const unsigned long long ticks = (st[PROBE_I + 1] - st[PROBE_I]) * PROBE_MUL;
        const unsigned long long t0 = __builtin_amdgcn_s_memrealtime();
        while (__builtin_amdgcn_s_memrealtime() - t0 < ticks) __builtin_amdgcn_s_sleep(8);
    }
#endif
#ifdef PROBE_PH
    PH_STAMP();
    if (vcu == 0 && get_tid(lds) == 0) {
        const unsigned long long ticks = (phs[PROBE_PH + 1] - phs[PROBE_PH]) * PROBE_MUL;
        const unsigned long long t0 = __builtin_amdgcn_s_memrealtime();
        while (__builtin_amdgcn_s_memrealtime() - t0 < ticks) __builtin_amdgcn_s_sleep(8);
    }
#endif
}

extern "C" void kernel_launch(void* const* d_in, const int* in_sizes, int n_in, void* d_out, int out_size, void* d_ws, size_t ws_size, hipStream_t stream) {
    static int grid = 0;
    if (grid == 0) {
        if (n_in != 22 || ws_size < WS_END) { fprintf(stderr, "kernel_launch: unexpected n_in %d / ws_size %zu (need %zu)\n", n_in, ws_size, (size_t)WS_END); grid = -1; return; }
        int dev = 0, cus = 0, per_cu = 0;
        (void)hipGetDevice(&dev); (void)hipDeviceGetAttribute(&cus, hipDeviceAttributeMultiprocessorCount, dev);
        (void)hipFuncSetAttribute((const void*)fwd, hipFuncAttributeMaxDynamicSharedMemorySize, LDS_BYTES);
        (void)hipOccupancyMaxActiveBlocksPerMultiprocessor(&per_cu, (const void*)fwd, 512, LDS_BYTES);
        if (per_cu < 1) { fprintf(stderr, "kernel_launch: occupancy query says %d blocks/CU\n", per_cu); per_cu = 1; }
        grid = cus * per_cu;
        fprintf(stderr, "kernel_launch: grid %d (cus %d x %d)\n", grid, cus, per_cu);
    }
    if (grid < 0) return;
    Params p{};
    for (int i = 0; i < 22; ++i) p.in[i] = (const float*)d_in[i];
    p.out = (float*)d_out; p.ws = (unsigned char*)d_ws;
    (void)hipMemsetAsync((unsigned char*)d_ws + WS_CTL, 0, 65536, stream);
    void* args[] = {&p};
    hipError_t e = hipLaunchCooperativeKernel((const void*)fwd, dim3(grid), dim3(512), args, LDS_BYTES, stream);
    if (e != hipSuccess) fprintf(stderr, "kernel_launch: cooperative launch failed: %s (grid %d)\n", hipGetErrorString(e), grid);
}
```

```cpp
#include <hip/hip_runtime.h>
#include <hip/hip_cooperative_groups.h>
#include <cstdio>
#include <cstdint>

namespace cg = cooperative_groups;
#define LAS __attribute__((address_space(3)))
typedef unsigned short bf16_t;
typedef short bf16x8 __attribute__((ext_vector_type(8)));
typedef float f32x4 __attribute__((ext_vector_type(4)));
typedef unsigned u32x4 __attribute__((ext_vector_type(4)));
typedef unsigned u32x2 __attribute__((ext_vector_type(2)));
typedef int i32x4 __attribute__((ext_vector_type(4)));

constexpr int T = 65536, D = 1024, SEQ = 4096, NB = 16;
constexpr int INC = 3080;
constexpr int NPROJ = 3072;
constexpr int NE = 32, TOPK = 4, DFF = 1024;
constexpr float EPS = 1e-6f;
constexpr int CAP_ROWS = 270336;
constexpr float SC_H = 8.0f, SC_W = 64.0f, SC_HID = 4.0f;

constexpr size_t MB = 1024 * 1024;
constexpr size_t WS_CTL  = 0;
constexpr size_t WS_GATES = 1 * MB;
constexpr size_t WS_SSQR = 3 * MB;
constexpr size_t WS_SUMM = 4 * MB;
constexpr size_t WS_WRI  = 5 * MB;
constexpr size_t WS_WRT  = 5 * MB + 512 * 1024;
constexpr size_t WS_ENT  = 6 * MB;
constexpr size_t WS_WIN  = 38 * MB;
constexpr size_t WS_WOUT = 44 * MB;
constexpr size_t WS_WGU  = 46 * MB;
constexpr size_t WS_WDN  = 110 * MB;
constexpr size_t WS_HB8  = 142 * MB;
constexpr size_t WS_R1   = 238 * MB;
constexpr size_t WS_R2   = 366 * MB;
constexpr size_t WS_Y23  = 750 * MB;
constexpr size_t WS_END  = 1006 * MB;

constexpr int CW_CNT = 0;
constexpr int CW_WORK = 64;
constexpr int CW_BAR = 1024;

__device__ __forceinline__ unsigned pk2(float lo, float hi) { unsigned r; asm("v_cvt_pk_bf16_f32 %0, %1, %2" : "=v"(r) : "v"(lo), "v"(hi)); return r; }
__device__ __forceinline__ float bflo(unsigned u) { return __uint_as_float(u << 16); }
__device__ __forceinline__ float bfhi(unsigned u) { return __uint_as_float(u & 0xffff0000u); }
__device__ __forceinline__ float bf2f(bf16_t b) { return __uint_as_float(((unsigned)b) << 16); }
template <int CTRL, int RM> __device__ __forceinline__ float dpp_x(float v, float ident) {
    return __builtin_bit_cast(float, __builtin_amdgcn_update_dpp(__builtin_bit_cast(int, ident), __builtin_bit_cast(int, v), CTRL, RM, 0xf, false));
}
__device__ __forceinline__ float wave_sum(float s) {
    s += dpp_x<0x111, 0xf>(s, 0.f); s += dpp_x<0x112, 0xf>(s, 0.f); s += dpp_x<0x114, 0xf>(s, 0.f); s += dpp_x<0x118, 0xf>(s, 0.f);
    s += dpp_x<0x142, 0xa>(s, 0.f); s += dpp_x<0x143, 0xc>(s, 0.f);
    return __builtin_bit_cast(float, __builtin_amdgcn_readlane(__builtin_bit_cast(int, s), 63));
}
__device__ __forceinline__ float fexp(float x) { return __builtin_amdgcn_exp2f(x * 1.4426950408889634f); }
__device__ __forceinline__ float frcp(float x) { return __builtin_amdgcn_rcpf(x); }
__device__ __forceinline__ float fsqrt(float x) { return __builtin_amdgcn_sqrtf(x); }
__device__ __forceinline__ float frsq(float x) { return __builtin_amdgcn_rsqf(x); }
__device__ __forceinline__ float sigmoidf_(float x) { return frcp(1.0f + __builtin_amdgcn_exp2f(x * -1.4426950408889634f)); }
__device__ __forceinline__ float gelu_tanh(float x) {
    const float u2 = 1.5957691216057308f * (x + 0.044715f * x * x * x);
    return x * sigmoidf_(u2);
}

typedef int i32x8 __attribute__((ext_vector_type(8)));
__device__ __forceinline__ unsigned pk4_fp8(float a, float b, float c, float d) {
    int r = __builtin_amdgcn_cvt_pk_fp8_f32(a, b, 0, false); r = __builtin_amdgcn_cvt_pk_fp8_f32(c, d, r, true); return (unsigned)r;
}
__device__ __forceinline__ float clamp448(float x) { return fminf(fmaxf(x, -448.f), 448.f); }

struct Params {
    const float* in[22];
    float* out;
    unsigned char* ws;
    int pad0, pad1;
};
constexpr int LDS_PTAB_OFF = 159744 - 512 - 256 - 256;
struct PV {
    LAS unsigned char* l;
    __device__ __forceinline__ unsigned long long ptr(int i) const { const u32x2 v = *(volatile LAS u32x2*)(l + LDS_PTAB_OFF + 8 * i);
        return ((unsigned long long)(unsigned)__builtin_amdgcn_readfirstlane((int)v.y) << 32) | (unsigned)__builtin_amdgcn_readfirstlane((int)v.x); }
    __device__ __forceinline__ const float* in(int i) const { return (const float*)(size_t)ptr(i); }
    __device__ __forceinline__ float* out() const { return (float*)(size_t)ptr(22); }
    __device__ __forceinline__ unsigned char* ws() const { return (unsigned char*)(size_t)ptr(23); }
};
enum { I_X = 0, I_N1W, I_WIN, I_GB, I_MNW, I_CW, I_CB, I_WR, I_BR, I_WI, I_BI, I_LAM, I_LNW, I_WOUT, I_N2W, I_RW, I_RB, I_WGU, I_BGU, I_WDN, I_BDN, I_FNW };


constexpr int LDS_BYTES = 159744, LDS_TAB = LDS_BYTES - 512, LDS_BARST = LDS_BYTES - 16;
__device__ __forceinline__ int get_tid(LAS unsigned char* lds) {
    const unsigned slot = (unsigned)__builtin_amdgcn_s_getreg(((6 - 1) << 11) | 4);
    const int w = __builtin_amdgcn_readfirstlane(*(volatile LAS int*)(lds + LDS_TAB + 4 * slot));
    int lane; asm volatile("v_mbcnt_lo_u32_b32 %0, -1, 0\n\tv_mbcnt_hi_u32_b32 %0, -1, %0" : "=v"(lane));
    return w * 64 + lane;
}
#define XB_TMO      128
#define XB_XCNT(j)  (256  + 64 * (j))
#define XB_XSUB(j)  (1280 + 64 * (j))
#define XB_XGEN(j)  (2304 + 64 * (j))
#define XB_TOP      3328
#define XB_TOPGEN   3392
#define XCD_BAR_WORDS 3456
#define XB_SPIN_CAP (1u << 22)
__device__ __forceinline__ unsigned xb_ld(unsigned* p)              { return __hip_atomic_load(p, __ATOMIC_RELAXED, __HIP_MEMORY_SCOPE_AGENT); }
__device__ __forceinline__ unsigned xb_add(unsigned* p, unsigned v) { return __hip_atomic_fetch_add(p, v, __ATOMIC_RELAXED, __HIP_MEMORY_SCOPE_AGENT); }
__device__ __forceinline__ unsigned xb_xcc_id() { return (unsigned)__builtin_amdgcn_s_getreg((3 << 11) | 20) & 0xFu; }
#define XB_SPIN(cond, bar) do { unsigned _sp = 0; while (cond) { __builtin_amdgcn_s_sleep(1); \
    if ((++_sp & 255u) == 0u) { if (xb_ld(&(bar)[XB_TMO])) break; if (_sp > XB_SPIN_CAP) { atomicAdd(&(bar)[XB_TMO], 1u); break; } } } } while (0)
__device__ __forceinline__ void xcd_barrier_complete(unsigned* bar, unsigned x, unsigned G, unsigned& nloc, unsigned& nx) {
    unsigned sum, cnt, mine, sp = 0u;
    for (;;) {
        sum = 0u; cnt = 0u; mine = 0u;
#pragma unroll
        for (unsigned j = 0; j < 16; ++j) { const unsigned c = xb_ld(&bar[XB_XCNT(j)]); sum += c; cnt += (c > 0u) ? 1u : 0u; mine = (j == x) ? c : mine; }
        if (sum == G) break;
        __builtin_amdgcn_s_sleep(1);
        if ((++sp & 255u) == 0u) { if (xb_ld(&bar[XB_TMO])) break; if (sp > XB_SPIN_CAP) { atomicAdd(&bar[XB_TMO], 1u); break; } }
    }
    nloc = mine > 0u ? mine : 1u; nx = cnt > 0u ? cnt : 1u;
}
__device__ __forceinline__ void grid_barrier(unsigned* bar, LAS unsigned char* lds) {
    asm volatile("s_waitcnt vmcnt(0)" ::: "memory");
    __syncthreads();
    if (get_tid(lds) == 0) {
        volatile LAS unsigned* st = (volatile LAS unsigned*)(lds + LDS_BARST);
        const unsigned x = xb_xcc_id();
        __builtin_amdgcn_s_waitcnt(0);
        unsigned nloc = st[0], nx = st[1];
        if (nloc == 0u) { xcd_barrier_complete(bar, x, gridDim.x, nloc, nx); st[0] = nloc; st[1] = nx; }
        const unsigned old = xb_add(&bar[XB_XSUB(x)], 1u);
        const unsigned gen = old / nloc;
        if (old + 1u == (gen + 1u) * nloc) {
            __builtin_amdgcn_fence(__ATOMIC_RELEASE, "agent");
            asm volatile("s_waitcnt vmcnt(0)" ::: "memory");
            const unsigned og = xb_add(&bar[XB_TOP], 1u);
            const unsigned tg = og / nx;
            if (og + 1u == (tg + 1u) * nx) xb_add(&bar[XB_TOPGEN], 1u);
            else XB_SPIN(xb_ld(&bar[XB_TOPGEN]) == tg, bar);
            __builtin_amdgcn_fence(__ATOMIC_ACQUIRE, "agent");
            xb_add(&bar[XB_XGEN(x)], 1u);
            asm volatile("s_waitcnt vmcnt(0)" ::: "memory");
        } else {
            XB_SPIN(xb_ld(&bar[XB_XGEN(x)]) == gen, bar);
            __builtin_amdgcn_fence(__ATOMIC_ACQUIRE, "agent");
            asm volatile("s_waitcnt vmcnt(0)" ::: "memory");
        }
    }
    __syncthreads();
}

#ifdef PROBE_G
#define GSTAMP(ws_, tid_, i_) do { if (((i_) == PROBE_I || (i_) == PROBE_I + PROBE_SPAN) && blockIdx.x == PROBE_BLK && (tid_) == 0) ((volatile unsigned long long*)((ws_) + WS_CTL + 40960))[i_] = __builtin_amdgcn_s_memrealtime(); } while (0)
#else
#define GSTAMP(ws_, tid_, i_) do { } while (0)
#endif
__device__ __forceinline__ void tr_item(const float* __restrict__ W, int ldw, int col0, bf16_t* dst, int K, int k0, const float* sk, float mul, LAS float* scr, int lane) {
    float v[32];
    const float* src = W + (size_t)(k0 + (lane >> 5)) * ldw + col0 + (lane & 31);
#pragma unroll
    for (int i = 0; i < 32; ++i) v[i] = __builtin_nontemporal_load(src + (size_t)(2 * i) * ldw);
#pragma unroll
    for (int i = 0; i < 32; ++i) { const int kk = 2 * i + (lane >> 5); const float s = sk ? sk[k0 + kk] * mul : mul; scr[kk * 33 + (lane & 31)] = v[i] * s; }
    asm volatile("s_waitcnt lgkmcnt(0)" ::: "memory");
    const int c = lane & 7;
#pragma unroll
    for (int j = 0; j < 4; ++j) { const int n = (lane >> 3) + 8 * j; const LAS float* s = scr + (8 * c) * 33 + n;
        u32x4 o; o.x = pk2(s[0 * 33], s[1 * 33]); o.y = pk2(s[2 * 33], s[3 * 33]); o.z = pk2(s[4 * 33], s[5 * 33]); o.w = pk2(s[6 * 33], s[7 * 33]);
        *(u32x4*)(dst + (size_t)n * K + k0 + 8 * c) = o; }
    asm volatile("s_waitcnt lgkmcnt(0)" ::: "memory");
}
__device__ __forceinline__ void tr_item_f8(const float* __restrict__ W, int ldw, int col0, unsigned char* dst, int K, int k0, const float* sk, float mul, LAS float* scr, int lane) {
    float v[32];
    const float* src = W + (size_t)(k0 + (lane >> 5)) * ldw + col0 + (lane & 31);
#pragma unroll
    for (int i = 0; i < 32; ++i) v[i] = __builtin_nontemporal_load(src + (size_t)(2 * i) * ldw);
#pragma unroll
    for (int i = 0; i < 32; ++i) { const int kk = 2 * i + (lane >> 5); const float s = sk ? sk[k0 + kk] * mul : mul; scr[kk * 33 + (lane & 31)] = clamp448(v[i] * s); }
    asm volatile("s_waitcnt lgkmcnt(0)" ::: "memory");
    const int c = lane & 3;
#pragma unroll
    for (int j = 0; j < 2; ++j) { const int n = (lane >> 2) + 16 * j; const LAS float* s = scr + (16 * c) * 33 + n;
        u32x4 o; o.x = pk4_fp8(s[0 * 33], s[1 * 33], s[2 * 33], s[3 * 33]); o.y = pk4_fp8(s[4 * 33], s[5 * 33], s[6 * 33], s[7 * 33]);
        o.z = pk4_fp8(s[8 * 33], s[9 * 33], s[10 * 33], s[11 * 33]); o.w = pk4_fp8(s[12 * 33], s[13 * 33], s[14 * 33], s[15 * 33]);
        *(u32x4*)(dst + (size_t)n * K + k0 + 16 * c) = o; }
    asm volatile("s_waitcnt lgkmcnt(0)" ::: "memory");
}
constexpr int IT_WIN = 16 * 96, IT_WOUT = 16 * 32, IT_WGU_E = 16 * 64, IT_WDN_E = 16 * 32;
__device__ __forceinline__ void conv_item_small(const PV& p, int it, LAS float* scr, int lane) {
    if (it < IT_WIN) {
        const int kb = it / 96, nb = it % 96, n0 = 32 * nb, sec = n0 >> 9;
        const int secoff = sec == 0 ? 0 : sec == 1 ? 512 : sec == 2 ? 1024 : sec == 3 ? 1544 : sec == 4 ? 2056 : 2568;
        const float mul = sec == 1 ? 0.08838834764831845f : 1.0f;
        tr_item(p.in(I_WIN), INC, secoff + (n0 & 511), (bf16_t*)(p.ws() + WS_WIN) + (size_t)n0 * D, D, 64 * kb, nullptr, mul, scr, lane);
    } else {
        it -= IT_WIN; const int kb = it / 32, nb = it % 32, k0 = 64 * kb;
        const float* sk = k0 < 512 ? p.in(I_MNW) : p.in(I_LNW) - 512;
        tr_item(p.in(I_WOUT), D, 32 * nb, (bf16_t*)(p.ws() + WS_WOUT) + (size_t)(32 * nb) * D, D, k0, sk, 1.0f, scr, lane);
    }
}
__device__ __forceinline__ void conv_item_moe(const PV& p, int it, LAS float* scr, int lane) {
    if (it < NE * IT_WGU_E) {
        const int e = it / IT_WGU_E, r = it % IT_WGU_E, kb = r / 64, nb = r % 64, n0 = 32 * nb, j = n0 >> 8, c0 = n0 & 255;
        const int srccol = c0 < 128 ? 128 * j + c0 : 1024 + 128 * j + (c0 - 128);
        tr_item_f8(p.in(I_WGU) + (size_t)e * D * 2 * DFF, 2 * DFF, srccol, (unsigned char*)(p.ws() + WS_WGU) + ((size_t)e * 2 * DFF + n0) * D, D, 64 * kb, p.in(I_N2W), SC_W, scr, lane);
    } else {
        it -= NE * IT_WGU_E; const int e = it / IT_WDN_E, r = it % IT_WDN_E, kb = r / 32, nb = r % 32;
        tr_item_f8(p.in(I_WDN) + (size_t)e * DFF * D, D, 32 * nb, (unsigned char*)(p.ws() + WS_WDN) + ((size_t)e * D + 32 * nb) * DFF, DFF, 64 * kb, nullptr, SC_W, scr, lane);
    }
}
__device__ __forceinline__ void xpass_rows(const PV& p, LAS unsigned char* lds, int gw, int ngw, int lane) {
    LAS float* WG = (LAS float*)(lds + 69632);
    { const float* wg = p.in(I_WIN) + 1536;
      for (int i = get_tid(lds); i < 2048; i += 512) { const int k = i >> 1, q = i & 1; const f32x4 a = *(const f32x4*)(wg + (size_t)k * INC + 4 * q);
          const int rho = ((k >> 8) * 4 + (k & 3)) * 64 + ((k >> 2) & 63); *(LAS f32x4*)(WG + rho * 12 + 4 * q) = a; } }
    __syncthreads();
    f32x4 w1[4];
#pragma unroll
    for (int j = 0; j < 4; ++j) w1[j] = *(const f32x4*)(p.in(I_N1W) + 256 * j + 4 * lane);
    const float gb = lane < 8 ? p.in(I_GB)[lane] : 0.f;
    bf16_t* XN = (bf16_t*)(p.ws() + WS_R1); float* GATES = (float*)(p.ws() + WS_GATES);
    for (int m = gw; m < T; m += ngw) {
        const f32x4* xr = (const f32x4*)(p.in(I_X) + (size_t)m * D) + lane;
        f32x4 v[4]; float s = 0.f;
#pragma unroll
        for (int j = 0; j < 4; ++j) { v[j] = xr[64 * j]; s += (v[j].x * v[j].x + v[j].y * v[j].y) + (v[j].z * v[j].z + v[j].w * v[j].w); }
        const float rstd = frsq(wave_sum(s) * (1.0f / D) + EPS);
        float g[8];
#pragma unroll
        for (int q = 0; q < 8; ++q) g[q] = 0.f;
        unsigned long long* o8 = (unsigned long long*)(XN + (size_t)m * D) + lane;
#pragma unroll
        for (int j = 0; j < 4; ++j) { v[j] = v[j] * rstd * w1[j];
            o8[64 * j] = (unsigned long long)pk2(v[j].x, v[j].y) | ((unsigned long long)pk2(v[j].z, v[j].w) << 32);
#pragma unroll
            for (int c = 0; c < 4; ++c) { const float xv = v[j][c]; const LAS f32x4* wrow = (const LAS f32x4*)(WG + ((j * 4 + c) * 64 + lane) * 12); const f32x4 wa = wrow[0], wb = wrow[1];
                g[0] += xv * wa.x; g[1] += xv * wa.y; g[2] += xv * wa.z; g[3] += xv * wa.w; g[4] += xv * wb.x; g[5] += xv * wb.y; g[6] += xv * wb.z; g[7] += xv * wb.w; } }
        float mine = 0.f;
#pragma unroll
        for (int q = 0; q < 8; ++q) { const float t = wave_sum(g[q]); if (lane == q) mine = t; }
        if (lane < 8) { float val = mine + gb; if (lane >= 4) val = -log1pf(fexp(-val)); GATES[(size_t)m * 8 + lane] = val; }
    }
}
__device__ __forceinline__ void prep_phase(const PV& p, LAS unsigned char* lds) {
    const int tid = get_tid(lds), lane = tid & 63, wave = tid >> 6, gw = blockIdx.x * 8 + wave, ngw = gridDim.x * 8;
    LAS float* scr = (LAS float*)(lds + wave * 8448);
    for (int it = gw; it < IT_WIN + IT_WOUT; it += ngw) conv_item_small(p, it, scr, lane);
    bf16_t* WRI = (bf16_t*)(p.ws() + WS_WRI);
    for (int i = blockIdx.x * 512 + tid; i < 4 * 256 * 128; i += gridDim.x * 512) { const int h = i >> 15, n = (i >> 7) & 255, k = i & 127;
        const float v = n < 128 ? p.in(I_WR)[(h * 128 + k) * 128 + n] : p.in(I_WI)[(h * 128 + k) * 128 + n - 128]; WRI[i] = (bf16_t)(pk2(v, 0.f) & 0xffff); }
    { bf16_t* WRT = (bf16_t*)(p.ws() + WS_WRT);
      for (int i = blockIdx.x * 512 + tid; i < 32 * 1024; i += gridDim.x * 512) { const int e = i >> 10, k = i & 1023; const float v = p.in(I_RW)[k * 32 + e] * p.in(I_N2W)[k];
          const unsigned h = pk2(v, 0.f) & 0xffffu; const float lo = v - __uint_as_float(h << 16); WRT[i] = (bf16_t)h; WRT[32 * 1024 + i] = (bf16_t)(pk2(lo, 0.f) & 0xffffu); } }
    xpass_rows(p, lds, gw, ngw, lane);
}
__device__ __forceinline__ void moe_conv_phase(const PV& p, LAS unsigned char* lds, int b0) {
    const int tid = get_tid(lds), lane = tid & 63, wave = tid >> 6;
    if ((int)blockIdx.x < b0) return;
    const int gw = ((int)blockIdx.x - b0) * 8 + wave, ngw = ((int)gridDim.x - b0) * 8;
    LAS float* scr = (LAS float*)(lds + wave * 8448);
    for (int it = gw; it < NE * (IT_WGU_E + IT_WDN_E); it += ngw) conv_item_moe(p, it, scr, lane);
}

namespace pg8 {
constexpr int BM = 256, BK = 64, HALF = 128, HTB = HALF * BK * 2, STAGE_BYTES = 8 * HTB;
__device__ __forceinline__ int lds_byte(int r, int c) { const int st = (r >> 4) * 2 + (c >> 5), rr = r & 15, cc = c & 31, ob = rr * 64 + cc * 2; return st * 1024 + (ob ^ (((ob >> 9) & 1) << 5)); }
__device__ __forceinline__ void stage_rc(int b, int& R, int& C) { const int st = b / 1024, sb = b % 1024, swz = sb ^ (((sb >> 9) & 1) << 5); R = (st >> 1) * 16 + swz / 64; C = (st & 1) * 32 + (swz % 64) / 2; }
__device__ __forceinline__ int perm32(int rho) { const int n = rho >> 4, i = rho & 15; return 8 * (i >> 2) + 4 * n + (i & 3); }
struct Unit { const char* b; const char* a; int i0, i1, i2, i3; };
#define PG8_GLDS2(ldsa, s0, v0, s1, v1) do { unsigned _keep; \
        asm volatile("s_mov_b32 %0, m0\n\ts_mov_b32 m0, %5\n\ts_nop 0\n\tglobal_load_lds_dwordx4 %1, %2\n\ts_mov_b32 m0, %6\n\ts_nop 0\n\tglobal_load_lds_dwordx4 %3, %4\n\ts_mov_b32 m0, %0" \
                     : "=&s"(_keep) : "v"(v0), "s"((const char*)(s0)), "v"(v1), "s"((const char*)(s1)), "s"(ldsa), "s"((ldsa) + 8192u) : "memory"); } while (0)
template <bool F8, bool GATHER, class Epi, class Sched>
__device__ __forceinline__ void gemm_phase(LAS unsigned char* lds, const char* Abase, int pitch, const Sched& S, const Epi& E, unsigned char* pws = nullptr, int pslot = 0) {
    const int tid = get_tid(lds);
    const int wid = __builtin_amdgcn_readfirstlane(tid >> 6), lane = tid & 63, wr = wid >> 2, wc = wid & 3, fr = lane & 15, fq = lane >> 4;
    const int nt = pitch / 128;
    unsigned vA, vB;
    { int R0, C0; stage_rc(tid * 16, R0, C0); const int Rb0 = Epi::PERM ? ((R0 & ~31) + perm32(R0 & 31)) : R0;
      vA = (unsigned)(R0 * pitch + 2 * C0); vB = (unsigned)(Rb0 * pitch + 2 * C0); }
    const size_t kstep = 128, hstep = (size_t)HALF * pitch, q64 = (size_t)64 * pitch;
    const unsigned ldsb0 = (unsigned)__builtin_amdgcn_readfirstlane((int)((unsigned)(size_t)lds + (unsigned)wid * 1024u));
    const int aoff = lds_byte(wr * 64 + fr, fq * 8), boff = lds_byte(wc * 32 + fr, fq * 8);
    constexpr int HOFF = 1024;
#define PG8_SA(b, h) (((b) * 2 + (h)) * HTB)
#define PG8_SB(b, h) ((4 + (b) * 2 + (h)) * HTB)
#define PG8_STAGEB(bufoff, gbase) PG8_GLDS2(ldsb0 + (unsigned)(bufoff), (gbase), vB, (gbase) + q64, vB)
#define PG8_STAGEA(bufoff, kp, h) do { if constexpr (GATHER) { if ((h) == 0) PG8_GLDS2(ldsb0 + (unsigned)(bufoff), (kp), g0, (kp), g1); else PG8_GLDS2(ldsb0 + (unsigned)(bufoff), (kp), g2, (kp), g3); } \
        else PG8_GLDS2(ldsb0 + (unsigned)(bufoff), (kp) + (h) * hstep, vA, (kp) + (h) * hstep + q64, vA); } while (0)
#define PG8_RD(p) (*(const LAS u32x4*)(p))
#define PG8_LDA(dst, b, h) do { _Pragma("unroll") for (int m = 0; m < 4; ++m) { dst[m][0] = PG8_RD(lds + PG8_SA(b, h) + aoff + m * 2048); dst[m][1] = PG8_RD(lds + PG8_SA(b, h) + aoff + m * 2048 + HOFF); } } while (0)
#define PG8_LDB(dst, b, h) do { _Pragma("unroll") for (int n = 0; n < 2; ++n) { dst[n][0] = PG8_RD(lds + PG8_SB(b, h) + boff + n * 2048); dst[n][1] = PG8_RD(lds + PG8_SB(b, h) + boff + n * 2048 + HOFF); } } while (0)
#define PG8_CAT(v) __builtin_bit_cast(i32x8, __builtin_shufflevector((v)[0], (v)[1], 0, 1, 2, 3, 4, 5, 6, 7))
#define PG8_MMA(ai, bj, At, Bt) do { __builtin_amdgcn_s_setprio(1); _Pragma("unroll") for (int m = 0; m < 4; ++m) _Pragma("unroll") for (int n = 0; n < 2; ++n) { \
        if constexpr (F8) acc[ai][bj][m][n] = __builtin_amdgcn_mfma_scale_f32_16x16x128_f8f6f4(PG8_CAT(Bt[n]), PG8_CAT(At[m]), acc[ai][bj][m][n], 0, 0, 0, 0, 0, 0);     \
        else { acc[ai][bj][m][n] = __builtin_amdgcn_mfma_f32_16x16x32_bf16(__builtin_bit_cast(bf16x8, Bt[n][0]), __builtin_bit_cast(bf16x8, At[m][0]), acc[ai][bj][m][n], 0, 0, 0); \
               acc[ai][bj][m][n] = __builtin_amdgcn_mfma_f32_16x16x32_bf16(__builtin_bit_cast(bf16x8, Bt[n][1]), __builtin_bit_cast(bf16x8, At[m][1]), acc[ai][bj][m][n], 0, 0, 0); } } \
        __builtin_amdgcn_s_setprio(0); } while (0)
#define PG8_WAIT_V(n) asm volatile("s_waitcnt vmcnt(" #n ")" ::: "memory")
#define PG8_WAIT_L(n) asm volatile("s_waitcnt lgkmcnt(" #n ")" ::: "memory")
#define PG8_BAR __builtin_amdgcn_s_barrier()
#define PG8_SCHED __builtin_amdgcn_sched_barrier(0)
    Unit cur, nxt; int ui = 0;
    if (!S.next(0, cur)) return;
    f32x4 acc[2][2][4][2];
#pragma unroll
    for (int a = 0; a < 2; ++a)
#pragma unroll
        for (int b = 0; b < 2; ++b)
#pragma unroll
            for (int m = 0; m < 4; ++m)
#pragma unroll
                for (int n = 0; n < 2; ++n) acc[a][b][m][n] = (f32x4){0.f, 0.f, 0.f, 0.f};
    u32x4 At[4][2], B0[2][2], B1[2][2];
    unsigned g0 = 0, g1 = 0, g2 = 0, g3 = 0;
    if constexpr (GATHER) { S.goffs(cur, tid, 0, g0, g1); S.goffs(cur, tid, 1, g2, g3); }
    const char* cA = GATHER ? Abase : cur.a; const char* cB = cur.b;
    PG8_STAGEB(PG8_SB(0, 0), cB); PG8_STAGEB(PG8_SB(0, 1), cB + hstep); PG8_STAGEA(PG8_SA(0, 0), cA, 0); PG8_STAGEA(PG8_SA(0, 1), cA, 1);
    if (wr == 1) PG8_BAR;
    PG8_WAIT_V(2); PG8_BAR;
    PG8_STAGEB(PG8_SB(1, 0), cB + kstep); PG8_STAGEA(PG8_SA(1, 0), cA + kstep, 0); PG8_STAGEB(PG8_SB(1, 1), cB + hstep + kstep);
    PG8_WAIT_V(6); PG8_BAR;
    for (;;) {
#ifdef PROBE_G
        if (pws && ui == 2) GSTAMP(pws, tid, pslot);
#endif
        const bool has_next = S.next(ui + 1, nxt);
        const char* nB = has_next ? nxt.b : cB; const char* nA = GATHER ? Abase : (has_next ? nxt.a : cA);
#ifdef PROBE_G
        if (pws && ui == 2) GSTAMP(pws, tid, pslot + 1);
#endif
#pragma unroll 1
        for (int t = 0; t < nt; t += 2) {
            const bool last = (t == nt - 2);
            const char* a1 = cA + (size_t)(t + 1) * kstep;
            const char* a2 = last ? nA : cA + (size_t)(t + 2) * kstep; const char* b2 = last ? nB : cB + (size_t)(t + 2) * kstep;
            const char* a3 = a2 + kstep; const char* b3 = b2 + kstep;
            PG8_LDB(B0, 0, 0); PG8_LDB(B1, 0, 1); PG8_SCHED; PG8_LDA(At, 0, 0); PG8_STAGEA(PG8_SA(1, 1), a1, 1);
            if constexpr (GATHER) { if (last && has_next) { S.goffs(nxt, tid, 0, g0, g1); S.goffs(nxt, tid, 1, g2, g3); } }
            PG8_WAIT_V(8); PG8_WAIT_L(0); PG8_BAR; PG8_MMA(0, 0, At, B0); PG8_MMA(0, 1, At, B1); PG8_BAR; PG8_SCHED;
            PG8_LDA(At, 0, 1); PG8_STAGEB(PG8_SB(0, 0), b2); PG8_STAGEB(PG8_SB(0, 1), b2 + hstep); PG8_STAGEA(PG8_SA(0, 0), a2, 0);
            PG8_WAIT_V(8); PG8_WAIT_L(0); PG8_BAR; PG8_MMA(1, 0, At, B0); PG8_MMA(1, 1, At, B1); PG8_BAR; PG8_SCHED;
            PG8_LDB(B0, 1, 0); PG8_LDB(B1, 1, 1); PG8_SCHED; PG8_LDA(At, 1, 0); PG8_STAGEA(PG8_SA(0, 1), a2, 1);
            PG8_WAIT_V(8); PG8_WAIT_L(0); PG8_BAR; PG8_MMA(0, 0, At, B0); PG8_MMA(0, 1, At, B1); PG8_BAR; PG8_SCHED;
            PG8_LDA(At, 1, 1); PG8_STAGEB(PG8_SB(1, 0), b3); PG8_STAGEB(PG8_SB(1, 1), b3 + hstep); PG8_STAGEA(PG8_SA(1, 0), a3, 0);
            PG8_WAIT_V(8); PG8_WAIT_L(0); PG8_BAR; PG8_MMA(1, 0, At, B0); PG8_MMA(1, 1, At, B1); PG8_BAR; PG8_SCHED;
        }
#ifdef PROBE_G
        if (pws && ui == 2) GSTAMP(pws, tid, pslot + 2);
#endif
        if (wr == 0) PG8_BAR;
        { int efr = fr, efq = fq; asm volatile("" : "+v"(efr), "+v"(efq));
          E(acc, cur, wr, wc, efr, efq); }
#ifdef PROBE_G
        if (pws && ui == 2) GSTAMP(pws, tid, pslot + 3);
        if (pws && ui == 3) GSTAMP(pws, tid, pslot + 4);
#endif
        if (!has_next) break;
#pragma unroll
        for (int a = 0; a < 2; ++a)
#pragma unroll
            for (int b = 0; b < 2; ++b)
#pragma unroll
                for (int m = 0; m < 4; ++m)
#pragma unroll
                    for (int n = 0; n < 2; ++n) acc[a][b][m][n] = (f32x4){0.f, 0.f, 0.f, 0.f};
        cur = nxt; cB = nB; cA = nA; ++ui;
        if (wr == 1) PG8_BAR;
    }
    PG8_WAIT_V(0);
    PG8_BAR;
#undef PG8_SA
#undef PG8_SB
#undef PG8_STAGEA
#undef PG8_STAGEB
#undef PG8_RD
#undef PG8_CAT
#undef PG8_LDA
#undef PG8_LDB
#undef PG8_MMA
#undef PG8_WAIT_V
#undef PG8_WAIT_L
#undef PG8_BAR
#undef PG8_SCHED
}
struct TileOrder {
    int nM, nN, nwg, G, c;
    __device__ __forceinline__ void init(int nM_, int nN_, int G_, int c_) { nM = nM_; nN = nN_; nwg = nM * nN; G = G_; c = c_; }
    __device__ __forceinline__ bool tile(int i, int& pm, int& pn) const {
        const long L = (long)i * G + c; if (L >= nwg) return false;
        int wgid = (int)L; { const int q = nwg / 8, r = nwg % 8, xcd = wgid % 8, off = wgid / 8; wgid = (xcd < r ? xcd * (q + 1) : r * (q + 1) + (xcd - r) * q) + off; }
        const int nig = 8 * nN, gid = wgid / nig, fm = gid * 8, gsz = (nM - fm) < 8 ? (nM - fm) : 8;
        pm = fm + ((wgid % nig) % gsz); pn = (wgid % nig) / gsz; return true;
    }
};
}

struct DenseSched {
    pg8::TileOrder o; const char* A; const char* Bt; int pitch;
    __device__ __forceinline__ bool next(int i, pg8::Unit& u) const { int pm, pn; if (!o.tile(i, pm, pn)) return false; u.i0 = pm; u.i1 = pn; u.i2 = 0; u.i3 = 0;
        u.a = A + (size_t)pm * 256 * pitch; u.b = Bt + (size_t)pn * 256 * pitch; return true; }
    __device__ __forceinline__ void goffs(const pg8::Unit&, int, int, unsigned&, unsigned&) const {}
};
struct EpiInProj {
    static constexpr bool PERM = true;
    bf16_t* PROJ;
    __device__ __forceinline__ void operator()(const f32x4 (&acc)[2][2][4][2], const pg8::Unit& u, int wr, int wc, int fr, int fq) const {
        const int row0 = u.i0 * 256 + wr * 64 + fr, col0 = u.i1 * 256 + wc * 32 + 8 * fq;
#pragma unroll
        for (int ai = 0; ai < 2; ++ai)
#pragma unroll
            for (int m = 0; m < 4; ++m) { bf16_t* rowp = PROJ + (size_t)(row0 + ai * 128 + m * 16) * NPROJ + col0;
#pragma unroll
                for (int bj = 0; bj < 2; ++bj) { const f32x4 v0 = acc[ai][bj][m][0], v1 = acc[ai][bj][m][1];
                    u32x4 w; w.x = pk2(v0[0], v0[1]); w.y = pk2(v0[2], v0[3]); w.z = pk2(v1[0], v1[1]); w.w = pk2(v1[2], v1[3]);
                    *(u32x4*)(rowp + bj * 128) = w; } }
    }
};
struct EpiOutProj {
    static constexpr bool PERM = false;
    const float* X; float* H;
    __device__ __forceinline__ void operator()(const f32x4 (&acc)[2][2][4][2], const pg8::Unit& u, int wr, int wc, int fr, int fq) const {
        const int row0 = u.i0 * 256 + wr * 64 + fr, col0 = u.i1 * 256 + wc * 32 + 4 * fq;
#pragma unroll
        for (int ai = 0; ai < 2; ++ai)
#pragma unroll
            for (int m = 0; m < 4; ++m) { const size_t off = (size_t)(row0 + ai * 128 + m * 16) * D + col0;
#pragma unroll
                for (int bj = 0; bj < 2; ++bj)
#pragma unroll
                    for (int n = 0; n < 2; ++n) { const f32x4 x = *(const f32x4*)(X + off + bj * 128 + n * 16); *(f32x4*)(H + off + bj * 128 + n * 16) = x + acc[ai][bj][m][n]; }
                asm volatile("" ::: "memory"); }
    }
};


constexpr int LDS_MOE_TAB = 131072;
template <bool GATHER, int NT  , int NROWS  >
struct MoeSched {
    const unsigned* cnt; const i32x4* ENT; const char* A; const char* Bt; LAS unsigned char* lds; int lo, hi, G, c, tot;
    __device__ __forceinline__ int cnt_s(int e) const { return __builtin_amdgcn_readfirstlane((int)cnt[e]); }
    __device__ __forceinline__ int tab(int i) const { return __builtin_amdgcn_readfirstlane(*(volatile LAS int*)(lds + LDS_MOE_TAB + 4 * i)); }
    __device__ __forceinline__ void init_tot(int tid) {
        if (tid == 0) { int t = 0; for (int e = lo; e < hi; ++e) { const int te = ((int)cnt[e] + 255) >> 8; *(volatile LAS int*)(lds + LDS_MOE_TAB + 4 * (e - lo)) = t; *(volatile LAS int*)(lds + LDS_MOE_TAB + 4 * (64 + e - lo)) = te; t += te; }
            *(volatile LAS int*)(lds + LDS_MOE_TAB + 4 * (hi - lo)) = t; }
        __syncthreads();
        tot = tab(hi - lo) * NT;
    }
    __device__ __forceinline__ bool next(int i, pg8::Unit& u) const {
        const int L = i * G + c; if (L >= tot) return false;
        int W; { const int q = tot / 8, r = tot % 8, xcd = L % 8, off = L / 8; W = (xcd < r ? xcd * (q + 1) : r * (q + 1) + (xcd - r) * q) + off; }
        int a = 0, b = hi - lo;
        while (b - a > 1) { const int m = (a + b) >> 1; if (tab(m) * NT <= W) a = m; else b = m; }
        const int pre = tab(a), te = tab(64 + a); W -= pre * NT;
        constexpr int nig = 8 * NT; const int gid = W / nig, fm = gid * 8, gsz = (te - fm) < 8 ? (te - fm) : 8; int j = W - gid * nig, n = 0;
        while (j >= gsz) { j -= gsz; ++n; }
        u.i0 = lo + a; u.i1 = fm + j; u.i2 = n; u.i3 = pre * 256;
        u.b = Bt + ((size_t)u.i0 * NROWS + (size_t)u.i2 * 256) * 1024; u.a = A + (size_t)(u.i3 + u.i1 * 256) * 1024;
        return true;
    }
    __device__ __forceinline__ void goffs(const pg8::Unit& u, int tid, int h, unsigned& o0, unsigned& o1) const {
        if constexpr (GATHER) { int R0, C0; pg8::stage_rc(tid * 16, R0, C0);
            const int ce = cnt_s(u.i0), p0 = u.i1 * 256 + h * 128 + R0; const i32x4* en = ENT + (size_t)u.i0 * T;
            const int t0 = p0 < ce ? en[p0].x : 0, t1 = p0 + 64 < ce ? en[p0 + 64].x : 0;
            o0 = (unsigned)t0 * 1024u + 2u * C0; o1 = (unsigned)t1 * 1024u + 2u * C0; }
    }
};
struct EpiG1 {
    static constexpr bool PERM = true;
    unsigned char* HID; const i32x4* ENT; const unsigned* cnt; const float* bgu;
    __device__ __forceinline__ void operator()(const f32x4 (&acc)[2][2][4][2], const pg8::Unit& u, int wr, int wc, int fr, int fq) const {
        const int e = u.i0, ce = __builtin_amdgcn_readfirstlane((int)cnt[e]), hc = u.i2 * 128 + wc * 32 + 8 * fq; const i32x4* en = ENT + (size_t)e * T;
        float rs[8];
#pragma unroll
        for (int q = 0; q < 8; ++q) { const int pos = u.i1 * 256 + (q >> 2) * 128 + wr * 64 + (q & 3) * 16 + fr; rs[q] = pos < ce ? __int_as_float(en[pos].y) * (1.0f / (SC_H * SC_W)) : 0.f; }
        const float* bg = bgu + (size_t)e * 2 * DFF + hc;
        const f32x4 bg0 = *(const f32x4*)bg, bg1 = *(const f32x4*)(bg + 4), bu0 = *(const f32x4*)(bg + DFF), bu1 = *(const f32x4*)(bg + DFF + 4);
#pragma unroll
        for (int ai = 0; ai < 2; ++ai)
#pragma unroll
            for (int m = 0; m < 4; ++m) { const int pos = u.i1 * 256 + ai * 128 + wr * 64 + m * 16 + fr;
                const float rstd = rs[ai * 4 + m];
                float hv[8];
#pragma unroll
                for (int q = 0; q < 8; ++q) { const int n = q >> 2, j = q & 3; float g = acc[ai][0][m][n][j] * rstd + (n ? bg1[j] : bg0[j]), up = acc[ai][1][m][n][j] * rstd + (n ? bu1[j] : bu0[j]);
                    g = fminf(g, 7.0f); up = fminf(fmaxf(up, -7.0f), 7.0f); hv[q] = (up + 1.0f) * g * sigmoidf_(1.702f * g) * SC_HID; }
                u32x2 w; w.x = pk4_fp8(hv[0], hv[1], hv[2], hv[3]); w.y = pk4_fp8(hv[4], hv[5], hv[6], hv[7]);
                *(u32x2*)(HID + (size_t)(u.i3 + pos) * DFF + hc) = w; }
    }
};
struct EpiG2 {
    static constexpr bool PERM = true;
    bf16_t* OUT01; bf16_t* Y23; const i32x4* ENT; const unsigned* cnt; const float* bdn;
    __device__ __forceinline__ void operator()(const f32x4 (&acc)[2][2][4][2], const pg8::Unit& u, int wr, int wc, int fr, int fq) const {
        const int e = u.i0, ce = __builtin_amdgcn_readfirstlane((int)cnt[e]), col0 = u.i2 * 256 + wc * 32 + 8 * fq; const i32x4* en = ENT + (size_t)e * T;
        int tk[8], kk[8]; float gt[8];
#pragma unroll
        for (int q = 0; q < 8; ++q) { const int pos = u.i1 * 256 + (q >> 2) * 128 + wr * 64 + (q & 3) * 16 + fr; const i32x4 v = pos < ce ? en[pos] : (i32x4){-1, 0, 0, 0}; tk[q] = v.x; kk[q] = v.z; gt[q] = __int_as_float(v.w); }
        const float* bd = bdn + (size_t)e * D + col0;
        f32x4 b[2][2];
#pragma unroll
        for (int bj = 0; bj < 2; ++bj) { b[bj][0] = *(const f32x4*)(bd + bj * 128); b[bj][1] = *(const f32x4*)(bd + bj * 128 + 4); }
#pragma unroll
        for (int ai = 0; ai < 2; ++ai)
#pragma unroll
            for (int m = 0; m < 4; ++m) { const int q = ai * 4 + m;
                if (tk[q] >= 0) { const float gate = gt[q];
                    bf16_t* dst = (kk[q] < 2 ? OUT01 : Y23) + (size_t)tk[q] * 2048 + (kk[q] & 1) * 1024 + col0;
#pragma unroll
                    for (int bj = 0; bj < 2; ++bj) { const f32x4 y0 = (acc[ai][bj][m][0] * (1.0f / (SC_HID * SC_W)) + b[bj][0]) * gate, y1 = (acc[ai][bj][m][1] * (1.0f / (SC_HID * SC_W)) + b[bj][1]) * gate;
                        u32x4 w; w.x = pk2(y0[0], y0[1]); w.y = pk2(y0[2], y0[3]); w.z = pk2(y1[0], y1[1]); w.w = pk2(y1[2], y1[3]);
                        *(u32x4*)(dst + bj * 128) = w; } } }
    }
};

constexpr int ML_QS = 0, ML_KS = 17408, ML_VS = 34816, ML_PS = 52224, ML_CT = 61440, ML_DENP = 96256, ML_DI = 96768, ML_SSQP = 97024, ML_NARR = 99072, ML_END = 99584;
__device__ __forceinline__ bf16x8 tr_pair(unsigned a0, unsigned a1) {
    u32x2 lo, hi; asm volatile("ds_read_b64_tr_b16 %0, %2\n\tds_read_b64_tr_b16 %1, %3\n\ts_waitcnt lgkmcnt(0)" : "=&v"(lo), "=&v"(hi) : "v"(a0), "v"(a1) : "memory");
    u32x4 r; r.x = lo.x; r.y = lo.y; r.z = hi.x; r.w = hi.y; return __builtin_bit_cast(bf16x8, r);
}
#define TR8(dst, base, OFF0, STEP) do { u32x2 _l[8], _h[8]; \
    asm volatile("ds_read_b64_tr_b16 %0, %16 offset:%17\n\tds_read_b64_tr_b16 %1, %16 offset:%17+1088\n\tds_read_b64_tr_b16 %2, %16 offset:%17+%18\n\tds_read_b64_tr_b16 %3, %16 offset:%17+%18+1088\n\t" \
                 "ds_read_b64_tr_b16 %4, %16 offset:%17+2*%18\n\tds_read_b64_tr_b16 %5, %16 offset:%17+2*%18+1088\n\tds_read_b64_tr_b16 %6, %16 offset:%17+3*%18\n\tds_read_b64_tr_b16 %7, %16 offset:%17+3*%18+1088\n\t" \
                 "ds_read_b64_tr_b16 %8, %16 offset:%17+4*%18\n\tds_read_b64_tr_b16 %9, %16 offset:%17+4*%18+1088\n\tds_read_b64_tr_b16 %10, %16 offset:%17+5*%18\n\tds_read_b64_tr_b16 %11, %16 offset:%17+5*%18+1088\n\t" \
                 "ds_read_b64_tr_b16 %12, %16 offset:%17+6*%18\n\tds_read_b64_tr_b16 %13, %16 offset:%17+6*%18+1088\n\tds_read_b64_tr_b16 %14, %16 offset:%17+7*%18\n\tds_read_b64_tr_b16 %15, %16 offset:%17+7*%18+1088\n\ts_waitcnt lgkmcnt(0)" \
                 : "=&v"(_l[0]), "=&v"(_h[0]), "=&v"(_l[1]), "=&v"(_h[1]), "=&v"(_l[2]), "=&v"(_h[2]), "=&v"(_l[3]), "=&v"(_h[3]), "=&v"(_l[4]), "=&v"(_h[4]), "=&v"(_l[5]), "=&v"(_h[5]), "=&v"(_l[6]), "=&v"(_h[6]), "=&v"(_l[7]), "=&v"(_h[7]) \
                 : "v"(base), "i"(OFF0), "i"(STEP) : "memory"); \
    _Pragma("unroll") for (int _p = 0; _p < 8; ++_p) { u32x4 _r; _r.x = _l[_p].x; _r.y = _l[_p].y; _r.z = _h[_p].x; _r.w = _h[_p].y; dst[_p] = __builtin_bit_cast(bf16x8, _r); } } while (0)
__device__ __forceinline__ float wave_scan_add(float s) {
    s += dpp_x<0x111, 0xf>(s, 0.f); s += dpp_x<0x112, 0xf>(s, 0.f); s += dpp_x<0x114, 0xf>(s, 0.f); s += dpp_x<0x118, 0xf>(s, 0.f);
    s += dpp_x<0x142, 0xa>(s, 0.f); s += dpp_x<0x143, 0xc>(s, 0.f); return s;
}
__device__ __forceinline__ float wave_scan_max(float s) {
    const float ni = -INFINITY;
    s = fmaxf(s, dpp_x<0x111, 0xf>(s, ni)); s = fmaxf(s, dpp_x<0x112, 0xf>(s, ni)); s = fmaxf(s, dpp_x<0x114, 0xf>(s, ni)); s = fmaxf(s, dpp_x<0x118, 0xf>(s, ni));
    s = fmaxf(s, dpp_x<0x142, 0xa>(s, ni)); s = fmaxf(s, dpp_x<0x143, 0xc>(s, ni)); return s;
}
__device__ __forceinline__ void unpack16(const u32x4& a, const u32x4& b, float (&f)[16]) {
    const unsigned w[8] = {a.x, a.y, a.z, a.w, b.x, b.y, b.z, b.w};
#pragma unroll
    for (int i = 0; i < 8; ++i) { f[2 * i] = bflo(w[i]); f[2 * i + 1] = bfhi(w[i]); }
}
__device__ __forceinline__ void mlstm_phase(const PV& p, LAS unsigned char* lds, int bh) {
    const int tid = get_tid(lds);
    const int lane = tid & 63, w = __builtin_amdgcn_readfirstlane(tid >> 6), fr = lane & 15, fq = lane >> 4, tq = (lane & 15) >> 2, tp = lane & 3;
    const int b = bh >> 2, h = bh & 3, srow = tid >> 3, sseg = tid & 7;
    const bf16_t* PROJ = (const bf16_t*)(p.ws() + WS_R2); const float* GATES = (const float*)(p.ws() + WS_GATES); bf16_t* MIX = (bf16_t*)(p.ws() + WS_R1);
    LAS float* DENP = (LAS float*)(lds + ML_DENP); LAS float* DI = (LAS float*)(lds + ML_DI); LAS float* SSQP = (LAS float*)(lds + ML_SSQP); LAS float* NARR = (LAS float*)(lds + ML_NARR);
    const unsigned ldsb = (unsigned)(size_t)lds;
    for (int i = tid; i < 34816 / 16; i += 512) *(LAS u32x4*)(lds + ML_CT + 16 * i) = (u32x4){0u, 0u, 0u, 0u};
    if (tid < 128) NARR[tid] = 0.f;
    f32x4 c3[8];
#pragma unroll
    for (int i = 0; i < 8; ++i) c3[i] = (f32x4){0.f, 0.f, 0.f, 0.f};
    f32x4 nacc = (f32x4){0.f, 0.f, 0.f, 0.f}; float mprev = 0.f;
    bf16x8 ones;
#pragma unroll
    for (int jj = 0; jj < 8; ++jj) ones[jj] = (short)0x3F80;
    float ig = GATES[((size_t)b * SEQ + lane) * 8 + h], lf = GATES[((size_t)b * SEQ + lane) * 8 + 4 + h];
    u32x4 rq0, rq1, rk0, rk1, rv0, rv1;
    { const bf16_t* pr = PROJ + ((size_t)b * SEQ + srow) * NPROJ + h * 128 + 16 * sseg;
      rq0 = *(const u32x4*)pr; rq1 = *(const u32x4*)(pr + 8); rk0 = *(const u32x4*)(pr + 512); rk1 = *(const u32x4*)(pr + 520); rv0 = *(const u32x4*)(pr + 1024); rv1 = *(const u32x4*)(pr + 1032); }
    __syncthreads();
    for (int c = 0; c < SEQ / 64; ++c) {
        const size_t row0 = (size_t)b * SEQ + (size_t)c * 64;
        const float bc = wave_scan_add(lf), u = ig - bc, cm = wave_scan_max(u);
        const float Mt = fmaxf(cm, mprev), M63 = __builtin_bit_cast(float, __builtin_amdgcn_readlane(__builtin_bit_cast(int, Mt), 63)), bL = __builtin_bit_cast(float, __builtin_amdgcn_readlane(__builtin_bit_cast(int, bc), 63));
        if (c + 1 < SEQ / 64) { ig = GATES[(row0 + 64 + lane) * 8 + h]; lf = GATES[(row0 + 64 + lane) * 8 + 4 + h]; }
        const float sq = fexp(M63 - Mt), sk = fexp(u - M63), fl = fexp(-bc - Mt), decay = fexp(mprev - M63);
        mprev = bL + M63;
        { const float sqv = __shfl(sq, srow), skv = __shfl(sk, srow);
          float f[16]; unpack16(rq0, rq1, f);
          float part = 0.f;
#pragma unroll
          for (int j = 0; j < 16; ++j) { f[j] *= sqv; part += f[j] * NARR[16 * sseg + j]; }
          part += __shfl_xor(part, 1); part += __shfl_xor(part, 2); part += __shfl_xor(part, 4);
          if (sseg == 0) DI[srow] = decay * part;
          u32x4 o0, o1; o0.x = pk2(f[0], f[1]); o0.y = pk2(f[2], f[3]); o0.z = pk2(f[4], f[5]); o0.w = pk2(f[6], f[7]); o1.x = pk2(f[8], f[9]); o1.y = pk2(f[10], f[11]); o1.z = pk2(f[12], f[13]); o1.w = pk2(f[14], f[15]);
          *(LAS u32x4*)(lds + ML_QS + srow * 272 + sseg * 32) = o0; *(LAS u32x4*)(lds + ML_QS + srow * 272 + sseg * 32 + 16) = o1;
          unpack16(rk0, rk1, f);
#pragma unroll
          for (int j = 0; j < 16; ++j) f[j] *= skv;
          o0.x = pk2(f[0], f[1]); o0.y = pk2(f[2], f[3]); o0.z = pk2(f[4], f[5]); o0.w = pk2(f[6], f[7]); o1.x = pk2(f[8], f[9]); o1.y = pk2(f[10], f[11]); o1.z = pk2(f[12], f[13]); o1.w = pk2(f[14], f[15]);
          *(LAS u32x4*)(lds + ML_KS + srow * 272 + sseg * 32) = o0; *(LAS u32x4*)(lds + ML_KS + srow * 272 + sseg * 32 + 16) = o1;
          *(LAS u32x4*)(lds + ML_VS + srow * 272 + sseg * 32) = rv0; *(LAS u32x4*)(lds + ML_VS + srow * 272 + sseg * 32 + 16) = rv1; }
        if (c + 1 < SEQ / 64) { const bf16_t* pr = PROJ + (row0 + 64 + srow) * NPROJ + h * 128 + 16 * sseg;
          rq0 = *(const u32x4*)pr; rq1 = *(const u32x4*)(pr + 8); rk0 = *(const u32x4*)(pr + 512); rk1 = *(const u32x4*)(pr + 520); rv0 = *(const u32x4*)(pr + 1024); rv1 = *(const u32x4*)(pr + 1032); }
        u32x2 og[4];
#pragma unroll
        for (int ti = 0; ti < 4; ++ti) og[ti] = *(const u32x2*)(PROJ + (row0 + 16 * ti + fr) * NPROJ + 1536 + h * 128 + 16 * w + 4 * fq);
        __syncthreads();
        { const int ti = w >> 1; float dsum = 0.f;
#pragma unroll
          for (int jj = 0; jj < 2; ++jj) { const int sj = 2 * (w & 1) + jj;
            f32x4 a = (f32x4){0.f, 0.f, 0.f, 0.f};
            if (sj <= ti) {
#pragma unroll
                for (int ks = 0; ks < 4; ++ks) { const bf16x8 ka = *(const LAS bf16x8*)(lds + ML_KS + (16 * sj + fr) * 272 + (32 * ks + 8 * fq) * 2), qb = *(const LAS bf16x8*)(lds + ML_QS + (16 * ti + fr) * 272 + (32 * ks + 8 * fq) * 2);
                    a = __builtin_amdgcn_mfma_f32_16x16x32_bf16(ka, qb, a, 0, 0, 0); }
                const int t = 16 * ti + fr, s0 = 16 * sj + 4 * fq;
#pragma unroll
                for (int r = 0; r < 4; ++r) { if (s0 + r > t) a[r] = 0.f; dsum += a[r]; }
            }
            u32x2 pw; pw.x = pk2(a[0], a[1]); pw.y = pk2(a[2], a[3]);
            *(LAS u32x2*)(lds + ML_PS + (16 * ti + fr) * 144 + (16 * sj + 4 * fq) * 2) = pw; }
          dsum += __shfl_xor(dsum, 16); dsum += __shfl_xor(dsum, 32);
          if (fq == 0) DENP[(w & 1) * 64 + 16 * ti + fr] = dsum; }
        __syncthreads();
        bf16x8 av[2];
        { u32x2 l0, h0, l1, h1; const unsigned a0 = ldsb + ML_VS + (8 * fq + tq) * 272 + (16 * w + 4 * tp) * 2;
          asm volatile("ds_read_b64_tr_b16 %0, %4\n\tds_read_b64_tr_b16 %1, %4 offset:1088\n\tds_read_b64_tr_b16 %2, %4 offset:8704\n\tds_read_b64_tr_b16 %3, %4 offset:9792\n\ts_waitcnt lgkmcnt(0)"
                       : "=&v"(l0), "=&v"(h0), "=&v"(l1), "=&v"(h1) : "v"(a0) : "memory");
          u32x4 r; r.x = l0.x; r.y = l0.y; r.z = h0.x; r.w = h0.y; av[0] = __builtin_bit_cast(bf16x8, r); r.x = l1.x; r.y = l1.y; r.z = h1.x; r.w = h1.y; av[1] = __builtin_bit_cast(bf16x8, r); }
        bf16x8 ac[4];
#pragma unroll
        for (int ks = 0; ks < 4; ++ks) ac[ks] = *(const LAS bf16x8*)(lds + ML_CT + (16 * w + fr) * 272 + (32 * ks + 8 * fq) * 2);
        float xs[4][4];
#pragma unroll
        for (int ti = 0; ti < 4; ++ti) { f32x4 a = (f32x4){0.f, 0.f, 0.f, 0.f}, a2 = (f32x4){0.f, 0.f, 0.f, 0.f};
#pragma unroll
            for (int ks = 0; ks < 2; ++ks) { const bf16x8 pb = *(const LAS bf16x8*)(lds + ML_PS + (16 * ti + fr) * 144 + (32 * ks + 8 * fq) * 2); a = __builtin_amdgcn_mfma_f32_16x16x32_bf16(av[ks], pb, a, 0, 0, 0); }
#pragma unroll
            for (int ks = 0; ks < 4; ++ks) { const bf16x8 qb = *(const LAS bf16x8*)(lds + ML_QS + (16 * ti + fr) * 272 + (32 * ks + 8 * fq) * 2); a2 = __builtin_amdgcn_mfma_f32_16x16x32_bf16(ac[ks], qb, a2, 0, 0, 0); }
            a = a + a2 * decay;
            const int t = 16 * ti + fr; const float den = DENP[t] + DENP[64 + t] + DI[t], flt = __shfl(fl, t), inv = frcp(fmaxf(fabsf(den), flt));
            xs[ti][0] = sigmoidf_(bflo(og[ti].x)) * a[0] * inv; xs[ti][1] = sigmoidf_(bfhi(og[ti].x)) * a[1] * inv; xs[ti][2] = sigmoidf_(bflo(og[ti].y)) * a[2] * inv; xs[ti][3] = sigmoidf_(bfhi(og[ti].y)) * a[3] * inv;
            float ss = xs[ti][0] * xs[ti][0] + xs[ti][1] * xs[ti][1] + xs[ti][2] * xs[ti][2] + xs[ti][3] * xs[ti][3];
            ss += __shfl_xor(ss, 16); ss += __shfl_xor(ss, 32);
            if (fq == 0) SSQP[w * 64 + t] = ss; }
        { const unsigned kb = ldsb + ML_KS + (8 * fq + tq) * 272 + 4 * tp * 2;
          bf16x8 k0[8], k1[8];
          TR8(k0, kb, 0, 32); TR8(k1, kb, 8704, 32);
#pragma unroll
          for (int i = 0; i < 8; ++i) { c3[i] = c3[i] * decay;
              c3[i] = __builtin_amdgcn_mfma_f32_16x16x32_bf16(k0[i], av[0], c3[i], 0, 0, 0); c3[i] = __builtin_amdgcn_mfma_f32_16x16x32_bf16(k1[i], av[1], c3[i], 0, 0, 0);
              if (i == w) { nacc = nacc * decay; nacc = __builtin_amdgcn_mfma_f32_16x16x32_bf16(k0[i], ones, nacc, 0, 0, 0); nacc = __builtin_amdgcn_mfma_f32_16x16x32_bf16(k1[i], ones, nacc, 0, 0, 0); } }
          if (fr == 0) *(LAS f32x4*)(NARR + 16 * w + 4 * fq) = nacc; }
        __syncthreads();
#pragma unroll
        for (int ti = 0; ti < 4; ++ti) { const int t = 16 * ti + fr; float s = 0.f;
#pragma unroll
            for (int ww = 0; ww < 8; ++ww) s += SSQP[ww * 64 + t];
            const float rs = frsq(s * (1.0f / 128.f) + EPS);
            u32x2 o; o.x = pk2(xs[ti][0] * rs, xs[ti][1] * rs); o.y = pk2(xs[ti][2] * rs, xs[ti][3] * rs);
            *(u32x2*)(MIX + (row0 + t) * D + h * 128 + 16 * w + 4 * fq) = o; }
#pragma unroll
        for (int i = 0; i < 8; ++i) { u32x2 cw; cw.x = pk2(c3[i][0], c3[i][1]); cw.y = pk2(c3[i][2], c3[i][3]);
            *(LAS u32x2*)(lds + ML_CT + (16 * w + fr) * 272 + (16 * i + 4 * fq) * 2) = cw; }
    }
    __syncthreads();
}


constexpr int RL_XC = 0, RL_RG = 34816, RL_OUT = 69632, RL_CW = 104448, RL_CARRY = 114688, RL_SSQP = 116736, RL_END = 124928;
template <int S> __device__ __forceinline__ float dpp_shr(float v, float ident) {
    return __builtin_bit_cast(float, __builtin_amdgcn_update_dpp(__builtin_bit_cast(int, ident), __builtin_bit_cast(int, v), 0x110 + S, 0xf, 0xf, false));
}
__device__ __forceinline__ float row_last(float v) { return __builtin_bit_cast(float, __builtin_amdgcn_ds_swizzle(__builtin_bit_cast(int, v), 0x1F0)); }
template <bool FINAL>
__device__ __forceinline__ void rglru_item(const PV& p, LAS unsigned char* lds, int item) {
    const int tid = get_tid(lds);
    const int lane = tid & 63, w = __builtin_amdgcn_readfirstlane(tid >> 6), fr = lane & 15, fq = lane >> 4, srow = tid >> 3, sseg = tid & 7;
    const int b = item >> 4, chunk = item & 15;
    const bf16_t* PROJ = (const bf16_t*)(p.ws() + WS_R2); bf16_t* MIX = (bf16_t*)(p.ws() + WS_R1); float* SUMM = (float*)(p.ws() + WS_SUMM); const bf16_t* WRI = (const bf16_t*)(p.ws() + WS_WRI);
    LAS float* CW = (LAS float*)(lds + RL_CW); LAS float* CARRY = (LAS float*)(lds + RL_CARRY); LAS float* SSQP = (LAS float*)(lds + RL_SSQP);
    const size_t tok0 = (size_t)b * SEQ + (size_t)chunk * 256;
    if (FINAL) GSTAMP(p.ws(), tid, 0);
    for (int i = tid; i < 2560; i += 512) CW[i] = i < 2048 ? p.in(I_CW)[i] : p.in(I_CB)[i - 2048];
    if (FINAL) {
        float carry = 0.f;
        for (int cc = 0; cc < chunk; ++cc) { const float2 ab = *(const float2*)(SUMM + ((size_t)(b * 16 + cc) * 512 + tid) * 2); carry = ab.x * carry + ab.y; }
        CARRY[tid] = carry;
        for (int i = tid; i < 2048; i += 512) SSQP[i] = 0.f;
    }
    u32x4 rx[8], rgr[2];
    auto prefetch = [&](int sidx) {
        const int hd = sidx >> 2, step = sidx & 3; const int tl = step * 64 + srow; const size_t tok = tok0 + tl; const int tseq = chunk * 256 + tl;
        const bf16_t* px = PROJ + tok * NPROJ + 2048 + hd * 128 + 16 * sseg;
#pragma unroll
        for (int j = 0; j < 4; ++j) { if (tseq - 3 + j >= 0) { rx[2 * j] = *(const u32x4*)(px + (ptrdiff_t)(j - 3) * NPROJ); rx[2 * j + 1] = *(const u32x4*)(px + (ptrdiff_t)(j - 3) * NPROJ + 8); } else { rx[2 * j] = (u32x4){0u, 0u, 0u, 0u}; rx[2 * j + 1] = (u32x4){0u, 0u, 0u, 0u}; } }
        if (FINAL) { rgr[0] = *(const u32x4*)(px + 512); rgr[1] = *(const u32x4*)(px + 520); }
    };
    prefetch(0);
    __syncthreads();
    if (FINAL) GSTAMP(p.ws(), tid, 1);
    float hc[4], ptot[4], brv[4], biv[4], spv[4];
    bf16x8 br[4], bi[4], bid;
    for (int sidx = 0; sidx < 16; ++sidx) {
        const int hd = sidx >> 2, step = sidx & 3, buf = sidx & 1;
        if (step == 0) {
#pragma unroll
            for (int ks = 0; ks < 4; ++ks) { br[ks] = *(const bf16x8*)(WRI + ((size_t)(hd * 256 + 16 * w + fr) * 128 + 32 * ks + 8 * fq)); bi[ks] = *(const bf16x8*)(WRI + ((size_t)(hd * 256 + 128 + 16 * w + fr) * 128 + 32 * ks + 8 * fq)); }
#pragma unroll
            for (int jj = 0; jj < 8; ++jj) bid[jj] = (8 * fq + jj == 16 * (w & 1) + fr) ? (short)0x3F80 : (short)0;
#pragma unroll
            for (int r = 0; r < 4; ++r) { const int ch = hd * 128 + 16 * w + 4 * fq + r; brv[r] = p.in(I_BR)[ch]; biv[r] = p.in(I_BI)[ch]; spv[r] = log1pf(fexp(-p.in(I_LAM)[ch]));
                hc[r] = FINAL ? CARRY[ch] : 0.f; ptot[r] = 1.f; }
        }
        { float xc[16];
          const LAS f32x4* cb4 = (const LAS f32x4*)(CW + 2048 + hd * 128 + 16 * sseg);
#pragma unroll
          for (int q = 0; q < 4; ++q) { const f32x4 v = cb4[q]; xc[4 * q] = v.x; xc[4 * q + 1] = v.y; xc[4 * q + 2] = v.z; xc[4 * q + 3] = v.w; }
#pragma unroll
          for (int j = 0; j < 4; ++j) { float xf[16]; unpack16(rx[2 * j], rx[2 * j + 1], xf); const LAS f32x4* cw4 = (const LAS f32x4*)(CW + j * 512 + hd * 128 + 16 * sseg);
#pragma unroll
              for (int q = 0; q < 4; ++q) { const f32x4 v = cw4[q]; xc[4 * q] += v.x * xf[4 * q]; xc[4 * q + 1] += v.y * xf[4 * q + 1]; xc[4 * q + 2] += v.z * xf[4 * q + 2]; xc[4 * q + 3] += v.w * xf[4 * q + 3]; } }
          u32x4 o0, o1; o0.x = pk2(xc[0], xc[1]); o0.y = pk2(xc[2], xc[3]); o0.z = pk2(xc[4], xc[5]); o0.w = pk2(xc[6], xc[7]); o1.x = pk2(xc[8], xc[9]); o1.y = pk2(xc[10], xc[11]); o1.z = pk2(xc[12], xc[13]); o1.w = pk2(xc[14], xc[15]);
          *(LAS u32x4*)(lds + RL_XC + buf * 17408 + srow * 272 + sseg * 32) = o0; *(LAS u32x4*)(lds + RL_XC + buf * 17408 + srow * 272 + sseg * 32 + 16) = o1;
          if (FINAL) { *(LAS u32x4*)(lds + RL_RG + buf * 17408 + srow * 272 + sseg * 32) = rgr[0]; *(LAS u32x4*)(lds + RL_RG + buf * 17408 + srow * 272 + sseg * 32 + 16) = rgr[1]; } }
        if (sidx + 1 < 16) prefetch(sidx + 1);
        __syncthreads();
        if (FINAL && sidx > 0) { const int ps = sidx - 1, phd = ps >> 2, pstep = ps & 3, pbuf = ps & 1;
            const u32x4 v0 = *(const LAS u32x4*)(lds + RL_OUT + pbuf * 17408 + srow * 272 + sseg * 32), v1 = *(const LAS u32x4*)(lds + RL_OUT + pbuf * 17408 + srow * 272 + sseg * 32 + 16);
            bf16_t* dst = MIX + (tok0 + pstep * 64 + srow) * D + 512 + phd * 128 + 16 * sseg; *(u32x4*)dst = v0; *(u32x4*)(dst + 8) = v1; }
        const int ksx = w >> 1;
#pragma unroll
        for (int m = 0; m < 4; ++m) {
            f32x4 ar = (f32x4){0.f, 0.f, 0.f, 0.f}, ai = ar, ax = ar, ag = ar;
#pragma unroll
            for (int ks = 0; ks < 4; ++ks) { const bf16x8 a = *(const LAS bf16x8*)(lds + RL_XC + buf * 17408 + (16 * m + fr) * 272 + (32 * ks + 8 * fq) * 2);
                ar = __builtin_amdgcn_mfma_f32_16x16x32_bf16(br[ks], a, ar, 0, 0, 0); ai = __builtin_amdgcn_mfma_f32_16x16x32_bf16(bi[ks], a, ai, 0, 0, 0); }
            { const bf16x8 a = *(const LAS bf16x8*)(lds + RL_XC + buf * 17408 + (16 * m + fr) * 272 + (32 * ksx + 8 * fq) * 2); ax = __builtin_amdgcn_mfma_f32_16x16x32_bf16(bid, a, ax, 0, 0, 0); }
            if (FINAL) { const bf16x8 a = *(const LAS bf16x8*)(lds + RL_RG + buf * 17408 + (16 * m + fr) * 272 + (32 * ksx + 8 * fq) * 2); ag = __builtin_amdgcn_mfma_f32_16x16x32_bf16(bid, a, ag, 0, 0, 0); }
            float P[4], H[4];
#pragma unroll
            for (int r = 0; r < 4; ++r) { const float rr = sigmoidf_(ar[r] + brv[r]), ii = sigmoidf_(ai[r] + biv[r]), a = fexp(-8.0f * rr * spv[r]);
                P[r] = a; H[r] = fsqrt(fmaxf(1.0f - a * a, 0.f)) * (ii * ax[r]); }
#pragma unroll
            for (int r = 0; r < 4; ++r) { { const float Pp = dpp_shr<1>(P[r], 1.f), Hp = dpp_shr<1>(H[r], 0.f); H[r] = P[r] * Hp + H[r]; P[r] = P[r] * Pp; }
                { const float Pp = dpp_shr<2>(P[r], 1.f), Hp = dpp_shr<2>(H[r], 0.f); H[r] = P[r] * Hp + H[r]; P[r] = P[r] * Pp; }
                { const float Pp = dpp_shr<4>(P[r], 1.f), Hp = dpp_shr<4>(H[r], 0.f); H[r] = P[r] * Hp + H[r]; P[r] = P[r] * Pp; }
                { const float Pp = dpp_shr<8>(P[r], 1.f), Hp = dpp_shr<8>(H[r], 0.f); H[r] = P[r] * Hp + H[r]; P[r] = P[r] * Pp; } }
            float gq[4]; float ss = 0.f;
#pragma unroll
            for (int r = 0; r < 4; ++r) { const float hv = H[r] + P[r] * hc[r];
                if (FINAL) { gq[r] = gelu_tanh(ag[r]) * hv; ss += gq[r] * gq[r]; } else ptot[r] *= row_last(P[r]);
                hc[r] = row_last(hv); }
            if (FINAL) {
                u32x2 ow; ow.x = pk2(gq[0], gq[1]); ow.y = pk2(gq[2], gq[3]);
                *(LAS u32x2*)(lds + RL_OUT + buf * 17408 + (16 * m + fr) * 272 + (16 * w + 4 * fq) * 2) = ow;
                ss += __shfl_xor(ss, 16); ss += __shfl_xor(ss, 32);
                if (fq == 0) SSQP[w * 256 + step * 64 + 16 * m + fr] += ss;
            }
        }
        if (!FINAL && step == 3 && fr == 0) {
#pragma unroll
            for (int r = 0; r < 4; ++r) *(float2*)(SUMM + ((size_t)(b * 16 + chunk) * 512 + hd * 128 + 16 * w + 4 * fq + r) * 2) = make_float2(ptot[r], hc[r]); }
    }
    if (FINAL) {
        __syncthreads();
        GSTAMP(p.ws(), tid, 2);
        { const int ps = 15, phd = 3, pstep = 3, pbuf = ps & 1;
          const u32x4 v0 = *(const LAS u32x4*)(lds + RL_OUT + pbuf * 17408 + srow * 272 + sseg * 32), v1 = *(const LAS u32x4*)(lds + RL_OUT + pbuf * 17408 + srow * 272 + sseg * 32 + 16);
          bf16_t* dst = MIX + (tok0 + pstep * 64 + srow) * D + 512 + phd * 128 + 16 * sseg; *(u32x4*)dst = v0; *(u32x4*)(dst + 8) = v1; }
        asm volatile("s_waitcnt vmcnt(0)" ::: "memory");
        __syncthreads();
        for (int i = tid; i < 256 * 64; i += 512) { const int tl = i >> 6, c8 = i & 63; float s = 0.f;
#pragma unroll
            for (int ww = 0; ww < 8; ++ww) s += SSQP[ww * 256 + tl];
            const float rs = frsq(s * (1.0f / 512.f) + EPS);
            u32x4* ptr = (u32x4*)(MIX + (tok0 + tl) * D + 512 + c8 * 8); u32x4 v = *ptr;
            v.x = pk2(bflo(v.x) * rs, bfhi(v.x) * rs); v.y = pk2(bflo(v.y) * rs, bfhi(v.y) * rs); v.z = pk2(bflo(v.z) * rs, bfhi(v.z) * rs); v.w = pk2(bflo(v.w) * rs, bfhi(v.w) * rs);
            *ptr = v; }
    }
    __syncthreads();
    if (FINAL) GSTAMP(p.ws(), tid, 3);
}

constexpr int RT_WH = 0, RT_WL = 66048, RT_SELE = 132096, RT_SELG = RT_SELE + 4096, RT_RSTD = RT_SELG + 4096, RT_HIST = RT_RSTD + 1024, RT_BASE = RT_HIST + 128, RT_LDS = RT_BASE + 128;
template <int N> __device__ __forceinline__ float row_ror_f(float v) { return __builtin_bit_cast(float, __builtin_amdgcn_update_dpp(0, __builtin_bit_cast(int, v), 0x120 + N, 0xf, 0xf, false)); }
template <int N> __device__ __forceinline__ int row_ror_i(int v) { return __builtin_amdgcn_update_dpp(0, v, 0x120 + N, 0xf, 0xf, false); }
__device__ __forceinline__ float row_max16(float v) { v = fmaxf(v, row_ror_f<8>(v)); v = fmaxf(v, row_ror_f<4>(v)); v = fmaxf(v, row_ror_f<2>(v)); v = fmaxf(v, row_ror_f<1>(v)); return v; }
__device__ __forceinline__ int row_min16(int v) { v = min(v, row_ror_i<8>(v)); v = min(v, row_ror_i<4>(v)); v = min(v, row_ror_i<2>(v)); v = min(v, row_ror_i<1>(v)); return v; }
__device__ __forceinline__ void routing_block(const PV& p, LAS unsigned char* lds, int tb) {
    const int tid = get_tid(lds), lane = tid & 63, wave = __builtin_amdgcn_readfirstlane(tid >> 6), fr = lane & 15, fq = lane >> 4;
    LAS int* selE = (LAS int*)(lds + RT_SELE); LAS float* selG = (LAS float*)(lds + RT_SELG);
    LAS float* rstds = (LAS float*)(lds + RT_RSTD); LAS int* hist = (LAS int*)(lds + RT_HIST); LAS int* base = (LAS int*)(lds + RT_BASE);
    { const u32x4* src = (const u32x4*)(p.ws() + WS_WRT);
      for (int i = tid; i < 2 * 32 * 128; i += 512) { const int hl = i >> 12, e = (i >> 7) & 31, c = i & 127; *(LAS u32x4*)(lds + (hl ? RT_WL : RT_WH) + e * 2064 + c * 16) = src[i]; } }
    if (tid < 32) hist[tid] = 0;
    __syncthreads();
    const float* H = p.out(); bf16_t* HB = (bf16_t*)(p.ws() + WS_R1); unsigned char* HB8 = (unsigned char*)(p.ws() + WS_HB8);
    const size_t tok0 = (size_t)tb * 256 + 32 * wave;
    f32x4 acc[2][2];
#pragma unroll
    for (int m = 0; m < 2; ++m)
#pragma unroll
        for (int hf = 0; hf < 2; ++hf) acc[m][hf] = (f32x4){0.f, 0.f, 0.f, 0.f};
    float ss[2] = {0.f, 0.f};
#pragma unroll 2
    for (int ks = 0; ks < 32; ++ks) {
        bf16x8 ah[2], al[2];
#pragma unroll
        for (int m = 0; m < 2; ++m) { const size_t off = (tok0 + 16 * m + fr) * D + 32 * ks + 8 * fq;
            const f32x4 x0 = *(const f32x4*)(H + off), x1 = *(const f32x4*)(H + off + 4);
            ss[m] += (x0.x * x0.x + x0.y * x0.y) + (x0.z * x0.z + x0.w * x0.w) + (x1.x * x1.x + x1.y * x1.y) + (x1.z * x1.z + x1.w * x1.w);
            u32x4 hi; hi.x = pk2(x0.x, x0.y); hi.y = pk2(x0.z, x0.w); hi.z = pk2(x1.x, x1.y); hi.w = pk2(x1.z, x1.w);
            u32x4 lo; lo.x = pk2(x0.x - bflo(hi.x), x0.y - bfhi(hi.x)); lo.y = pk2(x0.z - bflo(hi.y), x0.w - bfhi(hi.y)); lo.z = pk2(x1.x - bflo(hi.z), x1.y - bfhi(hi.z)); lo.w = pk2(x1.z - bflo(hi.w), x1.w - bfhi(hi.w));
            ah[m] = __builtin_bit_cast(bf16x8, hi); al[m] = __builtin_bit_cast(bf16x8, lo);
            *(u32x4*)(HB + off) = hi;
            u32x2 f8; f8.x = pk4_fp8(clamp448(x0.x * SC_H), clamp448(x0.y * SC_H), clamp448(x0.z * SC_H), clamp448(x0.w * SC_H)); f8.y = pk4_fp8(clamp448(x1.x * SC_H), clamp448(x1.y * SC_H), clamp448(x1.z * SC_H), clamp448(x1.w * SC_H));
            *(u32x2*)(HB8 + off) = f8; }
#pragma unroll
        for (int hf = 0; hf < 2; ++hf) { const bf16x8 bh = *(const LAS bf16x8*)(lds + RT_WH + (16 * hf + fr) * 2064 + (32 * ks + 8 * fq) * 2), bl = *(const LAS bf16x8*)(lds + RT_WL + (16 * hf + fr) * 2064 + (32 * ks + 8 * fq) * 2);
#pragma unroll
            for (int m = 0; m < 2; ++m) { acc[m][hf] = __builtin_amdgcn_mfma_f32_16x16x32_bf16(ah[m], bh, acc[m][hf], 0, 0, 0); acc[m][hf] = __builtin_amdgcn_mfma_f32_16x16x32_bf16(al[m], bh, acc[m][hf], 0, 0, 0);
                acc[m][hf] = __builtin_amdgcn_mfma_f32_16x16x32_bf16(ah[m], bl, acc[m][hf], 0, 0, 0); } }
    }
#pragma unroll
    for (int m = 0; m < 2; ++m) { float s = ss[m]; s += __shfl_xor(s, 16); s += __shfl_xor(s, 32); if (fq == 0) rstds[32 * wave + 16 * m + fr] = frsq(s * (1.0f / D) + EPS); }
    const float rb0 = p.in(I_RB)[fr], rb1 = p.in(I_RB)[16 + fr];
#pragma unroll
    for (int m = 0; m < 2; ++m)
#pragma unroll
        for (int r = 0; r < 4; ++r) { const int tl = 32 * wave + 16 * m + 4 * fq + r; const float rstd = rstds[tl];
            float l0 = acc[m][0][r] * rstd + rb0, l1 = acc[m][1][r] * rstd + rb1;
            float tv[4]; int te[4];
#pragma unroll
            for (int k = 0; k < 4; ++k) { const float mx = row_max16(fmaxf(l0, l1));
                const int cand = l0 == mx ? fr : (l1 == mx ? 16 + fr : 99), sel = row_min16(cand);
                tv[k] = mx; te[k] = sel; if (sel == fr) l0 = -INFINITY; if (sel == 16 + fr) l1 = -INFINITY; }
            const float e1 = fexp(tv[1] - tv[0]), e2 = fexp(tv[2] - tv[0]), e3 = fexp(tv[3] - tv[0]), inv = 1.0f / (1.0f + e1 + e2 + e3);
            if (fr < 4) { const int ee = fr == 0 ? te[0] : fr == 1 ? te[1] : fr == 2 ? te[2] : te[3]; const float gg = (fr == 0 ? 1.0f : fr == 1 ? e1 : fr == 2 ? e2 : e3) * inv;
                selE[tl * 4 + fr] = ee; selG[tl * 4 + fr] = gg; } }
    __syncthreads();
    int myrank[2], mye[2];
#pragma unroll
    for (int q = 0; q < 2; ++q) { const int a = tid + 512 * q; mye[q] = selE[a]; myrank[q] = atomicAdd((int*)(hist + mye[q]), 1); }
    __syncthreads();
    unsigned* ctl = (unsigned*)(p.ws() + WS_CTL);
    if (tid < 32) base[tid] = (int)atomicAdd(ctl + CW_CNT + tid, (unsigned)hist[tid]);
    __syncthreads();
    i32x4* ENT = (i32x4*)(p.ws() + WS_ENT);
#pragma unroll
    for (int q = 0; q < 2; ++q) { const int a = tid + 512 * q, tl = a >> 2, k = a & 3; const int pos = base[mye[q]] + myrank[q];
        i32x4 en; en.x = tb * 256 + tl; en.y = __float_as_int(rstds[tl]); en.z = k; en.w = __float_as_int(selG[a]); ENT[(size_t)mye[q] * T + pos] = en; }
}
__device__ __forceinline__ void routing_phase(const PV& p, LAS unsigned char* lds) {
    for (int tb = blockIdx.x; tb < T / 256; tb += gridDim.x) { routing_block(p, lds, tb); __syncthreads(); }
}

struct Rounds { int es; int nr; __device__ __forceinline__ int lo(int r) const { return r == 0 ? 0 : es; } __device__ __forceinline__ int hi(int r) const { return r == 0 ? es : NE; } };
__device__ __forceinline__ int pad256(int c) { return (c + 255) & ~255; }
__device__ __forceinline__ Rounds make_rounds(const unsigned* cnt) {
    Rounds R; int sum = 0, e = 0;
    for (; e < NE; ++e) { const int pc = pad256((int)cnt[e]); if (sum + pc > CAP_ROWS) break; sum += pc; }
    R.es = e; R.nr = e < NE ? 2 : 1; return R;
}
__device__ __forceinline__ void combine_rows(const PV& p, int gw, int ngw, int lane) {
    const bf16_t* HB = (const bf16_t*)(p.ws() + WS_R1); const bf16_t* Y23 = (const bf16_t*)(p.ws() + WS_Y23);
    f32x4 fw[4];
#pragma unroll
    for (int q = 0; q < 4; ++q) fw[q] = *(const f32x4*)(p.in(I_FNW) + 512 * (q >> 1) + 8 * lane + 4 * (q & 1));
    for (int m = gw; m < T; m += ngw) {
        float v[16];
        const u32x4 h0 = *(const u32x4*)(HB + (size_t)m * D + 8 * lane), h1 = *(const u32x4*)(HB + (size_t)m * D + 512 + 8 * lane);
        const unsigned hw[8] = {h0.x, h0.y, h0.z, h0.w, h1.x, h1.y, h1.z, h1.w};
#pragma unroll
        for (int q = 0; q < 8; ++q) { v[2 * q] = bflo(hw[q]); v[2 * q + 1] = bfhi(hw[q]); }
#pragma unroll
        for (int k = 0; k < 4; ++k) { const bf16_t* yb = (k < 2 ? (const bf16_t*)p.out() : Y23) + (size_t)m * 2048 + (k & 1) * 1024;
            const u32x4 y0 = *(const u32x4*)(yb + 8 * lane), y1 = *(const u32x4*)(yb + 512 + 8 * lane);
            const unsigned yw[8] = {y0.x, y0.y, y0.z, y0.w, y1.x, y1.y, y1.z, y1.w};
#pragma unroll
            for (int q = 0; q < 8; ++q) { v[2 * q] += bflo(yw[q]); v[2 * q + 1] += bfhi(yw[q]); } }
        float s = 0.f;
#pragma unroll
        for (int q = 0; q < 16; ++q) s += v[q] * v[q];
        const float rstd = frsq(wave_sum(s) * (1.0f / D) + EPS);
        float* o = p.out() + (size_t)m * D;
#pragma unroll
        for (int q = 0; q < 4; ++q) { f32x4 r; r.x = v[4 * q] * rstd * fw[q].x; r.y = v[4 * q + 1] * rstd * fw[q].y; r.z = v[4 * q + 2] * rstd * fw[q].z; r.w = v[4 * q + 3] * rstd * fw[q].w;
            *(f32x4*)(o + 512 * (q >> 1) + 8 * lane + 4 * (q & 1)) = r; }
    }
}
#ifndef REP_P0
#define REP_P0 1
#endif
#ifndef REP_P1
#define REP_P1 1
#endif
#ifndef REP_P2
#define REP_P2 1
#endif
#ifndef REP_P3
#define REP_P3 1
#endif
#ifndef REP_P4
#define REP_P4 1
#endif
#ifndef REP_G1
#define REP_G1 1
#endif
#ifndef REP_G2
#define REP_G2 1
#endif
__global__ void __launch_bounds__(512, 2) fwd(Params kp) {
    extern __shared__ __attribute__((aligned(16))) unsigned char lds_[];
    LAS unsigned char* lds = (LAS unsigned char*)lds_;
    {
        const int t0 = threadIdx.x;
        if (t0 < 22) *(volatile LAS unsigned long long*)(lds + LDS_PTAB_OFF + 8 * t0) = (unsigned long long)(size_t)kp.in[t0];
        if (t0 == 22) *(volatile LAS unsigned long long*)(lds + LDS_PTAB_OFF + 8 * 22) = (unsigned long long)(size_t)kp.out;
        if (t0 == 23) *(volatile LAS unsigned long long*)(lds + LDS_PTAB_OFF + 8 * 23) = (unsigned long long)(size_t)kp.ws;
    }
    unsigned char* ws = kp.ws;
    unsigned* bar = (unsigned*)(ws + WS_CTL) + CW_BAR;
    const PV p{lds};
    {
        const int t0 = threadIdx.x;
        const unsigned slot = (unsigned)__builtin_amdgcn_s_getreg(((6 - 1) << 11) | 4);
        if ((t0 & 63) == 0) *(volatile LAS int*)(lds + LDS_TAB + 4 * slot) = t0 >> 6;
        if (t0 == 0) { *(volatile LAS unsigned*)(lds + LDS_BARST) = 0u; *(volatile LAS unsigned*)(lds + LDS_BARST + 4) = 0u;
            const unsigned x = xb_xcc_id(), rank = xb_add(&bar[XB_XCNT(x)], 1u);
            *(volatile LAS unsigned*)(lds + LDS_BARST + 8) = rank * 8u + x; }
        __syncthreads();
    }
#ifdef PROBE_PH
    volatile LAS unsigned long long* phs = (volatile LAS unsigned long long*)(lds + LDS_TAB - 256); int nph = 0;
#define PH_STAMP() do { if (get_tid(lds) == 0) phs[nph] = __builtin_amdgcn_s_memrealtime(); ++nph; } while (0)
    PH_STAMP();
#define GRID_BAR() do { grid_barrier(bar, lds); PH_STAMP(); } while (0)
#else
#define PH_STAMP() do { } while (0)
#define GRID_BAR() grid_barrier(bar, lds)
#endif
    for (int rep = 0; rep < REP_P0; ++rep) { prep_phase(p, lds);
    cg::this_grid().sync(); PH_STAMP(); }
    int vcu = (int)blockIdx.x;
    { bool even = (gridDim.x % 8u) == 0u;
      for (unsigned j = 0; j < 16; ++j) { const unsigned c = xb_ld(&bar[XB_XCNT(j)]); if (c != (j < 8 ? gridDim.x / 8u : 0u)) even = false; }
      if (even) vcu = (int)*(volatile LAS unsigned*)(lds + LDS_BARST + 8);
      vcu = __builtin_amdgcn_readfirstlane(vcu); }
    for (int rep = 0; rep < REP_P1; ++rep) {
    { DenseSched S; S.o.init(T / 256, NPROJ / 256, gridDim.x, vcu); S.A = (const char*)(ws + WS_R1); S.Bt = (const char*)(ws + WS_WIN); S.pitch = 2 * D; EpiInProj E{(bf16_t*)(ws + WS_R2)};
      pg8::gemm_phase<false, false>(lds, (const char*)(ws + WS_R1), 2 * D, S, E); }
    GRID_BAR(); }
    for (int rep = 0; rep < REP_P2; ++rep) {
    GSTAMP(ws, get_tid(lds), 4);
    if (blockIdx.x < 64) mlstm_phase(p, lds, blockIdx.x);
    else {
        for (int it = blockIdx.x - 64; it < 256; it += gridDim.x - 64) rglru_item<false>(p, lds, it);
        GSTAMP(ws, get_tid(lds), 5);
        moe_conv_phase(p, lds, 64); }
    GSTAMP(ws, get_tid(lds), 6);
    GRID_BAR(); }
    for (int rep = 0; rep < REP_P3; ++rep) {
    for (int it = blockIdx.x; it < 256; it += gridDim.x) rglru_item<true>(p, lds, it);
    GRID_BAR(); }
    for (int rep = 0; rep < REP_P4; ++rep) {
    { DenseSched S; S.o.init(T / 256, D / 256, gridDim.x, vcu); S.A = (const char*)(ws + WS_R1); S.Bt = (const char*)(ws + WS_WOUT); S.pitch = 2 * D; EpiOutProj E{p.in(I_X), p.out()};
      pg8::gemm_phase<false, false>(lds, (const char*)(ws + WS_R1), 2 * D, S, E); }
    GRID_BAR(); }
    routing_phase(p, lds);
    GRID_BAR();
    const unsigned* cnt = (const unsigned*)(ws + WS_CTL) + CW_CNT;
    const Rounds RR = make_rounds(cnt);
    for (int r = 0; r < RR.nr; ++r) {
        for (int rep = 0; rep < REP_G1; ++rep) {
        { MoeSched<true, 8, 2 * DFF> S{cnt, (const i32x4*)(ws + WS_ENT), (const char*)(ws + WS_HB8), (const char*)(ws + WS_WGU), lds, RR.lo(r), RR.hi(r), (int)gridDim.x, vcu, 0}; S.init_tot(get_tid(lds));
          EpiG1 E{(unsigned char*)(ws + WS_R2), (const i32x4*)(ws + WS_ENT), cnt, p.in(I_BGU)};
          pg8::gemm_phase<true, true>(lds, (const char*)(ws + WS_HB8), D, S, E, ws, 8); }
        GRID_BAR(); }
        for (int rep = 0; rep < REP_G2; ++rep) {
        { MoeSched<false, 4, D> S{cnt, (const i32x4*)(ws + WS_ENT), (const char*)(ws + WS_R2), (const char*)(ws + WS_WDN), lds, RR.lo(r), RR.hi(r), (int)gridDim.x, vcu, 0}; S.init_tot(get_tid(lds));
          EpiG2 E{(bf16_t*)p.out(), (bf16_t*)(ws + WS_Y23), (const i32x4*)(ws + WS_ENT), cnt, p.in(I_BDN)};
          pg8::gemm_phase<true, false>(lds, (const char*)(ws + WS_R2), DFF, S, E, ws, 16); }
        GRID_BAR(); }
    }
    { const int tid = get_tid(lds); combine_rows(p, blockIdx.x * 8 + (tid >> 6), gridDim.x * 8, tid & 63); }
#ifdef PROBE_G
    if (blockIdx.x == PROBE_BLK && get_tid(lds) == 0) {
        const volatile unsigned long long* st = (const volatile unsigned long long*)(ws + WS_CTL + 40960);
        const unsigned long long ticks = (st[PROBE_I + PROBE_SPAN] - st[PROBE_I]) * PROBE_MUL;
        const unsigned long long t0 = __builtin_amdgcn_s_memrealtime();
        while (__builtin_amdgcn_s_memrealtime() - t0 < ticks) __builtin_amdgcn_s_sleep(8);
    }
#endif
#ifdef PROBE_PH
    PH_STAMP();
    if (vcu == 0 && get_tid(lds) == 0) {
        const unsigned long long ticks = (phs[PROBE_PH + 1] - phs[PROBE_PH]) * PROBE_MUL;
        const unsigned long long t0 = __builtin_amdgcn_s_memrealtime();
        while (__builtin_amdgcn_s_memrealtime() - t0 < ticks) __builtin_amdgcn_s_sleep(8);
    }
#endif
}

extern "C" void kernel_launch(void* const* d_in, const int* in_sizes, int n_in, void* d_out, int out_size, void* d_ws, size_t ws_size, hipStream_t stream) {
    static int grid = 0;
    if (grid == 0) {
        if (n_in != 22 || ws_size < WS_END) { fprintf(stderr, "kernel_launch: unexpected n_in %d / ws_size %zu (need %zu)\n", n_in, ws_size, (size_t)WS_END); grid = -1; return; }
        int dev = 0, cus = 0, per_cu = 0;
        (void)hipGetDevice(&dev); (void)hipDeviceGetAttribute(&cus, hipDeviceAttributeMultiprocessorCount, dev);
        (void)hipFuncSetAttribute((const void*)fwd, hipFuncAttributeMaxDynamicSharedMemorySize, LDS_BYTES);
        (void)hipOccupancyMaxActiveBlocksPerMultiprocessor(&per_cu, (const void*)fwd, 512, LDS_BYTES);
        if (per_cu < 1) { fprintf(stderr, "kernel_launch: occupancy query says %d blocks/CU\n", per_cu); per_cu = 1; }
        grid = cus * per_cu;
        fprintf(stderr, "kernel_launch: grid %d (cus %d x %d)\n", grid, cus, per_cu);
    }
    if (grid < 0) return;
    Params p{};
    for (int i = 0; i < 22; ++i) p.in[i] = (const float*)d_in[i];
    p.out = (float*)d_out; p.ws = (unsigned char*)d_ws;
    (void)hipMemsetAsync((unsigned char*)d_ws + WS_CTL, 0, 65536, stream);
    void* args[] = {&p};
    hipError_t e = hipLaunchCooperativeKernel((const void*)fwd, dim3(grid), dim3(512), args, LDS_BYTES, stream);
    if (e != hipSuccess) fprintf(stderr, "kernel_launch: cooperative launch failed: %s (grid %d)\n", hipGetErrorString(e), grid);
}
```

```cpp
#include <hip/hip_runtime.h>
#include <hip/hip_cooperative_groups.h>
#include <cstdio>
#include <cstdint>

namespace cg = cooperative_groups;
#define LAS __attribute__((address_space(3)))
typedef unsigned short bf16_t;
typedef short bf16x8 __attribute__((ext_vector_type(8)));
typedef float f32x4 __attribute__((ext_vector_type(4)));
typedef unsigned u32x4 __attribute__((ext_vector_type(4)));
typedef unsigned u32x2 __attribute__((ext_vector_type(2)));
typedef int i32x4 __attribute__((ext_vector_type(4)));

constexpr int T = 65536, D = 1024, SEQ = 4096, NB = 16;
constexpr int INC = 3080;
constexpr int NPROJ = 3072;
constexpr int NE = 32, TOPK = 4, DFF = 1024;
constexpr float EPS = 1e-6f;
constexpr int CAP_ROWS = 270336;
constexpr float SC_H = 8.0f, SC_W = 64.0f, SC_HID = 4.0f;

constexpr size_t MB = 1024 * 1024;
constexpr size_t WS_CTL  = 0;
constexpr size_t WS_GATES = 1 * MB;
constexpr size_t WS_SSQR = 3 * MB;
constexpr size_t WS_SUMM = 4 * MB;
constexpr size_t WS_WRI  = 5 * MB;
constexpr size_t WS_WRT  = 5 * MB + 512 * 1024;
constexpr size_t WS_ENT  = 6 * MB;
constexpr size_t WS_WIN  = 38 * MB;
constexpr size_t WS_WOUT = 44 * MB;
constexpr size_t WS_WGU  = 46 * MB;
constexpr size_t WS_WDN  = 110 * MB;
constexpr size_t WS_HB8  = 142 * MB;
constexpr size_t WS_R1   = 238 * MB;
constexpr size_t WS_R2   = 366 * MB;
constexpr size_t WS_Y23  = 750 * MB;
constexpr size_t WS_HB   = 878 * MB;
constexpr float SC_Y = 32.0f;
constexpr size_t WS_END  = 1006 * MB;

constexpr int CW_CNT = 0;
constexpr int CW_WORK = 64;
constexpr int CW_CNTA = 128;
constexpr int CW_BAR = 1024;

__device__ __forceinline__ unsigned pk2(float lo, float hi) { unsigned r; asm("v_cvt_pk_bf16_f32 %0, %1, %2" : "=v"(r) : "v"(lo), "v"(hi)); return r; }
__device__ __forceinline__ float bflo(unsigned u) { return __uint_as_float(u << 16); }
__device__ __forceinline__ float bfhi(unsigned u) { return __uint_as_float(u & 0xffff0000u); }
__device__ __forceinline__ float bf2f(bf16_t b) { return __uint_as_float(((unsigned)b) << 16); }
template <int CTRL, int RM> __device__ __forceinline__ float dpp_x(float v, float ident) {
    return __builtin_bit_cast(float, __builtin_amdgcn_update_dpp(__builtin_bit_cast(int, ident), __builtin_bit_cast(int, v), CTRL, RM, 0xf, false));
}
__device__ __forceinline__ float wave_sum(float s) {
    s += dpp_x<0x111, 0xf>(s, 0.f); s += dpp_x<0x112, 0xf>(s, 0.f); s += dpp_x<0x114, 0xf>(s, 0.f); s += dpp_x<0x118, 0xf>(s, 0.f);
    s += dpp_x<0x142, 0xa>(s, 0.f); s += dpp_x<0x143, 0xc>(s, 0.f);
    return __builtin_bit_cast(float, __builtin_amdgcn_readlane(__builtin_bit_cast(int, s), 63));
}
__device__ __forceinline__ float fexp(float x) { return __builtin_amdgcn_exp2f(x * 1.4426950408889634f); }
__device__ __forceinline__ float frcp(float x) { return __builtin_amdgcn_rcpf(x); }
__device__ __forceinline__ float fsqrt(float x) { return __builtin_amdgcn_sqrtf(x); }
__device__ __forceinline__ float frsq(float x) { return __builtin_amdgcn_rsqf(x); }
__device__ __forceinline__ float sigmoidf_(float x) { return frcp(1.0f + __builtin_amdgcn_exp2f(x * -1.4426950408889634f)); }
__device__ __forceinline__ float gelu_tanh(float x) {
    const float u2 = 1.5957691216057308f * (x + 0.044715f * x * x * x);
    return x * sigmoidf_(u2);
}

typedef int i32x8 __attribute__((ext_vector_type(8)));
__device__ __forceinline__ unsigned pk4_fp8(float a, float b, float c, float d) {
    int r = __builtin_amdgcn_cvt_pk_fp8_f32(a, b, 0, false); r = __builtin_amdgcn_cvt_pk_fp8_f32(c, d, r, true); return (unsigned)r;
}
__device__ __forceinline__ float clamp448(float x) { return fminf(fmaxf(x, -448.f), 448.f); }

struct Params {
    const float* in[22];
    float* out;
    unsigned char* ws;
    int pad0, pad1;
};
constexpr int LDS_PTAB_OFF = 159744 - 512 - 256 - 256;
struct PV {
    LAS unsigned char* l;
    __device__ __forceinline__ unsigned long long ptr(int i) const { const u32x2 v = *(volatile LAS u32x2*)(l + LDS_PTAB_OFF + 8 * i);
        return ((unsigned long long)(unsigned)__builtin_amdgcn_readfirstlane((int)v.y) << 32) | (unsigned)__builtin_amdgcn_readfirstlane((int)v.x); }
    __device__ __forceinline__ const float* in(int i) const { return (const float*)(size_t)ptr(i); }
    __device__ __forceinline__ float* out() const { return (float*)(size_t)ptr(22); }
    __device__ __forceinline__ unsigned char* ws() const { return (unsigned char*)(size_t)ptr(23); }
};
enum { I_X = 0, I_N1W, I_WIN, I_GB, I_MNW, I_CW, I_CB, I_WR, I_BR, I_WI, I_BI, I_LAM, I_LNW, I_WOUT, I_N2W, I_RW, I_RB, I_WGU, I_BGU, I_WDN, I_BDN, I_FNW };


constexpr int LDS_BYTES = 159744, LDS_TAB = LDS_BYTES - 512, LDS_BARST = LDS_BYTES - 16;
__device__ __forceinline__ int get_tid(LAS unsigned char* lds) {
    const unsigned slot = (unsigned)__builtin_amdgcn_s_getreg(((6 - 1) << 11) | 4);
    const int w = __builtin_amdgcn_readfirstlane(*(volatile LAS int*)(lds + LDS_TAB + 4 * slot));
    int lane; asm volatile("v_mbcnt_lo_u32_b32 %0, -1, 0\n\tv_mbcnt_hi_u32_b32 %0, -1, %0" : "=v"(lane));
    return w * 64 + lane;
}
#define XB_TMO      128
#define XB_XCNT(j)  (256  + 64 * (j))
#define XB_XSUB(j)  (1280 + 64 * (j))
#define XB_XGEN(j)  (2304 + 64 * (j))
#define XB_TOP      3328
#define XB_TOPGEN   3392
#define XCD_BAR_WORDS 3456
#define XB_SPIN_CAP (1u << 22)
__device__ __forceinline__ unsigned xb_ld(unsigned* p)              { return __hip_atomic_load(p, __ATOMIC_RELAXED, __HIP_MEMORY_SCOPE_AGENT); }
__device__ __forceinline__ unsigned xb_add(unsigned* p, unsigned v) { return __hip_atomic_fetch_add(p, v, __ATOMIC_RELAXED, __HIP_MEMORY_SCOPE_AGENT); }
__device__ __forceinline__ unsigned xb_xcc_id() { return (unsigned)__builtin_amdgcn_s_getreg((3 << 11) | 20) & 0xFu; }
#define XB_SPIN(cond, bar) do { unsigned _sp = 0; while (cond) { __builtin_amdgcn_s_sleep(1); \
    if ((++_sp & 255u) == 0u) { if (xb_ld(&(bar)[XB_TMO])) break; if (_sp > XB_SPIN_CAP) { atomicAdd(&(bar)[XB_TMO], 1u); break; } } } } while (0)
__device__ __forceinline__ void xcd_barrier_complete(unsigned* bar, unsigned x, unsigned G, unsigned& nloc, unsigned& nx) {
    unsigned sum, cnt, mine, sp = 0u;
    for (;;) {
        sum = 0u; cnt = 0u; mine = 0u;
#pragma unroll
        for (unsigned j = 0; j < 16; ++j) { const unsigned c = xb_ld(&bar[XB_XCNT(j)]); sum += c; cnt += (c > 0u) ? 1u : 0u; mine = (j == x) ? c : mine; }
        if (sum == G) break;
        __builtin_amdgcn_s_sleep(1);
        if ((++sp & 255u) == 0u) { if (xb_ld(&bar[XB_TMO])) break; if (sp > XB_SPIN_CAP) { atomicAdd(&bar[XB_TMO], 1u); break; } }
    }
    nloc = mine > 0u ? mine : 1u; nx = cnt > 0u ? cnt : 1u;
}
__device__ __forceinline__ void grid_barrier(unsigned* bar, LAS unsigned char* lds) {
    asm volatile("s_waitcnt vmcnt(0)" ::: "memory");
    __syncthreads();
    if (get_tid(lds) == 0) {
        volatile LAS unsigned* st = (volatile LAS unsigned*)(lds + LDS_BARST);
        const unsigned x = xb_xcc_id();
        __builtin_amdgcn_s_waitcnt(0);
        unsigned nloc = st[0], nx = st[1];
        if (nloc == 0u) { xcd_barrier_complete(bar, x, gridDim.x, nloc, nx); st[0] = nloc; st[1] = nx; }
        const unsigned old = xb_add(&bar[XB_XSUB(x)], 1u);
        const unsigned gen = old / nloc;
        if (old + 1u == (gen + 1u) * nloc) {
            __builtin_amdgcn_fence(__ATOMIC_RELEASE, "agent");
            asm volatile("s_waitcnt vmcnt(0)" ::: "memory");
            const unsigned og = xb_add(&bar[XB_TOP], 1u);
            const unsigned tg = og / nx;
            if (og + 1u == (tg + 1u) * nx) xb_add(&bar[XB_TOPGEN], 1u);
            else XB_SPIN(xb_ld(&bar[XB_TOPGEN]) == tg, bar);
            __builtin_amdgcn_fence(__ATOMIC_ACQUIRE, "agent");
            xb_add(&bar[XB_XGEN(x)], 1u);
            asm volatile("s_waitcnt vmcnt(0)" ::: "memory");
        } else {
            XB_SPIN(xb_ld(&bar[XB_XGEN(x)]) == gen, bar);
            __builtin_amdgcn_fence(__ATOMIC_ACQUIRE, "agent");
            asm volatile("s_waitcnt vmcnt(0)" ::: "memory");
        }
    }
    __syncthreads();
}

#ifdef PROBE_G
#define GSTAMP(ws_, tid_, i_) do { if (((i_) == PROBE_I || (i_) == PROBE_I + PROBE_SPAN) && blockIdx.x == PROBE_BLK && (tid_) == 0) ((volatile unsigned long long*)((ws_) + WS_CTL + 40960))[i_] = __builtin_amdgcn_s_memrealtime(); } while (0)
#else
#define GSTAMP(ws_, tid_, i_) do { } while (0)
#endif
__device__ __forceinline__ void tr_item(const float* __restrict__ W, int ldw, int col0, bf16_t* dst, int K, int k0, const float* sk, float mul, LAS float* scr, int lane) {
    float v[32];
    const float* src = W + (size_t)(k0 + (lane >> 5)) * ldw + col0 + (lane & 31);
#pragma unroll
    for (int i = 0; i < 32; ++i) v[i] = __builtin_nontemporal_load(src + (size_t)(2 * i) * ldw);
#pragma unroll
    for (int i = 0; i < 32; ++i) { const int kk = 2 * i + (lane >> 5); const float s = sk ? sk[k0 + kk] * mul : mul; scr[kk * 33 + (lane & 31)] = v[i] * s; }
    asm volatile("s_waitcnt lgkmcnt(0)" ::: "memory");
    const int c = lane & 7;
#pragma unroll
    for (int j = 0; j < 4; ++j) { const int n = (lane >> 3) + 8 * j; const LAS float* s = scr + (8 * c) * 33 + n;
        u32x4 o; o.x = pk2(s[0 * 33], s[1 * 33]); o.y = pk2(s[2 * 33], s[3 * 33]); o.z = pk2(s[4 * 33], s[5 * 33]); o.w = pk2(s[6 * 33], s[7 * 33]);
        *(u32x4*)(dst + (size_t)n * K + k0 + 8 * c) = o; }
    asm volatile("s_waitcnt lgkmcnt(0)" ::: "memory");
}
__device__ __forceinline__ void tr_item_f8(const float* __restrict__ W, int ldw, int col0, unsigned char* dst, int K, int k0, const float* sk, float mul, LAS float* scr, int lane) {
    f32x4 v[16];
    const int r = lane >> 4, c4 = lane & 15;
    const float* src = W + (size_t)(k0 + r) * ldw + col0 + 4 * c4;
#pragma unroll
    for (int i = 0; i < 16; ++i) v[i] = __builtin_nontemporal_load((const f32x4*)(src + (size_t)(4 * i) * ldw));
#pragma unroll
    for (int i = 0; i < 16; ++i) { const int kk = 4 * i + r; const float s = sk ? sk[k0 + kk] * mul : mul; f32x4 t = v[i] * s;
        t.x = clamp448(t.x); t.y = clamp448(t.y); t.z = clamp448(t.z); t.w = clamp448(t.w); *(LAS f32x4*)(scr + kk * 68 + 4 * c4) = t; }
    asm volatile("s_waitcnt lgkmcnt(0)" ::: "memory");
    const int c = lane & 3, nn = lane >> 2;
#pragma unroll
    for (int j = 0; j < 4; ++j) { const int n = nn + 16 * j; const LAS float* s = scr + (16 * c) * 68 + n;
        u32x4 o; o.x = pk4_fp8(s[0 * 68], s[1 * 68], s[2 * 68], s[3 * 68]); o.y = pk4_fp8(s[4 * 68], s[5 * 68], s[6 * 68], s[7 * 68]);
        o.z = pk4_fp8(s[8 * 68], s[9 * 68], s[10 * 68], s[11 * 68]); o.w = pk4_fp8(s[12 * 68], s[13 * 68], s[14 * 68], s[15 * 68]);
        *(u32x4*)(dst + (size_t)n * K + k0 + 16 * c) = o; }
    asm volatile("s_waitcnt lgkmcnt(0)" ::: "memory");
}
constexpr int IT_WIN = 16 * 96, IT_WOUT = 16 * 32, IT_WGU_E = 16 * 32, IT_WDN_E = 16 * 16;
__device__ __forceinline__ void conv_item_small(const PV& p, int it, LAS float* scr, int lane) {
    if (it < IT_WIN) {
        const int kb = it / 96, nb = it % 96, n0 = 32 * nb, sec = n0 >> 9;
        const int secoff = sec == 0 ? 0 : sec == 1 ? 512 : sec == 2 ? 1024 : sec == 3 ? 1544 : sec == 4 ? 2056 : 2568;
        const float mul = sec == 1 ? 0.08838834764831845f : 1.0f;
        tr_item(p.in(I_WIN), INC, secoff + (n0 & 511), (bf16_t*)(p.ws() + WS_WIN) + (size_t)n0 * D, D, 64 * kb, nullptr, mul, scr, lane);
    } else {
        it -= IT_WIN; const int kb = it / 32, nb = it % 32, k0 = 64 * kb;
        const float* sk = k0 < 512 ? p.in(I_MNW) : p.in(I_LNW) - 512;
        tr_item(p.in(I_WOUT), D, 32 * nb, (bf16_t*)(p.ws() + WS_WOUT) + (size_t)(32 * nb) * D, D, k0, sk, 1.0f, scr, lane);
    }
}
__device__ __forceinline__ void conv_item_moe(const PV& p, int it, LAS float* scr, int lane) {
    if (it < NE * IT_WGU_E) {
        const int e = it / IT_WGU_E, r = it % IT_WGU_E, kb = r / 32, nb = r % 32, n0 = 64 * nb, j = n0 >> 8, c0 = n0 & 255;
        const int srccol = c0 < 128 ? 128 * j + c0 : 1024 + 128 * j + (c0 - 128);
        tr_item_f8(p.in(I_WGU) + (size_t)e * D * 2 * DFF, 2 * DFF, srccol, (unsigned char*)(p.ws() + WS_WGU) + ((size_t)e * 2 * DFF + n0) * D, D, 64 * kb, p.in(I_N2W), SC_W, scr, lane);
    } else {
        it -= NE * IT_WGU_E; const int e = it / IT_WDN_E, r = it % IT_WDN_E, kb = r / 16, nb = r % 16;
        tr_item_f8(p.in(I_WDN) + (size_t)e * DFF * D, D, 64 * nb, (unsigned char*)(p.ws() + WS_WDN) + ((size_t)e * D + 64 * nb) * DFF, DFF, 64 * kb, nullptr, SC_W, scr, lane);
    }
}
__device__ __forceinline__ void xpass_rows(const PV& p, LAS unsigned char* lds, int gw, int ngw, int lane) {
    LAS float* WG = (LAS float*)(lds + 69632);
    { const float* wg = p.in(I_WIN) + 1536;
      for (int i = get_tid(lds); i < 2048; i += 512) { const int k = i >> 1, q = i & 1; const f32x4 a = *(const f32x4*)(wg + (size_t)k * INC + 4 * q);
          const int rho = ((k >> 8) * 4 + (k & 3)) * 64 + ((k >> 2) & 63); *(LAS f32x4*)(WG + rho * 12 + 4 * q) = a; } }
    __syncthreads();
    f32x4 w1[4];
#pragma unroll
    for (int j = 0; j < 4; ++j) w1[j] = *(const f32x4*)(p.in(I_N1W) + 256 * j + 4 * lane);
    const float gb = lane < 8 ? p.in(I_GB)[lane] : 0.f;
    bf16_t* XN = (bf16_t*)(p.ws() + WS_R1); float* GATES = (float*)(p.ws() + WS_GATES);
    for (int m = gw; m < T; m += ngw) {
        const f32x4* xr = (const f32x4*)(p.in(I_X) + (size_t)m * D) + lane;
        f32x4 v[4]; float s = 0.f;
#pragma unroll
        for (int j = 0; j < 4; ++j) { v[j] = xr[64 * j]; s += (v[j].x * v[j].x + v[j].y * v[j].y) + (v[j].z * v[j].z + v[j].w * v[j].w); }
        const float rstd = frsq(wave_sum(s) * (1.0f / D) + EPS);
        float g[8];
#pragma unroll
        for (int q = 0; q < 8; ++q) g[q] = 0.f;
        unsigned long long* o8 = (unsigned long long*)(XN + (size_t)m * D) + lane;
#pragma unroll
        for (int j = 0; j < 4; ++j) { v[j] = v[j] * rstd * w1[j];
            o8[64 * j] = (unsigned long long)pk2(v[j].x, v[j].y) | ((unsigned long long)pk2(v[j].z, v[j].w) << 32);
#pragma unroll
            for (int c = 0; c < 4; ++c) { const float xv = v[j][c]; const LAS f32x4* wrow = (const LAS f32x4*)(WG + ((j * 4 + c) * 64 + lane) * 12); const f32x4 wa = wrow[0], wb = wrow[1];
                g[0] += xv * wa.x; g[1] += xv * wa.y; g[2] += xv * wa.z; g[3] += xv * wa.w; g[4] += xv * wb.x; g[5] += xv * wb.y; g[6] += xv * wb.z; g[7] += xv * wb.w; } }
        float mine = 0.f;
#pragma unroll
        for (int q = 0; q < 8; ++q) { const float t = wave_sum(g[q]); if (lane == q) mine = t; }
        if (lane < 8) { float val = mine + gb; if (lane >= 4) val = -log1pf(fexp(-val)); GATES[(size_t)m * 8 + lane] = val; }
    }
}
__device__ __forceinline__ void prep_phase(const PV& p, LAS unsigned char* lds) {
    const int tid = get_tid(lds), lane = tid & 63, wave = tid >> 6, gw = blockIdx.x * 8 + wave, ngw = gridDim.x * 8;
    LAS float* scr = (LAS float*)(lds + wave * 8448);
    for (int it = gw; it < IT_WIN + IT_WOUT; it += ngw) conv_item_small(p, it, scr, lane);
    bf16_t* WRI = (bf16_t*)(p.ws() + WS_WRI);
    for (int i = blockIdx.x * 512 + tid; i < 4 * 256 * 128; i += gridDim.x * 512) { const int h = i >> 15, n = (i >> 7) & 255, k = i & 127;
        const float v = n < 128 ? p.in(I_WR)[(h * 128 + k) * 128 + n] : p.in(I_WI)[(h * 128 + k) * 128 + n - 128]; WRI[i] = (bf16_t)(pk2(v, 0.f) & 0xffff); }
    { bf16_t* WRT = (bf16_t*)(p.ws() + WS_WRT);
      for (int i = blockIdx.x * 512 + tid; i < 32 * 1024; i += gridDim.x * 512) { const int e = i >> 10, k = i & 1023; const float v = p.in(I_RW)[k * 32 + e] * p.in(I_N2W)[k];
          const unsigned h = pk2(v, 0.f) & 0xffffu; const float lo = v - __uint_as_float(h << 16); WRT[i] = (bf16_t)h; WRT[32 * 1024 + i] = (bf16_t)(pk2(lo, 0.f) & 0xffffu); } }
    xpass_rows(p, lds, gw, ngw, lane);
}
__device__ __forceinline__ void moe_conv_phase(const PV& p, LAS unsigned char* lds, int b0) {
    const int tid = get_tid(lds), lane = tid & 63, wave = tid >> 6;
    if ((int)blockIdx.x < b0) return;
    const int gw = ((int)blockIdx.x - b0) * 8 + wave, ngw = ((int)gridDim.x - b0) * 8;
    LAS float* scr = (LAS float*)(lds + wave * 17408);
    for (int it = gw; it < NE * (IT_WGU_E + IT_WDN_E); it += ngw) conv_item_moe(p, it, scr, lane);
}

namespace pg8 {
constexpr int BM = 256, BK = 64, HALF = 128, HTB = HALF * BK * 2, STAGE_BYTES = 8 * HTB;
__device__ __forceinline__ int lds_byte(int r, int c) { const int st = (r >> 4) * 2 + (c >> 5), rr = r & 15, cc = c & 31, ob = rr * 64 + cc * 2; return st * 1024 + (ob ^ (((ob >> 9) & 1) << 5)); }
__device__ __forceinline__ void stage_rc(int b, int& R, int& C) { const int st = b / 1024, sb = b % 1024, swz = sb ^ (((sb >> 9) & 1) << 5); R = (st >> 1) * 16 + swz / 64; C = (st & 1) * 32 + (swz % 64) / 2; }
__device__ __forceinline__ int perm32(int rho) { const int n = rho >> 4, i = rho & 15; return 8 * (i >> 2) + 4 * n + (i & 3); }
struct Unit { const char* b; const char* a; int i0, i1, i2, i3; };
#define PG8_GLDS2(ldsa, s0, v0, s1, v1) do { unsigned _keep; \
        asm volatile("s_mov_b32 %0, m0\n\ts_mov_b32 m0, %5\n\ts_nop 0\n\tglobal_load_lds_dwordx4 %1, %2\n\ts_mov_b32 m0, %6\n\ts_nop 0\n\tglobal_load_lds_dwordx4 %3, %4\n\ts_mov_b32 m0, %0" \
                     : "=&s"(_keep) : "v"(v0), "s"((const char*)(s0)), "v"(v1), "s"((const char*)(s1)), "s"(ldsa), "s"((ldsa) + 8192u) : "memory"); } while (0)
template <bool F8, bool GATHER, class Epi, class Sched>
__device__ __forceinline__ void gemm_phase(LAS unsigned char* lds, const char* Abase, int pitch, const Sched& S, const Epi& E, unsigned char* pws = nullptr, int pslot = 0) {
    const int tid = get_tid(lds);
    const int wid = __builtin_amdgcn_readfirstlane(tid >> 6), lane = tid & 63, wr = wid >> 2, wc = wid & 3, fr = lane & 15, fq = lane >> 4;
    const int nt = pitch / 128;
    unsigned vA, vB;
    { int R0, C0; stage_rc(tid * 16, R0, C0); const int Rb0 = Epi::PERM ? ((R0 & ~31) + perm32(R0 & 31)) : R0;
      vA = (unsigned)(R0 * pitch + 2 * C0); vB = (unsigned)(Rb0 * pitch + 2 * C0); }
    const size_t kstep = 128, hstep = (size_t)HALF * pitch, q64 = (size_t)64 * pitch;
    const unsigned ldsb0 = (unsigned)__builtin_amdgcn_readfirstlane((int)((unsigned)(size_t)lds + (unsigned)wid * 1024u));
    const int aoff = lds_byte(wr * 64 + fr, fq * 8), boff = lds_byte(wc * 32 + fr, fq * 8);
    constexpr int HOFF = 1024;
#define PG8_SA(b, h) (((b) * 2 + (h)) * HTB)
#define PG8_SB(b, h) ((4 + (b) * 2 + (h)) * HTB)
#define PG8_STAGEB(bufoff, gbase) PG8_GLDS2(ldsb0 + (unsigned)(bufoff), (gbase), vB, (gbase) + q64, vB)
#define PG8_STAGEA(bufoff, kp, h) do { if constexpr (GATHER) { if ((h) == 0) PG8_GLDS2(ldsb0 + (unsigned)(bufoff), (kp), g0, (kp), g1); else PG8_GLDS2(ldsb0 + (unsigned)(bufoff), (kp), g2, (kp), g3); } \
        else PG8_GLDS2(ldsb0 + (unsigned)(bufoff), (kp) + (h) * hstep, vA, (kp) + (h) * hstep + q64, vA); } while (0)
#define PG8_RD(p) (*(const LAS u32x4*)(p))
#define PG8_LDA(dst, b, h) do { _Pragma("unroll") for (int m = 0; m < 4; ++m) { dst[m][0] = PG8_RD(lds + PG8_SA(b, h) + aoff + m * 2048); dst[m][1] = PG8_RD(lds + PG8_SA(b, h) + aoff + m * 2048 + HOFF); } } while (0)
#define PG8_LDB(dst, b, h) do { _Pragma("unroll") for (int n = 0; n < 2; ++n) { dst[n][0] = PG8_RD(lds + PG8_SB(b, h) + boff + n * 2048); dst[n][1] = PG8_RD(lds + PG8_SB(b, h) + boff + n * 2048 + HOFF); } } while (0)
#define PG8_CAT(v) __builtin_bit_cast(i32x8, __builtin_shufflevector((v)[0], (v)[1], 0, 1, 2, 3, 4, 5, 6, 7))
#define PG8_MMA(ai, bj, At, Bt) do { __builtin_amdgcn_s_setprio(1); _Pragma("unroll") for (int m = 0; m < 4; ++m) _Pragma("unroll") for (int n = 0; n < 2; ++n) { \
        if constexpr (F8) acc[ai][bj][m][n] = __builtin_amdgcn_mfma_scale_f32_16x16x128_f8f6f4(PG8_CAT(Bt[n]), PG8_CAT(At[m]), acc[ai][bj][m][n], 0, 0, 0, 0, 0, 0);     \
        else { acc[ai][bj][m][n] = __builtin_amdgcn_mfma_f32_16x16x32_bf16(__builtin_bit_cast(bf16x8, Bt[n][0]), __builtin_bit_cast(bf16x8, At[m][0]), acc[ai][bj][m][n], 0, 0, 0); \
               acc[ai][bj][m][n] = __builtin_amdgcn_mfma_f32_16x16x32_bf16(__builtin_bit_cast(bf16x8, Bt[n][1]), __builtin_bit_cast(bf16x8, At[m][1]), acc[ai][bj][m][n], 0, 0, 0); } } \
        __builtin_amdgcn_s_setprio(0); } while (0)
#define PG8_WAIT_V(n) asm volatile("s_waitcnt vmcnt(" #n ")" ::: "memory")
#define PG8_WAIT_L(n) asm volatile("s_waitcnt lgkmcnt(" #n ")" ::: "memory")
#define PG8_BAR __builtin_amdgcn_s_barrier()
#define PG8_SCHED __builtin_amdgcn_sched_barrier(0)
    Unit cur, nxt; int ui = 0;
    if (!S.next(0, cur)) return;
    f32x4 acc[2][2][4][2];
#pragma unroll
    for (int a = 0; a < 2; ++a)
#pragma unroll
        for (int b = 0; b < 2; ++b)
#pragma unroll
            for (int m = 0; m < 4; ++m)
#pragma unroll
                for (int n = 0; n < 2; ++n) acc[a][b][m][n] = (f32x4){0.f, 0.f, 0.f, 0.f};
    u32x4 At[4][2], B0[2][2], B1[2][2];
    unsigned g0 = 0, g1 = 0, g2 = 0, g3 = 0;
    if constexpr (GATHER) { S.goffs(cur, tid, 0, g0, g1); S.goffs(cur, tid, 1, g2, g3); }
    const char* cA = GATHER ? Abase : cur.a; const char* cB = cur.b;
    PG8_STAGEB(PG8_SB(0, 0), cB); PG8_STAGEB(PG8_SB(0, 1), cB + hstep); PG8_STAGEA(PG8_SA(0, 0), cA, 0); PG8_STAGEA(PG8_SA(0, 1), cA, 1);
    if (wr == 1) PG8_BAR;
    PG8_WAIT_V(2); PG8_BAR;
    PG8_STAGEB(PG8_SB(1, 0), cB + kstep); PG8_STAGEA(PG8_SA(1, 0), cA + kstep, 0); PG8_STAGEB(PG8_SB(1, 1), cB + hstep + kstep);
    PG8_WAIT_V(6); PG8_BAR;
    for (;;) {
#ifdef PROBE_G
        if (pws && ui == 2) GSTAMP(pws, tid, pslot);
#endif
        const bool has_next = S.next(ui + 1, nxt);
        const char* nB = has_next ? nxt.b : cB; const char* nA = GATHER ? Abase : (has_next ? nxt.a : cA);
#ifdef PROBE_G
        if (pws && ui == 2) GSTAMP(pws, tid, pslot + 1);
#endif
#pragma unroll 1
        for (int t = 0; t < nt; t += 2) {
            const bool last = (t == nt - 2);
            const char* a1 = cA + (size_t)(t + 1) * kstep;
            const char* a2 = last ? nA : cA + (size_t)(t + 2) * kstep; const char* b2 = last ? nB : cB + (size_t)(t + 2) * kstep;
            const char* a3 = a2 + kstep; const char* b3 = b2 + kstep;
            PG8_LDB(B0, 0, 0); PG8_LDB(B1, 0, 1); PG8_SCHED; PG8_LDA(At, 0, 0); PG8_STAGEA(PG8_SA(1, 1), a1, 1);
            if constexpr (GATHER) { if (last && has_next) { S.goffs(nxt, tid, 0, g0, g1); S.goffs(nxt, tid, 1, g2, g3); } }
            PG8_WAIT_V(8); PG8_WAIT_L(0); PG8_BAR; PG8_MMA(0, 0, At, B0); PG8_MMA(0, 1, At, B1); PG8_BAR; PG8_SCHED;
            PG8_LDA(At, 0, 1); PG8_STAGEB(PG8_SB(0, 0), b2); PG8_STAGEB(PG8_SB(0, 1), b2 + hstep); PG8_STAGEA(PG8_SA(0, 0), a2, 0);
            PG8_WAIT_V(8); PG8_WAIT_L(0); PG8_BAR; PG8_MMA(1, 0, At, B0); PG8_MMA(1, 1, At, B1); PG8_BAR; PG8_SCHED;
            PG8_LDB(B0, 1, 0); PG8_LDB(B1, 1, 1); PG8_SCHED; PG8_LDA(At, 1, 0); PG8_STAGEA(PG8_SA(0, 1), a2, 1);
            PG8_WAIT_V(8); PG8_WAIT_L(0); PG8_BAR; PG8_MMA(0, 0, At, B0); PG8_MMA(0, 1, At, B1); PG8_BAR; PG8_SCHED;
            PG8_LDA(At, 1, 1); PG8_STAGEB(PG8_SB(1, 0), b3); PG8_STAGEB(PG8_SB(1, 1), b3 + hstep); PG8_STAGEA(PG8_SA(1, 0), a3, 0);
            PG8_WAIT_V(8); PG8_WAIT_L(0); PG8_BAR; PG8_MMA(1, 0, At, B0); PG8_MMA(1, 1, At, B1); PG8_BAR; PG8_SCHED;
        }
#ifdef PROBE_G
        if (pws && ui == 2) GSTAMP(pws, tid, pslot + 2);
#endif
        if (wr == 0) PG8_BAR;
        { int efr = fr, efq = fq; asm volatile("" : "+v"(efr), "+v"(efq));
          E(acc, cur, wr, wc, efr, efq); }
#ifdef PROBE_G
        if (pws && ui == 2) GSTAMP(pws, tid, pslot + 3);
        if (pws && ui == 3) GSTAMP(pws, tid, pslot + 4);
#endif
        if (!has_next) break;
#pragma unroll
        for (int a = 0; a < 2; ++a)
#pragma unroll
            for (int b = 0; b < 2; ++b)
#pragma unroll
                for (int m = 0; m < 4; ++m)
#pragma unroll
                    for (int n = 0; n < 2; ++n) acc[a][b][m][n] = (f32x4){0.f, 0.f, 0.f, 0.f};
        cur = nxt; cB = nB; cA = nA; ++ui;
        if (wr == 1) PG8_BAR;
    }
    PG8_WAIT_V(0);
    PG8_BAR;
#undef PG8_SA
#undef PG8_SB
#undef PG8_STAGEA
#undef PG8_STAGEB
#undef PG8_RD
#undef PG8_CAT
#undef PG8_LDA
#undef PG8_LDB
#undef PG8_MMA
#undef PG8_WAIT_V
#undef PG8_WAIT_L
#undef PG8_BAR
#undef PG8_SCHED
}
struct TileOrder {
    int nM, nN, nwg, G, c;
    __device__ __forceinline__ void init(int nM_, int nN_, int G_, int c_) { nM = nM_; nN = nN_; nwg = nM * nN; G = G_; c = c_; }
    __device__ __forceinline__ bool tile(int i, int& pm, int& pn) const {
        const long L = (long)i * G + c; if (L >= nwg) return false;
        int wgid = (int)L; { const int q = nwg / 8, r = nwg % 8, xcd = wgid % 8, off = wgid / 8; wgid = (xcd < r ? xcd * (q + 1) : r * (q + 1) + (xcd - r) * q) + off; }
        const int nig = 8 * nN, gid = wgid / nig, fm = gid * 8, gsz = (nM - fm) < 8 ? (nM - fm) : 8;
        pm = fm + ((wgid % nig) % gsz); pn = (wgid % nig) / gsz; return true;
    }
};
}

struct DenseSched {
    pg8::TileOrder o; const char* A; const char* Bt; int pitch;
    __device__ __forceinline__ bool next(int i, pg8::Unit& u) const { int pm, pn; if (!o.tile(i, pm, pn)) return false; u.i0 = pm; u.i1 = pn; u.i2 = 0; u.i3 = 0;
        u.a = A + (size_t)pm * 256 * pitch; u.b = Bt + (size_t)pn * 256 * pitch; return true; }
    __device__ __forceinline__ void goffs(const pg8::Unit&, int, int, unsigned&, unsigned&) const {}
};
struct EpiInProj {
    static constexpr bool PERM = true;
    bf16_t* PROJ;
    __device__ __forceinline__ void operator()(const f32x4 (&acc)[2][2][4][2], const pg8::Unit& u, int wr, int wc, int fr, int fq) const {
        const int row0 = u.i0 * 256 + wr * 64 + fr, col0 = u.i1 * 256 + wc * 32 + 8 * fq;
#pragma unroll
        for (int ai = 0; ai < 2; ++ai)
#pragma unroll
            for (int m = 0; m < 4; ++m) { bf16_t* rowp = PROJ + (size_t)(row0 + ai * 128 + m * 16) * NPROJ + col0;
#pragma unroll
                for (int bj = 0; bj < 2; ++bj) { const f32x4 v0 = acc[ai][bj][m][0], v1 = acc[ai][bj][m][1];
                    u32x4 w; w.x = pk2(v0[0], v0[1]); w.y = pk2(v0[2], v0[3]); w.z = pk2(v1[0], v1[1]); w.w = pk2(v1[2], v1[3]);
                    *(u32x4*)(rowp + bj * 128) = w; } }
    }
};
struct EpiOutProj {
    static constexpr bool PERM = true;
    const float* X; bf16_t* HB;
    __device__ __forceinline__ void operator()(const f32x4 (&acc)[2][2][4][2], const pg8::Unit& u, int wr, int wc, int fr, int fq) const {
        const int row0 = u.i0 * 256 + wr * 64 + fr, col0 = u.i1 * 256 + wc * 32 + 8 * fq;
#pragma unroll
        for (int ai = 0; ai < 2; ++ai)
#pragma unroll
            for (int m = 0; m < 4; ++m) { const size_t off = (size_t)(row0 + ai * 128 + m * 16) * D + col0;
#pragma unroll
                for (int bj = 0; bj < 2; ++bj) { const f32x4 x0 = *(const f32x4*)(X + off + bj * 128), x1 = *(const f32x4*)(X + off + bj * 128 + 4);
                    const f32x4 v0 = x0 + acc[ai][bj][m][0], v1 = x1 + acc[ai][bj][m][1];
                    u32x4 w; w.x = pk2(v0[0], v0[1]); w.y = pk2(v0[2], v0[3]); w.z = pk2(v1[0], v1[1]); w.w = pk2(v1[2], v1[3]);
                    *(u32x4*)(HB + off + bj * 128) = w; }
                asm volatile("" ::: "memory"); }
    }
};

constexpr int LDS_MOE_TAB = 131072;
template <bool GATHER, int NT  , int NROWS  >
struct MoeSched {
    const unsigned* cnt; const i32x4* ENT; const char* A; const char* Bt; LAS unsigned char* lds; int lo, hi, G, c, tot;
    __device__ __forceinline__ int cnt_s(int e) const { return __builtin_amdgcn_readfirstlane((int)cnt[e]); }
    __device__ __forceinline__ int tab(int i) const { return __builtin_amdgcn_readfirstlane(*(volatile LAS int*)(lds + LDS_MOE_TAB + 4 * i)); }
    __device__ __forceinline__ void init_tot(int tid) {
        if (tid == 0) { int t = 0; for (int e = lo; e < hi; ++e) { const int te = ((int)cnt[e] + 255) >> 8; *(volatile LAS int*)(lds + LDS_MOE_TAB + 4 * (e - lo)) = t; *(volatile LAS int*)(lds + LDS_MOE_TAB + 4 * (64 + e - lo)) = te; t += te; }
            *(volatile LAS int*)(lds + LDS_MOE_TAB + 4 * (hi - lo)) = t; }
        __syncthreads();
        tot = tab(hi - lo) * NT;
    }
    __device__ __forceinline__ bool next(int i, pg8::Unit& u) const {
        const int L = i * G + c; if (L >= tot) return false;
        int W; { const int q = tot / 8, r = tot % 8, xcd = L % 8, off = L / 8; W = (xcd < r ? xcd * (q + 1) : r * (q + 1) + (xcd - r) * q) + off; }
        int a = 0, b = hi - lo;
        while (b - a > 1) { const int m = (a + b) >> 1; if (tab(m) * NT <= W) a = m; else b = m; }
        const int pre = tab(a), te = tab(64 + a); W -= pre * NT;
        constexpr int nig = 8 * NT; const int gid = W / nig, fm = gid * 8, gsz = (te - fm) < 8 ? (te - fm) : 8; int j = W - gid * nig, n = 0;
        while (j >= gsz) { j -= gsz; ++n; }
        u.i0 = lo + a; u.i1 = fm + j; u.i2 = n; u.i3 = pre * 256;
        u.b = Bt + ((size_t)u.i0 * NROWS + (size_t)u.i2 * 256) * 1024; u.a = A + (size_t)(u.i3 + u.i1 * 256) * 1024;
        return true;
    }
    __device__ __forceinline__ void goffs(const pg8::Unit& u, int tid, int h, unsigned& o0, unsigned& o1) const {
        if constexpr (GATHER) { int R0, C0; pg8::stage_rc(tid * 16, R0, C0);
            const int ce = cnt_s(u.i0), p0 = u.i1 * 256 + h * 128 + R0; const i32x4* en = ENT + (size_t)u.i0 * T;
            const int t0 = p0 < ce ? en[p0].x : 0, t1 = p0 + 64 < ce ? en[p0 + 64].x : 0;
            o0 = (unsigned)t0 * 1024u + 2u * C0; o1 = (unsigned)t1 * 1024u + 2u * C0; }
    }
};
struct EpiG1 {
    static constexpr bool PERM = true;
    unsigned char* HID; const i32x4* ENT; const unsigned* cnt; const float* bgu;
    __device__ __forceinline__ void operator()(const f32x4 (&acc)[2][2][4][2], const pg8::Unit& u, int wr, int wc, int fr, int fq) const {
        const int e = u.i0, ce = __builtin_amdgcn_readfirstlane((int)cnt[e]), hc = u.i2 * 128 + wc * 32 + 8 * fq; const i32x4* en = ENT + (size_t)e * T;
        float rs[8];
#pragma unroll
        for (int q = 0; q < 8; ++q) { const int pos = u.i1 * 256 + (q >> 2) * 128 + wr * 64 + (q & 3) * 16 + fr; rs[q] = pos < ce ? __int_as_float(en[pos].y) * (1.0f / (SC_H * SC_W)) : 0.f; }
        const float* bg = bgu + (size_t)e * 2 * DFF + hc;
        const f32x4 bg0 = *(const f32x4*)bg, bg1 = *(const f32x4*)(bg + 4), bu0 = *(const f32x4*)(bg + DFF), bu1 = *(const f32x4*)(bg + DFF + 4);
#pragma unroll
        for (int ai = 0; ai < 2; ++ai)
#pragma unroll
            for (int m = 0; m < 4; ++m) { const int pos = u.i1 * 256 + ai * 128 + wr * 64 + m * 16 + fr;
                const float rstd = rs[ai * 4 + m];
                float hv[8];
#pragma unroll
                for (int q = 0; q < 8; ++q) { const int n = q >> 2, j = q & 3; float g = acc[ai][0][m][n][j] * rstd + (n ? bg1[j] : bg0[j]), up = acc[ai][1][m][n][j] * rstd + (n ? bu1[j] : bu0[j]);
                    g = fminf(g, 7.0f); up = fminf(fmaxf(up, -7.0f), 7.0f); hv[q] = (up + 1.0f) * g * sigmoidf_(1.702f * g) * SC_HID; }
                u32x2 w; w.x = pk4_fp8(hv[0], hv[1], hv[2], hv[3]); w.y = pk4_fp8(hv[4], hv[5], hv[6], hv[7]);
                *(u32x2*)(HID + (size_t)(u.i3 + pos) * DFF + hc) = w; }
    }
};
struct EpiG2 {
    static constexpr bool PERM = true;
    unsigned char* OUT01; unsigned char* Y23; const i32x4* ENT; const unsigned* cnt; const float* bdn;
    __device__ __forceinline__ void operator()(const f32x4 (&acc)[2][2][4][2], const pg8::Unit& u, int wr, int wc, int fr, int fq) const {
        const int e = u.i0, ce = __builtin_amdgcn_readfirstlane((int)cnt[e]), col0 = u.i2 * 256 + wc * 32 + 8 * fq; const i32x4* en = ENT + (size_t)e * T;
        int tk[8], kk[8]; float gt[8];
#pragma unroll
        for (int q = 0; q < 8; ++q) { const int pos = u.i1 * 256 + (q >> 2) * 128 + wr * 64 + (q & 3) * 16 + fr; const i32x4 v = pos < ce ? en[pos] : (i32x4){-1, 0, 0, 0}; tk[q] = v.x; kk[q] = v.z; gt[q] = __int_as_float(v.w) * SC_Y; }
        const float* bd = bdn + (size_t)e * D + col0;
        f32x4 b[2][2];
#pragma unroll
        for (int bj = 0; bj < 2; ++bj) { b[bj][0] = *(const f32x4*)(bd + bj * 128); b[bj][1] = *(const f32x4*)(bd + bj * 128 + 4); }
#pragma unroll
        for (int ai = 0; ai < 2; ++ai)
#pragma unroll
            for (int m = 0; m < 4; ++m) { const int q = ai * 4 + m;
                if (tk[q] >= 0) { const float gate = gt[q];
                    unsigned char* dst = (kk[q] < 2 ? OUT01 + (size_t)tk[q] * 4096 : Y23 + (size_t)tk[q] * 2048) + (kk[q] & 1) * 1024 + col0;
#pragma unroll
                    for (int bj = 0; bj < 2; ++bj) { const f32x4 y0 = (acc[ai][bj][m][0] * (1.0f / (SC_HID * SC_W)) + b[bj][0]) * gate, y1 = (acc[ai][bj][m][1] * (1.0f / (SC_HID * SC_W)) + b[bj][1]) * gate;
                        u32x2 w; w.x = pk4_fp8(clamp448(y0[0]), clamp448(y0[1]), clamp448(y0[2]), clamp448(y0[3])); w.y = pk4_fp8(clamp448(y1[0]), clamp448(y1[1]), clamp448(y1[2]), clamp448(y1[3]));
                        *(u32x2*)(dst + bj * 128) = w; } } }
    }
};

#define LDS_BARRIER() do { asm volatile("s_waitcnt lgkmcnt(0)" ::: "memory"); __builtin_amdgcn_s_barrier(); asm volatile("" ::: "memory"); } while (0)
constexpr int ML_QS = 0, ML_KS = 17408, ML_VS = 34816, ML_PS = 52224, ML_CT = 61440, ML_DENP = 96256, ML_DI = 96768, ML_SSQP = 97024, ML_NARR = 99072, ML_END = 99584;
__device__ __forceinline__ bf16x8 tr_pair(unsigned a0, unsigned a1) {
    u32x2 lo, hi; asm volatile("ds_read_b64_tr_b16 %0, %2\n\tds_read_b64_tr_b16 %1, %3\n\ts_waitcnt lgkmcnt(0)" : "=&v"(lo), "=&v"(hi) : "v"(a0), "v"(a1) : "memory");
    u32x4 r; r.x = lo.x; r.y = lo.y; r.z = hi.x; r.w = hi.y; return __builtin_bit_cast(bf16x8, r);
}
#define TR8(dst, base, OFF0, STEP) do { u32x2 _l[8], _h[8]; \
    asm volatile("ds_read_b64_tr_b16 %0, %16 offset:%17\n\tds_read_b64_tr_b16 %1, %16 offset:%17+1088\n\tds_read_b64_tr_b16 %2, %16 offset:%17+%18\n\tds_read_b64_tr_b16 %3, %16 offset:%17+%18+1088\n\t" \
                 "ds_read_b64_tr_b16 %4, %16 offset:%17+2*%18\n\tds_read_b64_tr_b16 %5, %16 offset:%17+2*%18+1088\n\tds_read_b64_tr_b16 %6, %16 offset:%17+3*%18\n\tds_read_b64_tr_b16 %7, %16 offset:%17+3*%18+1088\n\t" \
                 "ds_read_b64_tr_b16 %8, %16 offset:%17+4*%18\n\tds_read_b64_tr_b16 %9, %16 offset:%17+4*%18+1088\n\tds_read_b64_tr_b16 %10, %16 offset:%17+5*%18\n\tds_read_b64_tr_b16 %11, %16 offset:%17+5*%18+1088\n\t" \
                 "ds_read_b64_tr_b16 %12, %16 offset:%17+6*%18\n\tds_read_b64_tr_b16 %13, %16 offset:%17+6*%18+1088\n\tds_read_b64_tr_b16 %14, %16 offset:%17+7*%18\n\tds_read_b64_tr_b16 %15, %16 offset:%17+7*%18+1088\n\ts_waitcnt lgkmcnt(0)" \
                 : "=&v"(_l[0]), "=&v"(_h[0]), "=&v"(_l[1]), "=&v"(_h[1]), "=&v"(_l[2]), "=&v"(_h[2]), "=&v"(_l[3]), "=&v"(_h[3]), "=&v"(_l[4]), "=&v"(_h[4]), "=&v"(_l[5]), "=&v"(_h[5]), "=&v"(_l[6]), "=&v"(_h[6]), "=&v"(_l[7]), "=&v"(_h[7]) \
                 : "v"(base), "i"(OFF0), "i"(STEP) : "memory"); \
    _Pragma("unroll") for (int _p = 0; _p < 8; ++_p) { u32x4 _r; _r.x = _l[_p].x; _r.y = _l[_p].y; _r.z = _h[_p].x; _r.w = _h[_p].y; dst[_p] = __builtin_bit_cast(bf16x8, _r); } } while (0)
__device__ __forceinline__ float wave_scan_add(float s) {
    s += dpp_x<0x111, 0xf>(s, 0.f); s += dpp_x<0x112, 0xf>(s, 0.f); s += dpp_x<0x114, 0xf>(s, 0.f); s += dpp_x<0x118, 0xf>(s, 0.f);
    s += dpp_x<0x142, 0xa>(s, 0.f); s += dpp_x<0x143, 0xc>(s, 0.f); return s;
}
__device__ __forceinline__ float wave_scan_max(float s) {
    const float ni = -INFINITY;
    s = fmaxf(s, dpp_x<0x111, 0xf>(s, ni)); s = fmaxf(s, dpp_x<0x112, 0xf>(s, ni)); s = fmaxf(s, dpp_x<0x114, 0xf>(s, ni)); s = fmaxf(s, dpp_x<0x118, 0xf>(s, ni));
    s = fmaxf(s, dpp_x<0x142, 0xa>(s, ni)); s = fmaxf(s, dpp_x<0x143, 0xc>(s, ni)); return s;
}
__device__ __forceinline__ void unpack16(const u32x4& a, const u32x4& b, float (&f)[16]) {
    const unsigned w[8] = {a.x, a.y, a.z, a.w, b.x, b.y, b.z, b.w};
#pragma unroll
    for (int i = 0; i < 8; ++i) { f[2 * i] = bflo(w[i]); f[2 * i + 1] = bfhi(w[i]); }
}
__device__ __forceinline__ void mlstm_phase(const PV& p, LAS unsigned char* lds, int bh) {
    const int tid = get_tid(lds);
    const int lane = tid & 63, w = __builtin_amdgcn_readfirstlane(tid >> 6), fr = lane & 15, fq = lane >> 4, tq = (lane & 15) >> 2, tp = lane & 3;
    const int b = bh >> 2, h = bh & 3, srow = tid >> 3, sseg = tid & 7;
    const bf16_t* PROJ = (const bf16_t*)(p.ws() + WS_R2); const float* GATES = (const float*)(p.ws() + WS_GATES); bf16_t* MIX = (bf16_t*)(p.ws() + WS_R1);
    LAS float* DENP = (LAS float*)(lds + ML_DENP); LAS float* DI = (LAS float*)(lds + ML_DI); LAS float* SSQP = (LAS float*)(lds + ML_SSQP); LAS float* NARR = (LAS float*)(lds + ML_NARR);
    const unsigned ldsb = (unsigned)(size_t)lds;
    for (int i = tid; i < 34816 / 16; i += 512) *(LAS u32x4*)(lds + ML_CT + 16 * i) = (u32x4){0u, 0u, 0u, 0u};
    if (tid < 128) NARR[tid] = 0.f;
    f32x4 c3[8];
#pragma unroll
    for (int i = 0; i < 8; ++i) c3[i] = (f32x4){0.f, 0.f, 0.f, 0.f};
    f32x4 nacc = (f32x4){0.f, 0.f, 0.f, 0.f}; float mprev = 0.f;
    bf16x8 ones;
#pragma unroll
    for (int jj = 0; jj < 8; ++jj) ones[jj] = (short)0x3F80;
    float ig = GATES[((size_t)b * SEQ + lane) * 8 + h], lf = GATES[((size_t)b * SEQ + lane) * 8 + 4 + h];
    u32x4 rq0, rq1, rk0, rk1, rv0, rv1;
    u32x2 pend[4]; size_t prow0 = 0; bool have_pend = false;
    { const bf16_t* pr = PROJ + ((size_t)b * SEQ + srow) * NPROJ + h * 128 + 16 * sseg;
      rq0 = *(const u32x4*)pr; rq1 = *(const u32x4*)(pr + 8); rk0 = *(const u32x4*)(pr + 512); rk1 = *(const u32x4*)(pr + 520); rv0 = *(const u32x4*)(pr + 1024); rv1 = *(const u32x4*)(pr + 1032); }
    __syncthreads();
    for (int c = 0; c < SEQ / 64; ++c) {
        const size_t row0 = (size_t)b * SEQ + (size_t)c * 64;
        if (c == 10) GSTAMP(p.ws(), tid, 20);
        u32x2 og[4];
#pragma unroll
        for (int ti = 0; ti < 4; ++ti) og[ti] = *(const u32x2*)(PROJ + (row0 + 16 * ti + fr) * NPROJ + 1536 + h * 128 + 16 * w + 4 * fq);
        const float bc = wave_scan_add(lf), u = ig - bc, cm = wave_scan_max(u);
        const float Mt = fmaxf(cm, mprev), M63 = __builtin_bit_cast(float, __builtin_amdgcn_readlane(__builtin_bit_cast(int, Mt), 63)), bL = __builtin_bit_cast(float, __builtin_amdgcn_readlane(__builtin_bit_cast(int, bc), 63));
        if (c + 1 < SEQ / 64) { ig = GATES[(row0 + 64 + lane) * 8 + h]; lf = GATES[(row0 + 64 + lane) * 8 + 4 + h]; }
        const float sq = fexp(M63 - Mt), sk = fexp(u - M63), fl = fexp(-bc - Mt), decay = fexp(mprev - M63);
        mprev = bL + M63;
        { const float sqv = __shfl(sq, srow), skv = __shfl(sk, srow);
          float f[16]; unpack16(rq0, rq1, f);
          float part = 0.f;
#pragma unroll
          for (int j = 0; j < 16; ++j) { f[j] *= sqv; part += f[j] * NARR[16 * sseg + j]; }
          part += __shfl_xor(part, 1); part += __shfl_xor(part, 2); part += __shfl_xor(part, 4);
          if (sseg == 0) DI[srow] = decay * part;
          u32x4 o0, o1; o0.x = pk2(f[0], f[1]); o0.y = pk2(f[2], f[3]); o0.z = pk2(f[4], f[5]); o0.w = pk2(f[6], f[7]); o1.x = pk2(f[8], f[9]); o1.y = pk2(f[10], f[11]); o1.z = pk2(f[12], f[13]); o1.w = pk2(f[14], f[15]);
          *(LAS u32x4*)(lds + ML_QS + srow * 272 + sseg * 32) = o0; *(LAS u32x4*)(lds + ML_QS + srow * 272 + sseg * 32 + 16) = o1;
          unpack16(rk0, rk1, f);
#pragma unroll
          for (int j = 0; j < 16; ++j) f[j] *= skv;
          o0.x = pk2(f[0], f[1]); o0.y = pk2(f[2], f[3]); o0.z = pk2(f[4], f[5]); o0.w = pk2(f[6], f[7]); o1.x = pk2(f[8], f[9]); o1.y = pk2(f[10], f[11]); o1.z = pk2(f[12], f[13]); o1.w = pk2(f[14], f[15]);
          *(LAS u32x4*)(lds + ML_KS + srow * 272 + sseg * 32) = o0; *(LAS u32x4*)(lds + ML_KS + srow * 272 + sseg * 32 + 16) = o1;
          *(LAS u32x4*)(lds + ML_VS + srow * 272 + sseg * 32) = rv0; *(LAS u32x4*)(lds + ML_VS + srow * 272 + sseg * 32 + 16) = rv1; }
        if (c + 1 < SEQ / 64) { const bf16_t* pr = PROJ + (row0 + 64 + srow) * NPROJ + h * 128 + 16 * sseg;
          rq0 = *(const u32x4*)pr; rq1 = *(const u32x4*)(pr + 8); rk0 = *(const u32x4*)(pr + 512); rk1 = *(const u32x4*)(pr + 520); rv0 = *(const u32x4*)(pr + 1024); rv1 = *(const u32x4*)(pr + 1032); }
        if (c == 10) GSTAMP(p.ws(), tid, 21);
        LDS_BARRIER();
        if (have_pend) {
#pragma unroll
            for (int ti = 0; ti < 4; ++ti) *(u32x2*)(MIX + (prow0 + 16 * ti + fr) * D + h * 128 + 16 * w + 4 * fq) = pend[ti]; }
        if (c == 10) GSTAMP(p.ws(), tid, 22);
        { const int ti = w >> 1; float dsum = 0.f;
#pragma unroll
          for (int jj = 0; jj < 2; ++jj) { const int sj = 2 * (w & 1) + jj;
            f32x4 a = (f32x4){0.f, 0.f, 0.f, 0.f};
            if (sj <= ti) {
#pragma unroll
                for (int ks = 0; ks < 4; ++ks) { const bf16x8 ka = *(const LAS bf16x8*)(lds + ML_KS + (16 * sj + fr) * 272 + (32 * ks + 8 * fq) * 2), qb = *(const LAS bf16x8*)(lds + ML_QS + (16 * ti + fr) * 272 + (32 * ks + 8 * fq) * 2);
                    a = __builtin_amdgcn_mfma_f32_16x16x32_bf16(ka, qb, a, 0, 0, 0); }
                const int t = 16 * ti + fr, s0 = 16 * sj + 4 * fq;
#pragma unroll
                for (int r = 0; r < 4; ++r) { if (s0 + r > t) a[r] = 0.f; dsum += a[r]; }
            }
            u32x2 pw; pw.x = pk2(a[0], a[1]); pw.y = pk2(a[2], a[3]);
            *(LAS u32x2*)(lds + ML_PS + (16 * ti + fr) * 144 + (16 * sj + 4 * fq) * 2) = pw; }
          dsum += __shfl_xor(dsum, 16); dsum += __shfl_xor(dsum, 32);
          if (fq == 0) DENP[(w & 1) * 64 + 16 * ti + fr] = dsum; }
        if (c == 10) GSTAMP(p.ws(), tid, 23);
        LDS_BARRIER();
        if (c == 10) GSTAMP(p.ws(), tid, 24);
        bf16x8 av[2];
        { u32x2 l0, h0, l1, h1; const unsigned a0 = ldsb + ML_VS + (8 * fq + tq) * 272 + (16 * w + 4 * tp) * 2;
          asm volatile("ds_read_b64_tr_b16 %0, %4\n\tds_read_b64_tr_b16 %1, %4 offset:1088\n\tds_read_b64_tr_b16 %2, %4 offset:8704\n\tds_read_b64_tr_b16 %3, %4 offset:9792\n\ts_waitcnt lgkmcnt(0)"
                       : "=&v"(l0), "=&v"(h0), "=&v"(l1), "=&v"(h1) : "v"(a0) : "memory");
          u32x4 r; r.x = l0.x; r.y = l0.y; r.z = h0.x; r.w = h0.y; av[0] = __builtin_bit_cast(bf16x8, r); r.x = l1.x; r.y = l1.y; r.z = h1.x; r.w = h1.y; av[1] = __builtin_bit_cast(bf16x8, r); }
        bf16x8 ac[4];
#pragma unroll
        for (int ks = 0; ks < 4; ++ks) ac[ks] = *(const LAS bf16x8*)(lds + ML_CT + (16 * w + fr) * 272 + (32 * ks + 8 * fq) * 2);
        float xs[4][4];
#pragma unroll
        for (int ti = 0; ti < 4; ++ti) { f32x4 a = (f32x4){0.f, 0.f, 0.f, 0.f}, a2 = (f32x4){0.f, 0.f, 0.f, 0.f};
#pragma unroll
            for (int ks = 0; ks < 2; ++ks) { const bf16x8 pb = *(const LAS bf16x8*)(lds + ML_PS + (16 * ti + fr) * 144 + (32 * ks + 8 * fq) * 2); a = __builtin_amdgcn_mfma_f32_16x16x32_bf16(av[ks], pb, a, 0, 0, 0); }
#pragma unroll
            for (int ks = 0; ks < 4; ++ks) { const bf16x8 qb = *(const LAS bf16x8*)(lds + ML_QS + (16 * ti + fr) * 272 + (32 * ks + 8 * fq) * 2); a2 = __builtin_amdgcn_mfma_f32_16x16x32_bf16(ac[ks], qb, a2, 0, 0, 0); }
            a = a + a2 * decay;
            const int t = 16 * ti + fr; const float den = DENP[t] + DENP[64 + t] + DI[t], flt = __shfl(fl, t), inv = frcp(fmaxf(fabsf(den), flt));
            xs[ti][0] = sigmoidf_(bflo(og[ti].x)) * a[0] * inv; xs[ti][1] = sigmoidf_(bfhi(og[ti].x)) * a[1] * inv; xs[ti][2] = sigmoidf_(bflo(og[ti].y)) * a[2] * inv; xs[ti][3] = sigmoidf_(bfhi(og[ti].y)) * a[3] * inv;
            float ss = xs[ti][0] * xs[ti][0] + xs[ti][1] * xs[ti][1] + xs[ti][2] * xs[ti][2] + xs[ti][3] * xs[ti][3];
            ss += __shfl_xor(ss, 16); ss += __shfl_xor(ss, 32);
            if (fq == 0) SSQP[w * 64 + t] = ss; }
        { const unsigned kb = ldsb + ML_KS + (8 * fq + tq) * 272 + 4 * tp * 2;
          bf16x8 k0[8], k1[8];
          TR8(k0, kb, 0, 32); TR8(k1, kb, 8704, 32);
#pragma unroll
          for (int i = 0; i < 8; ++i) { c3[i] = c3[i] * decay;
              c3[i] = __builtin_amdgcn_mfma_f32_16x16x32_bf16(k0[i], av[0], c3[i], 0, 0, 0); c3[i] = __builtin_amdgcn_mfma_f32_16x16x32_bf16(k1[i], av[1], c3[i], 0, 0, 0);
              if (i == w) { nacc = nacc * decay; nacc = __builtin_amdgcn_mfma_f32_16x16x32_bf16(k0[i], ones, nacc, 0, 0, 0); nacc = __builtin_amdgcn_mfma_f32_16x16x32_bf16(k1[i], ones, nacc, 0, 0, 0); } }
          if (fr == 0) *(LAS f32x4*)(NARR + 16 * w + 4 * fq) = nacc; }
        if (c == 10) GSTAMP(p.ws(), tid, 25);
        LDS_BARRIER();
        if (c == 10) GSTAMP(p.ws(), tid, 26);
        if (c == 11) GSTAMP(p.ws(), tid, 27);
#pragma unroll
        for (int ti = 0; ti < 4; ++ti) { const int t = 16 * ti + fr; float s = 0.f;
#pragma unroll
            for (int ww = 0; ww < 8; ++ww) s += SSQP[ww * 64 + t];
            const float rs = frsq(s * (1.0f / 128.f) + EPS);
            pend[ti].x = pk2(xs[ti][0] * rs, xs[ti][1] * rs); pend[ti].y = pk2(xs[ti][2] * rs, xs[ti][3] * rs); }
        prow0 = row0; have_pend = true;
#pragma unroll
        for (int i = 0; i < 8; ++i) { u32x2 cw; cw.x = pk2(c3[i][0], c3[i][1]); cw.y = pk2(c3[i][2], c3[i][3]);
            *(LAS u32x2*)(lds + ML_CT + (16 * w + fr) * 272 + (16 * i + 4 * fq) * 2) = cw; }
    }
#pragma unroll
    for (int ti = 0; ti < 4; ++ti) *(u32x2*)(MIX + (prow0 + 16 * ti + fr) * D + h * 128 + 16 * w + 4 * fq) = pend[ti];
    __syncthreads();
}


constexpr int RL_XC = 0, RL_RG = 34816, RL_OUT = 69632, RL_CW = 104448, RL_CARRY = 114688, RL_SSQP = 116736, RL_END = 124928;
template <int S> __device__ __forceinline__ float dpp_shr(float v, float ident) {
    return __builtin_bit_cast(float, __builtin_amdgcn_update_dpp(__builtin_bit_cast(int, ident), __builtin_bit_cast(int, v), 0x110 + S, 0xf, 0xf, false));
}
__device__ __forceinline__ float row_last(float v) { return __builtin_bit_cast(float, __builtin_amdgcn_ds_swizzle(__builtin_bit_cast(int, v), 0x1F0)); }
template <bool FINAL>
__device__ __forceinline__ void rglru_item(const PV& p, LAS unsigned char* lds, int item) {
    const int tid = get_tid(lds);
    const int lane = tid & 63, w = __builtin_amdgcn_readfirstlane(tid >> 6), fr = lane & 15, fq = lane >> 4, srow = tid >> 3, sseg = tid & 7;
    const int b = item >> 4, chunk = item & 15;
    const bf16_t* PROJ = (const bf16_t*)(p.ws() + WS_R2); bf16_t* MIX = (bf16_t*)(p.ws() + WS_R1); float* SUMM = (float*)(p.ws() + WS_SUMM); const bf16_t* WRI = (const bf16_t*)(p.ws() + WS_WRI);
    LAS float* CW = (LAS float*)(lds + RL_CW); LAS float* CARRY = (LAS float*)(lds + RL_CARRY); LAS float* SSQP = (LAS float*)(lds + RL_SSQP);
    const size_t tok0 = (size_t)b * SEQ + (size_t)chunk * 256;
    if (FINAL) GSTAMP(p.ws(), tid, 0);
    for (int i = tid; i < 2560; i += 512) CW[i] = i < 2048 ? p.in(I_CW)[i] : p.in(I_CB)[i - 2048];
    if (FINAL) {
        float carry = 0.f;
        for (int cc = 0; cc < chunk; ++cc) { const float2 ab = *(const float2*)(SUMM + ((size_t)(b * 16 + cc) * 512 + tid) * 2); carry = ab.x * carry + ab.y; }
        CARRY[tid] = carry;
        for (int i = tid; i < 2048; i += 512) SSQP[i] = 0.f;
    }
    u32x4 rx[8], rgr[2];
    auto prefetch = [&](int sidx) {
        const int hd = sidx >> 2, step = sidx & 3; const int tl = step * 64 + srow; const size_t tok = tok0 + tl; const int tseq = chunk * 256 + tl;
        const bf16_t* px = PROJ + tok * NPROJ + 2048 + hd * 128 + 16 * sseg;
#pragma unroll
        for (int j = 0; j < 4; ++j) { if (tseq - 3 + j >= 0) { rx[2 * j] = *(const u32x4*)(px + (ptrdiff_t)(j - 3) * NPROJ); rx[2 * j + 1] = *(const u32x4*)(px + (ptrdiff_t)(j - 3) * NPROJ + 8); } else { rx[2 * j] = (u32x4){0u, 0u, 0u, 0u}; rx[2 * j + 1] = (u32x4){0u, 0u, 0u, 0u}; } }
        if (FINAL) { rgr[0] = *(const u32x4*)(px + 512); rgr[1] = *(const u32x4*)(px + 520); }
    };
    prefetch(0);
    __syncthreads();
    if (FINAL) GSTAMP(p.ws(), tid, 1);
    float hc[4], ptot[4], brv[4], biv[4], spv[4];
    bf16x8 br[4], bi[4], bid;
    for (int sidx = 0; sidx < 16; ++sidx) {
        const int hd = sidx >> 2, step = sidx & 3, buf = sidx & 1;
        if (step == 0) {
#pragma unroll
            for (int ks = 0; ks < 4; ++ks) { br[ks] = *(const bf16x8*)(WRI + ((size_t)(hd * 256 + 16 * w + fr) * 128 + 32 * ks + 8 * fq)); bi[ks] = *(const bf16x8*)(WRI + ((size_t)(hd * 256 + 128 + 16 * w + fr) * 128 + 32 * ks + 8 * fq)); }
#pragma unroll
            for (int jj = 0; jj < 8; ++jj) bid[jj] = (8 * fq + jj == 16 * (w & 1) + fr) ? (short)0x3F80 : (short)0;
#pragma unroll
            for (int r = 0; r < 4; ++r) { const int ch = hd * 128 + 16 * w + 4 * fq + r; brv[r] = p.in(I_BR)[ch]; biv[r] = p.in(I_BI)[ch]; spv[r] = log1pf(fexp(-p.in(I_LAM)[ch]));
                hc[r] = FINAL ? CARRY[ch] : 0.f; ptot[r] = 1.f; }
        }
        { float xc[16];
          const LAS f32x4* cb4 = (const LAS f32x4*)(CW + 2048 + hd * 128 + 16 * sseg);
#pragma unroll
          for (int q = 0; q < 4; ++q) { const f32x4 v = cb4[q]; xc[4 * q] = v.x; xc[4 * q + 1] = v.y; xc[4 * q + 2] = v.z; xc[4 * q + 3] = v.w; }
#pragma unroll
          for (int j = 0; j < 4; ++j) { float xf[16]; unpack16(rx[2 * j], rx[2 * j + 1], xf); const LAS f32x4* cw4 = (const LAS f32x4*)(CW + j * 512 + hd * 128 + 16 * sseg);
#pragma unroll
              for (int q = 0; q < 4; ++q) { const f32x4 v = cw4[q]; xc[4 * q] += v.x * xf[4 * q]; xc[4 * q + 1] += v.y * xf[4 * q + 1]; xc[4 * q + 2] += v.z * xf[4 * q + 2]; xc[4 * q + 3] += v.w * xf[4 * q + 3]; } }
          u32x4 o0, o1; o0.x = pk2(xc[0], xc[1]); o0.y = pk2(xc[2], xc[3]); o0.z = pk2(xc[4], xc[5]); o0.w = pk2(xc[6], xc[7]); o1.x = pk2(xc[8], xc[9]); o1.y = pk2(xc[10], xc[11]); o1.z = pk2(xc[12], xc[13]); o1.w = pk2(xc[14], xc[15]);
          *(LAS u32x4*)(lds + RL_XC + buf * 17408 + srow * 272 + sseg * 32) = o0; *(LAS u32x4*)(lds + RL_XC + buf * 17408 + srow * 272 + sseg * 32 + 16) = o1;
          if (FINAL) { *(LAS u32x4*)(lds + RL_RG + buf * 17408 + srow * 272 + sseg * 32) = rgr[0]; *(LAS u32x4*)(lds + RL_RG + buf * 17408 + srow * 272 + sseg * 32 + 16) = rgr[1]; } }
        if (sidx + 1 < 16) prefetch(sidx + 1);
        LDS_BARRIER();
        if (FINAL && sidx > 0) { const int ps = sidx - 1, phd = ps >> 2, pstep = ps & 3, pbuf = ps & 1;
            const u32x4 v0 = *(const LAS u32x4*)(lds + RL_OUT + pbuf * 17408 + srow * 272 + sseg * 32), v1 = *(const LAS u32x4*)(lds + RL_OUT + pbuf * 17408 + srow * 272 + sseg * 32 + 16);
            bf16_t* dst = MIX + (tok0 + pstep * 64 + srow) * D + 512 + phd * 128 + 16 * sseg; *(u32x4*)dst = v0; *(u32x4*)(dst + 8) = v1; }
        const int ksx = w >> 1;
#pragma unroll
        for (int m = 0; m < 4; ++m) {
            f32x4 ar = (f32x4){0.f, 0.f, 0.f, 0.f}, ai = ar, ax = ar, ag = ar;
#pragma unroll
            for (int ks = 0; ks < 4; ++ks) { const bf16x8 a = *(const LAS bf16x8*)(lds + RL_XC + buf * 17408 + (16 * m + fr) * 272 + (32 * ks + 8 * fq) * 2);
                ar = __builtin_amdgcn_mfma_f32_16x16x32_bf16(br[ks], a, ar, 0, 0, 0); ai = __builtin_amdgcn_mfma_f32_16x16x32_bf16(bi[ks], a, ai, 0, 0, 0); }
            { const bf16x8 a = *(const LAS bf16x8*)(lds + RL_XC + buf * 17408 + (16 * m + fr) * 272 + (32 * ksx + 8 * fq) * 2); ax = __builtin_amdgcn_mfma_f32_16x16x32_bf16(bid, a, ax, 0, 0, 0); }
            if (FINAL) { const bf16x8 a = *(const LAS bf16x8*)(lds + RL_RG + buf * 17408 + (16 * m + fr) * 272 + (32 * ksx + 8 * fq) * 2); ag = __builtin_amdgcn_mfma_f32_16x16x32_bf16(bid, a, ag, 0, 0, 0); }
            float P[4], H[4];
#pragma unroll
            for (int r = 0; r < 4; ++r) { const float rr = sigmoidf_(ar[r] + brv[r]), ii = sigmoidf_(ai[r] + biv[r]), a = fexp(-8.0f * rr * spv[r]);
                P[r] = a; H[r] = fsqrt(fmaxf(1.0f - a * a, 0.f)) * (ii * ax[r]); }
#pragma unroll
            for (int r = 0; r < 4; ++r) { { const float Pp = dpp_shr<1>(P[r], 1.f), Hp = dpp_shr<1>(H[r], 0.f); H[r] = P[r] * Hp + H[r]; P[r] = P[r] * Pp; }
                { const float Pp = dpp_shr<2>(P[r], 1.f), Hp = dpp_shr<2>(H[r], 0.f); H[r] = P[r] * Hp + H[r]; P[r] = P[r] * Pp; }
                { const float Pp = dpp_shr<4>(P[r], 1.f), Hp = dpp_shr<4>(H[r], 0.f); H[r] = P[r] * Hp + H[r]; P[r] = P[r] * Pp; }
                { const float Pp = dpp_shr<8>(P[r], 1.f), Hp = dpp_shr<8>(H[r], 0.f); H[r] = P[r] * Hp + H[r]; P[r] = P[r] * Pp; } }
            float gq[4]; float ss = 0.f;
#pragma unroll
            for (int r = 0; r < 4; ++r) { const float hv = H[r] + P[r] * hc[r];
                if (FINAL) { gq[r] = gelu_tanh(ag[r]) * hv; ss += gq[r] * gq[r]; } else ptot[r] *= row_last(P[r]);
                hc[r] = row_last(hv); }
            if (FINAL) {
                u32x2 ow; ow.x = pk2(gq[0], gq[1]); ow.y = pk2(gq[2], gq[3]);
                *(LAS u32x2*)(lds + RL_OUT + buf * 17408 + (16 * m + fr) * 272 + (16 * w + 4 * fq) * 2) = ow;
                ss += __shfl_xor(ss, 16); ss += __shfl_xor(ss, 32);
                if (fq == 0) SSQP[w * 256 + step * 64 + 16 * m + fr] += ss;
            }
        }
        if (!FINAL && step == 3 && fr == 0) {
#pragma unroll
            for (int r = 0; r < 4; ++r) *(float2*)(SUMM + ((size_t)(b * 16 + chunk) * 512 + hd * 128 + 16 * w + 4 * fq + r) * 2) = make_float2(ptot[r], hc[r]); }
    }
    if (FINAL) {
        __syncthreads();
        GSTAMP(p.ws(), tid, 2);
        { const int ps = 15, phd = 3, pstep = 3, pbuf = ps & 1;
          const u32x4 v0 = *(const LAS u32x4*)(lds + RL_OUT + pbuf * 17408 + srow * 272 + sseg * 32), v1 = *(const LAS u32x4*)(lds + RL_OUT + pbuf * 17408 + srow * 272 + sseg * 32 + 16);
          bf16_t* dst = MIX + (tok0 + pstep * 64 + srow) * D + 512 + phd * 128 + 16 * sseg; *(u32x4*)dst = v0; *(u32x4*)(dst + 8) = v1; }
        asm volatile("s_waitcnt vmcnt(0)" ::: "memory");
        __syncthreads();
        for (int i = tid; i < 256 * 64; i += 512) { const int tl = i >> 6, c8 = i & 63; float s = 0.f;
#pragma unroll
            for (int ww = 0; ww < 8; ++ww) s += SSQP[ww * 256 + tl];
            const float rs = frsq(s * (1.0f / 512.f) + EPS);
            u32x4* ptr = (u32x4*)(MIX + (tok0 + tl) * D + 512 + c8 * 8); u32x4 v = *ptr;
            v.x = pk2(bflo(v.x) * rs, bfhi(v.x) * rs); v.y = pk2(bflo(v.y) * rs, bfhi(v.y) * rs); v.z = pk2(bflo(v.z) * rs, bfhi(v.z) * rs); v.w = pk2(bflo(v.w) * rs, bfhi(v.w) * rs);
            *ptr = v; }
    }
    __syncthreads();
    if (FINAL) GSTAMP(p.ws(), tid, 3);
}

constexpr int RT_WH = 0, RT_WL = 66048, RT_SELE = 132096, RT_SELG = RT_SELE + 4096, RT_RSTD = RT_SELG + 4096, RT_HIST = RT_RSTD + 1024, RT_BASE = RT_HIST + 128, RT_LDS = RT_BASE + 128;
template <int N> __device__ __forceinline__ float row_ror_f(float v) { return __builtin_bit_cast(float, __builtin_amdgcn_update_dpp(0, __builtin_bit_cast(int, v), 0x120 + N, 0xf, 0xf, false)); }
template <int N> __device__ __forceinline__ int row_ror_i(int v) { return __builtin_amdgcn_update_dpp(0, v, 0x120 + N, 0xf, 0xf, false); }
__device__ __forceinline__ float row_max16(float v) { v = fmaxf(v, row_ror_f<8>(v)); v = fmaxf(v, row_ror_f<4>(v)); v = fmaxf(v, row_ror_f<2>(v)); v = fmaxf(v, row_ror_f<1>(v)); return v; }
__device__ __forceinline__ int row_min16(int v) { v = min(v, row_ror_i<8>(v)); v = min(v, row_ror_i<4>(v)); v = min(v, row_ror_i<2>(v)); v = min(v, row_ror_i<1>(v)); return v; }
__device__ __forceinline__ void routing_block(const PV& p, LAS unsigned char* lds, int tb) {
    const int tid = get_tid(lds), lane = tid & 63, wave = __builtin_amdgcn_readfirstlane(tid >> 6), fr = lane & 15, fq = lane >> 4;
    LAS int* selE = (LAS int*)(lds + RT_SELE); LAS float* selG = (LAS float*)(lds + RT_SELG);
    LAS float* rstds = (LAS float*)(lds + RT_RSTD); LAS int* hist = (LAS int*)(lds + RT_HIST); LAS int* base = (LAS int*)(lds + RT_BASE);
    { const u32x4* src = (const u32x4*)(p.ws() + WS_WRT);
      for (int i = tid; i < 2 * 32 * 128; i += 512) { const int hl = i >> 12, e = (i >> 7) & 31, c = i & 127; *(LAS u32x4*)(lds + (hl ? RT_WL : RT_WH) + e * 2064 + c * 16) = src[i]; } }
    if (tid < 32) hist[tid] = 0;
    __syncthreads();
    const bf16_t* HB = (const bf16_t*)(p.ws() + WS_HB); unsigned char* HB8 = (unsigned char*)(p.ws() + WS_HB8);
    const size_t tok0 = (size_t)tb * 256 + 32 * wave;
    f32x4 acc[2][2];
#pragma unroll
    for (int m = 0; m < 2; ++m)
#pragma unroll
        for (int hf = 0; hf < 2; ++hf) acc[m][hf] = (f32x4){0.f, 0.f, 0.f, 0.f};
    float ss[2] = {0.f, 0.f};
#pragma unroll 4
    for (int ks = 0; ks < 32; ++ks) {
        bf16x8 ah[2];
#pragma unroll
        for (int m = 0; m < 2; ++m) { const size_t off = (tok0 + 16 * m + fr) * D + 32 * ks + 8 * fq;
            const u32x4 hv = *(const u32x4*)(HB + off);
            const float x0 = bflo(hv.x), x1 = bfhi(hv.x), x2 = bflo(hv.y), x3 = bfhi(hv.y), x4 = bflo(hv.z), x5 = bfhi(hv.z), x6 = bflo(hv.w), x7 = bfhi(hv.w);
            ss[m] += (x0 * x0 + x1 * x1) + (x2 * x2 + x3 * x3) + (x4 * x4 + x5 * x5) + (x6 * x6 + x7 * x7);
            ah[m] = __builtin_bit_cast(bf16x8, hv);
            u32x2 f8; f8.x = pk4_fp8(clamp448(x0 * SC_H), clamp448(x1 * SC_H), clamp448(x2 * SC_H), clamp448(x3 * SC_H)); f8.y = pk4_fp8(clamp448(x4 * SC_H), clamp448(x5 * SC_H), clamp448(x6 * SC_H), clamp448(x7 * SC_H));
            *(u32x2*)(HB8 + off) = f8; }
#pragma unroll
        for (int hf = 0; hf < 2; ++hf) { const bf16x8 bh = *(const LAS bf16x8*)(lds + RT_WH + (16 * hf + fr) * 2064 + (32 * ks + 8 * fq) * 2), bl = *(const LAS bf16x8*)(lds + RT_WL + (16 * hf + fr) * 2064 + (32 * ks + 8 * fq) * 2);
#pragma unroll
            for (int m = 0; m < 2; ++m) { acc[m][hf] = __builtin_amdgcn_mfma_f32_16x16x32_bf16(ah[m], bh, acc[m][hf], 0, 0, 0); acc[m][hf] = __builtin_amdgcn_mfma_f32_16x16x32_bf16(ah[m], bl, acc[m][hf], 0, 0, 0); } }
    }
#pragma unroll
    for (int m = 0; m < 2; ++m) { float s = ss[m]; s += __shfl_xor(s, 16); s += __shfl_xor(s, 32); if (fq == 0) rstds[32 * wave + 16 * m + fr] = frsq(s * (1.0f / D) + EPS); }
    const float rb0 = p.in(I_RB)[fr], rb1 = p.in(I_RB)[16 + fr];
#pragma unroll
    for (int m = 0; m < 2; ++m)
#pragma unroll
        for (int r = 0; r < 4; ++r) { const int tl = 32 * wave + 16 * m + 4 * fq + r; const float rstd = rstds[tl];
            float l0 = acc[m][0][r] * rstd + rb0, l1 = acc[m][1][r] * rstd + rb1;
            float tv[4]; int te[4];
#pragma unroll
            for (int k = 0; k < 4; ++k) { const float mx = row_max16(fmaxf(l0, l1));
                const int cand = l0 == mx ? fr : (l1 == mx ? 16 + fr : 99), sel = row_min16(cand);
                tv[k] = mx; te[k] = sel; if (sel == fr) l0 = -INFINITY; if (sel == 16 + fr) l1 = -INFINITY; }
            const float e1 = fexp(tv[1] - tv[0]), e2 = fexp(tv[2] - tv[0]), e3 = fexp(tv[3] - tv[0]), inv = 1.0f / (1.0f + e1 + e2 + e3);
            if (fr < 4) { const int ee = fr == 0 ? te[0] : fr == 1 ? te[1] : fr == 2 ? te[2] : te[3]; const float gg = (fr == 0 ? 1.0f : fr == 1 ? e1 : fr == 2 ? e2 : e3) * inv;
                selE[tl * 4 + fr] = ee; selG[tl * 4 + fr] = gg; } }
    __syncthreads();
    int myrank[2], mye[2];
#pragma unroll
    for (int q = 0; q < 2; ++q) { const int a = tid + 512 * q; mye[q] = selE[a]; myrank[q] = atomicAdd((int*)(hist + mye[q]), 1); }
    __syncthreads();
    unsigned* ctl = (unsigned*)(p.ws() + WS_CTL);
    if (tid < 32) base[tid] = (int)atomicAdd(ctl + CW_CNT + tid, (unsigned)hist[tid]);
    __syncthreads();
    i32x4* ENT = (i32x4*)(p.ws() + WS_ENT);
#pragma unroll
    for (int q = 0; q < 2; ++q) { const int a = tid + 512 * q, tl = a >> 2, k = a & 3; const int pos = base[mye[q]] + myrank[q];
        i32x4 en; en.x = tb * 256 + tl; en.y = __float_as_int(rstds[tl]); en.z = k; en.w = __float_as_int(selG[a]); ENT[(size_t)mye[q] * T + pos] = en; }
}
__device__ __forceinline__ void routing_phase(const PV& p, LAS unsigned char* lds) {
    for (int tb = blockIdx.x; tb < T / 256; tb += gridDim.x) { routing_block(p, lds, tb); __syncthreads(); }
}

struct Rounds { int es; int nr; __device__ __forceinline__ int lo(int r) const { return r == 0 ? 0 : es; } __device__ __forceinline__ int hi(int r) const { return r == 0 ? es : NE; } };
__device__ __forceinline__ int pad256(int c) { return (c + 255) & ~255; }
__device__ __forceinline__ Rounds make_rounds(const unsigned* cnt) {
    Rounds R; int sum = 0, e = 0;
    for (; e < NE; ++e) { const int pc = pad256((int)cnt[e]); if (sum + pc > CAP_ROWS) break; sum += pc; }
    R.es = e; R.nr = e < NE ? 2 : 1; return R;
}
__device__ __forceinline__ float f8lane(unsigned w, int i) { return i == 0 ? __builtin_amdgcn_cvt_f32_fp8((int)w, 0) : i == 1 ? __builtin_amdgcn_cvt_f32_fp8((int)w, 1) : i == 2 ? __builtin_amdgcn_cvt_f32_fp8((int)w, 2) : __builtin_amdgcn_cvt_f32_fp8((int)w, 3); }
__device__ __forceinline__ void combine_rows(const PV& p, int gw, int ngw, int lane) {
    const bf16_t* HB = (const bf16_t*)(p.ws() + WS_HB); const unsigned char* Y23 = (const unsigned char*)(p.ws() + WS_Y23);
    f32x4 fw[4];
#pragma unroll
    for (int q = 0; q < 4; ++q) fw[q] = *(const f32x4*)(p.in(I_FNW) + 16 * lane + 4 * q);
    for (int m = gw; m < T; m += ngw) {
        float v[16];
        const u32x4 h0 = *(const u32x4*)(HB + (size_t)m * D + 16 * lane), h1 = *(const u32x4*)(HB + (size_t)m * D + 16 * lane + 8);
        const unsigned hw[8] = {h0.x, h0.y, h0.z, h0.w, h1.x, h1.y, h1.z, h1.w};
#pragma unroll
        for (int q = 0; q < 8; ++q) { v[2 * q] = bflo(hw[q]); v[2 * q + 1] = bfhi(hw[q]); }
        float ys[16];
#pragma unroll
        for (int q = 0; q < 16; ++q) ys[q] = 0.f;
#pragma unroll
        for (int k = 0; k < 4; ++k) { const unsigned char* yb = (k < 2 ? (const unsigned char*)p.out() + (size_t)m * 4096 : Y23 + (size_t)m * 2048) + (k & 1) * 1024;
            const u32x4 y = *(const u32x4*)(yb + 16 * lane); const unsigned yw[4] = {y.x, y.y, y.z, y.w};
#pragma unroll
            for (int q = 0; q < 4; ++q) { ys[4 * q] += f8lane(yw[q], 0); ys[4 * q + 1] += f8lane(yw[q], 1); ys[4 * q + 2] += f8lane(yw[q], 2); ys[4 * q + 3] += f8lane(yw[q], 3); } }
        float s = 0.f;
#pragma unroll
        for (int q = 0; q < 16; ++q) { v[q] += ys[q] * (1.0f / SC_Y); s += v[q] * v[q]; }
        const float rstd = frsq(wave_sum(s) * (1.0f / D) + EPS);
        float* o = p.out() + (size_t)m * D + 16 * lane;
#pragma unroll
        for (int q = 0; q < 4; ++q) { f32x4 r; r.x = v[4 * q] * rstd * fw[q].x; r.y = v[4 * q + 1] * rstd * fw[q].y; r.z = v[4 * q + 2] * rstd * fw[q].z; r.w = v[4 * q + 3] * rstd * fw[q].w;
            *(f32x4*)(o + 4 * q) = r; }
    }
}
#ifndef REP_P0
#define REP_P0 1
#endif
#ifndef REP_P1
#define REP_P1 1
#endif
#ifndef REP_P2
#define REP_P2 1
#endif
#ifndef REP_P3
#define REP_P3 1
#endif
#ifndef REP_P4
#define REP_P4 1
#endif
#ifndef REP_G1
#define REP_G1 1
#endif
#ifndef REP_G2
#define REP_G2 1
#endif
__global__ void __launch_bounds__(512, 2) fwd(Params kp) {
    extern __shared__ __attribute__((aligned(16))) unsigned char lds_[];
    LAS unsigned char* lds = (LAS unsigned char*)lds_;
    {
        const int t0 = threadIdx.x;
        if (t0 < 22) *(volatile LAS unsigned long long*)(lds + LDS_PTAB_OFF + 8 * t0) = (unsigned long long)(size_t)kp.in[t0];
        if (t0 == 22) *(volatile LAS unsigned long long*)(lds + LDS_PTAB_OFF + 8 * 22) = (unsigned long long)(size_t)kp.out;
        if (t0 == 23) *(volatile LAS unsigned long long*)(lds + LDS_PTAB_OFF + 8 * 23) = (unsigned long long)(size_t)kp.ws;
    }
    unsigned char* ws = kp.ws;
    unsigned* bar = (unsigned*)(ws + WS_CTL) + CW_BAR;
    const PV p{lds};
    {
        const int t0 = threadIdx.x;
        const unsigned slot = (unsigned)__builtin_amdgcn_s_getreg(((6 - 1) << 11) | 4);
        if ((t0 & 63) == 0) *(volatile LAS int*)(lds + LDS_TAB + 4 * slot) = t0 >> 6;
        if (t0 == 0) { *(volatile LAS unsigned*)(lds + LDS_BARST) = 0u; *(volatile LAS unsigned*)(lds + LDS_BARST + 4) = 0u;
            const unsigned x = xb_xcc_id(), rank = xb_add(&bar[XB_XCNT(x)], 1u);
            *(volatile LAS unsigned*)(lds + LDS_BARST + 8) = rank * 8u + x; }
        __syncthreads();
    }
#ifdef PROBE_PH
    volatile LAS unsigned long long* phs = (volatile LAS unsigned long long*)(lds + LDS_TAB - 256); int nph = 0;
#define PH_STAMP() do { if (get_tid(lds) == 0) phs[nph] = __builtin_amdgcn_s_memrealtime(); ++nph; } while (0)
    PH_STAMP();
#define GRID_BAR() do { grid_barrier(bar, lds); PH_STAMP(); } while (0)
#else
#define PH_STAMP() do { } while (0)
#define GRID_BAR() grid_barrier(bar, lds)
#endif
    for (int rep = 0; rep < REP_P0; ++rep) { prep_phase(p, lds);
    cg::this_grid().sync(); PH_STAMP(); }
    int vcu = (int)blockIdx.x;
    { bool even = (gridDim.x % 8u) == 0u;
      for (unsigned j = 0; j < 16; ++j) { const unsigned c = xb_ld(&bar[XB_XCNT(j)]); if (c != (j < 8 ? gridDim.x / 8u : 0u)) even = false; }
      if (even) vcu = (int)*(volatile LAS unsigned*)(lds + LDS_BARST + 8);
      vcu = __builtin_amdgcn_readfirstlane(vcu); }
    for (int rep = 0; rep < REP_P1; ++rep) {
    { DenseSched S; S.o.init(T / 256, NPROJ / 256, gridDim.x, vcu); S.A = (const char*)(ws + WS_R1); S.Bt = (const char*)(ws + WS_WIN); S.pitch = 2 * D; EpiInProj E{(bf16_t*)(ws + WS_R2)};
      pg8::gemm_phase<false, false>(lds, (const char*)(ws + WS_R1), 2 * D, S, E); }
    GRID_BAR(); }
    {
        unsigned* ctl = (unsigned*)(ws + WS_CTL);
        if (blockIdx.x < 64) mlstm_phase(p, lds, blockIdx.x);
        volatile LAS int* qslot = (volatile LAS int*)(lds + LDS_BARST + 12);
        for (;;) {
            const int tid = get_tid(lds);
            if (tid == 0) *qslot = (int)xb_add(ctl + CW_WORK, 1u);
            __syncthreads();
            const int idx = __builtin_amdgcn_readfirstlane(*qslot);
            __syncthreads();
            if (idx < 256) {
                rglru_item<false>(p, lds, idx);
                asm volatile("s_waitcnt vmcnt(0)" ::: "memory"); __syncthreads();
                if (get_tid(lds) == 0) { __builtin_amdgcn_fence(__ATOMIC_RELEASE, "agent"); asm volatile("s_waitcnt vmcnt(0)" ::: "memory"); (void)xb_add(ctl + CW_CNTA + 16 * (idx >> 4), 1u); }
            } else if (idx < 512) {
                const int it = idx - 256;
                if (get_tid(lds) == 0) { XB_SPIN(xb_ld(ctl + CW_CNTA + 16 * (it >> 4)) < 16u, bar); __builtin_amdgcn_fence(__ATOMIC_ACQUIRE, "agent"); asm volatile("s_waitcnt vmcnt(0)" ::: "memory"); }
                __syncthreads();
                rglru_item<true>(p, lds, it);
            } else if (idx < 512 + 384) {
                const int ch = idx - 512, wave = get_tid(lds) >> 6, lane = get_tid(lds) & 63;
                LAS float* scr = (LAS float*)(lds + wave * 17408);
                for (int q = 0; q < 8; ++q) conv_item_moe(p, ch * 64 + wave * 8 + q, scr, lane);
                __syncthreads();
            } else break;
        }
    }
    GRID_BAR();
    for (int rep = 0; rep < REP_P4; ++rep) {
    { DenseSched S; S.o.init(T / 256, D / 256, gridDim.x, vcu); S.A = (const char*)(ws + WS_R1); S.Bt = (const char*)(ws + WS_WOUT); S.pitch = 2 * D; EpiOutProj E{p.in(I_X), (bf16_t*)(ws + WS_HB)};
      pg8::gemm_phase<false, false>(lds, (const char*)(ws + WS_R1), 2 * D, S, E); }
    GRID_BAR(); }
    routing_phase(p, lds);
    GRID_BAR();
    const unsigned* cnt = (const unsigned*)(ws + WS_CTL) + CW_CNT;
    const Rounds RR = make_rounds(cnt);
    for (int r = 0; r < RR.nr; ++r) {
        for (int rep = 0; rep < REP_G1; ++rep) {
        { MoeSched<true, 8, 2 * DFF> S{cnt, (const i32x4*)(ws + WS_ENT), (const char*)(ws + WS_HB8), (const char*)(ws + WS_WGU), lds, RR.lo(r), RR.hi(r), (int)gridDim.x, vcu, 0}; S.init_tot(get_tid(lds));
          EpiG1 E{(unsigned char*)(ws + WS_R2), (const i32x4*)(ws + WS_ENT), cnt, p.in(I_BGU)};
          pg8::gemm_phase<true, true>(lds, (const char*)(ws + WS_HB8), D, S, E, ws, 8); }
        GRID_BAR(); }
        for (int rep = 0; rep < REP_G2; ++rep) {
        { MoeSched<false, 4, D> S{cnt, (const i32x4*)(ws + WS_ENT), (const char*)(ws + WS_R2), (const char*)(ws + WS_WDN), lds, RR.lo(r), RR.hi(r), (int)gridDim.x, vcu, 0}; S.init_tot(get_tid(lds));
          EpiG2 E{(unsigned char*)p.out(), (unsigned char*)(ws + WS_Y23), (const i32x4*)(ws + WS_ENT), cnt, p.in(I_BDN)};
          pg8::gemm_phase<true, false>(lds, (const char*)(ws + WS_R2), DFF, S, E, ws, 16); }
        GRID_BAR(); }
    }
    { const int tid = get_tid(lds); combine_rows(p, blockIdx.x * 8 + (tid >> 6), gridDim.x * 8, tid & 63); }
#ifdef PROBE_G
    if (blockIdx.x == PROBE_BLK && get_tid(lds) == 0) {
        const volatile unsigned long long* st = (const volatile unsigned long long*)(ws + WS_CTL + 40960);
        const unsigned long long ticks = (st[PROBE_I + PROBE_SPAN] - st[PROBE_I]) * PROBE_MUL;
        const unsigned long long t0 = __builtin_amdgcn_s_memrealtime();
        while (__builtin_amdgcn_s_memrealtime() - t0 < ticks) __builtin_amdgcn_s_sleep(8);
    }
#endif
#ifdef PROBE_PH
    PH_STAMP();
    if (vcu == 0 && get_tid(lds) == 0) {
        const unsigned long long ticks = (phs[PROBE_PH + 1] - phs[PROBE_PH]) * PROBE_MUL;
        const unsigned long long t0 = __builtin_amdgcn_s_memrealtime();
        while (__builtin_amdgcn_s_memrealtime() - t0 < ticks) __builtin_amdgcn_s_sleep(8);
    }
#endif
}

extern "C" void kernel_launch(void* const* d_in, const int* in_sizes, int n_in, void* d_out, int out_size, void* d_ws, size_t ws_size, hipStream_t stream) {
    static int grid = 0;
    if (grid == 0) {
        if (n_in != 22 || ws_size < WS_END) { fprintf(stderr, "kernel_launch: unexpected n_in %d / ws_size %zu (need %zu)\n", n_in, ws_size, (size_t)WS_END); grid = -1; return; }
        int dev = 0, cus = 0, per_cu = 0;
        (void)hipGetDevice(&dev); (void)hipDeviceGetAttribute(&cus, hipDeviceAttributeMultiprocessorCount, dev);
        (void)hipFuncSetAttribute((const void*)fwd, hipFuncAttributeMaxDynamicSharedMemorySize, LDS_BYTES);
        (void)hipOccupancyMaxActiveBlocksPerMultiprocessor(&per_cu, (const void*)fwd, 512, LDS_BYTES);
        if (per_cu < 1) { fprintf(stderr, "kernel_launch: occupancy query says %d blocks/CU\n", per_cu); per_cu = 1; }
        grid = cus * per_cu;
        fprintf(stderr, "kernel_launch: grid %d (cus %d x %d)\n", grid, cus, per_cu);
    }
    if (grid < 0) return;
    Params p{};
    for (int i = 0; i < 22; ++i) p.in[i] = (const float*)d_in[i];
    p.out = (float*)d_out; p.ws = (unsigned char*)d_ws;
    (void)hipMemsetAsync((unsigned char*)d_ws + WS_CTL, 0, 65536, stream);
    void* args[] = {&p};
    hipError_t e = hipLaunchCooperativeKernel((const void*)fwd, dim3(grid), dim3(512), args, LDS_BYTES, stream);
    if (e != hipSuccess) fprintf(stderr, "kernel_launch: cooperative launch failed: %s (grid %d)\n", hipGetErrorString(e), grid);
}
```

```cpp
#include <hip/hip_runtime.h>
#include <hip/hip_cooperative_groups.h>
#include <cstdio>
#include <cstdint>

namespace cg = cooperative_groups;
#define LAS __attribute__((address_space(3)))
typedef unsigned short bf16_t;
typedef short bf16x8 __attribute__((ext_vector_type(8)));
typedef float f32x4 __attribute__((ext_vector_type(4)));
typedef unsigned u32x4 __attribute__((ext_vector_type(4)));
typedef unsigned u32x2 __attribute__((ext_vector_type(2)));
typedef int i32x4 __attribute__((ext_vector_type(4)));

constexpr int T = 65536, D = 1024, SEQ = 4096, NB = 16;
constexpr int INC = 3080;
constexpr int NPROJ = 3072;
constexpr int NE = 32, TOPK = 4, DFF = 1024;
constexpr float EPS = 1e-6f;
constexpr int CAP_ROWS = 270336;
constexpr float SC_H = 8.0f, SC_W = 64.0f, SC_HID = 4.0f;

constexpr size_t MB = 1024 * 1024;
constexpr size_t WS_CTL  = 0;
constexpr size_t WS_GATES = 1 * MB;
constexpr size_t WS_SSQR = 3 * MB;
constexpr size_t WS_SUMM = 4 * MB;
constexpr size_t WS_WRI  = 5 * MB;
constexpr size_t WS_WRT  = 5 * MB + 512 * 1024;
constexpr size_t WS_ENT  = 6 * MB;
constexpr size_t WS_WIN  = 38 * MB;
constexpr size_t WS_WOUT = 44 * MB;
constexpr size_t WS_WGU  = 46 * MB;
constexpr size_t WS_WDN  = 110 * MB;
constexpr size_t WS_HB8  = 142 * MB;
constexpr size_t WS_R1   = 238 * MB;
constexpr size_t WS_R2   = 366 * MB;
constexpr size_t WS_Y23  = 750 * MB;
constexpr size_t WS_HB   = 878 * MB;
constexpr float SC_Y = 32.0f;
constexpr size_t WS_END  = 1006 * MB;

constexpr int CW_CNT = 0;
constexpr int CW_WORK = 64;
constexpr int CW_CNTA = 128;
constexpr int CW_BAR = 1024;

__device__ __forceinline__ unsigned pk2(float lo, float hi) { unsigned r; asm("v_cvt_pk_bf16_f32 %0, %1, %2" : "=v"(r) : "v"(lo), "v"(hi)); return r; }
__device__ __forceinline__ float bflo(unsigned u) { return __uint_as_float(u << 16); }
__device__ __forceinline__ float bfhi(unsigned u) { return __uint_as_float(u & 0xffff0000u); }
__device__ __forceinline__ float bf2f(bf16_t b) { return __uint_as_float(((unsigned)b) << 16); }
template <int CTRL, int RM> __device__ __forceinline__ float dpp_x(float v, float ident) {
    return __builtin_bit_cast(float, __builtin_amdgcn_update_dpp(__builtin_bit_cast(int, ident), __builtin_bit_cast(int, v), CTRL, RM, 0xf, false));
}
__device__ __forceinline__ float wave_sum(float s) {
    s += dpp_x<0x111, 0xf>(s, 0.f); s += dpp_x<0x112, 0xf>(s, 0.f); s += dpp_x<0x114, 0xf>(s, 0.f); s += dpp_x<0x118, 0xf>(s, 0.f);
    s += dpp_x<0x142, 0xa>(s, 0.f); s += dpp_x<0x143, 0xc>(s, 0.f);
    return __builtin_bit_cast(float, __builtin_amdgcn_readlane(__builtin_bit_cast(int, s), 63));
}
__device__ __forceinline__ float fexp(float x) { return __builtin_amdgcn_exp2f(x * 1.4426950408889634f); }
__device__ __forceinline__ float frcp(float x) { return __builtin_amdgcn_rcpf(x); }
__device__ __forceinline__ float fsqrt(float x) { return __builtin_amdgcn_sqrtf(x); }
__device__ __forceinline__ float frsq(float x) { return __builtin_amdgcn_rsqf(x); }
__device__ __forceinline__ float sigmoidf_(float x) { return frcp(1.0f + __builtin_amdgcn_exp2f(x * -1.4426950408889634f)); }
__device__ __forceinline__ float gelu_tanh(float x) {
    const float u2 = 1.5957691216057308f * (x + 0.044715f * x * x * x);
    return x * sigmoidf_(u2);
}

typedef int i32x8 __attribute__((ext_vector_type(8)));
__device__ __forceinline__ unsigned pk4_fp8(float a, float b, float c, float d) {
    int r = __builtin_amdgcn_cvt_pk_fp8_f32(a, b, 0, false); r = __builtin_amdgcn_cvt_pk_fp8_f32(c, d, r, true); return (unsigned)r;
}
__device__ __forceinline__ float clamp448(float x) { return fminf(fmaxf(x, -448.f), 448.f); }

struct Params {
    const float* in[22];
    float* out;
    unsigned char* ws;
    int pad0, pad1;
};
constexpr int LDS_PTAB_OFF = 159744 - 512 - 256 - 256;
struct PV {
    LAS unsigned char* l;
    __device__ __forceinline__ unsigned long long ptr(int i) const { const u32x2 v = *(volatile LAS u32x2*)(l + LDS_PTAB_OFF + 8 * i);
        return ((unsigned long long)(unsigned)__builtin_amdgcn_readfirstlane((int)v.y) << 32) | (unsigned)__builtin_amdgcn_readfirstlane((int)v.x); }
    __device__ __forceinline__ const float* in(int i) const { return (const float*)(const __attribute__((address_space(1))) float*)(size_t)ptr(i); }
    __device__ __forceinline__ float* out() const { return (float*)(__attribute__((address_space(1))) float*)(size_t)ptr(22); }
    __device__ __forceinline__ unsigned char* ws() const { return (unsigned char*)(__attribute__((address_space(1))) unsigned char*)(size_t)ptr(23); }
};
enum { I_X = 0, I_N1W, I_WIN, I_GB, I_MNW, I_CW, I_CB, I_WR, I_BR, I_WI, I_BI, I_LAM, I_LNW, I_WOUT, I_N2W, I_RW, I_RB, I_WGU, I_BGU, I_WDN, I_BDN, I_FNW };


constexpr int LDS_BYTES = 159744, LDS_TAB = LDS_BYTES - 512, LDS_BARST = LDS_BYTES - 16;
__device__ __forceinline__ int get_tid(LAS unsigned char* lds) {
    const unsigned slot = (unsigned)__builtin_amdgcn_s_getreg(((6 - 1) << 11) | 4);
    const int w = __builtin_amdgcn_readfirstlane(*(volatile LAS int*)(lds + LDS_TAB + 4 * slot));
    int lane; asm volatile("v_mbcnt_lo_u32_b32 %0, -1, 0\n\tv_mbcnt_hi_u32_b32 %0, -1, %0" : "=v"(lane));
    return w * 64 + lane;
}
#define XB_TMO      128
#define XB_XCNT(j)  (256  + 64 * (j))
#define XB_XSUB(j)  (1280 + 64 * (j))
#define XB_XGEN(j)  (2304 + 64 * (j))
#define XB_TOP      3328
#define XB_TOPGEN   3392
#define XCD_BAR_WORDS 3456
#define XB_SPIN_CAP (1u << 22)
__device__ __forceinline__ unsigned xb_ld(unsigned* p)              { return __hip_atomic_load(p, __ATOMIC_RELAXED, __HIP_MEMORY_SCOPE_AGENT); }
__device__ __forceinline__ unsigned xb_add(unsigned* p, unsigned v) { return __hip_atomic_fetch_add(p, v, __ATOMIC_RELAXED, __HIP_MEMORY_SCOPE_AGENT); }
__device__ __forceinline__ unsigned xb_xcc_id() { return (unsigned)__builtin_amdgcn_s_getreg((3 << 11) | 20) & 0xFu; }
#define XB_SPIN(cond, bar) do { unsigned _sp = 0; while (cond) { __builtin_amdgcn_s_sleep(1); \
    if ((++_sp & 255u) == 0u) { if (xb_ld(&(bar)[XB_TMO])) break; if (_sp > XB_SPIN_CAP) { atomicAdd(&(bar)[XB_TMO], 1u); break; } } } } while (0)
__device__ __forceinline__ void xcd_barrier_complete(unsigned* bar, unsigned x, unsigned G, unsigned& nloc, unsigned& nx) {
    unsigned sum, cnt, mine, sp = 0u;
    for (;;) {
        sum = 0u; cnt = 0u; mine = 0u;
#pragma unroll
        for (unsigned j = 0; j < 16; ++j) { const unsigned c = xb_ld(&bar[XB_XCNT(j)]); sum += c; cnt += (c > 0u) ? 1u : 0u; mine = (j == x) ? c : mine; }
        if (sum == G) break;
        __builtin_amdgcn_s_sleep(1);
        if ((++sp & 255u) == 0u) { if (xb_ld(&bar[XB_TMO])) break; if (sp > XB_SPIN_CAP) { atomicAdd(&bar[XB_TMO], 1u); break; } }
    }
    nloc = mine > 0u ? mine : 1u; nx = cnt > 0u ? cnt : 1u;
}
__device__ __forceinline__ void grid_barrier(unsigned* bar, LAS unsigned char* lds) {
    asm volatile("s_waitcnt vmcnt(0)" ::: "memory");
    __syncthreads();
    if (get_tid(lds) == 0) {
        volatile LAS unsigned* st = (volatile LAS unsigned*)(lds + LDS_BARST);
        const unsigned x = xb_xcc_id();
        __builtin_amdgcn_s_waitcnt(0);
        unsigned nloc = st[0], nx = st[1];
        if (nloc == 0u) { xcd_barrier_complete(bar, x, gridDim.x, nloc, nx); st[0] = nloc; st[1] = nx; }
        const unsigned old = xb_add(&bar[XB_XSUB(x)], 1u);
        const unsigned gen = old / nloc;
        if (old + 1u == (gen + 1u) * nloc) {
            __builtin_amdgcn_fence(__ATOMIC_RELEASE, "agent");
            asm volatile("s_waitcnt vmcnt(0)" ::: "memory");
            const unsigned og = xb_add(&bar[XB_TOP], 1u);
            const unsigned tg = og / nx;
            if (og + 1u == (tg + 1u) * nx) xb_add(&bar[XB_TOPGEN], 1u);
            else XB_SPIN(xb_ld(&bar[XB_TOPGEN]) == tg, bar);
            __builtin_amdgcn_fence(__ATOMIC_ACQUIRE, "agent");
            xb_add(&bar[XB_XGEN(x)], 1u);
            asm volatile("s_waitcnt vmcnt(0)" ::: "memory");
        } else {
            XB_SPIN(xb_ld(&bar[XB_XGEN(x)]) == gen, bar);
            __builtin_amdgcn_fence(__ATOMIC_ACQUIRE, "agent");
            asm volatile("s_waitcnt vmcnt(0)" ::: "memory");
        }
    }
    __syncthreads();
}

#ifdef PROBE_G
#define GSTAMP(ws_, tid_, i_) do { if (((i_) == PROBE_I || (i_) == PROBE_I + PROBE_SPAN) && blockIdx.x == PROBE_BLK && (tid_) == 0) ((volatile unsigned long long*)((ws_) + WS_CTL + 40960))[i_] = __builtin_amdgcn_s_memrealtime(); } while (0)
#else
#define GSTAMP(ws_, tid_, i_) do { } while (0)
#endif
__device__ __forceinline__ void tr_item(const float* __restrict__ W, int ldw, int col0, bf16_t* dst, int K, int k0, const float* sk, float mul, LAS float* scr, int lane) {
    float v[32];
    const float* src = W + (size_t)(k0 + (lane >> 5)) * ldw + col0 + (lane & 31);
#pragma unroll
    for (int i = 0; i < 32; ++i) v[i] = __builtin_nontemporal_load(src + (size_t)(2 * i) * ldw);
#pragma unroll
    for (int i = 0; i < 32; ++i) { const int kk = 2 * i + (lane >> 5); const float s = sk ? sk[k0 + kk] * mul : mul; scr[kk * 33 + (lane & 31)] = v[i] * s; }
    asm volatile("s_waitcnt lgkmcnt(0)" ::: "memory");
    const int c = lane & 7;
#pragma unroll
    for (int j = 0; j < 4; ++j) { const int n = (lane >> 3) + 8 * j; const LAS float* s = scr + (8 * c) * 33 + n;
        u32x4 o; o.x = pk2(s[0 * 33], s[1 * 33]); o.y = pk2(s[2 * 33], s[3 * 33]); o.z = pk2(s[4 * 33], s[5 * 33]); o.w = pk2(s[6 * 33], s[7 * 33]);
        *(u32x4*)(dst + (size_t)n * K + k0 + 8 * c) = o; }
    asm volatile("s_waitcnt lgkmcnt(0)" ::: "memory");
}
__device__ __forceinline__ void tr_item_f8(const float* __restrict__ W, int ldw, int col0, unsigned char* dst, int K, int k0, const float* sk, float mul, LAS float* scr, int lane) {
    f32x4 v[16];
    const int r = lane >> 4, c4 = lane & 15;
    const float* src = W + (size_t)(k0 + r) * ldw + col0 + 4 * c4;
#pragma unroll
    for (int i = 0; i < 16; ++i) v[i] = __builtin_nontemporal_load((const f32x4*)(src + (size_t)(4 * i) * ldw));
#pragma unroll
    for (int i = 0; i < 16; ++i) { const int kk = 4 * i + r; const float s = sk ? sk[k0 + kk] * mul : mul; f32x4 t = v[i] * s;
        t.x = clamp448(t.x); t.y = clamp448(t.y); t.z = clamp448(t.z); t.w = clamp448(t.w); *(LAS f32x4*)(scr + kk * 68 + 4 * c4) = t; }
    asm volatile("s_waitcnt lgkmcnt(0)" ::: "memory");
    const int c = lane & 3, nn = lane >> 2;
#pragma unroll
    for (int j = 0; j < 4; ++j) { const int n = nn + 16 * j; const LAS float* s = scr + (16 * c) * 68 + n;
        u32x4 o; o.x = pk4_fp8(s[0 * 68], s[1 * 68], s[2 * 68], s[3 * 68]); o.y = pk4_fp8(s[4 * 68], s[5 * 68], s[6 * 68], s[7 * 68]);
        o.z = pk4_fp8(s[8 * 68], s[9 * 68], s[10 * 68], s[11 * 68]); o.w = pk4_fp8(s[12 * 68], s[13 * 68], s[14 * 68], s[15 * 68]);
        *(u32x4*)(dst + (size_t)n * K + k0 + 16 * c) = o; }
    asm volatile("s_waitcnt lgkmcnt(0)" ::: "memory");
}
constexpr int IT_WIN = 16 * 96, IT_WOUT = 16 * 32, IT_WGU_E = 16 * 32, IT_WDN_E = 16 * 16;
__device__ __forceinline__ void conv_item_small(const PV& p, int it, LAS float* scr, int lane) {
    if (it < IT_WIN) {
        const int kb = it / 96, nb = it % 96, n0 = 32 * nb, sec = n0 >> 9;
        const int secoff = sec == 0 ? 0 : sec == 1 ? 512 : sec == 2 ? 1024 : sec == 3 ? 1544 : sec == 4 ? 2056 : 2568;
        const float mul = sec == 1 ? 0.08838834764831845f : 1.0f;
        tr_item(p.in(I_WIN), INC, secoff + (n0 & 511), (bf16_t*)(p.ws() + WS_WIN) + (size_t)n0 * D, D, 64 * kb, nullptr, mul, scr, lane);
    } else {
        it -= IT_WIN; const int kb = it / 32, nb = it % 32, k0 = 64 * kb;
        const float* sk = k0 < 512 ? p.in(I_MNW) : p.in(I_LNW) - 512;
        tr_item(p.in(I_WOUT), D, 32 * nb, (bf16_t*)(p.ws() + WS_WOUT) + (size_t)(32 * nb) * D, D, k0, sk, 1.0f, scr, lane);
    }
}
__device__ __forceinline__ void conv_item_moe(const PV& p, int it, LAS float* scr, int lane) {
    if (it < NE * IT_WGU_E) {
        const int e = it / IT_WGU_E, r = it % IT_WGU_E, kb = r / 32, nb = r % 32, n0 = 64 * nb, j = n0 >> 8, c0 = n0 & 255;
        const int srccol = c0 < 128 ? 128 * j + c0 : 1024 + 128 * j + (c0 - 128);
        tr_item_f8(p.in(I_WGU) + (size_t)e * D * 2 * DFF, 2 * DFF, srccol, (unsigned char*)(p.ws() + WS_WGU) + ((size_t)e * 2 * DFF + n0) * D, D, 64 * kb, p.in(I_N2W), SC_W, scr, lane);
    } else {
        it -= NE * IT_WGU_E; const int e = it / IT_WDN_E, r = it % IT_WDN_E, kb = r / 16, nb = r % 16;
        tr_item_f8(p.in(I_WDN) + (size_t)e * DFF * D, D, 64 * nb, (unsigned char*)(p.ws() + WS_WDN) + ((size_t)e * D + 64 * nb) * DFF, DFF, 64 * kb, nullptr, SC_W, scr, lane);
    }
}
__device__ __forceinline__ void xpass_rows(const PV& p, LAS unsigned char* lds, int gw, int ngw, int lane) {
    LAS float* WG = (LAS float*)(lds + 69632);
    { const float* wg = p.in(I_WIN) + 1536;
      for (int i = get_tid(lds); i < 2048; i += 512) { const int k = i >> 1, q = i & 1; const f32x4 a = *(const f32x4*)(wg + (size_t)k * INC + 4 * q);
          const int rho = ((k >> 8) * 4 + (k & 3)) * 64 + ((k >> 2) & 63); *(LAS f32x4*)(WG + rho * 12 + 4 * q) = a; } }
    __syncthreads();
    f32x4 w1[4];
#pragma unroll
    for (int j = 0; j < 4; ++j) w1[j] = *(const f32x4*)(p.in(I_N1W) + 256 * j + 4 * lane);
    const float gb = lane < 8 ? p.in(I_GB)[lane] : 0.f;
    bf16_t* XN = (bf16_t*)(p.ws() + WS_R1); float* GATES = (float*)(p.ws() + WS_GATES);
    for (int m = gw; m < T; m += ngw) {
        const f32x4* xr = (const f32x4*)(p.in(I_X) + (size_t)m * D) + lane;
        f32x4 v[4]; float s = 0.f;
#pragma unroll
        for (int j = 0; j < 4; ++j) { v[j] = xr[64 * j]; s += (v[j].x * v[j].x + v[j].y * v[j].y) + (v[j].z * v[j].z + v[j].w * v[j].w); }
        const float rstd = frsq(wave_sum(s) * (1.0f / D) + EPS);
        float g[8];
#pragma unroll
        for (int q = 0; q < 8; ++q) g[q] = 0.f;
        unsigned long long* o8 = (unsigned long long*)(XN + (size_t)m * D) + lane;
#pragma unroll
        for (int j = 0; j < 4; ++j) { v[j] = v[j] * rstd * w1[j];
            o8[64 * j] = (unsigned long long)pk2(v[j].x, v[j].y) | ((unsigned long long)pk2(v[j].z, v[j].w) << 32);
#pragma unroll
            for (int c = 0; c < 4; ++c) { const float xv = v[j][c]; const LAS f32x4* wrow = (const LAS f32x4*)(WG + ((j * 4 + c) * 64 + lane) * 12); const f32x4 wa = wrow[0], wb = wrow[1];
                g[0] += xv * wa.x; g[1] += xv * wa.y; g[2] += xv * wa.z; g[3] += xv * wa.w; g[4] += xv * wb.x; g[5] += xv * wb.y; g[6] += xv * wb.z; g[7] += xv * wb.w; } }
        float mine = 0.f;
#pragma unroll
        for (int q = 0; q < 8; ++q) { const float t = wave_sum(g[q]); if (lane == q) mine = t; }
        if (lane < 8) { float val = mine + gb; if (lane >= 4) val = -log1pf(fexp(-val)); GATES[(size_t)m * 8 + lane] = val; }
    }
}
__device__ __forceinline__ void prep_phase(const PV& p, LAS unsigned char* lds) {
    const int tid = get_tid(lds), lane = tid & 63, wave = tid >> 6, gw = blockIdx.x * 8 + wave, ngw = gridDim.x * 8;
    LAS float* scr = (LAS float*)(lds + wave * 8448);
    for (int it = gw; it < IT_WIN + IT_WOUT; it += ngw) conv_item_small(p, it, scr, lane);
    bf16_t* WRI = (bf16_t*)(p.ws() + WS_WRI);
    for (int i = blockIdx.x * 512 + tid; i < 4 * 256 * 128; i += gridDim.x * 512) { const int h = i >> 15, n = (i >> 7) & 255, k = i & 127;
        const float v = n < 128 ? p.in(I_WR)[(h * 128 + k) * 128 + n] : p.in(I_WI)[(h * 128 + k) * 128 + n - 128]; WRI[i] = (bf16_t)(pk2(v, 0.f) & 0xffff); }
    { bf16_t* WRT = (bf16_t*)(p.ws() + WS_WRT);
      for (int i = blockIdx.x * 512 + tid; i < 32 * 1024; i += gridDim.x * 512) { const int e = i >> 10, k = i & 1023; const float v = p.in(I_RW)[k * 32 + e] * p.in(I_N2W)[k];
          const unsigned h = pk2(v, 0.f) & 0xffffu; const float lo = v - __uint_as_float(h << 16); WRT[i] = (bf16_t)h; WRT[32 * 1024 + i] = (bf16_t)(pk2(lo, 0.f) & 0xffffu); } }
    xpass_rows(p, lds, gw, ngw, lane);
}
__device__ __forceinline__ void moe_conv_phase(const PV& p, LAS unsigned char* lds, int b0) {
    const int tid = get_tid(lds), lane = tid & 63, wave = tid >> 6;
    if ((int)blockIdx.x < b0) return;
    const int gw = ((int)blockIdx.x - b0) * 8 + wave, ngw = ((int)gridDim.x - b0) * 8;
    LAS float* scr = (LAS float*)(lds + wave * 17408);
    for (int it = gw; it < NE * (IT_WGU_E + IT_WDN_E); it += ngw) conv_item_moe(p, it, scr, lane);
}

namespace pg8 {
constexpr int BM = 256, BK = 64, HALF = 128, HTB = HALF * BK * 2, STAGE_BYTES = 8 * HTB;
constexpr int META_OFF = 132096, META_BYTES = 5120;
__device__ __forceinline__ int lds_byte(int r, int c) { const int st = (r >> 4) * 2 + (c >> 5), rr = r & 15, cc = c & 31, ob = rr * 64 + cc * 2; return st * 1024 + (ob ^ (((ob >> 9) & 1) << 5)); }
__device__ __forceinline__ void stage_rc(int b, int& R, int& C) { const int st = b / 1024, sb = b % 1024, swz = sb ^ (((sb >> 9) & 1) << 5); R = (st >> 1) * 16 + swz / 64; C = (st & 1) * 32 + (swz % 64) / 2; }
__device__ __forceinline__ int perm32(int rho) { const int n = rho >> 4, i = rho & 15; return 8 * (i >> 2) + 4 * n + (i & 3); }
struct Unit { const char* b; const char* a; int i0, i1, i2, i3, i4; };
#define PG8_GLDS2(ldsa, s0, v0, s1, v1) do { unsigned _keep; \
        asm volatile("s_mov_b32 %0, m0\n\ts_mov_b32 m0, %5\n\ts_nop 0\n\tglobal_load_lds_dwordx4 %1, %2\n\ts_mov_b32 m0, %6\n\ts_nop 0\n\tglobal_load_lds_dwordx4 %3, %4\n\ts_mov_b32 m0, %0" \
                     : "=&s"(_keep) : "v"(v0), "s"((const char*)(s0)), "v"(v1), "s"((const char*)(s1)), "s"(ldsa), "s"((ldsa) + 8192u) : "memory"); } while (0)
template <bool F8, bool GATHER, class Epi, class Sched>
__device__ __forceinline__ void gemm_phase(LAS unsigned char* lds, const char* Abase, int pitch, const Sched& S, const Epi& E, unsigned char* pws = nullptr, int pslot = 0) {
    const int tid = get_tid(lds);
    const int wid = __builtin_amdgcn_readfirstlane(tid >> 6), lane = tid & 63, wr = wid >> 2, wc = wid & 3, fr = lane & 15, fq = lane >> 4;
    const int nt = pitch / 128;
    unsigned vA, vB;
    { int R0, C0; stage_rc(tid * 16, R0, C0); const int Rb0 = Epi::PERM ? ((R0 & ~31) + perm32(R0 & 31)) : R0;
      vA = (unsigned)(R0 * pitch + 2 * C0); vB = (unsigned)(Rb0 * pitch + 2 * C0); }
    const size_t kstep = 128, hstep = (size_t)HALF * pitch, q64 = (size_t)64 * pitch;
    const unsigned ldsb0 = (unsigned)__builtin_amdgcn_readfirstlane((int)((unsigned)(size_t)lds + (unsigned)wid * 1024u));
    const int aoff = lds_byte(wr * 64 + fr, fq * 8), boff = lds_byte(wc * 32 + fr, fq * 8);
    constexpr int HOFF = 1024;
#define PG8_SA(b, h) (((b) * 2 + (h)) * HTB)
#define PG8_SB(b, h) ((4 + (b) * 2 + (h)) * HTB)
#define PG8_STAGEB(bufoff, gbase) PG8_GLDS2(ldsb0 + (unsigned)(bufoff), (gbase), vB, (gbase) + q64, vB)
#define PG8_STAGEA(bufoff, kp, h) do { if constexpr (GATHER) { if ((h) == 0) PG8_GLDS2(ldsb0 + (unsigned)(bufoff), (kp), g0, (kp), g1); else PG8_GLDS2(ldsb0 + (unsigned)(bufoff), (kp), g2, (kp), g3); } \
        else PG8_GLDS2(ldsb0 + (unsigned)(bufoff), (kp) + (h) * hstep, vA, (kp) + (h) * hstep + q64, vA); } while (0)
#define PG8_RD(p) (*(const LAS u32x4*)(p))
#define PG8_LDA(dst, b, h) do { _Pragma("unroll") for (int m = 0; m < 4; ++m) { dst[m][0] = PG8_RD(lds + PG8_SA(b, h) + aoff + m * 2048); dst[m][1] = PG8_RD(lds + PG8_SA(b, h) + aoff + m * 2048 + HOFF); } } while (0)
#define PG8_LDB(dst, b, h) do { _Pragma("unroll") for (int n = 0; n < 2; ++n) { dst[n][0] = PG8_RD(lds + PG8_SB(b, h) + boff + n * 2048); dst[n][1] = PG8_RD(lds + PG8_SB(b, h) + boff + n * 2048 + HOFF); } } while (0)
#define PG8_CAT(v) __builtin_bit_cast(i32x8, __builtin_shufflevector((v)[0], (v)[1], 0, 1, 2, 3, 4, 5, 6, 7))
#define PG8_MMA(ai, bj, At, Bt) do { __builtin_amdgcn_s_setprio(1); _Pragma("unroll") for (int m = 0; m < 4; ++m) _Pragma("unroll") for (int n = 0; n < 2; ++n) { \
        if constexpr (F8) acc[ai][bj][m][n] = __builtin_amdgcn_mfma_scale_f32_16x16x128_f8f6f4(PG8_CAT(Bt[n]), PG8_CAT(At[m]), acc[ai][bj][m][n], 0, 0, 0, 0, 0, 0);     \
        else { acc[ai][bj][m][n] = __builtin_amdgcn_mfma_f32_16x16x32_bf16(__builtin_bit_cast(bf16x8, Bt[n][0]), __builtin_bit_cast(bf16x8, At[m][0]), acc[ai][bj][m][n], 0, 0, 0); \
               acc[ai][bj][m][n] = __builtin_amdgcn_mfma_f32_16x16x32_bf16(__builtin_bit_cast(bf16x8, Bt[n][1]), __builtin_bit_cast(bf16x8, At[m][1]), acc[ai][bj][m][n], 0, 0, 0); } } \
        __builtin_amdgcn_s_setprio(0); } while (0)
#define PG8_GLDS1(ldsa, s0, v0) do { unsigned _keep; \
        asm volatile("s_mov_b32 %0, m0\n\ts_mov_b32 m0, %3\n\ts_nop 0\n\tglobal_load_lds_dwordx4 %1, %2\n\ts_mov_b32 m0, %0" : "=&s"(_keep) : "v"(v0), "s"((const char*)(s0)), "s"(ldsa) : "memory"); } while (0)
#define PG8_WAIT_V(n) asm volatile("s_waitcnt vmcnt(" #n ")" ::: "memory")
#define PG8_WAIT_L(n) asm volatile("s_waitcnt lgkmcnt(" #n ")" ::: "memory")
#define PG8_BAR __builtin_amdgcn_s_barrier()
#define PG8_SCHED __builtin_amdgcn_sched_barrier(0)
    Unit cur, nxt; int ui = 0;
    if (!S.next(0, cur)) return;
    f32x4 acc[2][2][4][2];
#pragma unroll
    for (int a = 0; a < 2; ++a)
#pragma unroll
        for (int b = 0; b < 2; ++b)
#pragma unroll
            for (int m = 0; m < 4; ++m)
#pragma unroll
                for (int n = 0; n < 2; ++n) acc[a][b][m][n] = (f32x4){0.f, 0.f, 0.f, 0.f};
    u32x4 At[4][2], B0[2][2], B1[2][2];
    unsigned g0 = 0, g1 = 0, g2 = 0, g3 = 0;
    if constexpr (GATHER) { S.goffs(cur, tid, 0, g0, g1); S.goffs(cur, tid, 1, g2, g3); }
    const char* cA = GATHER ? Abase : cur.a; const char* cB = cur.b;
    PG8_STAGEB(PG8_SB(0, 0), cB); PG8_STAGEB(PG8_SB(0, 1), cB + hstep); PG8_STAGEA(PG8_SA(0, 0), cA, 0); PG8_STAGEA(PG8_SA(0, 1), cA, 1);
    if (wr == 1) PG8_BAR;
    PG8_WAIT_V(2); PG8_BAR;
    PG8_STAGEB(PG8_SB(1, 0), cB + kstep); PG8_STAGEA(PG8_SA(1, 0), cA + kstep, 0); PG8_STAGEB(PG8_SB(1, 1), cB + hstep + kstep);
    PG8_WAIT_V(6); PG8_BAR;
    for (;;) {
#ifdef PROBE_G
        if (pws && ui == 2) GSTAMP(pws, tid, pslot);
#endif
        const bool has_next = S.next(ui + 1, nxt);
        const char* nB = has_next ? nxt.b : cB; const char* nA = GATHER ? Abase : (has_next ? nxt.a : cA);
#ifdef PROBE_G
        if (pws && ui == 2) GSTAMP(pws, tid, pslot + 1);
#endif
#pragma unroll 1
        for (int t = 0; t < nt; t += 2) {
            const bool last = (t == nt - 2);
            const char* a1 = cA + (size_t)(t + 1) * kstep;
            const char* a2 = last ? nA : cA + (size_t)(t + 2) * kstep; const char* b2 = last ? nB : cB + (size_t)(t + 2) * kstep;
            const char* a3 = a2 + kstep; const char* b3 = b2 + kstep;
            PG8_LDB(B0, 0, 0); PG8_LDB(B1, 0, 1); PG8_SCHED; PG8_LDA(At, 0, 0); PG8_STAGEA(PG8_SA(1, 1), a1, 1);
            if constexpr (Sched::HAS_META) { if (t == 0) S.meta_issue(cur, (unsigned)(size_t)lds + (unsigned)META_OFF + (unsigned)((ui & 1) * META_BYTES), wid, lane); }
            if constexpr (GATHER) { if (last && has_next) { S.goffs(nxt, tid, 0, g0, g1); S.goffs(nxt, tid, 1, g2, g3); } }
            PG8_WAIT_V(8); PG8_WAIT_L(0); PG8_BAR; PG8_MMA(0, 0, At, B0); PG8_MMA(0, 1, At, B1); PG8_BAR; PG8_SCHED;
            PG8_LDA(At, 0, 1); PG8_STAGEB(PG8_SB(0, 0), b2); PG8_STAGEB(PG8_SB(0, 1), b2 + hstep); PG8_STAGEA(PG8_SA(0, 0), a2, 0);
            PG8_WAIT_V(8); PG8_WAIT_L(0); PG8_BAR; PG8_MMA(1, 0, At, B0); PG8_MMA(1, 1, At, B1); PG8_BAR; PG8_SCHED;
            PG8_LDB(B0, 1, 0); PG8_LDB(B1, 1, 1); PG8_SCHED; PG8_LDA(At, 1, 0); PG8_STAGEA(PG8_SA(0, 1), a2, 1);
            PG8_WAIT_V(8); PG8_WAIT_L(0); PG8_BAR; PG8_MMA(0, 0, At, B0); PG8_MMA(0, 1, At, B1); PG8_BAR; PG8_SCHED;
            PG8_LDA(At, 1, 1); PG8_STAGEB(PG8_SB(1, 0), b3); PG8_STAGEB(PG8_SB(1, 1), b3 + hstep); PG8_STAGEA(PG8_SA(1, 0), a3, 0);
            PG8_WAIT_V(8); PG8_WAIT_L(0); PG8_BAR; PG8_MMA(1, 0, At, B0); PG8_MMA(1, 1, At, B1); PG8_BAR; PG8_SCHED;
        }
#ifdef PROBE_G
        if (pws && ui == 2) GSTAMP(pws, tid, pslot + 2);
#endif
        if (wr == 0) PG8_BAR;
        { int efr = fr, efq = fq; asm volatile("" : "+v"(efr), "+v"(efq));
          E(acc, cur, wr, wc, efr, efq, lds + META_OFF + (ui & 1) * META_BYTES); }
#ifdef PROBE_G
        if (pws && ui == 2) GSTAMP(pws, tid, pslot + 3);
        if (pws && ui == 3) GSTAMP(pws, tid, pslot + 4);
#endif
        if (!has_next) break;
#pragma unroll
        for (int a = 0; a < 2; ++a)
#pragma unroll
            for (int b = 0; b < 2; ++b)
#pragma unroll
                for (int m = 0; m < 4; ++m)
#pragma unroll
                    for (int n = 0; n < 2; ++n) acc[a][b][m][n] = (f32x4){0.f, 0.f, 0.f, 0.f};
        cur = nxt; cB = nB; cA = nA; ++ui;
        if (wr == 1) PG8_BAR;
    }
    PG8_WAIT_V(0);
    PG8_BAR;
#undef PG8_SA
#undef PG8_SB
#undef PG8_STAGEA
#undef PG8_STAGEB
#undef PG8_RD
#undef PG8_CAT
#undef PG8_LDA
#undef PG8_LDB
#undef PG8_MMA
#undef PG8_WAIT_V
#undef PG8_WAIT_L
#undef PG8_BAR
#undef PG8_SCHED
}
struct TileOrder {
    int nM, nN, nwg, G, c;
    __device__ __forceinline__ void init(int nM_, int nN_, int G_, int c_) { nM = nM_; nN = nN_; nwg = nM * nN; G = G_; c = c_; }
    __device__ __forceinline__ bool tile(int i, int& pm, int& pn) const {
        const long L = (long)i * G + c; if (L >= nwg) return false;
        int wgid = (int)L; { const int q = nwg / 8, r = nwg % 8, xcd = wgid % 8, off = wgid / 8; wgid = (xcd < r ? xcd * (q + 1) : r * (q + 1) + (xcd - r) * q) + off; }
        const int nig = 8 * nN, gid = wgid / nig, fm = gid * 8, gsz = (nM - fm) < 8 ? (nM - fm) : 8;
        pm = fm + ((wgid % nig) % gsz); pn = (wgid % nig) / gsz; return true;
    }
};
}

struct DenseSched {
    pg8::TileOrder o; const char* A; const char* Bt; int pitch;
    __device__ __forceinline__ bool next(int i, pg8::Unit& u) const { int pm, pn; if (!o.tile(i, pm, pn)) return false; u.i0 = pm; u.i1 = pn; u.i2 = 0; u.i3 = 0; u.i4 = 0;
        u.a = A + (size_t)pm * 256 * pitch; u.b = Bt + (size_t)pn * 256 * pitch; return true; }
    __device__ __forceinline__ void goffs(const pg8::Unit&, int, int, unsigned&, unsigned&) const {}
    static constexpr bool HAS_META = false;
    __device__ __forceinline__ void meta_issue(const pg8::Unit&, unsigned, int, int) const {}
};
struct EpiInProj {
    static constexpr bool PERM = true;
    bf16_t* PROJ;
    __device__ __forceinline__ void operator()(const f32x4 (&acc)[2][2][4][2], const pg8::Unit& u, int wr, int wc, int fr, int fq, const LAS unsigned char*) const {
        const int row0 = u.i0 * 256 + wr * 64 + fr, col0 = u.i1 * 256 + wc * 32 + 8 * fq;
#pragma unroll
        for (int ai = 0; ai < 2; ++ai)
#pragma unroll
            for (int m = 0; m < 4; ++m) { bf16_t* rowp = PROJ + (size_t)(row0 + ai * 128 + m * 16) * NPROJ + col0;
#pragma unroll
                for (int bj = 0; bj < 2; ++bj) { const f32x4 v0 = acc[ai][bj][m][0], v1 = acc[ai][bj][m][1];
                    u32x4 w; w.x = pk2(v0[0], v0[1]); w.y = pk2(v0[2], v0[3]); w.z = pk2(v1[0], v1[1]); w.w = pk2(v1[2], v1[3]);
                    *(u32x4*)(rowp + bj * 128) = w; } }
    }
};
struct EpiOutProj {
    static constexpr bool PERM = true;
    const float* X; bf16_t* HB;
    __device__ __forceinline__ void operator()(const f32x4 (&acc)[2][2][4][2], const pg8::Unit& u, int wr, int wc, int fr, int fq, const LAS unsigned char*) const {
        const int row0 = u.i0 * 256 + wr * 64 + fr, col0 = u.i1 * 256 + wc * 32 + 8 * fq;
#pragma unroll
        for (int ai = 0; ai < 2; ++ai)
#pragma unroll
            for (int m = 0; m < 4; ++m) { const size_t off = (size_t)(row0 + ai * 128 + m * 16) * D + col0;
#pragma unroll
                for (int bj = 0; bj < 2; ++bj) { const f32x4 x0 = *(const f32x4*)(X + off + bj * 128), x1 = *(const f32x4*)(X + off + bj * 128 + 4);
                    const f32x4 v0 = x0 + acc[ai][bj][m][0], v1 = x1 + acc[ai][bj][m][1];
                    u32x4 w; w.x = pk2(v0[0], v0[1]); w.y = pk2(v0[2], v0[3]); w.z = pk2(v1[0], v1[1]); w.w = pk2(v1[2], v1[3]);
                    *(u32x4*)(HB + off + bj * 128) = w; }
                asm volatile("" ::: "memory"); }
    }
};

constexpr int LDS_MOE_TAB = 131072;
template <bool GATHER, int NT  , int NROWS  >
struct MoeSched {
    const unsigned* cnt; const i32x4* ENT; const char* A; const char* Bt; LAS unsigned char* lds; int lo, hi, G, c, tot;
    __device__ __forceinline__ int cnt_s(int e) const { return __builtin_amdgcn_readfirstlane((int)cnt[e]); }
    __device__ __forceinline__ int tab(int i) const { return __builtin_amdgcn_readfirstlane(*(volatile LAS int*)(lds + LDS_MOE_TAB + 4 * i)); }
    __device__ __forceinline__ void init_tot(int tid) {
        if (tid == 0) { int t = 0; for (int e = lo; e < hi; ++e) { const int ce = (int)cnt[e], te = (ce + 255) >> 8; *(volatile LAS int*)(lds + LDS_MOE_TAB + 4 * (e - lo)) = t; *(volatile LAS int*)(lds + LDS_MOE_TAB + 4 * (64 + e - lo)) = te;
                *(volatile LAS int*)(lds + LDS_MOE_TAB + 4 * (128 + e - lo)) = ce; t += te; }
            *(volatile LAS int*)(lds + LDS_MOE_TAB + 4 * (hi - lo)) = t; }
        __syncthreads();
        tot = tab(hi - lo) * NT;
    }
    __device__ __forceinline__ bool next(int i, pg8::Unit& u) const {
        const int L = i * G + c; if (L >= tot) return false;
        int W; { const int q = tot / 8, r = tot % 8, xcd = L % 8, off = L / 8; W = (xcd < r ? xcd * (q + 1) : r * (q + 1) + (xcd - r) * q) + off; }
        int a = 0, b = hi - lo;
        while (b - a > 1) { const int m = (a + b) >> 1; if (tab(m) * NT <= W) a = m; else b = m; }
        const int pre = tab(a), te = tab(64 + a); W -= pre * NT;
        constexpr int nig = 8 * NT; const int gid = W / nig, fm = gid * 8, gsz = (te - fm) < 8 ? (te - fm) : 8; int j = W - gid * nig, n = 0;
        while (j >= gsz) { j -= gsz; ++n; }
        u.i0 = lo + a; u.i1 = fm + j; u.i2 = n; u.i3 = pre * 256; u.i4 = tab(128 + a);
        u.b = Bt + ((size_t)u.i0 * NROWS + (size_t)u.i2 * 256) * 1024; u.a = A + (size_t)(u.i3 + u.i1 * 256) * 1024;
        return true;
    }
    static constexpr bool HAS_META = true;
    const float* bias;
    __device__ __forceinline__ void meta_issue(const pg8::Unit& u, unsigned ldsa, int wid, int lane) const {
        if (wid < 4) { const unsigned voff = (unsigned)(((unsigned)u.i0 * (unsigned)T + (unsigned)(u.i1 * 256 + 64 * wid + lane)) * 16u); PG8_GLDS1(ldsa + 1024u * (unsigned)wid, (const char*)ENT, voff); }
        else if (wid == 4) { unsigned voff;
            if constexpr (GATHER) voff = (unsigned)((u.i0 * 2048 + (lane < 32 ? 128 * u.i2 + 4 * lane : 1024 + 128 * u.i2 + 4 * (lane - 32))) * 4);
            else voff = (unsigned)((u.i0 * 1024 + 256 * u.i2 + 4 * lane) * 4);
            PG8_GLDS1(ldsa + 4096u, (const char*)bias, voff); }
    }
    __device__ __forceinline__ void goffs(const pg8::Unit& u, int tid, int h, unsigned& o0, unsigned& o1) const {
        if constexpr (GATHER) { int R0, C0; pg8::stage_rc(tid * 16, R0, C0);
            const int ce = u.i4, p0 = u.i1 * 256 + h * 128 + R0; const i32x4* en = ENT + (size_t)u.i0 * T;
            const int t0 = p0 < ce ? en[p0].x : 0, t1 = p0 + 64 < ce ? en[p0 + 64].x : 0;
            o0 = (unsigned)t0 * 1024u + 2u * C0; o1 = (unsigned)t1 * 1024u + 2u * C0; }
    }
};
struct EpiG1 {
    static constexpr bool PERM = true;
    unsigned char* HID;
    __device__ __forceinline__ void operator()(const f32x4 (&acc)[2][2][4][2], const pg8::Unit& u, int wr, int wc, int fr, int fq, const LAS unsigned char* meta) const {
        const int ce = u.i4, hc = u.i2 * 128 + wc * 32 + 8 * fq;
        float rs[8];
#pragma unroll
        for (int q = 0; q < 8; ++q) { const int rl = (q >> 2) * 128 + wr * 64 + (q & 3) * 16 + fr; const float r = *(const LAS float*)(meta + 16 * rl + 4); rs[q] = u.i1 * 256 + rl < ce ? r * (1.0f / (SC_H * SC_W)) : 0.f; }
        const LAS float* bl = (const LAS float*)(meta + 4096) + wc * 32 + 8 * fq;
        const f32x4 bg0 = *(const LAS f32x4*)bl, bg1 = *(const LAS f32x4*)(bl + 4), bu0 = *(const LAS f32x4*)(bl + 128), bu1 = *(const LAS f32x4*)(bl + 132);
#pragma unroll
        for (int ai = 0; ai < 2; ++ai)
#pragma unroll
            for (int m = 0; m < 4; ++m) { const int pos = u.i1 * 256 + ai * 128 + wr * 64 + m * 16 + fr;
                const float rstd = rs[ai * 4 + m];
                float hv[8];
#pragma unroll
                for (int q = 0; q < 8; ++q) { const int n = q >> 2, j = q & 3; float g = acc[ai][0][m][n][j] * rstd + (n ? bg1[j] : bg0[j]), up = acc[ai][1][m][n][j] * rstd + (n ? bu1[j] : bu0[j]);
                    g = fminf(g, 7.0f); up = fminf(fmaxf(up, -7.0f), 7.0f); hv[q] = (up + 1.0f) * g * sigmoidf_(1.702f * g) * SC_HID; }
                u32x2 w; w.x = pk4_fp8(hv[0], hv[1], hv[2], hv[3]); w.y = pk4_fp8(hv[4], hv[5], hv[6], hv[7]);
                *(u32x2*)(HID + (size_t)(u.i3 + pos) * DFF + hc) = w; }
    }
};
struct EpiG2 {
    static constexpr bool PERM = true;
    unsigned char* OUT01; unsigned char* Y23;
    __device__ __forceinline__ void operator()(const f32x4 (&acc)[2][2][4][2], const pg8::Unit& u, int wr, int wc, int fr, int fq, const LAS unsigned char* meta) const {
        const int ce = u.i4, col0 = u.i2 * 256 + wc * 32 + 8 * fq;
        int tk[8], kk[8]; float gt[8];
#pragma unroll
        for (int q = 0; q < 8; ++q) { const int rl = (q >> 2) * 128 + wr * 64 + (q & 3) * 16 + fr; const i32x4 v = *(const LAS i32x4*)(meta + 16 * rl);
            tk[q] = u.i1 * 256 + rl < ce ? v.x : -1; kk[q] = v.z; gt[q] = __int_as_float(v.w) * SC_Y; }
        const LAS float* bl = (const LAS float*)(meta + 4096) + wc * 32 + 8 * fq;
        f32x4 b[2][2];
#pragma unroll
        for (int bj = 0; bj < 2; ++bj) { b[bj][0] = *(const LAS f32x4*)(bl + bj * 128); b[bj][1] = *(const LAS f32x4*)(bl + bj * 128 + 4); }
#pragma unroll
        for (int ai = 0; ai < 2; ++ai)
#pragma unroll
            for (int m = 0; m < 4; ++m) { const int q = ai * 4 + m;
                if (tk[q] >= 0) { const float gate = gt[q];
                    unsigned char* dst = (kk[q] < 2 ? OUT01 + (size_t)tk[q] * 4096 : Y23 + (size_t)tk[q] * 2048) + (kk[q] & 1) * 1024 + col0;
#pragma unroll
                    for (int bj = 0; bj < 2; ++bj) { const f32x4 y0 = (acc[ai][bj][m][0] * (1.0f / (SC_HID * SC_W)) + b[bj][0]) * gate, y1 = (acc[ai][bj][m][1] * (1.0f / (SC_HID * SC_W)) + b[bj][1]) * gate;
                        u32x2 w; w.x = pk4_fp8(clamp448(y0[0]), clamp448(y0[1]), clamp448(y0[2]), clamp448(y0[3])); w.y = pk4_fp8(clamp448(y1[0]), clamp448(y1[1]), clamp448(y1[2]), clamp448(y1[3]));
                        *(u32x2*)(dst + bj * 128) = w; } } }
    }
};

#define LDS_BARRIER() do { asm volatile("s_waitcnt lgkmcnt(0)" ::: "memory"); __builtin_amdgcn_s_barrier(); asm volatile("" ::: "memory"); } while (0)
constexpr int ML_QS = 0, ML_KS = 17408, ML_VS = 34816, ML_PS = 52224, ML_CT = 61440, ML_DENP = 96256, ML_DI = 96768, ML_SSQP = 97024, ML_NARR = 99072, ML_FLA = 99584, ML_END = 99840;
__device__ __forceinline__ bf16x8 tr_pair(unsigned a0, unsigned a1) {
    u32x2 lo, hi; asm volatile("ds_read_b64_tr_b16 %0, %2\n\tds_read_b64_tr_b16 %1, %3\n\ts_waitcnt lgkmcnt(0)" : "=&v"(lo), "=&v"(hi) : "v"(a0), "v"(a1) : "memory");
    u32x4 r; r.x = lo.x; r.y = lo.y; r.z = hi.x; r.w = hi.y; return __builtin_bit_cast(bf16x8, r);
}
#define TR8(dst, base, OFF0, STEP) do { u32x2 _l[8], _h[8]; \
    asm volatile("ds_read_b64_tr_b16 %0, %16 offset:%17\n\tds_read_b64_tr_b16 %1, %16 offset:%17+1088\n\tds_read_b64_tr_b16 %2, %16 offset:%17+%18\n\tds_read_b64_tr_b16 %3, %16 offset:%17+%18+1088\n\t" \
                 "ds_read_b64_tr_b16 %4, %16 offset:%17+2*%18\n\tds_read_b64_tr_b16 %5, %16 offset:%17+2*%18+1088\n\tds_read_b64_tr_b16 %6, %16 offset:%17+3*%18\n\tds_read_b64_tr_b16 %7, %16 offset:%17+3*%18+1088\n\t" \
                 "ds_read_b64_tr_b16 %8, %16 offset:%17+4*%18\n\tds_read_b64_tr_b16 %9, %16 offset:%17+4*%18+1088\n\tds_read_b64_tr_b16 %10, %16 offset:%17+5*%18\n\tds_read_b64_tr_b16 %11, %16 offset:%17+5*%18+1088\n\t" \
                 "ds_read_b64_tr_b16 %12, %16 offset:%17+6*%18\n\tds_read_b64_tr_b16 %13, %16 offset:%17+6*%18+1088\n\tds_read_b64_tr_b16 %14, %16 offset:%17+7*%18\n\tds_read_b64_tr_b16 %15, %16 offset:%17+7*%18+1088\n\ts_waitcnt lgkmcnt(0)" \
                 : "=&v"(_l[0]), "=&v"(_h[0]), "=&v"(_l[1]), "=&v"(_h[1]), "=&v"(_l[2]), "=&v"(_h[2]), "=&v"(_l[3]), "=&v"(_h[3]), "=&v"(_l[4]), "=&v"(_h[4]), "=&v"(_l[5]), "=&v"(_h[5]), "=&v"(_l[6]), "=&v"(_h[6]), "=&v"(_l[7]), "=&v"(_h[7]) \
                 : "v"(base), "i"(OFF0), "i"(STEP) : "memory"); \
    _Pragma("unroll") for (int _p = 0; _p < 8; ++_p) { u32x4 _r; _r.x = _l[_p].x; _r.y = _l[_p].y; _r.z = _h[_p].x; _r.w = _h[_p].y; dst[_p] = __builtin_bit_cast(bf16x8, _r); } } while (0)
__device__ __forceinline__ float wave_scan_add(float s) {
    s += dpp_x<0x111, 0xf>(s, 0.f); s += dpp_x<0x112, 0xf>(s, 0.f); s += dpp_x<0x114, 0xf>(s, 0.f); s += dpp_x<0x118, 0xf>(s, 0.f);
    s += dpp_x<0x142, 0xa>(s, 0.f); s += dpp_x<0x143, 0xc>(s, 0.f); return s;
}
__device__ __forceinline__ float wave_scan_max(float s) {
    const float ni = -INFINITY;
    s = fmaxf(s, dpp_x<0x111, 0xf>(s, ni)); s = fmaxf(s, dpp_x<0x112, 0xf>(s, ni)); s = fmaxf(s, dpp_x<0x114, 0xf>(s, ni)); s = fmaxf(s, dpp_x<0x118, 0xf>(s, ni));
    s = fmaxf(s, dpp_x<0x142, 0xa>(s, ni)); s = fmaxf(s, dpp_x<0x143, 0xc>(s, ni)); return s;
}
__device__ __forceinline__ void unpack16(const u32x4& a, const u32x4& b, float (&f)[16]) {
    const unsigned w[8] = {a.x, a.y, a.z, a.w, b.x, b.y, b.z, b.w};
#pragma unroll
    for (int i = 0; i < 8; ++i) { f[2 * i] = bflo(w[i]); f[2 * i + 1] = bfhi(w[i]); }
}
__device__ __forceinline__ void mlstm_phase(const PV& p, LAS unsigned char* lds, int bh) {
    const int tid = get_tid(lds);
    const int lane = tid & 63, w = __builtin_amdgcn_readfirstlane(tid >> 6), fr = lane & 15, fq = lane >> 4, tq = (lane & 15) >> 2, tp = lane & 3;
    const int b = bh >> 2, h = bh & 3, srow = tid >> 3, sseg = tid & 7;
    const bf16_t* PROJ = (const bf16_t*)(p.ws() + WS_R2); const float* GATES = (const float*)(p.ws() + WS_GATES); bf16_t* MIX = (bf16_t*)(p.ws() + WS_R1);
    LAS float* DENP = (LAS float*)(lds + ML_DENP); LAS float* DI = (LAS float*)(lds + ML_DI); LAS float* SSQP = (LAS float*)(lds + ML_SSQP); LAS float* NARR = (LAS float*)(lds + ML_NARR);
    const unsigned ldsb = (unsigned)(size_t)lds;
    for (int i = tid; i < 34816 / 16; i += 512) *(LAS u32x4*)(lds + ML_CT + 16 * i) = (u32x4){0u, 0u, 0u, 0u};
    if (tid < 128) NARR[tid] = 0.f;
    f32x4 c3[8];
#pragma unroll
    for (int i = 0; i < 8; ++i) c3[i] = (f32x4){0.f, 0.f, 0.f, 0.f};
    f32x4 nacc = (f32x4){0.f, 0.f, 0.f, 0.f}; float mprev = 0.f;
    bf16x8 ones;
#pragma unroll
    for (int jj = 0; jj < 8; ++jj) ones[jj] = (short)0x3F80;
    float ig = GATES[((size_t)b * SEQ + lane) * 8 + h], lf = GATES[((size_t)b * SEQ + lane) * 8 + 4 + h];
    u32x4 rq0, rq1, rk0, rk1, rv0, rv1;
    u32x2 pend[4]; size_t prow0 = 0; bool have_pend = false;
    { const bf16_t* pr = PROJ + ((size_t)b * SEQ + srow) * NPROJ + h * 128 + 16 * sseg;
      rq0 = *(const u32x4*)pr; rq1 = *(const u32x4*)(pr + 8); rk0 = *(const u32x4*)(pr + 512); rk1 = *(const u32x4*)(pr + 520); rv0 = *(const u32x4*)(pr + 1024); rv1 = *(const u32x4*)(pr + 1032); }
    __syncthreads();
    for (int c = 0; c < SEQ / 64; ++c) {
        const size_t row0 = (size_t)b * SEQ + (size_t)c * 64;
        if (c == 10) GSTAMP(p.ws(), tid, 20);
        u32x2 og[4];
#pragma unroll
        for (int ti = 0; ti < 4; ++ti) og[ti] = *(const u32x2*)(PROJ + (row0 + 16 * ti + fr) * NPROJ + 1536 + h * 128 + 16 * w + 4 * fq);
        const float bc = wave_scan_add(lf), u = ig - bc, cm = wave_scan_max(u);
        const float Mt = fmaxf(cm, mprev), M63 = __builtin_bit_cast(float, __builtin_amdgcn_readlane(__builtin_bit_cast(int, Mt), 63)), bL = __builtin_bit_cast(float, __builtin_amdgcn_readlane(__builtin_bit_cast(int, bc), 63));
        if (c + 1 < SEQ / 64) { ig = GATES[(row0 + 64 + lane) * 8 + h]; lf = GATES[(row0 + 64 + lane) * 8 + 4 + h]; }
        const float sq = fexp(M63 - Mt), sk = fexp(u - M63), fl = fexp(-bc - Mt), decay = fexp(mprev - M63);
        mprev = bL + M63;
        { const float sqv = __shfl(sq, srow), skv = __shfl(sk, srow);
          float f[16]; unpack16(rq0, rq1, f);
          float part = 0.f;
#pragma unroll
          for (int j = 0; j < 16; ++j) { f[j] *= sqv; part += f[j] * NARR[16 * sseg + j]; }
          part += dpp_x<0x101, 0xf>(part, 0.f); part += dpp_x<0x102, 0xf>(part, 0.f); part += dpp_x<0x104, 0xf>(part, 0.f);
          if (sseg == 0) DI[srow] = decay * part;
          if (w == 0) ((LAS float*)(lds + ML_FLA))[lane] = fl;
          u32x4 o0, o1; o0.x = pk2(f[0], f[1]); o0.y = pk2(f[2], f[3]); o0.z = pk2(f[4], f[5]); o0.w = pk2(f[6], f[7]); o1.x = pk2(f[8], f[9]); o1.y = pk2(f[10], f[11]); o1.z = pk2(f[12], f[13]); o1.w = pk2(f[14], f[15]);
          *(LAS u32x4*)(lds + ML_QS + srow * 272 + sseg * 32) = o0; *(LAS u32x4*)(lds + ML_QS + srow * 272 + sseg * 32 + 16) = o1;
          unpack16(rk0, rk1, f);
#pragma unroll
          for (int j = 0; j < 16; ++j) f[j] *= skv;
          o0.x = pk2(f[0], f[1]); o0.y = pk2(f[2], f[3]); o0.z = pk2(f[4], f[5]); o0.w = pk2(f[6], f[7]); o1.x = pk2(f[8], f[9]); o1.y = pk2(f[10], f[11]); o1.z = pk2(f[12], f[13]); o1.w = pk2(f[14], f[15]);
          *(LAS u32x4*)(lds + ML_KS + srow * 272 + sseg * 32) = o0; *(LAS u32x4*)(lds + ML_KS + srow * 272 + sseg * 32 + 16) = o1;
          *(LAS u32x4*)(lds + ML_VS + srow * 272 + sseg * 32) = rv0; *(LAS u32x4*)(lds + ML_VS + srow * 272 + sseg * 32 + 16) = rv1; }
        if (c + 1 < SEQ / 64) { const bf16_t* pr = PROJ + (row0 + 64 + srow) * NPROJ + h * 128 + 16 * sseg;
          rq0 = *(const u32x4*)pr; rq1 = *(const u32x4*)(pr + 8); rk0 = *(const u32x4*)(pr + 512); rk1 = *(const u32x4*)(pr + 520); rv0 = *(const u32x4*)(pr + 1024); rv1 = *(const u32x4*)(pr + 1032); }
        if (c == 10) GSTAMP(p.ws(), tid, 21);
        LDS_BARRIER();
        if (have_pend) {
#pragma unroll
            for (int ti = 0; ti < 4; ++ti) *(u32x2*)(MIX + (prow0 + 16 * ti + fr) * D + h * 128 + 16 * w + 4 * fq) = pend[ti]; }
        if (c == 10) GSTAMP(p.ws(), tid, 22);
        { const int ti = w >> 1; float dsum = 0.f;
          bf16x8 qf[4], kf[2][4];
#pragma unroll
          for (int ks = 0; ks < 4; ++ks) { qf[ks] = *(const LAS bf16x8*)(lds + ML_QS + (16 * ti + fr) * 272 + (32 * ks + 8 * fq) * 2);
#pragma unroll
              for (int jj = 0; jj < 2; ++jj) kf[jj][ks] = *(const LAS bf16x8*)(lds + ML_KS + (16 * (2 * (w & 1) + jj) + fr) * 272 + (32 * ks + 8 * fq) * 2); }
          __builtin_amdgcn_sched_barrier(0);
#pragma unroll
          for (int jj = 0; jj < 2; ++jj) { const int sj = 2 * (w & 1) + jj;
            f32x4 a = (f32x4){0.f, 0.f, 0.f, 0.f};
            if (sj <= ti) {
#pragma unroll
                for (int ks = 0; ks < 4; ++ks) a = __builtin_amdgcn_mfma_f32_16x16x32_bf16(kf[jj][ks], qf[ks], a, 0, 0, 0);
                const int t = 16 * ti + fr, s0 = 16 * sj + 4 * fq;
#pragma unroll
                for (int r = 0; r < 4; ++r) { if (s0 + r > t) a[r] = 0.f; dsum += a[r]; }
            }
            u32x2 pw; pw.x = pk2(a[0], a[1]); pw.y = pk2(a[2], a[3]);
            *(LAS u32x2*)(lds + ML_PS + (16 * ti + fr) * 144 + (16 * sj + 4 * fq) * 2) = pw; }
          dsum += __shfl_xor(dsum, 16); dsum += __shfl_xor(dsum, 32);
          if (fq == 0) DENP[(w & 1) * 64 + 16 * ti + fr] = dsum; }
        if (c == 10) GSTAMP(p.ws(), tid, 23);
        LDS_BARRIER();
        if (c == 10) GSTAMP(p.ws(), tid, 24);
        bf16x8 av[2];
        { u32x2 l0, h0, l1, h1; const unsigned a0 = ldsb + ML_VS + (8 * fq + tq) * 272 + (16 * w + 4 * tp) * 2;
          asm volatile("ds_read_b64_tr_b16 %0, %4\n\tds_read_b64_tr_b16 %1, %4 offset:1088\n\tds_read_b64_tr_b16 %2, %4 offset:8704\n\tds_read_b64_tr_b16 %3, %4 offset:9792\n\ts_waitcnt lgkmcnt(0)"
                       : "=&v"(l0), "=&v"(h0), "=&v"(l1), "=&v"(h1) : "v"(a0) : "memory");
          u32x4 r; r.x = l0.x; r.y = l0.y; r.z = h0.x; r.w = h0.y; av[0] = __builtin_bit_cast(bf16x8, r); r.x = l1.x; r.y = l1.y; r.z = h1.x; r.w = h1.y; av[1] = __builtin_bit_cast(bf16x8, r); }
        bf16x8 ac[4];
#pragma unroll
        for (int ks = 0; ks < 4; ++ks) ac[ks] = *(const LAS bf16x8*)(lds + ML_CT + (16 * w + fr) * 272 + (32 * ks + 8 * fq) * 2);
        float xs[4][4], ssq[4];
#pragma unroll
        for (int hh = 0; hh < 2; ++hh) {
            bf16x8 pb[2][2], qb[2][4]; float dn[2], fv[2];
#pragma unroll
            for (int q = 0; q < 2; ++q) { const int ti = 2 * hh + q, t = 16 * ti + fr;
#pragma unroll
                for (int ks = 0; ks < 2; ++ks) pb[q][ks] = *(const LAS bf16x8*)(lds + ML_PS + t * 144 + (32 * ks + 8 * fq) * 2);
#pragma unroll
                for (int ks = 0; ks < 4; ++ks) qb[q][ks] = *(const LAS bf16x8*)(lds + ML_QS + t * 272 + (32 * ks + 8 * fq) * 2);
                dn[q] = DENP[t] + DENP[64 + t] + DI[t]; fv[q] = ((const LAS float*)(lds + ML_FLA))[t]; }
            __builtin_amdgcn_sched_barrier(0);
#pragma unroll
            for (int q = 0; q < 2; ++q) { const int ti = 2 * hh + q; f32x4 a = (f32x4){0.f, 0.f, 0.f, 0.f}, a2 = (f32x4){0.f, 0.f, 0.f, 0.f};
#pragma unroll
                for (int ks = 0; ks < 2; ++ks) a = __builtin_amdgcn_mfma_f32_16x16x32_bf16(av[ks], pb[q][ks], a, 0, 0, 0);
#pragma unroll
                for (int ks = 0; ks < 4; ++ks) a2 = __builtin_amdgcn_mfma_f32_16x16x32_bf16(ac[ks], qb[q][ks], a2, 0, 0, 0);
                a = a + a2 * decay;
                const float inv = frcp(fmaxf(fabsf(dn[q]), fv[q]));
                xs[ti][0] = sigmoidf_(bflo(og[ti].x)) * a[0] * inv; xs[ti][1] = sigmoidf_(bfhi(og[ti].x)) * a[1] * inv; xs[ti][2] = sigmoidf_(bflo(og[ti].y)) * a[2] * inv; xs[ti][3] = sigmoidf_(bfhi(og[ti].y)) * a[3] * inv;
                ssq[ti] = xs[ti][0] * xs[ti][0] + xs[ti][1] * xs[ti][1] + xs[ti][2] * xs[ti][2] + xs[ti][3] * xs[ti][3]; } }
#pragma unroll
        for (int ti = 0; ti < 4; ++ti) ssq[ti] += __shfl_xor(ssq[ti], 16);
#pragma unroll
        for (int ti = 0; ti < 4; ++ti) ssq[ti] += __shfl_xor(ssq[ti], 32);
        if (fq == 0) {
#pragma unroll
            for (int ti = 0; ti < 4; ++ti) SSQP[w * 64 + 16 * ti + fr] = ssq[ti]; }
        { const unsigned kb = ldsb + ML_KS + (8 * fq + tq) * 272 + 4 * tp * 2;
          bf16x8 k0[8], k1[8];
          TR8(k0, kb, 0, 32); TR8(k1, kb, 8704, 32);
#pragma unroll
          for (int i = 0; i < 8; ++i) { c3[i] = c3[i] * decay;
              c3[i] = __builtin_amdgcn_mfma_f32_16x16x32_bf16(k0[i], av[0], c3[i], 0, 0, 0); c3[i] = __builtin_amdgcn_mfma_f32_16x16x32_bf16(k1[i], av[1], c3[i], 0, 0, 0);
              if (i == w) { nacc = nacc * decay; nacc = __builtin_amdgcn_mfma_f32_16x16x32_bf16(k0[i], ones, nacc, 0, 0, 0); nacc = __builtin_amdgcn_mfma_f32_16x16x32_bf16(k1[i], ones, nacc, 0, 0, 0); } }
          if (fr == 0) *(LAS f32x4*)(NARR + 16 * w + 4 * fq) = nacc; }
        if (c == 10) GSTAMP(p.ws(), tid, 25);
        LDS_BARRIER();
        if (c == 10) GSTAMP(p.ws(), tid, 26);
        if (c == 11) GSTAMP(p.ws(), tid, 27);
#pragma unroll
        for (int ti = 0; ti < 4; ++ti) { const int t = 16 * ti + fr; float s = 0.f;
#pragma unroll
            for (int ww = 0; ww < 8; ++ww) s += SSQP[ww * 64 + t];
            const float rs = frsq(s * (1.0f / 128.f) + EPS);
            pend[ti].x = pk2(xs[ti][0] * rs, xs[ti][1] * rs); pend[ti].y = pk2(xs[ti][2] * rs, xs[ti][3] * rs); }
        prow0 = row0; have_pend = true;
#pragma unroll
        for (int i = 0; i < 8; ++i) { u32x2 cw; cw.x = pk2(c3[i][0], c3[i][1]); cw.y = pk2(c3[i][2], c3[i][3]);
            *(LAS u32x2*)(lds + ML_CT + (16 * w + fr) * 272 + (16 * i + 4 * fq) * 2) = cw; }
    }
#pragma unroll
    for (int ti = 0; ti < 4; ++ti) *(u32x2*)(MIX + (prow0 + 16 * ti + fr) * D + h * 128 + 16 * w + 4 * fq) = pend[ti];
    __syncthreads();
}


constexpr int RL_XC = 0, RL_RG = 34816, RL_OUT = 69632, RL_CW = 104448, RL_CARRY = 114688, RL_SSQP = 116736, RL_END = 124928;
template <int S> __device__ __forceinline__ float dpp_shr(float v, float ident) {
    return __builtin_bit_cast(float, __builtin_amdgcn_update_dpp(__builtin_bit_cast(int, ident), __builtin_bit_cast(int, v), 0x110 + S, 0xf, 0xf, false));
}
__device__ __forceinline__ float row_last(float v) { return __builtin_bit_cast(float, __builtin_amdgcn_ds_swizzle(__builtin_bit_cast(int, v), 0x1F0)); }
template <bool FINAL>
__device__ __forceinline__ void rglru_item(const PV& p, LAS unsigned char* lds, int item) {
    const int tid = get_tid(lds);
    const int lane = tid & 63, w = __builtin_amdgcn_readfirstlane(tid >> 6), fr = lane & 15, fq = lane >> 4, srow = tid >> 3, sseg = tid & 7;
    const int b = item >> 4, chunk = item & 15;
    const bf16_t* PROJ = (const bf16_t*)(p.ws() + WS_R2); bf16_t* MIX = (bf16_t*)(p.ws() + WS_R1); float* SUMM = (float*)(p.ws() + WS_SUMM); const bf16_t* WRI = (const bf16_t*)(p.ws() + WS_WRI);
    LAS float* CW = (LAS float*)(lds + RL_CW); LAS float* CARRY = (LAS float*)(lds + RL_CARRY); LAS float* SSQP = (LAS float*)(lds + RL_SSQP);
    const size_t tok0 = (size_t)b * SEQ + (size_t)chunk * 256;
    if (FINAL) GSTAMP(p.ws(), tid, 0);
    for (int i = tid; i < 2560; i += 512) CW[i] = i < 2048 ? p.in(I_CW)[i] : p.in(I_CB)[i - 2048];
    if (FINAL) {
        float carry = 0.f;
        for (int cc = 0; cc < chunk; ++cc) { const float2 ab = *(const float2*)(SUMM + ((size_t)(b * 16 + cc) * 512 + tid) * 2); carry = ab.x * carry + ab.y; }
        CARRY[tid] = carry;
        for (int i = tid; i < 2048; i += 512) SSQP[i] = 0.f;
    }
    u32x4 rx[8], rgr[2];
    auto prefetch = [&](int sidx) {
        const int hd = sidx >> 2, step = sidx & 3; const int tl = step * 64 + srow; const size_t tok = tok0 + tl; const int tseq = chunk * 256 + tl;
        const bf16_t* px = PROJ + tok * NPROJ + 2048 + hd * 128 + 16 * sseg;
#pragma unroll
        for (int j = 0; j < 4; ++j) { if (tseq - 3 + j >= 0) { rx[2 * j] = *(const u32x4*)(px + (ptrdiff_t)(j - 3) * NPROJ); rx[2 * j + 1] = *(const u32x4*)(px + (ptrdiff_t)(j - 3) * NPROJ + 8); } else { rx[2 * j] = (u32x4){0u, 0u, 0u, 0u}; rx[2 * j + 1] = (u32x4){0u, 0u, 0u, 0u}; } }
        if (FINAL) { rgr[0] = *(const u32x4*)(px + 512); rgr[1] = *(const u32x4*)(px + 520); }
    };
    prefetch(0);
    __syncthreads();
    if (FINAL) GSTAMP(p.ws(), tid, 1);
    float hc[4], ptot[4], brv[4], biv[4], spv[4];
    bf16x8 br[4], bi[4], bid;
    for (int sidx = 0; sidx < 16; ++sidx) {
        const int hd = sidx >> 2, step = sidx & 3, buf = sidx & 1;
        if (step == 0) {
#pragma unroll
            for (int ks = 0; ks < 4; ++ks) { br[ks] = *(const bf16x8*)(WRI + ((size_t)(hd * 256 + 16 * w + fr) * 128 + 32 * ks + 8 * fq)); bi[ks] = *(const bf16x8*)(WRI + ((size_t)(hd * 256 + 128 + 16 * w + fr) * 128 + 32 * ks + 8 * fq)); }
#pragma unroll
            for (int jj = 0; jj < 8; ++jj) bid[jj] = (8 * fq + jj == 16 * (w & 1) + fr) ? (short)0x3F80 : (short)0;
#pragma unroll
            for (int r = 0; r < 4; ++r) { const int ch = hd * 128 + 16 * w + 4 * fq + r; brv[r] = p.in(I_BR)[ch]; biv[r] = p.in(I_BI)[ch]; spv[r] = log1pf(fexp(-p.in(I_LAM)[ch]));
                hc[r] = FINAL ? CARRY[ch] : 0.f; ptot[r] = 1.f; }
        }
        { float xc[16];
          const LAS f32x4* cb4 = (const LAS f32x4*)(CW + 2048 + hd * 128 + 16 * sseg);
#pragma unroll
          for (int q = 0; q < 4; ++q) { const f32x4 v = cb4[q]; xc[4 * q] = v.x; xc[4 * q + 1] = v.y; xc[4 * q + 2] = v.z; xc[4 * q + 3] = v.w; }
#pragma unroll
          for (int j = 0; j < 4; ++j) { float xf[16]; unpack16(rx[2 * j], rx[2 * j + 1], xf); const LAS f32x4* cw4 = (const LAS f32x4*)(CW + j * 512 + hd * 128 + 16 * sseg);
#pragma unroll
              for (int q = 0; q < 4; ++q) { const f32x4 v = cw4[q]; xc[4 * q] += v.x * xf[4 * q]; xc[4 * q + 1] += v.y * xf[4 * q + 1]; xc[4 * q + 2] += v.z * xf[4 * q + 2]; xc[4 * q + 3] += v.w * xf[4 * q + 3]; } }
          u32x4 o0, o1; o0.x = pk2(xc[0], xc[1]); o0.y = pk2(xc[2], xc[3]); o0.z = pk2(xc[4], xc[5]); o0.w = pk2(xc[6], xc[7]); o1.x = pk2(xc[8], xc[9]); o1.y = pk2(xc[10], xc[11]); o1.z = pk2(xc[12], xc[13]); o1.w = pk2(xc[14], xc[15]);
          *(LAS u32x4*)(lds + RL_XC + buf * 17408 + srow * 272 + sseg * 32) = o0; *(LAS u32x4*)(lds + RL_XC + buf * 17408 + srow * 272 + sseg * 32 + 16) = o1;
          if (FINAL) { *(LAS u32x4*)(lds + RL_RG + buf * 17408 + srow * 272 + sseg * 32) = rgr[0]; *(LAS u32x4*)(lds + RL_RG + buf * 17408 + srow * 272 + sseg * 32 + 16) = rgr[1]; } }
        if (sidx + 1 < 16) prefetch(sidx + 1);
        LDS_BARRIER();
        if (FINAL && sidx > 0) { const int ps = sidx - 1, phd = ps >> 2, pstep = ps & 3, pbuf = ps & 1;
            const u32x4 v0 = *(const LAS u32x4*)(lds + RL_OUT + pbuf * 17408 + srow * 272 + sseg * 32), v1 = *(const LAS u32x4*)(lds + RL_OUT + pbuf * 17408 + srow * 272 + sseg * 32 + 16);
            bf16_t* dst = MIX + (tok0 + pstep * 64 + srow) * D + 512 + phd * 128 + 16 * sseg; *(u32x4*)dst = v0; *(u32x4*)(dst + 8) = v1; }
        const int ksx = w >> 1;
#pragma unroll
        for (int m = 0; m < 4; ++m) {
            f32x4 ar = (f32x4){0.f, 0.f, 0.f, 0.f}, ai = ar, ax = ar, ag = ar;
#pragma unroll
            for (int ks = 0; ks < 4; ++ks) { const bf16x8 a = *(const LAS bf16x8*)(lds + RL_XC + buf * 17408 + (16 * m + fr) * 272 + (32 * ks + 8 * fq) * 2);
                ar = __builtin_amdgcn_mfma_f32_16x16x32_bf16(br[ks], a, ar, 0, 0, 0); ai = __builtin_amdgcn_mfma_f32_16x16x32_bf16(bi[ks], a, ai, 0, 0, 0); }
            { const bf16x8 a = *(const LAS bf16x8*)(lds + RL_XC + buf * 17408 + (16 * m + fr) * 272 + (32 * ksx + 8 * fq) * 2); ax = __builtin_amdgcn_mfma_f32_16x16x32_bf16(bid, a, ax, 0, 0, 0); }
            if (FINAL) { const bf16x8 a = *(const LAS bf16x8*)(lds + RL_RG + buf * 17408 + (16 * m + fr) * 272 + (32 * ksx + 8 * fq) * 2); ag = __builtin_amdgcn_mfma_f32_16x16x32_bf16(bid, a, ag, 0, 0, 0); }
            float P[4], H[4];
#pragma unroll
            for (int r = 0; r < 4; ++r) { const float rr = sigmoidf_(ar[r] + brv[r]), ii = sigmoidf_(ai[r] + biv[r]), a = fexp(-8.0f * rr * spv[r]);
                P[r] = a; H[r] = fsqrt(fmaxf(1.0f - a * a, 0.f)) * (ii * ax[r]); }
#pragma unroll
            for (int r = 0; r < 4; ++r) { { const float Pp = dpp_shr<1>(P[r], 1.f), Hp = dpp_shr<1>(H[r], 0.f); H[r] = P[r] * Hp + H[r]; P[r] = P[r] * Pp; }
                { const float Pp = dpp_shr<2>(P[r], 1.f), Hp = dpp_shr<2>(H[r], 0.f); H[r] = P[r] * Hp + H[r]; P[r] = P[r] * Pp; }
                { const float Pp = dpp_shr<4>(P[r], 1.f), Hp = dpp_shr<4>(H[r], 0.f); H[r] = P[r] * Hp + H[r]; P[r] = P[r] * Pp; }
                { const float Pp = dpp_shr<8>(P[r], 1.f), Hp = dpp_shr<8>(H[r], 0.f); H[r] = P[r] * Hp + H[r]; P[r] = P[r] * Pp; } }
            float gq[4]; float ss = 0.f;
#pragma unroll
            for (int r = 0; r < 4; ++r) { const float hv = H[r] + P[r] * hc[r];
                if (FINAL) { gq[r] = gelu_tanh(ag[r]) * hv; ss += gq[r] * gq[r]; } else ptot[r] *= row_last(P[r]);
                hc[r] = row_last(hv); }
            if (FINAL) {
                u32x2 ow; ow.x = pk2(gq[0], gq[1]); ow.y = pk2(gq[2], gq[3]);
                *(LAS u32x2*)(lds + RL_OUT + buf * 17408 + (16 * m + fr) * 272 + (16 * w + 4 * fq) * 2) = ow;
                ss += __shfl_xor(ss, 16); ss += __shfl_xor(ss, 32);
                if (fq == 0) SSQP[w * 256 + step * 64 + 16 * m + fr] += ss;
            }
        }
        if (!FINAL && step == 3 && fr == 0) {
#pragma unroll
            for (int r = 0; r < 4; ++r) *(float2*)(SUMM + ((size_t)(b * 16 + chunk) * 512 + hd * 128 + 16 * w + 4 * fq + r) * 2) = make_float2(ptot[r], hc[r]); }
    }
    if (FINAL) {
        __syncthreads();
        GSTAMP(p.ws(), tid, 2);
        { const int ps = 15, phd = 3, pstep = 3, pbuf = ps & 1;
          const u32x4 v0 = *(const LAS u32x4*)(lds + RL_OUT + pbuf * 17408 + srow * 272 + sseg * 32), v1 = *(const LAS u32x4*)(lds + RL_OUT + pbuf * 17408 + srow * 272 + sseg * 32 + 16);
          bf16_t* dst = MIX + (tok0 + pstep * 64 + srow) * D + 512 + phd * 128 + 16 * sseg; *(u32x4*)dst = v0; *(u32x4*)(dst + 8) = v1; }
        asm volatile("s_waitcnt vmcnt(0)" ::: "memory");
        __syncthreads();
        for (int i = tid; i < 256 * 64; i += 512) { const int tl = i >> 6, c8 = i & 63; float s = 0.f;
#pragma unroll
            for (int ww = 0; ww < 8; ++ww) s += SSQP[ww * 256 + tl];
            const float rs = frsq(s * (1.0f / 512.f) + EPS);
            u32x4* ptr = (u32x4*)(MIX + (tok0 + tl) * D + 512 + c8 * 8); u32x4 v = *ptr;
            v.x = pk2(bflo(v.x) * rs, bfhi(v.x) * rs); v.y = pk2(bflo(v.y) * rs, bfhi(v.y) * rs); v.z = pk2(bflo(v.z) * rs, bfhi(v.z) * rs); v.w = pk2(bflo(v.w) * rs, bfhi(v.w) * rs);
            *ptr = v; }
    }
    __syncthreads();
    if (FINAL) GSTAMP(p.ws(), tid, 3);
}

constexpr int RT_WH = 0, RT_WL = 66048, RT_SELE = 132096, RT_SELG = RT_SELE + 4096, RT_RSTD = RT_SELG + 4096, RT_HIST = RT_RSTD + 1024, RT_BASE = RT_HIST + 128, RT_LDS = RT_BASE + 128;
template <int N> __device__ __forceinline__ float row_ror_f(float v) { return __builtin_bit_cast(float, __builtin_amdgcn_update_dpp(0, __builtin_bit_cast(int, v), 0x120 + N, 0xf, 0xf, false)); }
template <int N> __device__ __forceinline__ int row_ror_i(int v) { return __builtin_amdgcn_update_dpp(0, v, 0x120 + N, 0xf, 0xf, false); }
__device__ __forceinline__ float row_max16(float v) { v = fmaxf(v, row_ror_f<8>(v)); v = fmaxf(v, row_ror_f<4>(v)); v = fmaxf(v, row_ror_f<2>(v)); v = fmaxf(v, row_ror_f<1>(v)); return v; }
__device__ __forceinline__ int row_min16(int v) { v = min(v, row_ror_i<8>(v)); v = min(v, row_ror_i<4>(v)); v = min(v, row_ror_i<2>(v)); v = min(v, row_ror_i<1>(v)); return v; }
__device__ __forceinline__ void routing_block(const PV& p, LAS unsigned char* lds, int tb) {
    const int tid = get_tid(lds), lane = tid & 63, wave = __builtin_amdgcn_readfirstlane(tid >> 6), fr = lane & 15, fq = lane >> 4;
    LAS int* selE = (LAS int*)(lds + RT_SELE); LAS float* selG = (LAS float*)(lds + RT_SELG);
    LAS float* rstds = (LAS float*)(lds + RT_RSTD); LAS int* hist = (LAS int*)(lds + RT_HIST); LAS int* base = (LAS int*)(lds + RT_BASE);
    { const u32x4* src = (const u32x4*)(p.ws() + WS_WRT);
      for (int i = tid; i < 2 * 32 * 128; i += 512) { const int hl = i >> 12, e = (i >> 7) & 31, c = i & 127; *(LAS u32x4*)(lds + (hl ? RT_WL : RT_WH) + e * 2064 + c * 16) = src[i]; } }
    if (tid < 32) hist[tid] = 0;
    __syncthreads();
    const bf16_t* HB = (const bf16_t*)(p.ws() + WS_HB); unsigned char* HB8 = (unsigned char*)(p.ws() + WS_HB8);
    const size_t tok0 = (size_t)tb * 256 + 32 * wave;
    f32x4 acc[2][2];
#pragma unroll
    for (int m = 0; m < 2; ++m)
#pragma unroll
        for (int hf = 0; hf < 2; ++hf) acc[m][hf] = (f32x4){0.f, 0.f, 0.f, 0.f};
    float ss[2] = {0.f, 0.f};
#pragma unroll 4
    for (int ks = 0; ks < 32; ++ks) {
        bf16x8 ah[2];
#pragma unroll
        for (int m = 0; m < 2; ++m) { const size_t off = (tok0 + 16 * m + fr) * D + 32 * ks + 8 * fq;
            const u32x4 hv = *(const u32x4*)(HB + off);
            const float x0 = bflo(hv.x), x1 = bfhi(hv.x), x2 = bflo(hv.y), x3 = bfhi(hv.y), x4 = bflo(hv.z), x5 = bfhi(hv.z), x6 = bflo(hv.w), x7 = bfhi(hv.w);
            ss[m] += (x0 * x0 + x1 * x1) + (x2 * x2 + x3 * x3) + (x4 * x4 + x5 * x5) + (x6 * x6 + x7 * x7);
            ah[m] = __builtin_bit_cast(bf16x8, hv);
            u32x2 f8; f8.x = pk4_fp8(clamp448(x0 * SC_H), clamp448(x1 * SC_H), clamp448(x2 * SC_H), clamp448(x3 * SC_H)); f8.y = pk4_fp8(clamp448(x4 * SC_H), clamp448(x5 * SC_H), clamp448(x6 * SC_H), clamp448(x7 * SC_H));
            *(u32x2*)(HB8 + off) = f8; }
#pragma unroll
        for (int hf = 0; hf < 2; ++hf) { const bf16x8 bh = *(const LAS bf16x8*)(lds + RT_WH + (16 * hf + fr) * 2064 + (32 * ks + 8 * fq) * 2), bl = *(const LAS bf16x8*)(lds + RT_WL + (16 * hf + fr) * 2064 + (32 * ks + 8 * fq) * 2);
#pragma unroll
            for (int m = 0; m < 2; ++m) { acc[m][hf] = __builtin_amdgcn_mfma_f32_16x16x32_bf16(ah[m], bh, acc[m][hf], 0, 0, 0); acc[m][hf] = __builtin_amdgcn_mfma_f32_16x16x32_bf16(ah[m], bl, acc[m][hf], 0, 0, 0); } }
    }
#pragma unroll
    for (int m = 0; m < 2; ++m) { float s = ss[m]; s += __shfl_xor(s, 16); s += __shfl_xor(s, 32); if (fq == 0) rstds[32 * wave + 16 * m + fr] = frsq(s * (1.0f / D) + EPS); }
    const float rb0 = p.in(I_RB)[fr], rb1 = p.in(I_RB)[16 + fr];
#pragma unroll
    for (int m = 0; m < 2; ++m)
#pragma unroll
        for (int r = 0; r < 4; ++r) { const int tl = 32 * wave + 16 * m + 4 * fq + r; const float rstd = rstds[tl];
            float l0 = acc[m][0][r] * rstd + rb0, l1 = acc[m][1][r] * rstd + rb1;
            float tv[4]; int te[4];
#pragma unroll
            for (int k = 0; k < 4; ++k) { const float mx = row_max16(fmaxf(l0, l1));
                const int cand = l0 == mx ? fr : (l1 == mx ? 16 + fr : 99), sel = row_min16(cand);
                tv[k] = mx; te[k] = sel; if (sel == fr) l0 = -INFINITY; if (sel == 16 + fr) l1 = -INFINITY; }
            const float e1 = fexp(tv[1] - tv[0]), e2 = fexp(tv[2] - tv[0]), e3 = fexp(tv[3] - tv[0]), inv = 1.0f / (1.0f + e1 + e2 + e3);
            if (fr < 4) { const int ee = fr == 0 ? te[0] : fr == 1 ? te[1] : fr == 2 ? te[2] : te[3]; const float gg = (fr == 0 ? 1.0f : fr == 1 ? e1 : fr == 2 ? e2 : e3) * inv;
                selE[tl * 4 + fr] = ee; selG[tl * 4 + fr] = gg; } }
    __syncthreads();
    int myrank[2], mye[2];
#pragma unroll
    for (int q = 0; q < 2; ++q) { const int a = tid + 512 * q; mye[q] = selE[a]; myrank[q] = atomicAdd((int*)(hist + mye[q]), 1); }
    __syncthreads();
    unsigned* ctl = (unsigned*)(p.ws() + WS_CTL);
    if (tid < 32) base[tid] = (int)atomicAdd(ctl + CW_CNT + tid, (unsigned)hist[tid]);
    __syncthreads();
    i32x4* ENT = (i32x4*)(p.ws() + WS_ENT);
#pragma unroll
    for (int q = 0; q < 2; ++q) { const int a = tid + 512 * q, tl = a >> 2, k = a & 3; const int pos = base[mye[q]] + myrank[q];
        i32x4 en; en.x = tb * 256 + tl; en.y = __float_as_int(rstds[tl]); en.z = k; en.w = __float_as_int(selG[a]); ENT[(size_t)mye[q] * T + pos] = en; }
}
__device__ __forceinline__ void routing_phase(const PV& p, LAS unsigned char* lds) {
    for (int tb = blockIdx.x; tb < T / 256; tb += gridDim.x) { routing_block(p, lds, tb); __syncthreads(); }
}

struct Rounds { int es; int nr; __device__ __forceinline__ int lo(int r) const { return r == 0 ? 0 : es; } __device__ __forceinline__ int hi(int r) const { return r == 0 ? es : NE; } };
__device__ __forceinline__ int pad256(int c) { return (c + 255) & ~255; }
__device__ __forceinline__ Rounds make_rounds(const unsigned* cnt) {
    Rounds R; int sum = 0, e = 0;
    for (; e < NE; ++e) { const int pc = pad256((int)cnt[e]); if (sum + pc > CAP_ROWS) break; sum += pc; }
    R.es = e; R.nr = e < NE ? 2 : 1; return R;
}
__device__ __forceinline__ float f8lane(unsigned w, int i) { return i == 0 ? __builtin_amdgcn_cvt_f32_fp8((int)w, 0) : i == 1 ? __builtin_amdgcn_cvt_f32_fp8((int)w, 1) : i == 2 ? __builtin_amdgcn_cvt_f32_fp8((int)w, 2) : __builtin_amdgcn_cvt_f32_fp8((int)w, 3); }
__device__ __forceinline__ void combine_rows(const PV& p, int gw, int ngw, int lane) {
    const bf16_t* HB = (const bf16_t*)(p.ws() + WS_HB); const unsigned char* Y23 = (const unsigned char*)(p.ws() + WS_Y23);
    f32x4 fw[4];
#pragma unroll
    for (int q = 0; q < 4; ++q) fw[q] = *(const f32x4*)(p.in(I_FNW) + 16 * lane + 4 * q);
    for (int m = gw; m < T; m += ngw) {
        float v[16];
        const u32x4 h0 = *(const u32x4*)(HB + (size_t)m * D + 16 * lane), h1 = *(const u32x4*)(HB + (size_t)m * D + 16 * lane + 8);
        const unsigned hw[8] = {h0.x, h0.y, h0.z, h0.w, h1.x, h1.y, h1.z, h1.w};
#pragma unroll
        for (int q = 0; q < 8; ++q) { v[2 * q] = bflo(hw[q]); v[2 * q + 1] = bfhi(hw[q]); }
        float ys[16];
#pragma unroll
        for (int q = 0; q < 16; ++q) ys[q] = 0.f;
#pragma unroll
        for (int k = 0; k < 4; ++k) { const unsigned char* yb = (k < 2 ? (const unsigned char*)p.out() + (size_t)m * 4096 : Y23 + (size_t)m * 2048) + (k & 1) * 1024;
            const u32x4 y = *(const u32x4*)(yb + 16 * lane); const unsigned yw[4] = {y.x, y.y, y.z, y.w};
#pragma unroll
            for (int q = 0; q < 4; ++q) { ys[4 * q] += f8lane(yw[q], 0); ys[4 * q + 1] += f8lane(yw[q], 1); ys[4 * q + 2] += f8lane(yw[q], 2); ys[4 * q + 3] += f8lane(yw[q], 3); } }
        float s = 0.f;
#pragma unroll
        for (int q = 0; q < 16; ++q) { v[q] += ys[q] * (1.0f / SC_Y); s += v[q] * v[q]; }
        const float rstd = frsq(wave_sum(s) * (1.0f / D) + EPS);
        float* o = p.out() + (size_t)m * D + 16 * lane;
#pragma unroll
        for (int q = 0; q < 4; ++q) { f32x4 r; r.x = v[4 * q] * rstd * fw[q].x; r.y = v[4 * q + 1] * rstd * fw[q].y; r.z = v[4 * q + 2] * rstd * fw[q].z; r.w = v[4 * q + 3] * rstd * fw[q].w;
            *(f32x4*)(o + 4 * q) = r; }
    }
}
#ifndef REP_P0
#define REP_P0 1
#endif
#ifndef REP_P1
#define REP_P1 1
#endif
#ifndef REP_P2
#define REP_P2 1
#endif
#ifndef REP_P3
#define REP_P3 1
#endif
#ifndef REP_P4
#define REP_P4 1
#endif
#ifndef REP_G1
#define REP_G1 1
#endif
#ifndef REP_G2
#define REP_G2 1
#endif
__global__ void __launch_bounds__(512, 2) fwd(Params kp) {
    extern __shared__ __attribute__((aligned(16))) unsigned char lds_[];
    LAS unsigned char* lds = (LAS unsigned char*)lds_;
    {
        const int t0 = threadIdx.x;
        if (t0 < 22) *(volatile LAS unsigned long long*)(lds + LDS_PTAB_OFF + 8 * t0) = (unsigned long long)(size_t)kp.in[t0];
        if (t0 == 22) *(volatile LAS unsigned long long*)(lds + LDS_PTAB_OFF + 8 * 22) = (unsigned long long)(size_t)kp.out;
        if (t0 == 23) *(volatile LAS unsigned long long*)(lds + LDS_PTAB_OFF + 8 * 23) = (unsigned long long)(size_t)kp.ws;
    }
    unsigned char* ws = kp.ws;
    unsigned* bar = (unsigned*)(ws + WS_CTL) + CW_BAR;
    const PV p{lds};
    {
        const int t0 = threadIdx.x;
        const unsigned slot = (unsigned)__builtin_amdgcn_s_getreg(((6 - 1) << 11) | 4);
        if ((t0 & 63) == 0) *(volatile LAS int*)(lds + LDS_TAB + 4 * slot) = t0 >> 6;
        if (t0 == 0) { *(volatile LAS unsigned*)(lds + LDS_BARST) = 0u; *(volatile LAS unsigned*)(lds + LDS_BARST + 4) = 0u;
            const unsigned x = xb_xcc_id(), rank = xb_add(&bar[XB_XCNT(x)], 1u);
            *(volatile LAS unsigned*)(lds + LDS_BARST + 8) = rank * 8u + x; }
        __syncthreads();
    }
#ifdef PROBE_PH
    volatile LAS unsigned long long* phs = (volatile LAS unsigned long long*)(lds + LDS_TAB - 256); int nph = 0;
#define PH_STAMP() do { if (get_tid(lds) == 0) phs[nph] = __builtin_amdgcn_s_memrealtime(); ++nph; } while (0)
    PH_STAMP();
#define GRID_BAR() do { grid_barrier(bar, lds); PH_STAMP(); } while (0)
#else
#define PH_STAMP() do { } while (0)
#define GRID_BAR() grid_barrier(bar, lds)
#endif
    for (int rep = 0; rep < REP_P0; ++rep) { prep_phase(p, lds);
    cg::this_grid().sync(); PH_STAMP(); }
    int vcu = (int)blockIdx.x;
    { bool even = (gridDim.x % 8u) == 0u;
      for (unsigned j = 0; j < 16; ++j) { const unsigned c = xb_ld(&bar[XB_XCNT(j)]); if (c != (j < 8 ? gridDim.x / 8u : 0u)) even = false; }
      if (even) vcu = (int)*(volatile LAS unsigned*)(lds + LDS_BARST + 8);
      vcu = __builtin_amdgcn_readfirstlane(vcu); }
    for (int rep = 0; rep < REP_P1; ++rep) {
    { DenseSched S; S.o.init(T / 256, NPROJ / 256, gridDim.x, vcu); S.A = (const char*)(ws + WS_R1); S.Bt = (const char*)(ws + WS_WIN); S.pitch = 2 * D; EpiInProj E{(bf16_t*)(ws + WS_R2)};
      pg8::gemm_phase<false, false>(lds, (const char*)(ws + WS_R1), 2 * D, S, E); }
    GRID_BAR(); }
    {
        unsigned* ctl = (unsigned*)(ws + WS_CTL);
        if (blockIdx.x < 64) mlstm_phase(p, lds, blockIdx.x);
        volatile LAS int* qslot = (volatile LAS int*)(lds + LDS_BARST + 12);
        for (;;) {
            const int tid = get_tid(lds);
            if (tid == 0) *qslot = (int)xb_add(ctl + CW_WORK, 1u);
            __syncthreads();
            const int idx = __builtin_amdgcn_readfirstlane(*qslot);
            __syncthreads();
            if (idx < 256) {
                rglru_item<false>(p, lds, idx);
                asm volatile("s_waitcnt vmcnt(0)" ::: "memory"); __syncthreads();
                if (get_tid(lds) == 0) { __builtin_amdgcn_fence(__ATOMIC_RELEASE, "agent"); asm volatile("s_waitcnt vmcnt(0)" ::: "memory"); (void)xb_add(ctl + CW_CNTA + 16 * (idx >> 4), 1u); }
            } else if (idx < 512) {
                const int it = idx - 256;
                if (get_tid(lds) == 0) { XB_SPIN(xb_ld(ctl + CW_CNTA + 16 * (it >> 4)) < 16u, bar); __builtin_amdgcn_fence(__ATOMIC_ACQUIRE, "agent"); asm volatile("s_waitcnt vmcnt(0)" ::: "memory"); }
                __syncthreads();
                rglru_item<true>(p, lds, it);
            } else if (idx < 512 + 384) {
                const int ch = idx - 512, wave = get_tid(lds) >> 6, lane = get_tid(lds) & 63;
                LAS float* scr = (LAS float*)(lds + wave * 17408);
                for (int q = 0; q < 8; ++q) conv_item_moe(p, ch * 64 + wave * 8 + q, scr, lane);
                __syncthreads();
            } else break;
        }
    }
    GRID_BAR();
    for (int rep = 0; rep < REP_P4; ++rep) {
    { DenseSched S; S.o.init(T / 256, D / 256, gridDim.x, vcu); S.A = (const char*)(ws + WS_R1); S.Bt = (const char*)(ws + WS_WOUT); S.pitch = 2 * D; EpiOutProj E{p.in(I_X), (bf16_t*)(ws + WS_HB)};
      pg8::gemm_phase<false, false>(lds, (const char*)(ws + WS_R1), 2 * D, S, E); }
    GRID_BAR(); }
    routing_phase(p, lds);
    GRID_BAR();
    const unsigned* cnt = (const unsigned*)(ws + WS_CTL) + CW_CNT;
    const Rounds RR = make_rounds(cnt);
    for (int r = 0; r < RR.nr; ++r) {
        for (int rep = 0; rep < REP_G1; ++rep) {
        { MoeSched<true, 8, 2 * DFF> S{cnt, (const i32x4*)(ws + WS_ENT), (const char*)(ws + WS_HB8), (const char*)(ws + WS_WGU), lds, RR.lo(r), RR.hi(r), (int)gridDim.x, vcu, 0, p.in(I_BGU)}; S.init_tot(get_tid(lds));
          EpiG1 E{(unsigned char*)(ws + WS_R2)};
          pg8::gemm_phase<true, true>(lds, (const char*)(ws + WS_HB8), D, S, E, ws, 8); }
        GRID_BAR(); }
        for (int rep = 0; rep < REP_G2; ++rep) {
        { MoeSched<false, 4, D> S{cnt, (const i32x4*)(ws + WS_ENT), (const char*)(ws + WS_R2), (const char*)(ws + WS_WDN), lds, RR.lo(r), RR.hi(r), (int)gridDim.x, vcu, 0, p.in(I_BDN)}; S.init_tot(get_tid(lds));
          EpiG2 E{(unsigned char*)p.out(), (unsigned char*)(ws + WS_Y23)};
          pg8::gemm_phase<true, false>(lds, (const char*)(ws + WS_R2), DFF, S, E, ws, 16); }
        GRID_BAR(); }
    }
    { const int tid = get_tid(lds); combine_rows(p, blockIdx.x * 8 + (tid >> 6), gridDim.x * 8, tid & 63); }
#ifdef PROBE_G
    if (blockIdx.x == PROBE_BLK && get_tid(lds) == 0) {
        const volatile unsigned long long* st = (const volatile unsigned long long*)(ws + WS_CTL + 40960);
        const unsigned long long ticks = (st[PROBE_I + PROBE_SPAN] - st[PROBE_I]) * PROBE_MUL;
        const unsigned long long t0 = __builtin_amdgcn_s_memrealtime();
        while (__builtin_amdgcn_s_memrealtime() - t0 < ticks) __builtin_amdgcn_s_sleep(8);
    }
#endif
#ifdef PROBE_PH
    PH_STAMP();
    if (vcu == 0 && get_tid(lds) == 0) {
        const unsigned long long ticks = (phs[PROBE_PH + 1] - phs[PROBE_PH]) * PROBE_MUL;
        const unsigned long long t0 = __builtin_amdgcn_s_memrealtime();
        while (__builtin_amdgcn_s_memrealtime() - t0 < ticks) __builtin_amdgcn_s_sleep(8);
    }
#endif
}

extern "C" void kernel_launch(void* const* d_in, const int* in_sizes, int n_in, void* d_out, int out_size, void* d_ws, size_t ws_size, hipStream_t stream) {
    static int grid = 0;
    if (grid == 0) {
        if (n_in != 22 || ws_size < WS_END) { fprintf(stderr, "kernel_launch: unexpected n_in %d / ws_size %zu (need %zu)\n", n_in, ws_size, (size_t)WS_END); grid = -1; return; }
        int dev = 0, cus = 0, per_cu = 0;
        (void)hipGetDevice(&dev); (void)hipDeviceGetAttribute(&cus, hipDeviceAttributeMultiprocessorCount, dev);
        (void)hipFuncSetAttribute((const void*)fwd, hipFuncAttributeMaxDynamicSharedMemorySize, LDS_BYTES);
        (void)hipOccupancyMaxActiveBlocksPerMultiprocessor(&per_cu, (const void*)fwd, 512, LDS_BYTES);
        if (per_cu < 1) { fprintf(stderr, "kernel_launch: occupancy query says %d blocks/CU\n", per_cu); per_cu = 1; }
        grid = cus * per_cu;
        fprintf(stderr, "kernel_launch: grid %d (cus %d x %d)\n", grid, cus, per_cu);
    }
    if (grid < 0) return;
    Params p{};
    for (int i = 0; i < 22; ++i) p.in[i] = (const float*)d_in[i];
    p.out = (float*)d_out; p.ws = (unsigned char*)d_ws;
    (void)hipMemsetAsync((unsigned char*)d_ws + WS_CTL, 0, 65536, stream);
    void* args[] = {&p};
    hipError_t e = hipLaunchCooperativeKernel((const void*)fwd, dim3(grid), dim3(512), args, LDS_BYTES, stream);
    if (e != hipSuccess) fprintf(stderr, "kernel_launch: cooperative launch failed: %s (grid %d)\n", hipGetErrorString(e), grid);
}
```

```cpp
#include <hip/hip_runtime.h>
#include <hip/hip_cooperative_groups.h>
#include <cstdio>
#include <cstdint>

namespace cg = cooperative_groups;
#define LAS __attribute__((address_space(3)))
typedef unsigned short bf16_t;
typedef short bf16x8 __attribute__((ext_vector_type(8)));
typedef float f32x4 __attribute__((ext_vector_type(4)));
typedef unsigned u32x4 __attribute__((ext_vector_type(4)));
typedef unsigned u32x2 __attribute__((ext_vector_type(2)));
typedef int i32x4 __attribute__((ext_vector_type(4)));

constexpr int T = 65536, D = 1024, SEQ = 4096, NB = 16;
constexpr int INC = 3080;
constexpr int NPROJ = 3072;
constexpr int NE = 32, TOPK = 4, DFF = 1024;
constexpr float EPS = 1e-6f;
constexpr int CAP_ROWS = 270336;
constexpr float SC_H = 8.0f, SC_W = 64.0f, SC_HID = 4.0f;

constexpr size_t MB = 1024 * 1024;
constexpr size_t WS_CTL  = 0;
constexpr size_t WS_GATES = 1 * MB;
constexpr size_t WS_SSQR = 3 * MB;
constexpr size_t WS_SUMM = 4 * MB;
constexpr size_t WS_WRI  = 5 * MB;
constexpr size_t WS_WRT  = 5 * MB + 512 * 1024;
constexpr size_t WS_ENT  = 6 * MB;
constexpr size_t WS_WIN  = 38 * MB;
constexpr size_t WS_WOUT = 44 * MB;
constexpr size_t WS_WGU  = 46 * MB;
constexpr size_t WS_WDN  = 110 * MB;
constexpr size_t WS_HB8  = 142 * MB;
constexpr size_t WS_R1   = 238 * MB;
constexpr size_t WS_R2   = 366 * MB;
constexpr size_t WS_Y23  = 750 * MB;
constexpr size_t WS_HB   = 878 * MB;
constexpr float SC_Y = 32.0f;
constexpr size_t WS_END  = 1006 * MB;

constexpr int CW_CNT = 0;
constexpr int CW_WORK = 64;
constexpr int CW_CNTA = 128;
constexpr int CW_BAR = 1024;

__device__ __forceinline__ unsigned pk2(float lo, float hi) { unsigned r; asm("v_cvt_pk_bf16_f32 %0, %1, %2" : "=v"(r) : "v"(lo), "v"(hi)); return r; }
__device__ __forceinline__ float bflo(unsigned u) { return __uint_as_float(u << 16); }
__device__ __forceinline__ float bfhi(unsigned u) { return __uint_as_float(u & 0xffff0000u); }
__device__ __forceinline__ float bf2f(bf16_t b) { return __uint_as_float(((unsigned)b) << 16); }
template <int CTRL, int RM> __device__ __forceinline__ float dpp_x(float v, float ident) {
    return __builtin_bit_cast(float, __builtin_amdgcn_update_dpp(__builtin_bit_cast(int, ident), __builtin_bit_cast(int, v), CTRL, RM, 0xf, false));
}
__device__ __forceinline__ float wave_sum(float s) {
    s += dpp_x<0x111, 0xf>(s, 0.f); s += dpp_x<0x112, 0xf>(s, 0.f); s += dpp_x<0x114, 0xf>(s, 0.f); s += dpp_x<0x118, 0xf>(s, 0.f);
    s += dpp_x<0x142, 0xa>(s, 0.f); s += dpp_x<0x143, 0xc>(s, 0.f);
    return __builtin_bit_cast(float, __builtin_amdgcn_readlane(__builtin_bit_cast(int, s), 63));
}
__device__ __forceinline__ float fexp(float x) { return __builtin_amdgcn_exp2f(x * 1.4426950408889634f); }
__device__ __forceinline__ float frcp(float x) { return __builtin_amdgcn_rcpf(x); }
__device__ __forceinline__ float fsqrt(float x) { return __builtin_amdgcn_sqrtf(x); }
__device__ __forceinline__ float frsq(float x) { return __builtin_amdgcn_rsqf(x); }
__device__ __forceinline__ float sigmoidf_(float x) { return frcp(1.0f + __builtin_amdgcn_exp2f(x * -1.4426950408889634f)); }
__device__ __forceinline__ float gelu_tanh(float x) {
    const float u2 = 1.5957691216057308f * (x + 0.044715f * x * x * x);
    return x * sigmoidf_(u2);
}

typedef int i32x8 __attribute__((ext_vector_type(8)));
__device__ __forceinline__ unsigned pk4_fp8(float a, float b, float c, float d) {
    int r = __builtin_amdgcn_cvt_pk_fp8_f32(a, b, 0, false); r = __builtin_amdgcn_cvt_pk_fp8_f32(c, d, r, true); return (unsigned)r;
}
__device__ __forceinline__ float clamp448(float x) { return fminf(fmaxf(x, -448.f), 448.f); }

struct Params {
    const float* in[22];
    float* out;
    unsigned char* ws;
    int pad0, pad1;
};
constexpr int LDS_PTAB_OFF = 159744 - 512 - 256 - 256;
struct PV {
    LAS unsigned char* l;
    __device__ __forceinline__ unsigned long long ptr(int i) const { const u32x2 v = *(volatile LAS u32x2*)(l + LDS_PTAB_OFF + 8 * i);
        return ((unsigned long long)(unsigned)__builtin_amdgcn_readfirstlane((int)v.y) << 32) | (unsigned)__builtin_amdgcn_readfirstlane((int)v.x); }
    __device__ __forceinline__ const float* in(int i) const { return (const float*)(const __attribute__((address_space(1))) float*)(size_t)ptr(i); }
    __device__ __forceinline__ float* out() const { return (float*)(__attribute__((address_space(1))) float*)(size_t)ptr(22); }
    __device__ __forceinline__ unsigned char* ws() const { return (unsigned char*)(__attribute__((address_space(1))) unsigned char*)(size_t)ptr(23); }
};
enum { I_X = 0, I_N1W, I_WIN, I_GB, I_MNW, I_CW, I_CB, I_WR, I_BR, I_WI, I_BI, I_LAM, I_LNW, I_WOUT, I_N2W, I_RW, I_RB, I_WGU, I_BGU, I_WDN, I_BDN, I_FNW };


constexpr int LDS_BYTES = 159744, LDS_TAB = LDS_BYTES - 512, LDS_BARST = LDS_BYTES - 16;
__device__ __forceinline__ int get_tid(LAS unsigned char* lds) {
    const unsigned slot = (unsigned)__builtin_amdgcn_s_getreg(((6 - 1) << 11) | 4);
    const int w = __builtin_amdgcn_readfirstlane(*(volatile LAS int*)(lds + LDS_TAB + 4 * slot));
    int lane; asm volatile("v_mbcnt_lo_u32_b32 %0, -1, 0\n\tv_mbcnt_hi_u32_b32 %0, -1, %0" : "=v"(lane));
    return w * 64 + lane;
}
#define XB_TMO      128
#define XB_XCNT(j)  (256  + 64 * (j))
#define XB_XSUB(j)  (1280 + 64 * (j))
#define XB_XGEN(j)  (2304 + 64 * (j))
#define XB_TOP      3328
#define XB_TOPGEN   3392
#define XCD_BAR_WORDS 3456
#define XB_SPIN_CAP (1u << 22)
__device__ __forceinline__ unsigned xb_ld(unsigned* p)              { return __hip_atomic_load(p, __ATOMIC_RELAXED, __HIP_MEMORY_SCOPE_AGENT); }
__device__ __forceinline__ unsigned xb_add(unsigned* p, unsigned v) { return __hip_atomic_fetch_add(p, v, __ATOMIC_RELAXED, __HIP_MEMORY_SCOPE_AGENT); }
__device__ __forceinline__ unsigned xb_xcc_id() { return (unsigned)__builtin_amdgcn_s_getreg((3 << 11) | 20) & 0xFu; }
#define XB_SPIN(cond, bar) do { unsigned _sp = 0; while (cond) { __builtin_amdgcn_s_sleep(1); \
    if ((++_sp & 255u) == 0u) { if (xb_ld(&(bar)[XB_TMO])) break; if (_sp > XB_SPIN_CAP) { atomicAdd(&(bar)[XB_TMO], 1u); break; } } } } while (0)
__device__ __forceinline__ void xcd_barrier_complete(unsigned* bar, unsigned x, unsigned G, unsigned& nloc, unsigned& nx) {
    unsigned sum, cnt, mine, sp = 0u;
    for (;;) {
        sum = 0u; cnt = 0u; mine = 0u;
#pragma unroll
        for (unsigned j = 0; j < 16; ++j) { const unsigned c = xb_ld(&bar[XB_XCNT(j)]); sum += c; cnt += (c > 0u) ? 1u : 0u; mine = (j == x) ? c : mine; }
        if (sum == G) break;
        __builtin_amdgcn_s_sleep(1);
        if ((++sp & 255u) == 0u) { if (xb_ld(&bar[XB_TMO])) break; if (sp > XB_SPIN_CAP) { atomicAdd(&bar[XB_TMO], 1u); break; } }
    }
    nloc = mine > 0u ? mine : 1u; nx = cnt > 0u ? cnt : 1u;
}
__device__ __forceinline__ void grid_barrier(unsigned* bar, LAS unsigned char* lds) {
    asm volatile("s_waitcnt vmcnt(0)" ::: "memory");
    __syncthreads();
    if (get_tid(lds) == 0) {
        volatile LAS unsigned* st = (volatile LAS unsigned*)(lds + LDS_BARST);
        const unsigned x = xb_xcc_id();
        __builtin_amdgcn_s_waitcnt(0);
        unsigned nloc = st[0], nx = st[1];
        if (nloc == 0u) { xcd_barrier_complete(bar, x, gridDim.x, nloc, nx); st[0] = nloc; st[1] = nx; }
        const unsigned old = xb_add(&bar[XB_XSUB(x)], 1u);
        const unsigned gen = old / nloc;
        if (old + 1u == (gen + 1u) * nloc) {
            __builtin_amdgcn_fence(__ATOMIC_RELEASE, "agent");
            asm volatile("s_waitcnt vmcnt(0)" ::: "memory");
            const unsigned og = xb_add(&bar[XB_TOP], 1u);
            const unsigned tg = og / nx;
            if (og + 1u == (tg + 1u) * nx) xb_add(&bar[XB_TOPGEN], 1u);
            else XB_SPIN(xb_ld(&bar[XB_TOPGEN]) == tg, bar);
            __builtin_amdgcn_fence(__ATOMIC_ACQUIRE, "agent");
            xb_add(&bar[XB_XGEN(x)], 1u);
            asm volatile("s_waitcnt vmcnt(0)" ::: "memory");
        } else {
            XB_SPIN(xb_ld(&bar[XB_XGEN(x)]) == gen, bar);
            __builtin_amdgcn_fence(__ATOMIC_ACQUIRE, "agent");
            asm volatile("s_waitcnt vmcnt(0)" ::: "memory");
        }
    }
    __syncthreads();
}

#ifdef PROBE_G
#define GSTAMP(ws_, tid_, i_) do { if (((i_) == PROBE_I || (i_) == PROBE_I + PROBE_SPAN) && blockIdx.x == PROBE_BLK && (tid_) == 0) ((volatile unsigned long long*)((ws_) + WS_CTL + 40960))[i_] = __builtin_amdgcn_s_memrealtime(); } while (0)
#else
#define GSTAMP(ws_, tid_, i_) do { } while (0)
#endif
__device__ __forceinline__ void tr_item(const float* __restrict__ W, int ldw, int col0, bf16_t* dst, int K, int k0, const float* sk, float mul, LAS float* scr, int lane) {
    float v[32];
    const float* src = W + (size_t)(k0 + (lane >> 5)) * ldw + col0 + (lane & 31);
#pragma unroll
    for (int i = 0; i < 32; ++i) v[i] = __builtin_nontemporal_load(src + (size_t)(2 * i) * ldw);
#pragma unroll
    for (int i = 0; i < 32; ++i) { const int kk = 2 * i + (lane >> 5); const float s = sk ? sk[k0 + kk] * mul : mul; scr[kk * 33 + (lane & 31)] = v[i] * s; }
    asm volatile("s_waitcnt lgkmcnt(0)" ::: "memory");
    const int c = lane & 7;
#pragma unroll
    for (int j = 0; j < 4; ++j) { const int n = (lane >> 3) + 8 * j; const LAS float* s = scr + (8 * c) * 33 + n;
        u32x4 o; o.x = pk2(s[0 * 33], s[1 * 33]); o.y = pk2(s[2 * 33], s[3 * 33]); o.z = pk2(s[4 * 33], s[5 * 33]); o.w = pk2(s[6 * 33], s[7 * 33]);
        *(u32x4*)(dst + (size_t)n * K + k0 + 8 * c) = o; }
    asm volatile("s_waitcnt lgkmcnt(0)" ::: "memory");
}
__device__ __forceinline__ void tr_item_f8(const float* __restrict__ W, int ldw, int col0, unsigned char* dst, int K, int k0, const float* sk, float mul, LAS float* scr, int lane) {
    f32x4 v[16];
    const int r = lane >> 4, c4 = lane & 15;
    const float* src = W + (size_t)(k0 + r) * ldw + col0 + 4 * c4;
#pragma unroll
    for (int i = 0; i < 16; ++i) v[i] = __builtin_nontemporal_load((const f32x4*)(src + (size_t)(4 * i) * ldw));
#pragma unroll
    for (int i = 0; i < 16; ++i) { const int kk = 4 * i + r; const float s = sk ? sk[k0 + kk] * mul : mul; f32x4 t = v[i] * s;
        t.x = clamp448(t.x); t.y = clamp448(t.y); t.z = clamp448(t.z); t.w = clamp448(t.w); *(LAS f32x4*)(scr + kk * 68 + 4 * c4) = t; }
    asm volatile("s_waitcnt lgkmcnt(0)" ::: "memory");
    const int c = lane & 3, nn = lane >> 2;
#pragma unroll
    for (int j = 0; j < 4; ++j) { const int n = nn + 16 * j; const LAS float* s = scr + (16 * c) * 68 + n;
        u32x4 o; o.x = pk4_fp8(s[0 * 68], s[1 * 68], s[2 * 68], s[3 * 68]); o.y = pk4_fp8(s[4 * 68], s[5 * 68], s[6 * 68], s[7 * 68]);
        o.z = pk4_fp8(s[8 * 68], s[9 * 68], s[10 * 68], s[11 * 68]); o.w = pk4_fp8(s[12 * 68], s[13 * 68], s[14 * 68], s[15 * 68]);
        *(u32x4*)(dst + (size_t)n * K + k0 + 16 * c) = o; }
    asm volatile("s_waitcnt lgkmcnt(0)" ::: "memory");
}
constexpr int IT_WIN = 16 * 96, IT_WOUT = 16 * 32, IT_WGU_E = 16 * 32, IT_WDN_E = 16 * 16;
__device__ __forceinline__ void conv_item_small(const PV& p, int it, LAS float* scr, int lane) {
    if (it < IT_WIN) {
        const int kb = it / 96, nb = it % 96, n0 = 32 * nb, sec = n0 >> 9;
        const int secoff = sec == 0 ? 0 : sec == 1 ? 512 : sec == 2 ? 1024 : sec == 3 ? 1544 : sec == 4 ? 2056 : 2568;
        const float mul = sec == 1 ? 0.08838834764831845f : 1.0f;
        tr_item(p.in(I_WIN), INC, secoff + (n0 & 511), (bf16_t*)(p.ws() + WS_WIN) + (size_t)n0 * D, D, 64 * kb, nullptr, mul, scr, lane);
    } else {
        it -= IT_WIN; const int kb = it / 32, nb = it % 32, k0 = 64 * kb;
        const float* sk = k0 < 512 ? p.in(I_MNW) : p.in(I_LNW) - 512;
        tr_item(p.in(I_WOUT), D, 32 * nb, (bf16_t*)(p.ws() + WS_WOUT) + (size_t)(32 * nb) * D, D, k0, sk, 1.0f, scr, lane);
    }
}
__device__ __forceinline__ void conv_item_moe(const PV& p, int it, LAS float* scr, int lane) {
    if (it < NE * IT_WGU_E) {
        const int e = it / IT_WGU_E, r = it % IT_WGU_E, kb = r / 32, nb = r % 32, n0 = 64 * nb, j = n0 >> 8, c0 = n0 & 255;
        const int srccol = c0 < 128 ? 128 * j + c0 : 1024 + 128 * j + (c0 - 128);
        tr_item_f8(p.in(I_WGU) + (size_t)e * D * 2 * DFF, 2 * DFF, srccol, (unsigned char*)(p.ws() + WS_WGU) + ((size_t)e * 2 * DFF + n0) * D, D, 64 * kb, p.in(I_N2W), SC_W, scr, lane);
    } else {
        it -= NE * IT_WGU_E; const int e = it / IT_WDN_E, r = it % IT_WDN_E, kb = r / 16, nb = r % 16;
        tr_item_f8(p.in(I_WDN) + (size_t)e * DFF * D, D, 64 * nb, (unsigned char*)(p.ws() + WS_WDN) + ((size_t)e * D + 64 * nb) * DFF, DFF, 64 * kb, nullptr, SC_W, scr, lane);
    }
}
__device__ __forceinline__ void xpass_rows(const PV& p, LAS unsigned char* lds, int gw, int ngw, int lane) {
    LAS float* WG = (LAS float*)(lds + 69632);
    { const float* wg = p.in(I_WIN) + 1536;
      for (int i = get_tid(lds); i < 2048; i += 512) { const int k = i >> 1, q = i & 1; const f32x4 a = *(const f32x4*)(wg + (size_t)k * INC + 4 * q);
          const int rho = ((k >> 8) * 4 + (k & 3)) * 64 + ((k >> 2) & 63); *(LAS f32x4*)(WG + rho * 12 + 4 * q) = a; } }
    __syncthreads();
    f32x4 w1[4];
#pragma unroll
    for (int j = 0; j < 4; ++j) w1[j] = *(const f32x4*)(p.in(I_N1W) + 256 * j + 4 * lane);
    const float gb = lane < 8 ? p.in(I_GB)[lane] : 0.f;
    bf16_t* XN = (bf16_t*)(p.ws() + WS_R1); float* GATES = (float*)(p.ws() + WS_GATES);
    const float* X = p.in(I_X);
    f32x4 nv[4];
    if (gw < T) {
#pragma unroll
        for (int j = 0; j < 4; ++j) nv[j] = ((const f32x4*)(X + (size_t)gw * D) + lane)[64 * j]; }
    for (int m = gw; m < T; m += ngw) {
        f32x4 v[4]; float s = 0.f;
#pragma unroll
        for (int j = 0; j < 4; ++j) { v[j] = nv[j]; s += (v[j].x * v[j].x + v[j].y * v[j].y) + (v[j].z * v[j].z + v[j].w * v[j].w); }
        if (m + ngw < T) {
#pragma unroll
            for (int j = 0; j < 4; ++j) nv[j] = ((const f32x4*)(X + (size_t)(m + ngw) * D) + lane)[64 * j]; }
        const float rstd = frsq(wave_sum(s) * (1.0f / D) + EPS);
        float g[8];
#pragma unroll
        for (int q = 0; q < 8; ++q) g[q] = 0.f;
        unsigned long long* o8 = (unsigned long long*)(XN + (size_t)m * D) + lane;
#pragma unroll
        for (int j = 0; j < 4; ++j) { v[j] = v[j] * rstd * w1[j];
            o8[64 * j] = (unsigned long long)pk2(v[j].x, v[j].y) | ((unsigned long long)pk2(v[j].z, v[j].w) << 32);
#pragma unroll
            for (int c = 0; c < 4; ++c) { const float xv = v[j][c]; const LAS f32x4* wrow = (const LAS f32x4*)(WG + ((j * 4 + c) * 64 + lane) * 12); const f32x4 wa = wrow[0], wb = wrow[1];
                g[0] += xv * wa.x; g[1] += xv * wa.y; g[2] += xv * wa.z; g[3] += xv * wa.w; g[4] += xv * wb.x; g[5] += xv * wb.y; g[6] += xv * wb.z; g[7] += xv * wb.w; } }
        float mine = 0.f;
#pragma unroll
        for (int q = 0; q < 8; ++q) { const float t = wave_sum(g[q]); if (lane == q) mine = t; }
        if (lane < 8) { float val = mine + gb; if (lane >= 4) val = -log1pf(fexp(-val)); GATES[(size_t)m * 8 + lane] = val; }
    }
}
__device__ __forceinline__ void prep_phase(const PV& p, LAS unsigned char* lds) {
    const int tid = get_tid(lds), lane = tid & 63, wave = tid >> 6, gw = blockIdx.x * 8 + wave, ngw = gridDim.x * 8;
    LAS float* scr = (LAS float*)(lds + wave * 8448);
    for (int it = gw; it < IT_WIN + IT_WOUT; it += ngw) conv_item_small(p, it, scr, lane);
    bf16_t* WRI = (bf16_t*)(p.ws() + WS_WRI);
    for (int i = blockIdx.x * 512 + tid; i < 4 * 256 * 128; i += gridDim.x * 512) { const int h = i >> 15, n = (i >> 7) & 255, k = i & 127;
        const float v = n < 128 ? p.in(I_WR)[(h * 128 + k) * 128 + n] : p.in(I_WI)[(h * 128 + k) * 128 + n - 128]; WRI[i] = (bf16_t)(pk2(v, 0.f) & 0xffff); }
    { bf16_t* WRT = (bf16_t*)(p.ws() + WS_WRT);
      for (int i = blockIdx.x * 512 + tid; i < 32 * 1024; i += gridDim.x * 512) { const int e = i >> 10, k = i & 1023; const float v = p.in(I_RW)[k * 32 + e] * p.in(I_N2W)[k];
          const unsigned h = pk2(v, 0.f) & 0xffffu; const float lo = v - __uint_as_float(h << 16); WRT[i] = (bf16_t)h; WRT[32 * 1024 + i] = (bf16_t)(pk2(lo, 0.f) & 0xffffu); } }
    xpass_rows(p, lds, gw, ngw, lane);
}
__device__ __forceinline__ void moe_conv_phase(const PV& p, LAS unsigned char* lds, int b0) {
    const int tid = get_tid(lds), lane = tid & 63, wave = tid >> 6;
    if ((int)blockIdx.x < b0) return;
    const int gw = ((int)blockIdx.x - b0) * 8 + wave, ngw = ((int)gridDim.x - b0) * 8;
    LAS float* scr = (LAS float*)(lds + wave * 17408);
    for (int it = gw; it < NE * (IT_WGU_E + IT_WDN_E); it += ngw) conv_item_moe(p, it, scr, lane);
}

namespace pg8 {
constexpr int BM = 256, BK = 64, HALF = 128, HTB = HALF * BK * 2, STAGE_BYTES = 8 * HTB;
constexpr int META_OFF = 134144, META_BYTES = 5120;
__device__ __forceinline__ int lds_byte(int r, int c) { const int st = (r >> 4) * 2 + (c >> 5), rr = r & 15, cc = c & 31, ob = rr * 64 + cc * 2; return st * 1024 + (ob ^ (((ob >> 9) & 1) << 5)); }
__device__ __forceinline__ void stage_rc(int b, int& R, int& C) { const int st = b / 1024, sb = b % 1024, swz = sb ^ (((sb >> 9) & 1) << 5); R = (st >> 1) * 16 + swz / 64; C = (st & 1) * 32 + (swz % 64) / 2; }
__device__ __forceinline__ int perm32(int rho) { const int n = rho >> 4, i = rho & 15; return 8 * (i >> 2) + 4 * n + (i & 3); }
struct Unit { const char* b; const char* a; int i0, i1, i2, i3, i4; };
#define PG8_GLDS2(ldsa, s0, v0, s1, v1) do { unsigned _keep; \
        asm volatile("s_mov_b32 %0, m0\n\ts_mov_b32 m0, %5\n\ts_nop 0\n\tglobal_load_lds_dwordx4 %1, %2\n\ts_mov_b32 m0, %6\n\ts_nop 0\n\tglobal_load_lds_dwordx4 %3, %4\n\ts_mov_b32 m0, %0" \
                     : "=&s"(_keep) : "v"(v0), "s"((const char*)(s0)), "v"(v1), "s"((const char*)(s1)), "s"(ldsa), "s"((ldsa) + 8192u) : "memory"); } while (0)
template <bool F8, bool GATHER, class Epi, class Sched>
__device__ __forceinline__ void gemm_phase(LAS unsigned char* lds, const char* Abase, int pitch, const Sched& S, const Epi& E, unsigned char* pws = nullptr, int pslot = 0) {
    const int tid = get_tid(lds);
    const int wid = __builtin_amdgcn_readfirstlane(tid >> 6), lane = tid & 63, wr = wid >> 2, wc = wid & 3, fr = lane & 15, fq = lane >> 4;
    const int nt = pitch / 128;
    unsigned vA, vB;
    { int R0, C0; stage_rc(tid * 16, R0, C0); const int Rb0 = Epi::PERM ? ((R0 & ~31) + perm32(R0 & 31)) : R0;
      vA = (unsigned)(R0 * pitch + 2 * C0); vB = (unsigned)(Rb0 * pitch + 2 * C0); }
    const size_t kstep = 128, hstep = (size_t)HALF * pitch, q64 = (size_t)64 * pitch;
    const unsigned ldsb0 = (unsigned)__builtin_amdgcn_readfirstlane((int)((unsigned)(size_t)lds + (unsigned)wid * 1024u));
    const int aoff = lds_byte(wr * 64 + fr, fq * 8), boff = lds_byte(wc * 32 + fr, fq * 8);
    constexpr int HOFF = 1024;
#define PG8_SA(b, h) (((b) * 2 + (h)) * HTB)
#define PG8_SB(b, h) ((4 + (b) * 2 + (h)) * HTB)
#define PG8_STAGEB(bufoff, gbase) PG8_GLDS2(ldsb0 + (unsigned)(bufoff), (gbase), vB, (gbase) + q64, vB)
#define PG8_STAGEA(bufoff, kp, h) do { if constexpr (GATHER) { if ((h) == 0) PG8_GLDS2(ldsb0 + (unsigned)(bufoff), (kp), g0, (kp), g1); else PG8_GLDS2(ldsb0 + (unsigned)(bufoff), (kp), g2, (kp), g3); } \
        else PG8_GLDS2(ldsb0 + (unsigned)(bufoff), (kp) + (h) * hstep, vA, (kp) + (h) * hstep + q64, vA); } while (0)
#define PG8_RD(p) (*(const LAS u32x4*)(p))
#define PG8_LDA(dst, b, h) do { _Pragma("unroll") for (int m = 0; m < 4; ++m) { dst[m][0] = PG8_RD(lds + PG8_SA(b, h) + aoff + m * 2048); dst[m][1] = PG8_RD(lds + PG8_SA(b, h) + aoff + m * 2048 + HOFF); } } while (0)
#define PG8_LDB(dst, b, h) do { _Pragma("unroll") for (int n = 0; n < 2; ++n) { dst[n][0] = PG8_RD(lds + PG8_SB(b, h) + boff + n * 2048); dst[n][1] = PG8_RD(lds + PG8_SB(b, h) + boff + n * 2048 + HOFF); } } while (0)
#define PG8_CAT(v) __builtin_bit_cast(i32x8, __builtin_shufflevector((v)[0], (v)[1], 0, 1, 2, 3, 4, 5, 6, 7))
#define PG8_MMA(ai, bj, At, Bt) do { __builtin_amdgcn_s_setprio(1); _Pragma("unroll") for (int m = 0; m < 4; ++m) _Pragma("unroll") for (int n = 0; n < 2; ++n) { \
        if constexpr (F8) acc[ai][bj][m][n] = __builtin_amdgcn_mfma_scale_f32_16x16x128_f8f6f4(PG8_CAT(Bt[n]), PG8_CAT(At[m]), acc[ai][bj][m][n], 0, 0, 0, 0, 0, 0);     \
        else { acc[ai][bj][m][n] = __builtin_amdgcn_mfma_f32_16x16x32_bf16(__builtin_bit_cast(bf16x8, Bt[n][0]), __builtin_bit_cast(bf16x8, At[m][0]), acc[ai][bj][m][n], 0, 0, 0); \
               acc[ai][bj][m][n] = __builtin_amdgcn_mfma_f32_16x16x32_bf16(__builtin_bit_cast(bf16x8, Bt[n][1]), __builtin_bit_cast(bf16x8, At[m][1]), acc[ai][bj][m][n], 0, 0, 0); } } \
        __builtin_amdgcn_s_setprio(0); } while (0)
#define PG8_GLDS1(ldsa, s0, v0) do { unsigned _keep; \
        asm volatile("s_mov_b32 %0, m0\n\ts_mov_b32 m0, %3\n\ts_nop 0\n\tglobal_load_lds_dwordx4 %1, %2\n\ts_mov_b32 m0, %0" : "=&s"(_keep) : "v"(v0), "s"((const char*)(s0)), "s"(ldsa) : "memory"); } while (0)
#define PG8_WAIT_V(n) asm volatile("s_waitcnt vmcnt(" #n ")" ::: "memory")
#define PG8_WAIT_L(n) asm volatile("s_waitcnt lgkmcnt(" #n ")" ::: "memory")
#define PG8_BAR __builtin_amdgcn_s_barrier()
#define PG8_SCHED __builtin_amdgcn_sched_barrier(0)
    Unit cur, nxt; int ui = 0;
    if (!S.next(0, cur)) return;
    f32x4 acc[2][2][4][2];
#pragma unroll
    for (int a = 0; a < 2; ++a)
#pragma unroll
        for (int b = 0; b < 2; ++b)
#pragma unroll
            for (int m = 0; m < 4; ++m)
#pragma unroll
                for (int n = 0; n < 2; ++n) acc[a][b][m][n] = (f32x4){0.f, 0.f, 0.f, 0.f};
    u32x4 At[4][2], B0[2][2], B1[2][2];
    unsigned g0 = 0, g1 = 0, g2 = 0, g3 = 0;
    if constexpr (GATHER) { S.goffs(cur, tid, 0, g0, g1); S.goffs(cur, tid, 1, g2, g3); }
    if constexpr (Sched::HAS_META) S.meta_issue(cur, (unsigned)(size_t)lds + (unsigned)META_OFF, wid, lane);
    const char* cA = GATHER ? Abase : cur.a; const char* cB = cur.b;
    PG8_STAGEB(PG8_SB(0, 0), cB); PG8_STAGEB(PG8_SB(0, 1), cB + hstep); PG8_STAGEA(PG8_SA(0, 0), cA, 0); PG8_STAGEA(PG8_SA(0, 1), cA, 1);
    if (wr == 1) PG8_BAR;
    PG8_WAIT_V(2); PG8_BAR;
    PG8_STAGEB(PG8_SB(1, 0), cB + kstep); PG8_STAGEA(PG8_SA(1, 0), cA + kstep, 0); PG8_STAGEB(PG8_SB(1, 1), cB + hstep + kstep);
    PG8_WAIT_V(6); PG8_BAR;
    for (;;) {
#ifdef PROBE_G
        if (pws && ui == 2) GSTAMP(pws, tid, pslot);
#endif
        const bool has_next = S.next(ui + 1, nxt);
        const char* nB = has_next ? nxt.b : cB; const char* nA = GATHER ? Abase : (has_next ? nxt.a : cA);
#ifdef PROBE_G
        if (pws && ui == 2) GSTAMP(pws, tid, pslot + 1);
#endif
#pragma unroll 1
        for (int t = 0; t < nt; t += 2) {
            const bool last = (t == nt - 2);
            const char* a1 = cA + (size_t)(t + 1) * kstep;
            const char* a2 = last ? nA : cA + (size_t)(t + 2) * kstep; const char* b2 = last ? nB : cB + (size_t)(t + 2) * kstep;
            const char* a3 = a2 + kstep; const char* b3 = b2 + kstep;
            PG8_LDB(B0, 0, 0); PG8_LDB(B1, 0, 1); PG8_SCHED; PG8_LDA(At, 0, 0); PG8_STAGEA(PG8_SA(1, 1), a1, 1);
            if constexpr (Sched::HAS_META) { if (t == 0 && has_next) S.meta_issue(nxt, (unsigned)(size_t)lds + (unsigned)META_OFF + (unsigned)(((ui + 1) % 3) * META_BYTES), wid, lane); }
            if constexpr (GATHER) { if (last && has_next) { const LAS unsigned char* nm = lds + META_OFF + ((ui + 1) % 3) * META_BYTES;
                                                      S.goffs_lds(nxt, tid, 0, nm, g0, g1); S.goffs_lds(nxt, tid, 1, nm, g2, g3); } }
            PG8_WAIT_V(8); PG8_WAIT_L(0); PG8_BAR; PG8_MMA(0, 0, At, B0); PG8_MMA(0, 1, At, B1); PG8_BAR; PG8_SCHED;
            PG8_LDA(At, 0, 1); PG8_STAGEB(PG8_SB(0, 0), b2); PG8_STAGEB(PG8_SB(0, 1), b2 + hstep); PG8_STAGEA(PG8_SA(0, 0), a2, 0);
            PG8_WAIT_V(8); PG8_WAIT_L(0); PG8_BAR; PG8_MMA(1, 0, At, B0); PG8_MMA(1, 1, At, B1); PG8_BAR; PG8_SCHED;
            PG8_LDB(B0, 1, 0); PG8_LDB(B1, 1, 1); PG8_SCHED; PG8_LDA(At, 1, 0); PG8_STAGEA(PG8_SA(0, 1), a2, 1);
            PG8_WAIT_V(8); PG8_WAIT_L(0); PG8_BAR; PG8_MMA(0, 0, At, B0); PG8_MMA(0, 1, At, B1); PG8_BAR; PG8_SCHED;
            PG8_LDA(At, 1, 1); PG8_STAGEB(PG8_SB(1, 0), b3); PG8_STAGEB(PG8_SB(1, 1), b3 + hstep); PG8_STAGEA(PG8_SA(1, 0), a3, 0);
            PG8_WAIT_V(8); PG8_WAIT_L(0); PG8_BAR; PG8_MMA(1, 0, At, B0); PG8_MMA(1, 1, At, B1); PG8_BAR; PG8_SCHED;
        }
#ifdef PROBE_G
        if (pws && ui == 2) GSTAMP(pws, tid, pslot + 2);
#endif
        if (wr == 0) PG8_BAR;
        { int efr = fr, efq = fq; asm volatile("" : "+v"(efr), "+v"(efq));
          E(acc, cur, wr, wc, efr, efq, lds + META_OFF + (ui % 3) * META_BYTES); }
#ifdef PROBE_G
        if (pws && ui == 2) GSTAMP(pws, tid, pslot + 3);
        if (pws && ui == 3) GSTAMP(pws, tid, pslot + 4);
#endif
        if (!has_next) break;
#pragma unroll
        for (int a = 0; a < 2; ++a)
#pragma unroll
            for (int b = 0; b < 2; ++b)
#pragma unroll
                for (int m = 0; m < 4; ++m)
#pragma unroll
                    for (int n = 0; n < 2; ++n) acc[a][b][m][n] = (f32x4){0.f, 0.f, 0.f, 0.f};
        cur = nxt; cB = nB; cA = nA; ++ui;
        if (wr == 1) PG8_BAR;
    }
    PG8_WAIT_V(0);
    PG8_BAR;
#undef PG8_SA
#undef PG8_SB
#undef PG8_STAGEA
#undef PG8_STAGEB
#undef PG8_RD
#undef PG8_CAT
#undef PG8_LDA
#undef PG8_LDB
#undef PG8_MMA
#undef PG8_WAIT_V
#undef PG8_WAIT_L
#undef PG8_BAR
#undef PG8_SCHED
}
struct TileOrder {
    int nM, nN, nwg, G, c;
    __device__ __forceinline__ void init(int nM_, int nN_, int G_, int c_) { nM = nM_; nN = nN_; nwg = nM * nN; G = G_; c = c_; }
    __device__ __forceinline__ bool tile(int i, int& pm, int& pn) const {
        const long L = (long)i * G + c; if (L >= nwg) return false;
        int wgid = (int)L; { const int q = nwg / 8, r = nwg % 8, xcd = wgid % 8, off = wgid / 8; wgid = (xcd < r ? xcd * (q + 1) : r * (q + 1) + (xcd - r) * q) + off; }
        const int nig = 8 * nN, gid = wgid / nig, fm = gid * 8, gsz = (nM - fm) < 8 ? (nM - fm) : 8;
        pm = fm + ((wgid % nig) % gsz); pn = (wgid % nig) / gsz; return true;
    }
};
}

struct DenseSched {
    pg8::TileOrder o; const char* A; const char* Bt; int pitch;
    __device__ __forceinline__ bool next(int i, pg8::Unit& u) const { int pm, pn; if (!o.tile(i, pm, pn)) return false; u.i0 = pm; u.i1 = pn; u.i2 = 0; u.i3 = 0; u.i4 = 0;
        u.a = A + (size_t)pm * 256 * pitch; u.b = Bt + (size_t)pn * 256 * pitch; return true; }
    __device__ __forceinline__ void goffs(const pg8::Unit&, int, int, unsigned&, unsigned&) const {}
    static constexpr bool HAS_META = false;
    __device__ __forceinline__ void meta_issue(const pg8::Unit&, unsigned, int, int) const {}
    __device__ __forceinline__ void goffs_lds(const pg8::Unit&, int, int, const LAS unsigned char*, unsigned&, unsigned&) const {}
};
struct EpiInProj {
    static constexpr bool PERM = true;
    bf16_t* PROJ;
    __device__ __forceinline__ void operator()(const f32x4 (&acc)[2][2][4][2], const pg8::Unit& u, int wr, int wc, int fr, int fq, const LAS unsigned char*) const {
        const int row0 = u.i0 * 256 + wr * 64 + fr, col0 = u.i1 * 256 + wc * 32 + 8 * fq;
#pragma unroll
        for (int ai = 0; ai < 2; ++ai)
#pragma unroll
            for (int m = 0; m < 4; ++m) { bf16_t* rowp = PROJ + (size_t)(row0 + ai * 128 + m * 16) * NPROJ + col0;
#pragma unroll
                for (int bj = 0; bj < 2; ++bj) { const f32x4 v0 = acc[ai][bj][m][0], v1 = acc[ai][bj][m][1];
                    u32x4 w; w.x = pk2(v0[0], v0[1]); w.y = pk2(v0[2], v0[3]); w.z = pk2(v1[0], v1[1]); w.w = pk2(v1[2], v1[3]);
                    *(u32x4*)(rowp + bj * 128) = w; } }
    }
};
struct EpiOutProj {
    static constexpr bool PERM = true;
    const float* X; bf16_t* HB;
    __device__ __forceinline__ void operator()(const f32x4 (&acc)[2][2][4][2], const pg8::Unit& u, int wr, int wc, int fr, int fq, const LAS unsigned char*) const {
        const int row0 = u.i0 * 256 + wr * 64 + fr, col0 = u.i1 * 256 + wc * 32 + 8 * fq;
#pragma unroll
        for (int ai = 0; ai < 2; ++ai)
#pragma unroll
            for (int m = 0; m < 4; ++m) { const size_t off = (size_t)(row0 + ai * 128 + m * 16) * D + col0;
#pragma unroll
                for (int bj = 0; bj < 2; ++bj) { const f32x4 x0 = *(const f32x4*)(X + off + bj * 128), x1 = *(const f32x4*)(X + off + bj * 128 + 4);
                    const f32x4 v0 = x0 + acc[ai][bj][m][0], v1 = x1 + acc[ai][bj][m][1];
                    u32x4 w; w.x = pk2(v0[0], v0[1]); w.y = pk2(v0[2], v0[3]); w.z = pk2(v1[0], v1[1]); w.w = pk2(v1[2], v1[3]);
                    *(u32x4*)(HB + off + bj * 128) = w; }
                asm volatile("" ::: "memory"); }
    }
};

constexpr int LDS_MOE_TAB = 131072;
template <bool GATHER, int NT  , int NROWS  >
struct MoeSched {
    const unsigned* cnt; const i32x4* ENT; const char* A; const char* Bt; LAS unsigned char* lds; int lo, hi, G, c, tot;
    __device__ __forceinline__ int cnt_s(int e) const { return __builtin_amdgcn_readfirstlane((int)cnt[e]); }
    __device__ __forceinline__ int tab(int i) const { return __builtin_amdgcn_readfirstlane(*(volatile LAS int*)(lds + LDS_MOE_TAB + 4 * i)); }
    __device__ __forceinline__ void init_tot(int tid) {
        if (tid == 0) { int t = 0; for (int e = lo; e < hi; ++e) { const int ce = (int)cnt[e], te = (ce + 255) >> 8; *(volatile LAS int*)(lds + LDS_MOE_TAB + 4 * (e - lo)) = t; *(volatile LAS int*)(lds + LDS_MOE_TAB + 4 * (64 + e - lo)) = te;
                *(volatile LAS int*)(lds + LDS_MOE_TAB + 4 * (128 + e - lo)) = ce; t += te; }
            *(volatile LAS int*)(lds + LDS_MOE_TAB + 4 * (hi - lo)) = t; }
        __syncthreads();
        tot = tab(hi - lo) * NT;
        for (int i = tid; i * G + c < tot && i < 64; i += 512) { int e, m, n, hb, ce; locate(i * G + c, e, m, n, hb, ce);
            *(LAS i32x4*)(lds + LDS_MOE_TAB + 1024 + 32 * i) = (i32x4){e, m, n, hb}; *(LAS int*)(lds + LDS_MOE_TAB + 1024 + 32 * i + 16) = ce; }
        __syncthreads();
    }
    __device__ __forceinline__ void locate(int L, int& e, int& m, int& n, int& hb, int& ce) const {
        int W; { const int q = tot / 8, r = tot % 8, xcd = L % 8, off = L / 8; W = (xcd < r ? xcd * (q + 1) : r * (q + 1) + (xcd - r) * q) + off; }
        int a = 0, b = hi - lo;
        while (b - a > 1) { const int mm = (a + b) >> 1; if (*(volatile LAS int*)(lds + LDS_MOE_TAB + 4 * mm) * NT <= W) a = mm; else b = mm; }
        const int pre = *(volatile LAS int*)(lds + LDS_MOE_TAB + 4 * a), te = *(volatile LAS int*)(lds + LDS_MOE_TAB + 4 * (64 + a)); W -= pre * NT;
        constexpr int nig = 8 * NT; const int gid = W / nig, fm = gid * 8, gsz = (te - fm) < 8 ? (te - fm) : 8; int j = W - gid * nig; n = 0;
        while (j >= gsz) { j -= gsz; ++n; }
        e = lo + a; m = fm + j; hb = pre * 256; ce = *(volatile LAS int*)(lds + LDS_MOE_TAB + 4 * (128 + a));
    }
    __device__ __forceinline__ bool next(int i, pg8::Unit& u) const {
        if (i * G + c >= tot) return false;
        const i32x4 d = *(volatile LAS i32x4*)(lds + LDS_MOE_TAB + 1024 + 32 * i); const int ce = *(volatile LAS int*)(lds + LDS_MOE_TAB + 1024 + 32 * i + 16);
        u.i0 = __builtin_amdgcn_readfirstlane(d.x); u.i1 = __builtin_amdgcn_readfirstlane(d.y); u.i2 = __builtin_amdgcn_readfirstlane(d.z); u.i3 = __builtin_amdgcn_readfirstlane(d.w); u.i4 = __builtin_amdgcn_readfirstlane(ce);
        u.b = Bt + ((size_t)u.i0 * NROWS + (size_t)u.i2 * 256) * 1024; u.a = A + (size_t)(u.i3 + u.i1 * 256) * 1024;
        return true;
    }
    static constexpr bool HAS_META = true;
    const float* bias;
    __device__ __forceinline__ void meta_issue(const pg8::Unit& u, unsigned ldsa, int wid, int lane) const {
        if (wid < 4) { const unsigned voff = (unsigned)(((unsigned)u.i0 * (unsigned)T + (unsigned)(u.i1 * 256 + 64 * wid + lane)) * 16u); PG8_GLDS1(ldsa + 1024u * (unsigned)wid, (const char*)ENT, voff); }
        else if (wid == 4) { unsigned voff;
            if constexpr (GATHER) voff = (unsigned)((u.i0 * 2048 + (lane < 32 ? 128 * u.i2 + 4 * lane : 1024 + 128 * u.i2 + 4 * (lane - 32))) * 4);
            else voff = (unsigned)((u.i0 * 1024 + 256 * u.i2 + 4 * lane) * 4);
            PG8_GLDS1(ldsa + 4096u, (const char*)bias, voff); }
    }
    __device__ __forceinline__ void goffs_lds(const pg8::Unit& u, int tid, int h, const LAS unsigned char* meta, unsigned& o0, unsigned& o1) const {
        if constexpr (GATHER) { int R0, C0; pg8::stage_rc(tid * 16, R0, C0);
            const int ce = u.i4, rl = h * 128 + R0, p0 = u.i1 * 256 + rl;
            const int e0 = *(const LAS int*)(meta + 16 * rl), e1 = *(const LAS int*)(meta + 16 * (rl + 64));
            const int t0 = p0 < ce ? e0 : 0, t1 = p0 + 64 < ce ? e1 : 0;
            o0 = (unsigned)t0 * 1024u + 2u * C0; o1 = (unsigned)t1 * 1024u + 2u * C0; }
    }
    __device__ __forceinline__ void goffs(const pg8::Unit& u, int tid, int h, unsigned& o0, unsigned& o1) const {
        if constexpr (GATHER) { int R0, C0; pg8::stage_rc(tid * 16, R0, C0);
            const int ce = u.i4, p0 = u.i1 * 256 + h * 128 + R0; const i32x4* en = ENT + (size_t)u.i0 * T;
            const int t0 = p0 < ce ? en[p0].x : 0, t1 = p0 + 64 < ce ? en[p0 + 64].x : 0;
            o0 = (unsigned)t0 * 1024u + 2u * C0; o1 = (unsigned)t1 * 1024u + 2u * C0; }
    }
};
struct EpiG1 {
    static constexpr bool PERM = true;
    unsigned char* HID;
    __device__ __forceinline__ void operator()(const f32x4 (&acc)[2][2][4][2], const pg8::Unit& u, int wr, int wc, int fr, int fq, const LAS unsigned char* meta) const {
        const int ce = u.i4, hc = u.i2 * 128 + wc * 32 + 8 * fq;
        float rs[8];
#pragma unroll
        for (int q = 0; q < 8; ++q) { const int rl = (q >> 2) * 128 + wr * 64 + (q & 3) * 16 + fr; const float r = *(const LAS float*)(meta + 16 * rl + 4); rs[q] = u.i1 * 256 + rl < ce ? r * (1.0f / (SC_H * SC_W)) : 0.f; }
        const LAS float* bl = (const LAS float*)(meta + 4096) + wc * 32 + 8 * fq;
        const f32x4 bg0 = *(const LAS f32x4*)bl, bg1 = *(const LAS f32x4*)(bl + 4), bu0 = *(const LAS f32x4*)(bl + 128), bu1 = *(const LAS f32x4*)(bl + 132);
#pragma unroll
        for (int ai = 0; ai < 2; ++ai)
#pragma unroll
            for (int m = 0; m < 4; ++m) { const int pos = u.i1 * 256 + ai * 128 + wr * 64 + m * 16 + fr;
                const float rstd = rs[ai * 4 + m];
                float hv[8];
#pragma unroll
                for (int q = 0; q < 8; ++q) { const int n = q >> 2, j = q & 3; float g = acc[ai][0][m][n][j] * rstd + (n ? bg1[j] : bg0[j]), up = acc[ai][1][m][n][j] * rstd + (n ? bu1[j] : bu0[j]);
                    g = fminf(g, 7.0f); up = fminf(fmaxf(up, -7.0f), 7.0f); hv[q] = (up + 1.0f) * g * sigmoidf_(1.702f * g) * SC_HID; }
                u32x2 w; w.x = pk4_fp8(hv[0], hv[1], hv[2], hv[3]); w.y = pk4_fp8(hv[4], hv[5], hv[6], hv[7]);
                *(u32x2*)(HID + (size_t)(u.i3 + pos) * DFF + hc) = w; }
    }
};
struct EpiG2 {
    static constexpr bool PERM = true;
    unsigned char* OUT01; unsigned char* Y23;
    __device__ __forceinline__ void operator()(const f32x4 (&acc)[2][2][4][2], const pg8::Unit& u, int wr, int wc, int fr, int fq, const LAS unsigned char* meta) const {
        const int ce = u.i4, col0 = u.i2 * 256 + wc * 32 + 8 * fq;
        int tk[8], kk[8]; float gt[8];
#pragma unroll
        for (int q = 0; q < 8; ++q) { const int rl = (q >> 2) * 128 + wr * 64 + (q & 3) * 16 + fr; const i32x4 v = *(const LAS i32x4*)(meta + 16 * rl);
            tk[q] = u.i1 * 256 + rl < ce ? v.x : -1; kk[q] = v.z; gt[q] = __int_as_float(v.w) * SC_Y; }
        const LAS float* bl = (const LAS float*)(meta + 4096) + wc * 32 + 8 * fq;
        f32x4 b[2][2];
#pragma unroll
        for (int bj = 0; bj < 2; ++bj) { b[bj][0] = *(const LAS f32x4*)(bl + bj * 128); b[bj][1] = *(const LAS f32x4*)(bl + bj * 128 + 4); }
#pragma unroll
        for (int ai = 0; ai < 2; ++ai)
#pragma unroll
            for (int m = 0; m < 4; ++m) { const int q = ai * 4 + m;
                if (tk[q] >= 0) { const float gate = gt[q];
                    unsigned char* dst = (kk[q] < 2 ? OUT01 + (size_t)tk[q] * 4096 : Y23 + (size_t)tk[q] * 2048) + (kk[q] & 1) * 1024 + col0;
#pragma unroll
                    for (int bj = 0; bj < 2; ++bj) { const f32x4 y0 = (acc[ai][bj][m][0] * (1.0f / (SC_HID * SC_W)) + b[bj][0]) * gate, y1 = (acc[ai][bj][m][1] * (1.0f / (SC_HID * SC_W)) + b[bj][1]) * gate;
                        u32x2 w; w.x = pk4_fp8(clamp448(y0[0]), clamp448(y0[1]), clamp448(y0[2]), clamp448(y0[3])); w.y = pk4_fp8(clamp448(y1[0]), clamp448(y1[1]), clamp448(y1[2]), clamp448(y1[3]));
                        *(u32x2*)(dst + bj * 128) = w; } } }
    }
};

#define LDS_BARRIER() do { asm volatile("s_waitcnt lgkmcnt(0)" ::: "memory"); __builtin_amdgcn_s_barrier(); asm volatile("" ::: "memory"); } while (0)
constexpr int ML_QS = 0, ML_KS = 17408, ML_VS = 34816, ML_PS = 52224, ML_CT = 61440, ML_DENP = 96256, ML_DI = 96768, ML_SSQP = 97024, ML_NARR = 99072, ML_FLA = 99584, ML_END = 99840;
__device__ __forceinline__ bf16x8 tr_pair(unsigned a0, unsigned a1) {
    u32x2 lo, hi; asm volatile("ds_read_b64_tr_b16 %0, %2\n\tds_read_b64_tr_b16 %1, %3\n\ts_waitcnt lgkmcnt(0)" : "=&v"(lo), "=&v"(hi) : "v"(a0), "v"(a1) : "memory");
    u32x4 r; r.x = lo.x; r.y = lo.y; r.z = hi.x; r.w = hi.y; return __builtin_bit_cast(bf16x8, r);
}
#define TR8(dst, base, OFF0, STEP) do { u32x2 _l[8], _h[8]; \
    asm volatile("ds_read_b64_tr_b16 %0, %16 offset:%17\n\tds_read_b64_tr_b16 %1, %16 offset:%17+1088\n\tds_read_b64_tr_b16 %2, %16 offset:%17+%18\n\tds_read_b64_tr_b16 %3, %16 offset:%17+%18+1088\n\t" \
                 "ds_read_b64_tr_b16 %4, %16 offset:%17+2*%18\n\tds_read_b64_tr_b16 %5, %16 offset:%17+2*%18+1088\n\tds_read_b64_tr_b16 %6, %16 offset:%17+3*%18\n\tds_read_b64_tr_b16 %7, %16 offset:%17+3*%18+1088\n\t" \
                 "ds_read_b64_tr_b16 %8, %16 offset:%17+4*%18\n\tds_read_b64_tr_b16 %9, %16 offset:%17+4*%18+1088\n\tds_read_b64_tr_b16 %10, %16 offset:%17+5*%18\n\tds_read_b64_tr_b16 %11, %16 offset:%17+5*%18+1088\n\t" \
                 "ds_read_b64_tr_b16 %12, %16 offset:%17+6*%18\n\tds_read_b64_tr_b16 %13, %16 offset:%17+6*%18+1088\n\tds_read_b64_tr_b16 %14, %16 offset:%17+7*%18\n\tds_read_b64_tr_b16 %15, %16 offset:%17+7*%18+1088\n\ts_waitcnt lgkmcnt(0)" \
                 : "=&v"(_l[0]), "=&v"(_h[0]), "=&v"(_l[1]), "=&v"(_h[1]), "=&v"(_l[2]), "=&v"(_h[2]), "=&v"(_l[3]), "=&v"(_h[3]), "=&v"(_l[4]), "=&v"(_h[4]), "=&v"(_l[5]), "=&v"(_h[5]), "=&v"(_l[6]), "=&v"(_h[6]), "=&v"(_l[7]), "=&v"(_h[7]) \
                 : "v"(base), "i"(OFF0), "i"(STEP) : "memory"); \
    _Pragma("unroll") for (int _p = 0; _p < 8; ++_p) { u32x4 _r; _r.x = _l[_p].x; _r.y = _l[_p].y; _r.z = _h[_p].x; _r.w = _h[_p].y; dst[_p] = __builtin_bit_cast(bf16x8, _r); } } while (0)
__device__ __forceinline__ float wave_scan_add(float s) {
    s += dpp_x<0x111, 0xf>(s, 0.f); s += dpp_x<0x112, 0xf>(s, 0.f); s += dpp_x<0x114, 0xf>(s, 0.f); s += dpp_x<0x118, 0xf>(s, 0.f);
    s += dpp_x<0x142, 0xa>(s, 0.f); s += dpp_x<0x143, 0xc>(s, 0.f); return s;
}
__device__ __forceinline__ float wave_scan_max(float s) {
    const float ni = -INFINITY;
    s = fmaxf(s, dpp_x<0x111, 0xf>(s, ni)); s = fmaxf(s, dpp_x<0x112, 0xf>(s, ni)); s = fmaxf(s, dpp_x<0x114, 0xf>(s, ni)); s = fmaxf(s, dpp_x<0x118, 0xf>(s, ni));
    s = fmaxf(s, dpp_x<0x142, 0xa>(s, ni)); s = fmaxf(s, dpp_x<0x143, 0xc>(s, ni)); return s;
}
__device__ __forceinline__ void unpack16(const u32x4& a, const u32x4& b, float (&f)[16]) {
    const unsigned w[8] = {a.x, a.y, a.z, a.w, b.x, b.y, b.z, b.w};
#pragma unroll
    for (int i = 0; i < 8; ++i) { f[2 * i] = bflo(w[i]); f[2 * i + 1] = bfhi(w[i]); }
}
__device__ __forceinline__ void mlstm_phase(const PV& p, LAS unsigned char* lds, int bh) {
    const int tid = get_tid(lds);
    const int lane = tid & 63, w = __builtin_amdgcn_readfirstlane(tid >> 6), fr = lane & 15, fq = lane >> 4, tq = (lane & 15) >> 2, tp = lane & 3;
    const int b = bh >> 2, h = bh & 3, srow = tid >> 3, sseg = tid & 7;
    const bf16_t* PROJ = (const bf16_t*)(p.ws() + WS_R2); const float* GATES = (const float*)(p.ws() + WS_GATES); bf16_t* MIX = (bf16_t*)(p.ws() + WS_R1);
    LAS float* DENP = (LAS float*)(lds + ML_DENP); LAS float* DI = (LAS float*)(lds + ML_DI); LAS float* SSQP = (LAS float*)(lds + ML_SSQP); LAS float* NARR = (LAS float*)(lds + ML_NARR);
    const unsigned ldsb = (unsigned)(size_t)lds;
    for (int i = tid; i < 34816 / 16; i += 512) *(LAS u32x4*)(lds + ML_CT + 16 * i) = (u32x4){0u, 0u, 0u, 0u};
    if (tid < 128) NARR[tid] = 0.f;
    f32x4 c3[8];
#pragma unroll
    for (int i = 0; i < 8; ++i) c3[i] = (f32x4){0.f, 0.f, 0.f, 0.f};
    f32x4 nacc = (f32x4){0.f, 0.f, 0.f, 0.f}; float mprev = 0.f;
    bf16x8 ones;
#pragma unroll
    for (int jj = 0; jj < 8; ++jj) ones[jj] = (short)0x3F80;
    float ig = GATES[((size_t)b * SEQ + lane) * 8 + h], lf = GATES[((size_t)b * SEQ + lane) * 8 + 4 + h];
    u32x4 rq0, rq1, rk0, rk1, rv0, rv1;
    u32x2 pend[4]; size_t prow0 = 0; bool have_pend = false;
    { const bf16_t* pr = PROJ + ((size_t)b * SEQ + srow) * NPROJ + h * 128 + 16 * sseg;
      rq0 = *(const u32x4*)pr; rq1 = *(const u32x4*)(pr + 8); rk0 = *(const u32x4*)(pr + 512); rk1 = *(const u32x4*)(pr + 520); rv0 = *(const u32x4*)(pr + 1024); rv1 = *(const u32x4*)(pr + 1032); }
    __syncthreads();
    for (int c = 0; c < SEQ / 64; ++c) {
        const size_t row0 = (size_t)b * SEQ + (size_t)c * 64;
        if (c == 10) GSTAMP(p.ws(), tid, 20);
        u32x2 og[4];
#pragma unroll
        for (int ti = 0; ti < 4; ++ti) og[ti] = *(const u32x2*)(PROJ + (row0 + 16 * ti + fr) * NPROJ + 1536 + h * 128 + 16 * w + 4 * fq);
        const float bc = wave_scan_add(lf), u = ig - bc, cm = wave_scan_max(u);
        const float Mt = fmaxf(cm, mprev), M63 = __builtin_bit_cast(float, __builtin_amdgcn_readlane(__builtin_bit_cast(int, Mt), 63)), bL = __builtin_bit_cast(float, __builtin_amdgcn_readlane(__builtin_bit_cast(int, bc), 63));
        if (c + 1 < SEQ / 64) { ig = GATES[(row0 + 64 + lane) * 8 + h]; lf = GATES[(row0 + 64 + lane) * 8 + 4 + h]; }
        const float sq = fexp(M63 - Mt), sk = fexp(u - M63), fl = fexp(-bc - Mt), decay = fexp(mprev - M63);
        mprev = bL + M63;
        { const float sqv = __shfl(sq, srow), skv = __shfl(sk, srow);
          float f[16]; unpack16(rq0, rq1, f);
          float part = 0.f;
#pragma unroll
          for (int j = 0; j < 16; ++j) { f[j] *= sqv; part += f[j] * NARR[16 * sseg + j]; }
          part += dpp_x<0x101, 0xf>(part, 0.f); part += dpp_x<0x102, 0xf>(part, 0.f); part += dpp_x<0x104, 0xf>(part, 0.f);
          if (sseg == 0) DI[srow] = decay * part;
          if (w == 0) ((LAS float*)(lds + ML_FLA))[lane] = fl;
          u32x4 o0, o1; o0.x = pk2(f[0], f[1]); o0.y = pk2(f[2], f[3]); o0.z = pk2(f[4], f[5]); o0.w = pk2(f[6], f[7]); o1.x = pk2(f[8], f[9]); o1.y = pk2(f[10], f[11]); o1.z = pk2(f[12], f[13]); o1.w = pk2(f[14], f[15]);
          *(LAS u32x4*)(lds + ML_QS + srow * 272 + sseg * 32) = o0; *(LAS u32x4*)(lds + ML_QS + srow * 272 + sseg * 32 + 16) = o1;
          unpack16(rk0, rk1, f);
#pragma unroll
          for (int j = 0; j < 16; ++j) f[j] *= skv;
          o0.x = pk2(f[0], f[1]); o0.y = pk2(f[2], f[3]); o0.z = pk2(f[4], f[5]); o0.w = pk2(f[6], f[7]); o1.x = pk2(f[8], f[9]); o1.y = pk2(f[10], f[11]); o1.z = pk2(f[12], f[13]); o1.w = pk2(f[14], f[15]);
          *(LAS u32x4*)(lds + ML_KS + srow * 272 + sseg * 32) = o0; *(LAS u32x4*)(lds + ML_KS + srow * 272 + sseg * 32 + 16) = o1;
          *(LAS u32x4*)(lds + ML_VS + srow * 272 + sseg * 32) = rv0; *(LAS u32x4*)(lds + ML_VS + srow * 272 + sseg * 32 + 16) = rv1; }
        if (c + 1 < SEQ / 64) { const bf16_t* pr = PROJ + (row0 + 64 + srow) * NPROJ + h * 128 + 16 * sseg;
          rq0 = *(const u32x4*)pr; rq1 = *(const u32x4*)(pr + 8); rk0 = *(const u32x4*)(pr + 512); rk1 = *(const u32x4*)(pr + 520); rv0 = *(const u32x4*)(pr + 1024); rv1 = *(const u32x4*)(pr + 1032); }
        if (c == 10) GSTAMP(p.ws(), tid, 21);
        LDS_BARRIER();
        if (have_pend) {
#pragma unroll
            for (int ti = 0; ti < 4; ++ti) *(u32x2*)(MIX + (prow0 + 16 * ti + fr) * D + h * 128 + 16 * w + 4 * fq) = pend[ti]; }
        if (c == 10) GSTAMP(p.ws(), tid, 22);
        { const int ti = w >> 1; float dsum = 0.f;
          bf16x8 qf[4], kf[2][4];
#pragma unroll
          for (int ks = 0; ks < 4; ++ks) { qf[ks] = *(const LAS bf16x8*)(lds + ML_QS + (16 * ti + fr) * 272 + (32 * ks + 8 * fq) * 2);
#pragma unroll
              for (int jj = 0; jj < 2; ++jj) kf[jj][ks] = *(const LAS bf16x8*)(lds + ML_KS + (16 * (2 * (w & 1) + jj) + fr) * 272 + (32 * ks + 8 * fq) * 2); }
          __builtin_amdgcn_sched_barrier(0);
#pragma unroll
          for (int jj = 0; jj < 2; ++jj) { const int sj = 2 * (w & 1) + jj;
            f32x4 a = (f32x4){0.f, 0.f, 0.f, 0.f};
            if (sj <= ti) {
#pragma unroll
                for (int ks = 0; ks < 4; ++ks) a = __builtin_amdgcn_mfma_f32_16x16x32_bf16(kf[jj][ks], qf[ks], a, 0, 0, 0);
                const int t = 16 * ti + fr, s0 = 16 * sj + 4 * fq;
#pragma unroll
                for (int r = 0; r < 4; ++r) { if (s0 + r > t) a[r] = 0.f; dsum += a[r]; }
            }
            u32x2 pw; pw.x = pk2(a[0], a[1]); pw.y = pk2(a[2], a[3]);
            *(LAS u32x2*)(lds + ML_PS + (16 * ti + fr) * 144 + (16 * sj + 4 * fq) * 2) = pw; }
          dsum += __shfl_xor(dsum, 16); dsum += __shfl_xor(dsum, 32);
          if (fq == 0) DENP[(w & 1) * 64 + 16 * ti + fr] = dsum; }
        if (c == 10) GSTAMP(p.ws(), tid, 23);
        LDS_BARRIER();
        if (c == 10) GSTAMP(p.ws(), tid, 24);
        bf16x8 av[2];
        { u32x2 l0, h0, l1, h1; const unsigned a0 = ldsb + ML_VS + (8 * fq + tq) * 272 + (16 * w + 4 * tp) * 2;
          asm volatile("ds_read_b64_tr_b16 %0, %4\n\tds_read_b64_tr_b16 %1, %4 offset:1088\n\tds_read_b64_tr_b16 %2, %4 offset:8704\n\tds_read_b64_tr_b16 %3, %4 offset:9792\n\ts_waitcnt lgkmcnt(0)"
                       : "=&v"(l0), "=&v"(h0), "=&v"(l1), "=&v"(h1) : "v"(a0) : "memory");
          u32x4 r; r.x = l0.x; r.y = l0.y; r.z = h0.x; r.w = h0.y; av[0] = __builtin_bit_cast(bf16x8, r); r.x = l1.x; r.y = l1.y; r.z = h1.x; r.w = h1.y; av[1] = __builtin_bit_cast(bf16x8, r); }
        bf16x8 ac[4];
#pragma unroll
        for (int ks = 0; ks < 4; ++ks) ac[ks] = *(const LAS bf16x8*)(lds + ML_CT + (16 * w + fr) * 272 + (32 * ks + 8 * fq) * 2);
        float xs[4][4], ssq[4];
#pragma unroll
        for (int hh = 0; hh < 2; ++hh) {
            bf16x8 pb[2][2], qb[2][4]; float dn[2], fv[2];
#pragma unroll
            for (int q = 0; q < 2; ++q) { const int ti = 2 * hh + q, t = 16 * ti + fr;
#pragma unroll
                for (int ks = 0; ks < 2; ++ks) pb[q][ks] = *(const LAS bf16x8*)(lds + ML_PS + t * 144 + (32 * ks + 8 * fq) * 2);
#pragma unroll
                for (int ks = 0; ks < 4; ++ks) qb[q][ks] = *(const LAS bf16x8*)(lds + ML_QS + t * 272 + (32 * ks + 8 * fq) * 2);
                dn[q] = DENP[t] + DENP[64 + t] + DI[t]; fv[q] = ((const LAS float*)(lds + ML_FLA))[t]; }
            __builtin_amdgcn_sched_barrier(0);
#pragma unroll
            for (int q = 0; q < 2; ++q) { const int ti = 2 * hh + q; f32x4 a = (f32x4){0.f, 0.f, 0.f, 0.f}, a2 = (f32x4){0.f, 0.f, 0.f, 0.f};
#pragma unroll
                for (int ks = 0; ks < 2; ++ks) a = __builtin_amdgcn_mfma_f32_16x16x32_bf16(av[ks], pb[q][ks], a, 0, 0, 0);
#pragma unroll
                for (int ks = 0; ks < 4; ++ks) a2 = __builtin_amdgcn_mfma_f32_16x16x32_bf16(ac[ks], qb[q][ks], a2, 0, 0, 0);
                a = a + a2 * decay;
                const float inv = frcp(fmaxf(fabsf(dn[q]), fv[q]));
                xs[ti][0] = sigmoidf_(bflo(og[ti].x)) * a[0] * inv; xs[ti][1] = sigmoidf_(bfhi(og[ti].x)) * a[1] * inv; xs[ti][2] = sigmoidf_(bflo(og[ti].y)) * a[2] * inv; xs[ti][3] = sigmoidf_(bfhi(og[ti].y)) * a[3] * inv;
                ssq[ti] = xs[ti][0] * xs[ti][0] + xs[ti][1] * xs[ti][1] + xs[ti][2] * xs[ti][2] + xs[ti][3] * xs[ti][3]; } }
#pragma unroll
        for (int ti = 0; ti < 4; ++ti) ssq[ti] += __shfl_xor(ssq[ti], 16);
#pragma unroll
        for (int ti = 0; ti < 4; ++ti) ssq[ti] += __shfl_xor(ssq[ti], 32);
        if (fq == 0) {
#pragma unroll
            for (int ti = 0; ti < 4; ++ti) SSQP[w * 64 + 16 * ti + fr] = ssq[ti]; }
        { const unsigned kb = ldsb + ML_KS + (8 * fq + tq) * 272 + 4 * tp * 2;
          bf16x8 k0[8], k1[8];
          TR8(k0, kb, 0, 32); TR8(k1, kb, 8704, 32);
#pragma unroll
          for (int i = 0; i < 8; ++i) { c3[i] = c3[i] * decay;
              c3[i] = __builtin_amdgcn_mfma_f32_16x16x32_bf16(k0[i], av[0], c3[i], 0, 0, 0); c3[i] = __builtin_amdgcn_mfma_f32_16x16x32_bf16(k1[i], av[1], c3[i], 0, 0, 0);
              if (i == w) { nacc = nacc * decay; nacc = __builtin_amdgcn_mfma_f32_16x16x32_bf16(k0[i], ones, nacc, 0, 0, 0); nacc = __builtin_amdgcn_mfma_f32_16x16x32_bf16(k1[i], ones, nacc, 0, 0, 0); } }
          if (fr == 0) *(LAS f32x4*)(NARR + 16 * w + 4 * fq) = nacc; }
        if (c == 10) GSTAMP(p.ws(), tid, 25);
        LDS_BARRIER();
        if (c == 10) GSTAMP(p.ws(), tid, 26);
        if (c == 11) GSTAMP(p.ws(), tid, 27);
#pragma unroll
        for (int ti = 0; ti < 4; ++ti) { const int t = 16 * ti + fr; float s = 0.f;
#pragma unroll
            for (int ww = 0; ww < 8; ++ww) s += SSQP[ww * 64 + t];
            const float rs = frsq(s * (1.0f / 128.f) + EPS);
            pend[ti].x = pk2(xs[ti][0] * rs, xs[ti][1] * rs); pend[ti].y = pk2(xs[ti][2] * rs, xs[ti][3] * rs); }
        prow0 = row0; have_pend = true;
#pragma unroll
        for (int i = 0; i < 8; ++i) { u32x2 cw; cw.x = pk2(c3[i][0], c3[i][1]); cw.y = pk2(c3[i][2], c3[i][3]);
            *(LAS u32x2*)(lds + ML_CT + (16 * w + fr) * 272 + (16 * i + 4 * fq) * 2) = cw; }
    }
#pragma unroll
    for (int ti = 0; ti < 4; ++ti) *(u32x2*)(MIX + (prow0 + 16 * ti + fr) * D + h * 128 + 16 * w + 4 * fq) = pend[ti];
    __syncthreads();
}


constexpr int RL_XC = 0, RL_RG = 34816, RL_OUT = 69632, RL_CW = 104448, RL_CARRY = 114688, RL_SSQP = 116736, RL_END = 124928;
template <int S> __device__ __forceinline__ float dpp_shr(float v, float ident) {
    return __builtin_bit_cast(float, __builtin_amdgcn_update_dpp(__builtin_bit_cast(int, ident), __builtin_bit_cast(int, v), 0x110 + S, 0xf, 0xf, false));
}
__device__ __forceinline__ float row_last(float v) { return __builtin_bit_cast(float, __builtin_amdgcn_ds_swizzle(__builtin_bit_cast(int, v), 0x1F0)); }
template <bool FINAL>
__device__ __forceinline__ void rglru_item(const PV& p, LAS unsigned char* lds, int item) {
    const int tid = get_tid(lds);
    const int lane = tid & 63, w = __builtin_amdgcn_readfirstlane(tid >> 6), fr = lane & 15, fq = lane >> 4, srow = tid >> 3, sseg = tid & 7;
    const int b = item >> 4, chunk = item & 15;
    const bf16_t* PROJ = (const bf16_t*)(p.ws() + WS_R2); bf16_t* MIX = (bf16_t*)(p.ws() + WS_R1); float* SUMM = (float*)(p.ws() + WS_SUMM); const bf16_t* WRI = (const bf16_t*)(p.ws() + WS_WRI);
    LAS float* CW = (LAS float*)(lds + RL_CW); LAS float* CARRY = (LAS float*)(lds + RL_CARRY); LAS float* SSQP = (LAS float*)(lds + RL_SSQP);
    const size_t tok0 = (size_t)b * SEQ + (size_t)chunk * 256;
    if (FINAL) GSTAMP(p.ws(), tid, 0);
    for (int i = tid; i < 2560; i += 512) CW[i] = i < 2048 ? p.in(I_CW)[i] : p.in(I_CB)[i - 2048];
    if (FINAL) {
        float carry = 0.f;
        for (int cc = 0; cc < chunk; ++cc) { const float2 ab = *(const float2*)(SUMM + ((size_t)(b * 16 + cc) * 512 + tid) * 2); carry = ab.x * carry + ab.y; }
        CARRY[tid] = carry;
        for (int i = tid; i < 2048; i += 512) SSQP[i] = 0.f;
    }
    u32x4 rx[8], rgr[2];
    auto prefetch = [&](int sidx) {
        const int hd = sidx >> 2, step = sidx & 3; const int tl = step * 64 + srow; const size_t tok = tok0 + tl; const int tseq = chunk * 256 + tl;
        const bf16_t* px = PROJ + tok * NPROJ + 2048 + hd * 128 + 16 * sseg;
#pragma unroll
        for (int j = 0; j < 4; ++j) { if (tseq - 3 + j >= 0) { rx[2 * j] = *(const u32x4*)(px + (ptrdiff_t)(j - 3) * NPROJ); rx[2 * j + 1] = *(const u32x4*)(px + (ptrdiff_t)(j - 3) * NPROJ + 8); } else { rx[2 * j] = (u32x4){0u, 0u, 0u, 0u}; rx[2 * j + 1] = (u32x4){0u, 0u, 0u, 0u}; } }
        if (FINAL) { rgr[0] = *(const u32x4*)(px + 512); rgr[1] = *(const u32x4*)(px + 520); }
    };
    prefetch(0);
    __syncthreads();
    if (FINAL) GSTAMP(p.ws(), tid, 1);
    float hc[4], ptot[4], brv[4], biv[4], spv[4];
    bf16x8 br[4], bi[4], bid;
    for (int sidx = 0; sidx < 16; ++sidx) {
        const int hd = sidx >> 2, step = sidx & 3, buf = sidx & 1;
        if (step == 0) {
#pragma unroll
            for (int ks = 0; ks < 4; ++ks) { br[ks] = *(const bf16x8*)(WRI + ((size_t)(hd * 256 + 16 * w + fr) * 128 + 32 * ks + 8 * fq)); bi[ks] = *(const bf16x8*)(WRI + ((size_t)(hd * 256 + 128 + 16 * w + fr) * 128 + 32 * ks + 8 * fq)); }
#pragma unroll
            for (int jj = 0; jj < 8; ++jj) bid[jj] = (8 * fq + jj == 16 * (w & 1) + fr) ? (short)0x3F80 : (short)0;
#pragma unroll
            for (int r = 0; r < 4; ++r) { const int ch = hd * 128 + 16 * w + 4 * fq + r; brv[r] = p.in(I_BR)[ch]; biv[r] = p.in(I_BI)[ch]; spv[r] = log1pf(fexp(-p.in(I_LAM)[ch]));
                hc[r] = FINAL ? CARRY[ch] : 0.f; ptot[r] = 1.f; }
        }
        { float xc[16];
          const LAS f32x4* cb4 = (const LAS f32x4*)(CW + 2048 + hd * 128 + 16 * sseg);
#pragma unroll
          for (int q = 0; q < 4; ++q) { const f32x4 v = cb4[q]; xc[4 * q] = v.x; xc[4 * q + 1] = v.y; xc[4 * q + 2] = v.z; xc[4 * q + 3] = v.w; }
#pragma unroll
          for (int j = 0; j < 4; ++j) { float xf[16]; unpack16(rx[2 * j], rx[2 * j + 1], xf); const LAS f32x4* cw4 = (const LAS f32x4*)(CW + j * 512 + hd * 128 + 16 * sseg);
#pragma unroll
              for (int q = 0; q < 4; ++q) { const f32x4 v = cw4[q]; xc[4 * q] += v.x * xf[4 * q]; xc[4 * q + 1] += v.y * xf[4 * q + 1]; xc[4 * q + 2] += v.z * xf[4 * q + 2]; xc[4 * q + 3] += v.w * xf[4 * q + 3]; } }
          u32x4 o0, o1; o0.x = pk2(xc[0], xc[1]); o0.y = pk2(xc[2], xc[3]); o0.z = pk2(xc[4], xc[5]); o0.w = pk2(xc[6], xc[7]); o1.x = pk2(xc[8], xc[9]); o1.y = pk2(xc[10], xc[11]); o1.z = pk2(xc[12], xc[13]); o1.w = pk2(xc[14], xc[15]);
          *(LAS u32x4*)(lds + RL_XC + buf * 17408 + srow * 272 + sseg * 32) = o0; *(LAS u32x4*)(lds + RL_XC + buf * 17408 + srow * 272 + sseg * 32 + 16) = o1;
          if (FINAL) { *(LAS u32x4*)(lds + RL_RG + buf * 17408 + srow * 272 + sseg * 32) = rgr[0]; *(LAS u32x4*)(lds + RL_RG + buf * 17408 + srow * 272 + sseg * 32 + 16) = rgr[1]; } }
        if (sidx + 1 < 16) prefetch(sidx + 1);
        LDS_BARRIER();
        if (FINAL && sidx > 0) { const int ps = sidx - 1, phd = ps >> 2, pstep = ps & 3, pbuf = ps & 1;
            const u32x4 v0 = *(const LAS u32x4*)(lds + RL_OUT + pbuf * 17408 + srow * 272 + sseg * 32), v1 = *(const LAS u32x4*)(lds + RL_OUT + pbuf * 17408 + srow * 272 + sseg * 32 + 16);
            bf16_t* dst = MIX + (tok0 + pstep * 64 + srow) * D + 512 + phd * 128 + 16 * sseg; *(u32x4*)dst = v0; *(u32x4*)(dst + 8) = v1; }
        const int ksx = w >> 1;
#pragma unroll
        for (int m = 0; m < 4; ++m) {
            f32x4 ar = (f32x4){0.f, 0.f, 0.f, 0.f}, ai = ar, ax = ar, ag = ar;
#pragma unroll
            for (int ks = 0; ks < 4; ++ks) { const bf16x8 a = *(const LAS bf16x8*)(lds + RL_XC + buf * 17408 + (16 * m + fr) * 272 + (32 * ks + 8 * fq) * 2);
                ar = __builtin_amdgcn_mfma_f32_16x16x32_bf16(br[ks], a, ar, 0, 0, 0); ai = __builtin_amdgcn_mfma_f32_16x16x32_bf16(bi[ks], a, ai, 0, 0, 0); }
            { const bf16x8 a = *(const LAS bf16x8*)(lds + RL_XC + buf * 17408 + (16 * m + fr) * 272 + (32 * ksx + 8 * fq) * 2); ax = __builtin_amdgcn_mfma_f32_16x16x32_bf16(bid, a, ax, 0, 0, 0); }
            if (FINAL) { const bf16x8 a = *(const LAS bf16x8*)(lds + RL_RG + buf * 17408 + (16 * m + fr) * 272 + (32 * ksx + 8 * fq) * 2); ag = __builtin_amdgcn_mfma_f32_16x16x32_bf16(bid, a, ag, 0, 0, 0); }
            float P[4], H[4];
#pragma unroll
            for (int r = 0; r < 4; ++r) { const float rr = sigmoidf_(ar[r] + brv[r]), ii = sigmoidf_(ai[r] + biv[r]), a = fexp(-8.0f * rr * spv[r]);
                P[r] = a; H[r] = fsqrt(fmaxf(1.0f - a * a, 0.f)) * (ii * ax[r]); }
#pragma unroll
            for (int r = 0; r < 4; ++r) { { const float Pp = dpp_shr<1>(P[r], 1.f), Hp = dpp_shr<1>(H[r], 0.f); H[r] = P[r] * Hp + H[r]; P[r] = P[r] * Pp; }
                { const float Pp = dpp_shr<2>(P[r], 1.f), Hp = dpp_shr<2>(H[r], 0.f); H[r] = P[r] * Hp + H[r]; P[r] = P[r] * Pp; }
                { const float Pp = dpp_shr<4>(P[r], 1.f), Hp = dpp_shr<4>(H[r], 0.f); H[r] = P[r] * Hp + H[r]; P[r] = P[r] * Pp; }
                { const float Pp = dpp_shr<8>(P[r], 1.f), Hp = dpp_shr<8>(H[r], 0.f); H[r] = P[r] * Hp + H[r]; P[r] = P[r] * Pp; } }
            float gq[4]; float ss = 0.f;
#pragma unroll
            for (int r = 0; r < 4; ++r) { const float hv = H[r] + P[r] * hc[r];
                if (FINAL) { gq[r] = gelu_tanh(ag[r]) * hv; ss += gq[r] * gq[r]; } else ptot[r] *= row_last(P[r]);
                hc[r] = row_last(hv); }
            if (FINAL) {
                u32x2 ow; ow.x = pk2(gq[0], gq[1]); ow.y = pk2(gq[2], gq[3]);
                *(LAS u32x2*)(lds + RL_OUT + buf * 17408 + (16 * m + fr) * 272 + (16 * w + 4 * fq) * 2) = ow;
                ss += __shfl_xor(ss, 16); ss += __shfl_xor(ss, 32);
                if (fq == 0) SSQP[w * 256 + step * 64 + 16 * m + fr] += ss;
            }
        }
        if (!FINAL && step == 3 && fr == 0) {
#pragma unroll
            for (int r = 0; r < 4; ++r) *(float2*)(SUMM + ((size_t)(b * 16 + chunk) * 512 + hd * 128 + 16 * w + 4 * fq + r) * 2) = make_float2(ptot[r], hc[r]); }
    }
    if (FINAL) {
        __syncthreads();
        GSTAMP(p.ws(), tid, 2);
        { const int ps = 15, phd = 3, pstep = 3, pbuf = ps & 1;
          const u32x4 v0 = *(const LAS u32x4*)(lds + RL_OUT + pbuf * 17408 + srow * 272 + sseg * 32), v1 = *(const LAS u32x4*)(lds + RL_OUT + pbuf * 17408 + srow * 272 + sseg * 32 + 16);
          bf16_t* dst = MIX + (tok0 + pstep * 64 + srow) * D + 512 + phd * 128 + 16 * sseg; *(u32x4*)dst = v0; *(u32x4*)(dst + 8) = v1; }
        asm volatile("s_waitcnt vmcnt(0)" ::: "memory");
        __syncthreads();
        for (int i = tid; i < 256 * 64; i += 512) { const int tl = i >> 6, c8 = i & 63; float s = 0.f;
#pragma unroll
            for (int ww = 0; ww < 8; ++ww) s += SSQP[ww * 256 + tl];
            const float rs = frsq(s * (1.0f / 512.f) + EPS);
            u32x4* ptr = (u32x4*)(MIX + (tok0 + tl) * D + 512 + c8 * 8); u32x4 v = *ptr;
            v.x = pk2(bflo(v.x) * rs, bfhi(v.x) * rs); v.y = pk2(bflo(v.y) * rs, bfhi(v.y) * rs); v.z = pk2(bflo(v.z) * rs, bfhi(v.z) * rs); v.w = pk2(bflo(v.w) * rs, bfhi(v.w) * rs);
            *ptr = v; }
    }
    __syncthreads();
    if (FINAL) GSTAMP(p.ws(), tid, 3);
}

constexpr int RT_WH = 0, RT_WL = 66048, RT_SELE = 132096, RT_SELG = RT_SELE + 4096, RT_RSTD = RT_SELG + 4096, RT_HIST = RT_RSTD + 1024, RT_BASE = RT_HIST + 128, RT_LDS = RT_BASE + 128;
template <int N> __device__ __forceinline__ float row_ror_f(float v) { return __builtin_bit_cast(float, __builtin_amdgcn_update_dpp(0, __builtin_bit_cast(int, v), 0x120 + N, 0xf, 0xf, false)); }
template <int N> __device__ __forceinline__ int row_ror_i(int v) { return __builtin_amdgcn_update_dpp(0, v, 0x120 + N, 0xf, 0xf, false); }
__device__ __forceinline__ float row_max16(float v) { v = fmaxf(v, row_ror_f<8>(v)); v = fmaxf(v, row_ror_f<4>(v)); v = fmaxf(v, row_ror_f<2>(v)); v = fmaxf(v, row_ror_f<1>(v)); return v; }
__device__ __forceinline__ int row_min16(int v) { v = min(v, row_ror_i<8>(v)); v = min(v, row_ror_i<4>(v)); v = min(v, row_ror_i<2>(v)); v = min(v, row_ror_i<1>(v)); return v; }
__device__ __forceinline__ void routing_block(const PV& p, LAS unsigned char* lds, int tb) {
    const int tid = get_tid(lds), lane = tid & 63, wave = __builtin_amdgcn_readfirstlane(tid >> 6), fr = lane & 15, fq = lane >> 4;
    LAS int* selE = (LAS int*)(lds + RT_SELE); LAS float* selG = (LAS float*)(lds + RT_SELG);
    LAS float* rstds = (LAS float*)(lds + RT_RSTD); LAS int* hist = (LAS int*)(lds + RT_HIST); LAS int* base = (LAS int*)(lds + RT_BASE);
    { const u32x4* src = (const u32x4*)(p.ws() + WS_WRT);
      for (int i = tid; i < 2 * 32 * 128; i += 512) { const int hl = i >> 12, e = (i >> 7) & 31, c = i & 127; *(LAS u32x4*)(lds + (hl ? RT_WL : RT_WH) + e * 2064 + c * 16) = src[i]; } }
    if (tid < 32) hist[tid] = 0;
    __syncthreads();
    const bf16_t* HB = (const bf16_t*)(p.ws() + WS_HB); unsigned char* HB8 = (unsigned char*)(p.ws() + WS_HB8);
    const size_t tok0 = (size_t)tb * 256 + 32 * wave;
    f32x4 acc[2][2];
#pragma unroll
    for (int m = 0; m < 2; ++m)
#pragma unroll
        for (int hf = 0; hf < 2; ++hf) acc[m][hf] = (f32x4){0.f, 0.f, 0.f, 0.f};
    float ss[2] = {0.f, 0.f};
#pragma unroll 4
    for (int ks = 0; ks < 32; ++ks) {
        bf16x8 ah[2];
#pragma unroll
        for (int m = 0; m < 2; ++m) { const size_t off = (tok0 + 16 * m + fr) * D + 32 * ks + 8 * fq;
            const u32x4 hv = *(const u32x4*)(HB + off);
            const float x0 = bflo(hv.x), x1 = bfhi(hv.x), x2 = bflo(hv.y), x3 = bfhi(hv.y), x4 = bflo(hv.z), x5 = bfhi(hv.z), x6 = bflo(hv.w), x7 = bfhi(hv.w);
            ss[m] += (x0 * x0 + x1 * x1) + (x2 * x2 + x3 * x3) + (x4 * x4 + x5 * x5) + (x6 * x6 + x7 * x7);
            ah[m] = __builtin_bit_cast(bf16x8, hv);
            u32x2 f8; f8.x = pk4_fp8(clamp448(x0 * SC_H), clamp448(x1 * SC_H), clamp448(x2 * SC_H), clamp448(x3 * SC_H)); f8.y = pk4_fp8(clamp448(x4 * SC_H), clamp448(x5 * SC_H), clamp448(x6 * SC_H), clamp448(x7 * SC_H));
            *(u32x2*)(HB8 + off) = f8; }
#pragma unroll
        for (int hf = 0; hf < 2; ++hf) { const bf16x8 bh = *(const LAS bf16x8*)(lds + RT_WH + (16 * hf + fr) * 2064 + (32 * ks + 8 * fq) * 2), bl = *(const LAS bf16x8*)(lds + RT_WL + (16 * hf + fr) * 2064 + (32 * ks + 8 * fq) * 2);
#pragma unroll
            for (int m = 0; m < 2; ++m) { acc[m][hf] = __builtin_amdgcn_mfma_f32_16x16x32_bf16(ah[m], bh, acc[m][hf], 0, 0, 0); acc[m][hf] = __builtin_amdgcn_mfma_f32_16x16x32_bf16(ah[m], bl, acc[m][hf], 0, 0, 0); } }
    }
#pragma unroll
    for (int m = 0; m < 2; ++m) { float s = ss[m]; s += __shfl_xor(s, 16); s += __shfl_xor(s, 32); if (fq == 0) rstds[32 * wave + 16 * m + fr] = frsq(s * (1.0f / D) + EPS); }
    const float rb0 = p.in(I_RB)[fr], rb1 = p.in(I_RB)[16 + fr];
#pragma unroll
    for (int m = 0; m < 2; ++m)
#pragma unroll
        for (int r = 0; r < 4; ++r) { const int tl = 32 * wave + 16 * m + 4 * fq + r; const float rstd = rstds[tl];
            float l0 = acc[m][0][r] * rstd + rb0, l1 = acc[m][1][r] * rstd + rb1;
            float tv[4]; int te[4];
#pragma unroll
            for (int k = 0; k < 4; ++k) { const float mx = row_max16(fmaxf(l0, l1));
                const int cand = l0 == mx ? fr : (l1 == mx ? 16 + fr : 99), sel = row_min16(cand);
                tv[k] = mx; te[k] = sel; if (sel == fr) l0 = -INFINITY; if (sel == 16 + fr) l1 = -INFINITY; }
            const float e1 = fexp(tv[1] - tv[0]), e2 = fexp(tv[2] - tv[0]), e3 = fexp(tv[3] - tv[0]), inv = 1.0f / (1.0f + e1 + e2 + e3);
            if (fr < 4) { const int ee = fr == 0 ? te[0] : fr == 1 ? te[1] : fr == 2 ? te[2] : te[3]; const float gg = (fr == 0 ? 1.0f : fr == 1 ? e1 : fr == 2 ? e2 : e3) * inv;
                selE[tl * 4 + fr] = ee; selG[tl * 4 + fr] = gg; } }
    __syncthreads();
    int myrank[2], mye[2];
#pragma unroll
    for (int q = 0; q < 2; ++q) { const int a = tid + 512 * q; mye[q] = selE[a]; myrank[q] = atomicAdd((int*)(hist + mye[q]), 1); }
    __syncthreads();
    unsigned* ctl = (unsigned*)(p.ws() + WS_CTL);
    if (tid < 32) base[tid] = (int)atomicAdd(ctl + CW_CNT + tid, (unsigned)hist[tid]);
    __syncthreads();
    i32x4* ENT = (i32x4*)(p.ws() + WS_ENT);
#pragma unroll
    for (int q = 0; q < 2; ++q) { const int a = tid + 512 * q, tl = a >> 2, k = a & 3; const int pos = base[mye[q]] + myrank[q];
        i32x4 en; en.x = tb * 256 + tl; en.y = __float_as_int(rstds[tl]); en.z = k; en.w = __float_as_int(selG[a]); ENT[(size_t)mye[q] * T + pos] = en; }
}
__device__ __forceinline__ void routing_phase(const PV& p, LAS unsigned char* lds) {
    for (int tb = blockIdx.x; tb < T / 256; tb += gridDim.x) { routing_block(p, lds, tb); __syncthreads(); }
}

struct Rounds { int es; int nr; __device__ __forceinline__ int lo(int r) const { return r == 0 ? 0 : es; } __device__ __forceinline__ int hi(int r) const { return r == 0 ? es : NE; } };
__device__ __forceinline__ int pad256(int c) { return (c + 255) & ~255; }
__device__ __forceinline__ Rounds make_rounds(const unsigned* cnt) {
    Rounds R; int sum = 0, e = 0;
    for (; e < NE; ++e) { const int pc = pad256((int)cnt[e]); if (sum + pc > CAP_ROWS) break; sum += pc; }
    R.es = e; R.nr = e < NE ? 2 : 1; return R;
}
__device__ __forceinline__ float f8lane(unsigned w, int i) { return i == 0 ? __builtin_amdgcn_cvt_f32_fp8((int)w, 0) : i == 1 ? __builtin_amdgcn_cvt_f32_fp8((int)w, 1) : i == 2 ? __builtin_amdgcn_cvt_f32_fp8((int)w, 2) : __builtin_amdgcn_cvt_f32_fp8((int)w, 3); }
__device__ __forceinline__ void combine_rows(const PV& p, int gw, int ngw, int lane) {
    const bf16_t* HB = (const bf16_t*)(p.ws() + WS_HB); const unsigned char* Y23 = (const unsigned char*)(p.ws() + WS_Y23);
    f32x4 fw[4];
#pragma unroll
    for (int q = 0; q < 4; ++q) fw[q] = *(const f32x4*)(p.in(I_FNW) + 16 * lane + 4 * q);
    for (int m = gw; m < T; m += ngw) {
        float v[16];
        const u32x4 h0 = *(const u32x4*)(HB + (size_t)m * D + 16 * lane), h1 = *(const u32x4*)(HB + (size_t)m * D + 16 * lane + 8);
        const unsigned hw[8] = {h0.x, h0.y, h0.z, h0.w, h1.x, h1.y, h1.z, h1.w};
#pragma unroll
        for (int q = 0; q < 8; ++q) { v[2 * q] = bflo(hw[q]); v[2 * q + 1] = bfhi(hw[q]); }
        float ys[16];
#pragma unroll
        for (int q = 0; q < 16; ++q) ys[q] = 0.f;
#pragma unroll
        for (int k = 0; k < 4; ++k) { const unsigned char* yb = (k < 2 ? (const unsigned char*)p.out() + (size_t)m * 4096 : Y23 + (size_t)m * 2048) + (k & 1) * 1024;
            const u32x4 y = *(const u32x4*)(yb + 16 * lane); const unsigned yw[4] = {y.x, y.y, y.z, y.w};
#pragma unroll
            for (int q = 0; q < 4; ++q) { ys[4 * q] += f8lane(yw[q], 0); ys[4 * q + 1] += f8lane(yw[q], 1); ys[4 * q + 2] += f8lane(yw[q], 2); ys[4 * q + 3] += f8lane(yw[q], 3); } }
        float s = 0.f;
#pragma unroll
        for (int q = 0; q < 16; ++q) { v[q] += ys[q] * (1.0f / SC_Y); s += v[q] * v[q]; }
        const float rstd = frsq(wave_sum(s) * (1.0f / D) + EPS);
        float* o = p.out() + (size_t)m * D + 16 * lane;
#pragma unroll
        for (int q = 0; q < 4; ++q) { f32x4 r; r.x = v[4 * q] * rstd * fw[q].x; r.y = v[4 * q + 1] * rstd * fw[q].y; r.z = v[4 * q + 2] * rstd * fw[q].z; r.w = v[4 * q + 3] * rstd * fw[q].w;
            *(f32x4*)(o + 4 * q) = r; }
    }
}
#ifndef REP_P0
#define REP_P0 1
#endif
#ifndef REP_P1
#define REP_P1 1
#endif
#ifndef REP_P2
#define REP_P2 1
#endif
#ifndef REP_P3
#define REP_P3 1
#endif
#ifndef REP_P4
#define REP_P4 1
#endif
#ifndef REP_G1
#define REP_G1 1
#endif
#ifndef REP_G2
#define REP_G2 1
#endif
__global__ void __launch_bounds__(512, 2) fwd(Params kp) {
    extern __shared__ __attribute__((aligned(16))) unsigned char lds_[];
    LAS unsigned char* lds = (LAS unsigned char*)lds_;
    {
        const int t0 = threadIdx.x;
        if (t0 < 22) *(volatile LAS unsigned long long*)(lds + LDS_PTAB_OFF + 8 * t0) = (unsigned long long)(size_t)kp.in[t0];
        if (t0 == 22) *(volatile LAS unsigned long long*)(lds + LDS_PTAB_OFF + 8 * 22) = (unsigned long long)(size_t)kp.out;
        if (t0 == 23) *(volatile LAS unsigned long long*)(lds + LDS_PTAB_OFF + 8 * 23) = (unsigned long long)(size_t)kp.ws;
    }
    unsigned char* ws = kp.ws;
    unsigned* bar = (unsigned*)(ws + WS_CTL) + CW_BAR;
    const PV p{lds};
    {
        const int t0 = threadIdx.x;
        const unsigned slot = (unsigned)__builtin_amdgcn_s_getreg(((6 - 1) << 11) | 4);
        if ((t0 & 63) == 0) *(volatile LAS int*)(lds + LDS_TAB + 4 * slot) = t0 >> 6;
        if (t0 == 0) { *(volatile LAS unsigned*)(lds + LDS_BARST) = 0u; *(volatile LAS unsigned*)(lds + LDS_BARST + 4) = 0u;
            const unsigned x = xb_xcc_id(), rank = xb_add(&bar[XB_XCNT(x)], 1u);
            *(volatile LAS unsigned*)(lds + LDS_BARST + 8) = rank * 8u + x; }
        __syncthreads();
    }
#ifdef PROBE_PH
    volatile LAS unsigned long long* phs = (volatile LAS unsigned long long*)(lds + LDS_TAB - 256); int nph = 0;
#define PH_STAMP() do { if (get_tid(lds) == 0) phs[nph] = __builtin_amdgcn_s_memrealtime(); ++nph; } while (0)
    PH_STAMP();
#define GRID_BAR() do { grid_barrier(bar, lds); PH_STAMP(); } while (0)
#else
#define PH_STAMP() do { } while (0)
#define GRID_BAR() grid_barrier(bar, lds)
#endif
    for (int rep = 0; rep < REP_P0; ++rep) { prep_phase(p, lds);
    cg::this_grid().sync(); PH_STAMP(); }
    int vcu = (int)blockIdx.x;
    { bool even = (gridDim.x % 8u) == 0u;
      for (unsigned j = 0; j < 16; ++j) { const unsigned c = xb_ld(&bar[XB_XCNT(j)]); if (c != (j < 8 ? gridDim.x / 8u : 0u)) even = false; }
      if (even) vcu = (int)*(volatile LAS unsigned*)(lds + LDS_BARST + 8);
      vcu = __builtin_amdgcn_readfirstlane(vcu); }
    for (int rep = 0; rep < REP_P1; ++rep) {
    { DenseSched S; S.o.init(T / 256, NPROJ / 256, gridDim.x, vcu); S.A = (const char*)(ws + WS_R1); S.Bt = (const char*)(ws + WS_WIN); S.pitch = 2 * D; EpiInProj E{(bf16_t*)(ws + WS_R2)};
      pg8::gemm_phase<false, false>(lds, (const char*)(ws + WS_R1), 2 * D, S, E); }
    GRID_BAR(); }
    {
        unsigned* ctl = (unsigned*)(ws + WS_CTL);
        if (blockIdx.x < 64) mlstm_phase(p, lds, blockIdx.x);
        volatile LAS int* qslot = (volatile LAS int*)(lds + LDS_BARST + 12);
        for (;;) {
            const int tid = get_tid(lds);
            if (tid == 0) *qslot = (int)xb_add(ctl + CW_WORK, 1u);
            __syncthreads();
            const int idx = __builtin_amdgcn_readfirstlane(*qslot);
            __syncthreads();
            if (idx < 256) {
                rglru_item<false>(p, lds, idx);
                asm volatile("s_waitcnt vmcnt(0)" ::: "memory"); __syncthreads();
                if (get_tid(lds) == 0) { __builtin_amdgcn_fence(__ATOMIC_RELEASE, "agent"); asm volatile("s_waitcnt vmcnt(0)" ::: "memory"); (void)xb_add(ctl + CW_CNTA + 16 * (idx >> 4), 1u); }
            } else if (idx < 512) {
                const int it = idx - 256;
                if (get_tid(lds) == 0) { XB_SPIN(xb_ld(ctl + CW_CNTA + 16 * (it >> 4)) < 16u, bar); __builtin_amdgcn_fence(__ATOMIC_ACQUIRE, "agent"); asm volatile("s_waitcnt vmcnt(0)" ::: "memory"); }
                __syncthreads();
                rglru_item<true>(p, lds, it);
            } else if (idx < 512 + 384) {
                const int ch = idx - 512, wave = get_tid(lds) >> 6, lane = get_tid(lds) & 63;
                LAS float* scr = (LAS float*)(lds + wave * 17408);
                for (int q = 0; q < 8; ++q) conv_item_moe(p, ch * 64 + wave * 8 + q, scr, lane);
                __syncthreads();
            } else break;
        }
    }
    GRID_BAR();
    for (int rep = 0; rep < REP_P4; ++rep) {
    { DenseSched S; S.o.init(T / 256, D / 256, gridDim.x, vcu); S.A = (const char*)(ws + WS_R1); S.Bt = (const char*)(ws + WS_WOUT); S.pitch = 2 * D; EpiOutProj E{p.in(I_X), (bf16_t*)(ws + WS_HB)};
      pg8::gemm_phase<false, false>(lds, (const char*)(ws + WS_R1), 2 * D, S, E); }
    GRID_BAR(); }
    routing_phase(p, lds);
    GRID_BAR();
    const unsigned* cnt = (const unsigned*)(ws + WS_CTL) + CW_CNT;
    const Rounds RR = make_rounds(cnt);
    for (int r = 0; r < RR.nr; ++r) {
        for (int rep = 0; rep < REP_G1; ++rep) {
        { MoeSched<true, 8, 2 * DFF> S{cnt, (const i32x4*)(ws + WS_ENT), (const char*)(ws + WS_HB8), (const char*)(ws + WS_WGU), lds, RR.lo(r), RR.hi(r), (int)gridDim.x, vcu, 0, p.in(I_BGU)}; S.init_tot(get_tid(lds));
          EpiG1 E{(unsigned char*)(ws + WS_R2)};
          pg8::gemm_phase<true, true>(lds, (const char*)(ws + WS_HB8), D, S, E, ws, 8); }
        GRID_BAR(); }
        for (int rep = 0; rep < REP_G2; ++rep) {
        { MoeSched<false, 4, D> S{cnt, (const i32x4*)(ws + WS_ENT), (const char*)(ws + WS_R2), (const char*)(ws + WS_WDN), lds, RR.lo(r), RR.hi(r), (int)gridDim.x, vcu, 0, p.in(I_BDN)}; S.init_tot(get_tid(lds));
          EpiG2 E{(unsigned char*)p.out(), (unsigned char*)(ws + WS_Y23)};
          pg8::gemm_phase<true, false>(lds, (const char*)(ws + WS_R2), DFF, S, E, ws, 16); }
        GRID_BAR(); }
    }
    { const int tid = get_tid(lds); combine_rows(p, blockIdx.x * 8 + (tid >> 6), gridDim.x * 8, tid & 63); }
#ifdef PROBE_G
    if (blockIdx.x == PROBE_BLK && get_tid(lds) == 0) {
        const volatile unsigned long long* st = (const volatile unsigned long long*)(ws + WS_CTL + 40960);
        const unsigned long long ticks = (st[PROBE_I + PROBE_SPAN] - st[PROBE_I]) * PROBE_MUL;
        const unsigned long long t0 = __builtin_amdgcn_s_memrealtime();
        while (__builtin_amdgcn_s_memrealtime() - t0 < ticks) __builtin_amdgcn_s_sleep(8);
    }
#endif
#ifdef PROBE_PH
    PH_STAMP();
    if (vcu == 0 && get_tid(lds) == 0) {
        const unsigned long long ticks = (phs[PROBE_PH + 1] - phs[PROBE_PH]) * PROBE_MUL;
        const unsigned long long t0 = __builtin_amdgcn_s_memrealtime();
        while (__builtin_amdgcn_s_memrealtime() - t0 < ticks) __builtin_amdgcn_s_sleep(8);
    }
#endif
}

extern "C" void kernel_launch(void* const* d_in, const int* in_sizes, int n_in, void* d_out, int out_size, void* d_ws, size_t ws_size, hipStream_t stream) {
    static int grid = 0;
    if (grid == 0) {
        if (n_in != 22 || ws_size < WS_END) { fprintf(stderr, "kernel_launch: unexpected n_in %d / ws_size %zu (need %zu)\n", n_in, ws_size, (size_t)WS_END); grid = -1; return; }
        int dev = 0, cus = 0, per_cu = 0;
        (void)hipGetDevice(&dev); (void)hipDeviceGetAttribute(&cus, hipDeviceAttributeMultiprocessorCount, dev);
        (void)hipFuncSetAttribute((const void*)fwd, hipFuncAttributeMaxDynamicSharedMemorySize, LDS_BYTES);
        (void)hipOccupancyMaxActiveBlocksPerMultiprocessor(&per_cu, (const void*)fwd, 512, LDS_BYTES);
        if (per_cu < 1) { fprintf(stderr, "kernel_launch: occupancy query says %d blocks/CU\n", per_cu); per_cu = 1; }
        grid = cus * per_cu;
        fprintf(stderr, "kernel_launch: grid %d (cus %d x %d)\n", grid, cus, per_cu);
    }
    if (grid < 0) return;
    Params p{};
    for (int i = 0; i < 22; ++i) p.in[i] = (const float*)d_in[i];
    p.out = (float*)d_out; p.ws = (unsigned char*)d_ws;
    (void)hipMemsetAsync((unsigned char*)d_ws + WS_CTL, 0, 65536, stream);
    void* args[] = {&p};
    hipError_t e = hipLaunchCooperativeKernel((const void*)fwd, dim3(grid), dim3(512), args, LDS_BYTES, stream);
    if (e != hipSuccess) fprintf(stderr, "kernel_launch: cooperative launch failed: %s (grid %d)\n", hipGetErrorString(e), grid);
}
```

```cpp
#include <hip/hip_runtime.h>
#include <hip/hip_cooperative_groups.h>
#include <cstdio>
#include <cstdint>

namespace cg = cooperative_groups;
#define LAS __attribute__((address_space(3)))
typedef unsigned short bf16_t;
typedef short bf16x8 __attribute__((ext_vector_type(8)));
typedef float f32x4 __attribute__((ext_vector_type(4)));
typedef unsigned u32x4 __attribute__((ext_vector_type(4)));
typedef unsigned u32x2 __attribute__((ext_vector_type(2)));
typedef int i32x4 __attribute__((ext_vector_type(4)));

constexpr int T = 65536, D = 1024, SEQ = 4096, NB = 16;
constexpr int INC = 3080;
constexpr int NPROJ = 3072;
constexpr int NE = 32, TOPK = 4, DFF = 1024;
constexpr float EPS = 1e-6f;
constexpr int CAP_ROWS = 270336;
constexpr float SC_H = 8.0f, SC_W = 64.0f, SC_HID = 4.0f;

constexpr size_t MB = 1024 * 1024;
constexpr size_t WS_CTL  = 0;
constexpr size_t WS_GATES = 1 * MB;
constexpr size_t WS_SSQR = 3 * MB;
constexpr size_t WS_SUMM = 4 * MB;
constexpr size_t WS_WRI  = 5 * MB;
constexpr size_t WS_WRT  = 5 * MB + 512 * 1024;
constexpr size_t WS_ENT  = 6 * MB;
constexpr size_t WS_WIN  = 38 * MB;
constexpr size_t WS_WOUT = 44 * MB;
constexpr size_t WS_WGU  = 46 * MB;
constexpr size_t WS_WDN  = 110 * MB;
constexpr size_t WS_HB8  = 142 * MB;
constexpr size_t WS_R1   = 238 * MB;
constexpr size_t WS_R2   = 366 * MB;
constexpr size_t WS_Y23  = 750 * MB;
constexpr size_t WS_QB   = 750 * MB;
constexpr size_t WS_NUML = 878 * MB;
constexpr size_t WS_DENL = 942 * MB;
constexpr size_t WS_MLST = 943 * MB;
constexpr size_t WS_MLSC = 946 * MB;
constexpr size_t WS_HB   = 878 * MB;
constexpr float SC_Y = 32.0f;
constexpr size_t WS_END  = 1006 * MB;

constexpr int CW_CNT = 0;
constexpr int CW_CONV = 96, CW_CACT = 112;
constexpr int CW_WORK = 64;
constexpr int CW_CNTA = 128;
constexpr int CW_MLF2 = 576;
constexpr int CW_MLF = 512;
constexpr int CW_BAR = 1024;

__device__ __forceinline__ unsigned pk2(float lo, float hi) { unsigned r; asm("v_cvt_pk_bf16_f32 %0, %1, %2" : "=v"(r) : "v"(lo), "v"(hi)); return r; }
__device__ __forceinline__ float bflo(unsigned u) { return __uint_as_float(u << 16); }
__device__ __forceinline__ float bfhi(unsigned u) { return __uint_as_float(u & 0xffff0000u); }
__device__ __forceinline__ float bf2f(bf16_t b) { return __uint_as_float(((unsigned)b) << 16); }
template <int CTRL, int RM> __device__ __forceinline__ float dpp_x(float v, float ident) {
    return __builtin_bit_cast(float, __builtin_amdgcn_update_dpp(__builtin_bit_cast(int, ident), __builtin_bit_cast(int, v), CTRL, RM, 0xf, false));
}
__device__ __forceinline__ float wave_sum(float s) {
    s += dpp_x<0x111, 0xf>(s, 0.f); s += dpp_x<0x112, 0xf>(s, 0.f); s += dpp_x<0x114, 0xf>(s, 0.f); s += dpp_x<0x118, 0xf>(s, 0.f);
    s += dpp_x<0x142, 0xa>(s, 0.f); s += dpp_x<0x143, 0xc>(s, 0.f);
    return __builtin_bit_cast(float, __builtin_amdgcn_readlane(__builtin_bit_cast(int, s), 63));
}
__device__ __forceinline__ float fexp(float x) { return __builtin_amdgcn_exp2f(x * 1.4426950408889634f); }
__device__ __forceinline__ float frcp(float x) { return __builtin_amdgcn_rcpf(x); }
__device__ __forceinline__ float fsqrt(float x) { return __builtin_amdgcn_sqrtf(x); }
__device__ __forceinline__ float frsq(float x) { return __builtin_amdgcn_rsqf(x); }
__device__ __forceinline__ float sigmoidf_(float x) { return frcp(1.0f + __builtin_amdgcn_exp2f(x * -1.4426950408889634f)); }
typedef float f32x2 __attribute__((ext_vector_type(2)));
__device__ __forceinline__ f32x2 exp2_2(f32x2 t) { return (f32x2){__builtin_amdgcn_exp2f(t.x), __builtin_amdgcn_exp2f(t.y)}; }
__device__ __forceinline__ f32x2 rcp_2(f32x2 t) { return (f32x2){__builtin_amdgcn_rcpf(t.x), __builtin_amdgcn_rcpf(t.y)}; }
__device__ __forceinline__ f32x2 sig_2(f32x2 x) { return rcp_2(exp2_2(x * -1.4426950408889634f) + 1.0f); }
__device__ __forceinline__ float gelu_tanh(float x) {
    const float u2 = 1.5957691216057308f * (x + 0.044715f * x * x * x);
    return x * sigmoidf_(u2);
}

typedef int i32x8 __attribute__((ext_vector_type(8)));
__device__ __forceinline__ unsigned pk4_fp8(float a, float b, float c, float d) {
    int r = __builtin_amdgcn_cvt_pk_fp8_f32(a, b, 0, false); r = __builtin_amdgcn_cvt_pk_fp8_f32(c, d, r, true); return (unsigned)r;
}
__device__ __forceinline__ float clamp448(float x) { return fminf(fmaxf(x, -448.f), 448.f); }

struct Params {
    const float* in[22];
    float* out;
    unsigned char* ws;
    int pad0, pad1;
};
constexpr int LDS_PTAB_OFF = 159744 - 512 - 256 - 256;
struct PV {
    LAS unsigned char* l;
    __device__ __forceinline__ unsigned long long ptr(int i) const { const u32x2 v = *(volatile LAS u32x2*)(l + LDS_PTAB_OFF + 8 * i);
        return ((unsigned long long)(unsigned)__builtin_amdgcn_readfirstlane((int)v.y) << 32) | (unsigned)__builtin_amdgcn_readfirstlane((int)v.x); }
    __device__ __forceinline__ const float* in(int i) const { return (const float*)(const __attribute__((address_space(1))) float*)(size_t)ptr(i); }
    __device__ __forceinline__ float* out() const { return (float*)(__attribute__((address_space(1))) float*)(size_t)ptr(22); }
    __device__ __forceinline__ unsigned char* ws() const { return (unsigned char*)(__attribute__((address_space(1))) unsigned char*)(size_t)ptr(23); }
};
enum { I_X = 0, I_N1W, I_WIN, I_GB, I_MNW, I_CW, I_CB, I_WR, I_BR, I_WI, I_BI, I_LAM, I_LNW, I_WOUT, I_N2W, I_RW, I_RB, I_WGU, I_BGU, I_WDN, I_BDN, I_FNW };


constexpr int LDS_BYTES = 159744, LDS_TAB = LDS_BYTES - 512, LDS_BARST = LDS_BYTES - 16;
__device__ __forceinline__ int get_tid(LAS unsigned char* lds) {
    const unsigned slot = (unsigned)__builtin_amdgcn_s_getreg(((6 - 1) << 11) | 4);
    const int w = __builtin_amdgcn_readfirstlane(*(volatile LAS int*)(lds + LDS_TAB + 4 * slot));
    int lane; asm volatile("v_mbcnt_lo_u32_b32 %0, -1, 0\n\tv_mbcnt_hi_u32_b32 %0, -1, %0" : "=v"(lane));
    return w * 64 + lane;
}
#define XB_TMO      128
#define XB_XCNT(j)  (256  + 64 * (j))
#define XB_XSUB(j)  (1280 + 64 * (j))
#define XB_XGEN(j)  (2304 + 64 * (j))
#define XB_TOP      3328
#define XB_TOPGEN   3392
#define XCD_BAR_WORDS 3456
#define XB_SPIN_CAP (1u << 22)
__device__ __forceinline__ unsigned xb_ld(unsigned* p)              { return __hip_atomic_load(p, __ATOMIC_RELAXED, __HIP_MEMORY_SCOPE_AGENT); }
__device__ __forceinline__ unsigned xb_add(unsigned* p, unsigned v) { return __hip_atomic_fetch_add(p, v, __ATOMIC_RELAXED, __HIP_MEMORY_SCOPE_AGENT); }
__device__ __forceinline__ unsigned xb_xcc_id() { return (unsigned)__builtin_amdgcn_s_getreg((3 << 11) | 20) & 0xFu; }
#define XB_SPIN(cond, bar) do { unsigned _sp = 0; while (cond) { __builtin_amdgcn_s_sleep(1); \
    if ((++_sp & 255u) == 0u) { if (xb_ld(&(bar)[XB_TMO])) break; if (_sp > XB_SPIN_CAP) { atomicAdd(&(bar)[XB_TMO], 1u); break; } } } } while (0)
__device__ __forceinline__ void xcd_barrier_complete(unsigned* bar, unsigned x, unsigned G, unsigned& nloc, unsigned& nx) {
    unsigned sum, cnt, mine, sp = 0u;
    for (;;) {
        sum = 0u; cnt = 0u; mine = 0u;
#pragma unroll
        for (unsigned j = 0; j < 16; ++j) { const unsigned c = xb_ld(&bar[XB_XCNT(j)]); sum += c; cnt += (c > 0u) ? 1u : 0u; mine = (j == x) ? c : mine; }
        if (sum == G) break;
        __builtin_amdgcn_s_sleep(1);
        if ((++sp & 255u) == 0u) { if (xb_ld(&bar[XB_TMO])) break; if (sp > XB_SPIN_CAP) { atomicAdd(&bar[XB_TMO], 1u); break; } }
    }
    nloc = mine > 0u ? mine : 1u; nx = cnt > 0u ? cnt : 1u;
}
__device__ __forceinline__ void grid_barrier(unsigned* bar, LAS unsigned char* lds) {
    asm volatile("s_waitcnt vmcnt(0)" ::: "memory");
    __syncthreads();
    if (get_tid(lds) == 0) {
        volatile LAS unsigned* st = (volatile LAS unsigned*)(lds + LDS_BARST);
        const unsigned x = xb_xcc_id();
        __builtin_amdgcn_s_waitcnt(0);
        unsigned nloc = st[0], nx = st[1];
        if (nloc == 0u) { xcd_barrier_complete(bar, x, gridDim.x, nloc, nx); st[0] = nloc; st[1] = nx; }
        const unsigned old = xb_add(&bar[XB_XSUB(x)], 1u);
        const unsigned gen = old / nloc;
        if (old + 1u == (gen + 1u) * nloc) {
            __builtin_amdgcn_fence(__ATOMIC_RELEASE, "agent");
            asm volatile("s_waitcnt vmcnt(0)" ::: "memory");
            const unsigned og = xb_add(&bar[XB_TOP], 1u);
            const unsigned tg = og / nx;
            if (og + 1u == (tg + 1u) * nx) xb_add(&bar[XB_TOPGEN], 1u);
            else XB_SPIN(xb_ld(&bar[XB_TOPGEN]) == tg, bar);
            __builtin_amdgcn_fence(__ATOMIC_ACQUIRE, "agent");
            xb_add(&bar[XB_XGEN(x)], 1u);
            asm volatile("s_waitcnt vmcnt(0)" ::: "memory");
        } else {
            XB_SPIN(xb_ld(&bar[XB_XGEN(x)]) == gen, bar);
            __builtin_amdgcn_fence(__ATOMIC_ACQUIRE, "agent");
            asm volatile("s_waitcnt vmcnt(0)" ::: "memory");
        }
    }
    __syncthreads();
}

#ifdef PROBE_G
#define GSTAMP(ws_, tid_, i_) do { if (((i_) == PROBE_I || (i_) == PROBE_I + PROBE_SPAN) && blockIdx.x == PROBE_BLK && (tid_) == 0) ((volatile unsigned long long*)((ws_) + WS_CTL + 40960))[i_] = __builtin_amdgcn_s_memrealtime(); } while (0)
#else
#define GSTAMP(ws_, tid_, i_) do { } while (0)
#endif
__device__ __forceinline__ void tr_item(const float* __restrict__ W, int ldw, int col0, bf16_t* dst, int K, int k0, const float* sk, float mul, LAS float* scr, int lane) {
    float v[32];
    const float* src = W + (size_t)(k0 + (lane >> 5)) * ldw + col0 + (lane & 31);
#pragma unroll
    for (int i = 0; i < 32; ++i) v[i] = __builtin_nontemporal_load(src + (size_t)(2 * i) * ldw);
#pragma unroll
    for (int i = 0; i < 32; ++i) { const int kk = 2 * i + (lane >> 5); const float s = sk ? sk[k0 + kk] * mul : mul; scr[kk * 33 + (lane & 31)] = v[i] * s; }
    asm volatile("s_waitcnt lgkmcnt(0)" ::: "memory");
    const int c = lane & 7;
#pragma unroll
    for (int j = 0; j < 4; ++j) { const int n = (lane >> 3) + 8 * j; const LAS float* s = scr + (8 * c) * 33 + n;
        u32x4 o; o.x = pk2(s[0 * 33], s[1 * 33]); o.y = pk2(s[2 * 33], s[3 * 33]); o.z = pk2(s[4 * 33], s[5 * 33]); o.w = pk2(s[6 * 33], s[7 * 33]);
        *(u32x4*)(dst + (size_t)n * K + k0 + 8 * c) = o; }
    asm volatile("s_waitcnt lgkmcnt(0)" ::: "memory");
}
__device__ __forceinline__ void tr_item_f8(const float* __restrict__ W, int ldw, int col0, unsigned char* dst, int K, int k0, const float* sk, float mul, LAS float* scr, int lane) {
    f32x4 v[16];
    const int r = lane >> 4, c4 = lane & 15;
    const float* src = W + (size_t)(k0 + r) * ldw + col0 + 4 * c4;
#pragma unroll
    for (int i = 0; i < 16; ++i) v[i] = __builtin_nontemporal_load((const f32x4*)(src + (size_t)(4 * i) * ldw));
#pragma unroll
    for (int i = 0; i < 16; ++i) { const int kk = 4 * i + r; const float s = sk ? sk[k0 + kk] * mul : mul; f32x4 t = v[i] * s;
        t.x = clamp448(t.x); t.y = clamp448(t.y); t.z = clamp448(t.z); t.w = clamp448(t.w); *(LAS f32x4*)(scr + kk * 68 + 4 * c4) = t; }
    asm volatile("s_waitcnt lgkmcnt(0)" ::: "memory");
    const int c = lane & 3, nn = lane >> 2;
#pragma unroll
    for (int j = 0; j < 4; ++j) { const int n = nn + 16 * j; const LAS float* s = scr + (16 * c) * 68 + n;
        u32x4 o; o.x = pk4_fp8(s[0 * 68], s[1 * 68], s[2 * 68], s[3 * 68]); o.y = pk4_fp8(s[4 * 68], s[5 * 68], s[6 * 68], s[7 * 68]);
        o.z = pk4_fp8(s[8 * 68], s[9 * 68], s[10 * 68], s[11 * 68]); o.w = pk4_fp8(s[12 * 68], s[13 * 68], s[14 * 68], s[15 * 68]);
        *(u32x4*)(dst + (size_t)n * K + k0 + 16 * c) = o; }
    asm volatile("s_waitcnt lgkmcnt(0)" ::: "memory");
}
constexpr int IT_WIN = 16 * 96, IT_WOUT = 16 * 32, IT_WGU_E = 16 * 32, IT_WDN_E = 16 * 16;
__device__ __forceinline__ void conv_item_small(const PV& p, int it, LAS float* scr, int lane) {
    if (it < IT_WIN) {
        const int kb = it / 96, nb = it % 96, n0 = 32 * nb, sec = n0 >> 9;
        const int secoff = sec == 0 ? 0 : sec == 1 ? 512 : sec == 2 ? 1024 : sec == 3 ? 1544 : sec == 4 ? 2056 : 2568;
        const float mul = sec == 1 ? 0.08838834764831845f : 1.0f;
        tr_item(p.in(I_WIN), INC, secoff + (n0 & 511), (bf16_t*)(p.ws() + WS_WIN) + (size_t)n0 * D, D, 64 * kb, nullptr, mul, scr, lane);
    } else {
        it -= IT_WIN; const int kb = it / 32, nb = it % 32, k0 = 64 * kb;
        const float* sk = k0 < 512 ? p.in(I_MNW) : p.in(I_LNW) - 512;
        tr_item(p.in(I_WOUT), D, 32 * nb, (bf16_t*)(p.ws() + WS_WOUT) + (size_t)(32 * nb) * D, D, k0, sk, 1.0f, scr, lane);
    }
}
__device__ __forceinline__ void conv_item_moe(const PV& p, int it, LAS float* scr, int lane) {
    if (it < NE * IT_WGU_E) {
        const int e = it / IT_WGU_E, r = it % IT_WGU_E, kb = r / 32, nb = r % 32, n0 = 64 * nb, j = n0 >> 8, c0 = n0 & 255;
        const int srccol = c0 < 128 ? 128 * j + c0 : 1024 + 128 * j + (c0 - 128);
        tr_item_f8(p.in(I_WGU) + (size_t)e * D * 2 * DFF, 2 * DFF, srccol, (unsigned char*)(p.ws() + WS_WGU) + ((size_t)e * 2 * DFF + n0) * D, D, 64 * kb, p.in(I_N2W), SC_W, scr, lane);
    } else {
        it -= NE * IT_WGU_E; const int e = it / IT_WDN_E, r = it % IT_WDN_E, kb = r / 16, nb = r % 16;
        tr_item_f8(p.in(I_WDN) + (size_t)e * DFF * D, D, 64 * nb, (unsigned char*)(p.ws() + WS_WDN) + ((size_t)e * D + 64 * nb) * DFF, DFF, 64 * kb, nullptr, SC_W, scr, lane);
    }
}
struct CvArgs { const float* W; int ldw, col0; unsigned char* dst; int K, k0; const float* sk; bool has_sk; };
__device__ __forceinline__ CvArgs conv_args_moe(const PV& p, int it) {
    CvArgs a;
    if (it < NE * IT_WGU_E) {
        const int e = it / IT_WGU_E, r = it % IT_WGU_E, kb = r / 32, nb = r % 32, n0 = 64 * nb, j = n0 >> 8, c0 = n0 & 255;
        a.W = p.in(I_WGU) + (size_t)e * D * 2 * DFF; a.ldw = 2 * DFF; a.col0 = c0 < 128 ? 128 * j + c0 : 1024 + 128 * j + (c0 - 128);
        a.dst = (unsigned char*)(p.ws() + WS_WGU) + ((size_t)e * 2 * DFF + n0) * D; a.K = D; a.k0 = 64 * kb; a.sk = p.in(I_N2W); a.has_sk = true;
    } else {
        it -= NE * IT_WGU_E; const int e = it / IT_WDN_E, r = it % IT_WDN_E, kb = r / 16, nb = r % 16;
        a.W = p.in(I_WDN) + (size_t)e * DFF * D; a.ldw = D; a.col0 = 64 * nb; a.dst = (unsigned char*)(p.ws() + WS_WDN) + ((size_t)e * D + 64 * nb) * DFF; a.K = DFF; a.k0 = 64 * kb; a.sk = p.in(I_N2W); a.has_sk = false;
    }
    return a;
}
__device__ __forceinline__ void tr_load_f8(const CvArgs& a, int lane, f32x4 (&v)[16], float (&s)[16]) {
    const int r = lane >> 4, c4 = lane & 15;
    const float* src = a.W + (size_t)(a.k0 + r) * a.ldw + a.col0 + 4 * c4;
#pragma unroll
    for (int i = 0; i < 16; ++i) v[i] = __builtin_nontemporal_load((const f32x4*)(src + (size_t)(4 * i) * a.ldw));
#pragma unroll
    for (int i = 0; i < 16; ++i) s[i] = a.sk[a.k0 + 4 * i + r];
}
__device__ __forceinline__ void tr_proc_f8(const CvArgs& a, f32x4 (&v)[16], float (&s)[16], float mul, LAS float* scr, int lane) {
    const int r = lane >> 4, c4 = lane & 15;
#pragma unroll
    for (int i = 0; i < 16; ++i) { const int kk = 4 * i + r; const float sc = a.has_sk ? s[i] * mul : mul; f32x4 t = v[i] * sc;
        t.x = clamp448(t.x); t.y = clamp448(t.y); t.z = clamp448(t.z); t.w = clamp448(t.w); *(LAS f32x4*)(scr + kk * 68 + 4 * c4) = t; }
    asm volatile("s_waitcnt lgkmcnt(0)" ::: "memory");
    const int c = lane & 3, nn = lane >> 2;
#pragma unroll
    for (int j = 0; j < 4; ++j) { const int n = nn + 16 * j; const LAS float* sp = scr + (16 * c) * 68 + n;
        u32x4 o; o.x = pk4_fp8(sp[0 * 68], sp[1 * 68], sp[2 * 68], sp[3 * 68]); o.y = pk4_fp8(sp[4 * 68], sp[5 * 68], sp[6 * 68], sp[7 * 68]);
        o.z = pk4_fp8(sp[8 * 68], sp[9 * 68], sp[10 * 68], sp[11 * 68]); o.w = pk4_fp8(sp[12 * 68], sp[13 * 68], sp[14 * 68], sp[15 * 68]);
        *(u32x4*)(a.dst + (size_t)n * a.K + a.k0 + 16 * c) = o; }
    asm volatile("s_waitcnt lgkmcnt(0)" ::: "memory");
}
__device__ __forceinline__ void conv_items8_moe(const PV& p, int it0, LAS float* scr, int lane) {
    f32x4 va[16], vb[16]; float sa[16], sb[16];
    CvArgs a = conv_args_moe(p, it0); tr_load_f8(a, lane, va, sa);
#pragma unroll
    for (int q = 0; q < 8; q += 2) {
        const CvArgs b = conv_args_moe(p, it0 + q + 1); tr_load_f8(b, lane, vb, sb);
        tr_proc_f8(a, va, sa, SC_W, scr, lane);
        if (q + 2 < 8) { a = conv_args_moe(p, it0 + q + 2); tr_load_f8(a, lane, va, sa); }
        tr_proc_f8(b, vb, sb, SC_W, scr, lane);
    }
}
__device__ __forceinline__ void xpass_rows(const PV& p, LAS unsigned char* lds, int gw, int ngw, int lane) {
    LAS float* WG = (LAS float*)(lds + 69632);
    { const float* wg = p.in(I_WIN) + 1536;
      for (int i = get_tid(lds); i < 2048; i += 512) { const int k = i >> 1, q = i & 1; const f32x4 a = *(const f32x4*)(wg + (size_t)k * INC + 4 * q);
          const int rho = ((k >> 8) * 4 + (k & 3)) * 64 + ((k >> 2) & 63); *(LAS f32x4*)(WG + rho * 12 + 4 * q) = a; } }
    __syncthreads();
    f32x4 w1[4];
#pragma unroll
    for (int j = 0; j < 4; ++j) w1[j] = *(const f32x4*)(p.in(I_N1W) + 256 * j + 4 * lane);
    const float gb = lane < 8 ? p.in(I_GB)[lane] : 0.f;
    bf16_t* XN = (bf16_t*)(p.ws() + WS_R1); float* GATES = (float*)(p.ws() + WS_GATES);
    const float* X = p.in(I_X);
    f32x4 nv[4];
    if (gw < T) {
#pragma unroll
        for (int j = 0; j < 4; ++j) nv[j] = __builtin_nontemporal_load(((const f32x4*)(X + (size_t)gw * D) + lane) + 64 * j); }
    for (int m = gw; m < T; m += ngw) {
        f32x4 v[4]; float s = 0.f;
#pragma unroll
        for (int j = 0; j < 4; ++j) { v[j] = nv[j]; s += (v[j].x * v[j].x + v[j].y * v[j].y) + (v[j].z * v[j].z + v[j].w * v[j].w); }
        if (m + ngw < T) {
#pragma unroll
            for (int j = 0; j < 4; ++j) nv[j] = __builtin_nontemporal_load(((const f32x4*)(X + (size_t)(m + ngw) * D) + lane) + 64 * j); }
        const float rstd = frsq(wave_sum(s) * (1.0f / D) + EPS);
        float g[8];
#pragma unroll
        for (int q = 0; q < 8; ++q) g[q] = 0.f;
        unsigned long long* o8 = (unsigned long long*)(XN + (size_t)m * D) + lane;
#pragma unroll
        for (int j = 0; j < 4; ++j) { v[j] = v[j] * rstd * w1[j];
            o8[64 * j] = (unsigned long long)pk2(v[j].x, v[j].y) | ((unsigned long long)pk2(v[j].z, v[j].w) << 32);
#pragma unroll
            for (int c = 0; c < 4; ++c) { const float xv = v[j][c]; const LAS f32x4* wrow = (const LAS f32x4*)(WG + ((j * 4 + c) * 64 + lane) * 12); const f32x4 wa = wrow[0], wb = wrow[1];
                g[0] += xv * wa.x; g[1] += xv * wa.y; g[2] += xv * wa.z; g[3] += xv * wa.w; g[4] += xv * wb.x; g[5] += xv * wb.y; g[6] += xv * wb.z; g[7] += xv * wb.w; } }
        float mine = 0.f;
#pragma unroll
        for (int q = 0; q < 8; ++q) { const float t = wave_sum(g[q]); if (lane == q) mine = t; }
        if (lane < 8) { float val = mine + gb; if (lane >= 4) val = -log1pf(fexp(-val)); GATES[(size_t)m * 8 + lane] = val; }
    }
}
__device__ __forceinline__ void prep_phase(const PV& p, LAS unsigned char* lds) {
    const int tid = get_tid(lds), lane = tid & 63, wave = tid >> 6, gw = blockIdx.x * 8 + wave, ngw = gridDim.x * 8;
    LAS float* scr = (LAS float*)(lds + wave * 8448);
    for (int it = gw; it < IT_WIN + IT_WOUT; it += ngw) conv_item_small(p, it, scr, lane);
    bf16_t* WRI = (bf16_t*)(p.ws() + WS_WRI);
    for (int i = blockIdx.x * 512 + tid; i < 4 * 256 * 128; i += gridDim.x * 512) { const int h = i >> 15, n = (i >> 7) & 255, k = i & 127;
        const float v = n < 128 ? p.in(I_WR)[(h * 128 + k) * 128 + n] : p.in(I_WI)[(h * 128 + k) * 128 + n - 128]; WRI[i] = (bf16_t)(pk2(v, 0.f) & 0xffff); }
    { bf16_t* WRT = (bf16_t*)(p.ws() + WS_WRT);
      for (int i = blockIdx.x * 512 + tid; i < 32 * 1024; i += gridDim.x * 512) { const int e = i >> 10, k = i & 1023; const float v = p.in(I_RW)[k * 32 + e] * p.in(I_N2W)[k];
          const unsigned h = pk2(v, 0.f) & 0xffffu; const float lo = v - __uint_as_float(h << 16); WRT[i] = (bf16_t)h; WRT[32 * 1024 + i] = (bf16_t)(pk2(lo, 0.f) & 0xffffu); } }
    xpass_rows(p, lds, gw, ngw, lane);
}
__device__ __forceinline__ void moe_conv_phase(const PV& p, LAS unsigned char* lds, int b0) {
    const int tid = get_tid(lds), lane = tid & 63, wave = tid >> 6;
    if ((int)blockIdx.x < b0) return;
    const int gw = ((int)blockIdx.x - b0) * 8 + wave, ngw = ((int)gridDim.x - b0) * 8;
    LAS float* scr = (LAS float*)(lds + wave * 17408);
    for (int it = gw; it < NE * (IT_WGU_E + IT_WDN_E); it += ngw) conv_item_moe(p, it, scr, lane);
}

namespace pg8 {
constexpr int BM = 256, BK = 64, HALF = 128, HTB = HALF * BK * 2, STAGE_BYTES = 8 * HTB;
constexpr int META_OFF = 134144, META_BYTES = 5120;
__device__ __forceinline__ int lds_byte(int r, int c) { const int st = (r >> 4) * 2 + (c >> 5), rr = r & 15, cc = c & 31, ob = rr * 64 + cc * 2; return st * 1024 + (ob ^ (((ob >> 9) & 1) << 5)); }
__device__ __forceinline__ void stage_rc(int b, int& R, int& C) { const int st = b / 1024, sb = b % 1024, swz = sb ^ (((sb >> 9) & 1) << 5); R = (st >> 1) * 16 + swz / 64; C = (st & 1) * 32 + (swz % 64) / 2; }
__device__ __forceinline__ int perm32(int rho) { const int n = rho >> 4, i = rho & 15; return 8 * (i >> 2) + 4 * n + (i & 3); }
__device__ __forceinline__ int lds_byte32(int r, int kbyte) { const int st = (r >> 4) * 2 + (kbyte >> 6), rr = r & 15, cp = (kbyte >> 4) & 3; return st * 1024 + rr * 64 + ((cp ^ (rr >> 2)) << 4) + (kbyte & 15); }
__device__ __forceinline__ void stage_rc32(int b, int& R, int& C) { const int st = b / 1024, sb = b % 1024, rr = sb >> 6, cp = ((sb >> 4) & 3) ^ (rr >> 2); R = (st >> 1) * 16 + rr; C = (st & 1) * 32 + (cp * 16 + (sb & 15)) / 2; }
__device__ __forceinline__ int perm32x(int rho) { return 16 * ((rho >> 2) & 1) + 4 * (rho >> 3) + (rho & 3); }
typedef float f32x16 __attribute__((ext_vector_type(16)));
template <bool F8> struct AccSel { typedef f32x4 type[2][2][4][2]; };
template <> struct AccSel<true> { typedef f32x16 type[2][2][2]; };
struct Unit { const char* b; const char* a; int i0, i1, i2, i3, i4; };
#define PG8_GLDS2(ldsa, s0, v0, s1, v1) do { unsigned _keep; \
        asm volatile("s_mov_b32 %0, m0\n\ts_mov_b32 m0, %5\n\ts_nop 0\n\tglobal_load_lds_dwordx4 %1, %2\n\ts_mov_b32 m0, %6\n\ts_nop 0\n\tglobal_load_lds_dwordx4 %3, %4\n\ts_mov_b32 m0, %0" \
                     : "=&s"(_keep) : "v"(v0), "s"((const char*)(s0)), "v"(v1), "s"((const char*)(s1)), "s"(ldsa), "s"((ldsa) + 8192u) : "memory"); } while (0)
template <bool F8, bool GATHER, class Epi, class Sched>
__device__ __forceinline__ void gemm_phase(LAS unsigned char* lds, const char* Abase, int pitch, const Sched& S, const Epi& E, unsigned char* pws = nullptr, int pslot = 0) {
    const int tid = get_tid(lds);
    const int wid = __builtin_amdgcn_readfirstlane(tid >> 6), lane = tid & 63, wr = wid >> 2, wc = wid & 3, fr = lane & 15, fq = lane >> 4;
    const int nt = pitch / 128;
    unsigned vA, vB;
    { int R0, C0; if constexpr (F8) stage_rc32(tid * 16, R0, C0); else stage_rc(tid * 16, R0, C0);
      const int Rb0 = Epi::PERM ? ((R0 & ~31) + (F8 ? perm32x(R0 & 31) : perm32(R0 & 31))) : R0;
      vA = (unsigned)(R0 * pitch + 2 * C0); vB = (unsigned)(Rb0 * pitch + 2 * C0); }
    const size_t kstep = 128, hstep = (size_t)HALF * pitch, q64 = (size_t)64 * pitch;
    const unsigned ldsb0 = (unsigned)__builtin_amdgcn_readfirstlane((int)((unsigned)(size_t)lds + (unsigned)wid * 1024u));
    const int aoff = F8 ? lds_byte32(wr * 64 + (lane & 31), 32 * (lane >> 5)) : lds_byte(wr * 64 + fr, fq * 8), boff = F8 ? lds_byte32(wc * 32 + (lane & 31), 32 * (lane >> 5)) : lds_byte(wc * 32 + fr, fq * 8);
    const int aoff2 = F8 ? lds_byte32(wr * 64 + (lane & 31), 32 * (lane >> 5) + 16) : 0, boff2 = F8 ? lds_byte32(wc * 32 + (lane & 31), 32 * (lane >> 5) + 16) : 0;
    constexpr int HOFF = 1024;
#define PG8_SA(b, h) (((b) * 2 + (h)) * HTB)
#define PG8_SB(b, h) ((4 + (b) * 2 + (h)) * HTB)
#define PG8_STAGEB(bufoff, gbase) PG8_GLDS2(ldsb0 + (unsigned)(bufoff), (gbase), vB, (gbase) + q64, vB)
#define PG8_STAGEA(bufoff, kp, h) do { if constexpr (GATHER) { if ((h) == 0) PG8_GLDS2(ldsb0 + (unsigned)(bufoff), (kp), g0, (kp), g1); else PG8_GLDS2(ldsb0 + (unsigned)(bufoff), (kp), g2, (kp), g3); } \
        else PG8_GLDS2(ldsb0 + (unsigned)(bufoff), (kp) + (h) * hstep, vA, (kp) + (h) * hstep + q64, vA); } while (0)
#define PG8_RD(p) (*(const LAS u32x4*)(p))
#define PG8_LDA(dst, b, h) do { if constexpr (F8) { _Pragma("unroll") for (int m = 0; m < 4; ++m) {   \
            dst[m][0] = PG8_RD(lds + PG8_SA(b, h) + aoff + (m >> 1) * 4096 + (m & 1) * HOFF); dst[m][1] = PG8_RD(lds + PG8_SA(b, h) + aoff2 + (m >> 1) * 4096 + (m & 1) * HOFF); } } \
        else { _Pragma("unroll") for (int m = 0; m < 4; ++m) { dst[m][0] = PG8_RD(lds + PG8_SA(b, h) + aoff + m * 2048); dst[m][1] = PG8_RD(lds + PG8_SA(b, h) + aoff + m * 2048 + HOFF); } } } while (0)
#define PG8_LDB(dst, b, h) do { if constexpr (F8) { _Pragma("unroll") for (int n = 0; n < 2; ++n) {   dst[n][0] = PG8_RD(lds + PG8_SB(b, h) + boff + n * HOFF); dst[n][1] = PG8_RD(lds + PG8_SB(b, h) + boff2 + n * HOFF); } } \
        else { _Pragma("unroll") for (int n = 0; n < 2; ++n) { dst[n][0] = PG8_RD(lds + PG8_SB(b, h) + boff + n * 2048); dst[n][1] = PG8_RD(lds + PG8_SB(b, h) + boff + n * 2048 + HOFF); } } } while (0)
#define PG8_CAT(v) __builtin_bit_cast(i32x8, __builtin_shufflevector((v)[0], (v)[1], 0, 1, 2, 3, 4, 5, 6, 7))
#define PG8_MMA(ai, bj, At, Bt) do { __builtin_amdgcn_s_setprio(1); \
        if constexpr (F8) { _Pragma("unroll") for (int s = 0; s < 2; ++s) _Pragma("unroll") for (int mb = 0; mb < 2; ++mb)     \
            acc[ai][bj][mb] = __builtin_amdgcn_mfma_scale_f32_32x32x64_f8f6f4(PG8_CAT(Bt[s]), PG8_CAT(At[2 * mb + s]), acc[ai][bj][mb], 0, 0, 0, 0, 0, 0); }     \
        else { _Pragma("unroll") for (int m = 0; m < 4; ++m) _Pragma("unroll") for (int n = 0; n < 2; ++n) { acc[ai][bj][m][n] = __builtin_amdgcn_mfma_f32_16x16x32_bf16(__builtin_bit_cast(bf16x8, Bt[n][0]), __builtin_bit_cast(bf16x8, At[m][0]), acc[ai][bj][m][n], 0, 0, 0); \
               acc[ai][bj][m][n] = __builtin_amdgcn_mfma_f32_16x16x32_bf16(__builtin_bit_cast(bf16x8, Bt[n][1]), __builtin_bit_cast(bf16x8, At[m][1]), acc[ai][bj][m][n], 0, 0, 0); } } \
        __builtin_amdgcn_s_setprio(0); } while (0)
#define PG8_GLDS1(ldsa, s0, v0) do { unsigned _keep; \
        asm volatile("s_mov_b32 %0, m0\n\ts_mov_b32 m0, %3\n\ts_nop 0\n\tglobal_load_lds_dwordx4 %1, %2\n\ts_mov_b32 m0, %0" : "=&s"(_keep) : "v"(v0), "s"((const char*)(s0)), "s"(ldsa) : "memory"); } while (0)
#define PG8_WAIT_V(n) asm volatile("s_waitcnt vmcnt(" #n ")" ::: "memory")
#define PG8_WAIT_L(n) asm volatile("s_waitcnt lgkmcnt(" #n ")" ::: "memory")
#define PG8_BAR __builtin_amdgcn_s_barrier()
#define PG8_SCHED __builtin_amdgcn_sched_barrier(0)
    Unit cur, nxt; int ui = 0;
    if (!S.next(0, cur)) return;
    typename AccSel<F8>::type acc;
#define PG8_ZERO() do { if constexpr (F8) { _Pragma("unroll") for (int a = 0; a < 2; ++a) _Pragma("unroll") for (int b = 0; b < 2; ++b) _Pragma("unroll") for (int m = 0; m < 2; ++m) _Pragma("unroll") for (int j = 0; j < 16; ++j) acc[a][b][m][j] = 0.f; } \
        else { _Pragma("unroll") for (int a = 0; a < 2; ++a) _Pragma("unroll") for (int b = 0; b < 2; ++b) _Pragma("unroll") for (int m = 0; m < 4; ++m) _Pragma("unroll") for (int n = 0; n < 2; ++n) acc[a][b][m][n] = (f32x4){0.f, 0.f, 0.f, 0.f}; } } while (0)
    PG8_ZERO();
    u32x4 At[4][2], B0[2][2], B1[2][2];
    unsigned g0 = 0, g1 = 0, g2 = 0, g3 = 0;
    if constexpr (GATHER) { S.goffs(cur, tid, 0, g0, g1); S.goffs(cur, tid, 1, g2, g3); }
    if constexpr (Sched::HAS_META) S.meta_issue(cur, (unsigned)(size_t)lds + (unsigned)META_OFF, wid, lane);
    const char* cA = GATHER ? Abase : cur.a; const char* cB = cur.b;
    PG8_STAGEB(PG8_SB(0, 0), cB); PG8_STAGEB(PG8_SB(0, 1), cB + hstep); PG8_STAGEA(PG8_SA(0, 0), cA, 0); PG8_STAGEA(PG8_SA(0, 1), cA, 1);
    if (wr == 1) PG8_BAR;
    PG8_WAIT_V(2); PG8_BAR;
    PG8_STAGEB(PG8_SB(1, 0), cB + kstep); PG8_STAGEA(PG8_SA(1, 0), cA + kstep, 0); PG8_STAGEB(PG8_SB(1, 1), cB + hstep + kstep);
    PG8_WAIT_V(6); PG8_BAR;
    for (;;) {
#ifdef PROBE_G
        if (pws && ui == 2) GSTAMP(pws, tid, pslot);
#endif
        const bool has_next = S.next(ui + 1, nxt);
        const char* nB = has_next ? nxt.b : cB; const char* nA = GATHER ? Abase : (has_next ? nxt.a : cA);
#ifdef PROBE_G
        if (pws && ui == 2) GSTAMP(pws, tid, pslot + 1);
#endif
#pragma unroll 1
        for (int t = 0; t < nt; t += 2) {
            const bool last = (t == nt - 2);
            const char* a1 = cA + (size_t)(t + 1) * kstep;
            const char* a2 = last ? nA : cA + (size_t)(t + 2) * kstep; const char* b2 = last ? nB : cB + (size_t)(t + 2) * kstep;
            const char* a3 = a2 + kstep; const char* b3 = b2 + kstep;
            PG8_LDB(B0, 0, 0); PG8_LDB(B1, 0, 1); PG8_SCHED; PG8_LDA(At, 0, 0); PG8_STAGEA(PG8_SA(1, 1), a1, 1);
            if constexpr (Sched::HAS_META) { if (t == 0 && has_next) S.meta_issue(nxt, (unsigned)(size_t)lds + (unsigned)META_OFF + (unsigned)(((ui + 1) % 3) * META_BYTES), wid, lane); }
            if constexpr (GATHER) { if (last && has_next) { const LAS unsigned char* nm = lds + META_OFF + ((ui + 1) % 3) * META_BYTES;
                                                      S.goffs_lds(nxt, tid, 0, nm, g0, g1); S.goffs_lds(nxt, tid, 1, nm, g2, g3); } }
            PG8_WAIT_V(8); PG8_WAIT_L(0); PG8_BAR; PG8_MMA(0, 0, At, B0); PG8_MMA(0, 1, At, B1); PG8_BAR; PG8_SCHED;
            PG8_LDA(At, 0, 1); PG8_STAGEB(PG8_SB(0, 0), b2); PG8_STAGEB(PG8_SB(0, 1), b2 + hstep); PG8_STAGEA(PG8_SA(0, 0), a2, 0);
            PG8_WAIT_V(8); PG8_WAIT_L(0); PG8_BAR; PG8_MMA(1, 0, At, B0); PG8_MMA(1, 1, At, B1); PG8_BAR; PG8_SCHED;
            PG8_LDB(B0, 1, 0); PG8_LDB(B1, 1, 1); PG8_SCHED; PG8_LDA(At, 1, 0); PG8_STAGEA(PG8_SA(0, 1), a2, 1);
            PG8_WAIT_V(8); PG8_WAIT_L(0); PG8_BAR; PG8_MMA(0, 0, At, B0); PG8_MMA(0, 1, At, B1); PG8_BAR; PG8_SCHED;
            PG8_LDA(At, 1, 1); PG8_STAGEB(PG8_SB(1, 0), b3); PG8_STAGEB(PG8_SB(1, 1), b3 + hstep); PG8_STAGEA(PG8_SA(1, 0), a3, 0);
            PG8_WAIT_V(8); PG8_WAIT_L(0); PG8_BAR; PG8_MMA(1, 0, At, B0); PG8_MMA(1, 1, At, B1); PG8_BAR; PG8_SCHED;
        }
#ifdef PROBE_G
        if (pws && ui == 2) GSTAMP(pws, tid, pslot + 2);
#endif
        if (wr == 0) PG8_BAR;
        { int efr = fr, efq = fq; asm volatile("" : "+v"(efr), "+v"(efq));
          E(acc, cur, wr, wc, efr, efq, lds + META_OFF + (ui % 3) * META_BYTES); }
#ifdef PROBE_G
        if (pws && ui == 2) GSTAMP(pws, tid, pslot + 3);
        if (pws && ui == 3) GSTAMP(pws, tid, pslot + 4);
#endif
        if (!has_next) break;
        PG8_ZERO();
        cur = nxt; cB = nB; cA = nA; ++ui;
        if (wr == 1) PG8_BAR;
    }
    PG8_WAIT_V(0);
    PG8_BAR;
#undef PG8_SA
#undef PG8_SB
#undef PG8_STAGEA
#undef PG8_STAGEB
#undef PG8_RD
#undef PG8_CAT
#undef PG8_LDA
#undef PG8_LDB
#undef PG8_MMA
#undef PG8_ZERO
#undef PG8_WAIT_V
#undef PG8_WAIT_L
#undef PG8_BAR
#undef PG8_SCHED
}
struct TileOrder {
    int nM, nN, nwg, G, c;
    __device__ __forceinline__ void init(int nM_, int nN_, int G_, int c_) { nM = nM_; nN = nN_; nwg = nM * nN; G = G_; c = c_; }
    __device__ __forceinline__ bool tile(int i, int& pm, int& pn) const {
        const long L = (long)i * G + c; if (L >= nwg) return false;
        int wgid = (int)L; { const int q = nwg / 8, r = nwg % 8, xcd = wgid % 8, off = wgid / 8; wgid = (xcd < r ? xcd * (q + 1) : r * (q + 1) + (xcd - r) * q) + off; }
        const int nig = 8 * nN, gid = wgid / nig, fm = gid * 8, gsz = (nM - fm) < 8 ? (nM - fm) : 8;
        pm = fm + ((wgid % nig) % gsz); pn = (wgid % nig) / gsz; return true;
    }
};
}

struct DenseSched {
    pg8::TileOrder o; const char* A; const char* Bt; int pitch;
    __device__ __forceinline__ bool next(int i, pg8::Unit& u) const { int pm, pn; if (!o.tile(i, pm, pn)) return false; u.i0 = pm; u.i1 = pn; u.i2 = 0; u.i3 = 0; u.i4 = 0;
        u.a = A + (size_t)pm * 256 * pitch; u.b = Bt + (size_t)pn * 256 * pitch; return true; }
    __device__ __forceinline__ void goffs(const pg8::Unit&, int, int, unsigned&, unsigned&) const {}
    static constexpr bool HAS_META = false;
    __device__ __forceinline__ void meta_issue(const pg8::Unit&, unsigned, int, int) const {}
    __device__ __forceinline__ void goffs_lds(const pg8::Unit&, int, int, const LAS unsigned char*, unsigned&, unsigned&) const {}
};
struct EpiInProj {
    static constexpr bool PERM = true;
    bf16_t* PROJ;
    __device__ __forceinline__ void operator()(const f32x4 (&acc)[2][2][4][2], const pg8::Unit& u, int wr, int wc, int fr, int fq, const LAS unsigned char*) const {
        const int row0 = u.i0 * 256 + wr * 64 + fr, col0 = u.i1 * 256 + wc * 32 + 8 * fq;
#pragma unroll
        for (int ai = 0; ai < 2; ++ai)
#pragma unroll
            for (int m = 0; m < 4; ++m) { bf16_t* rowp = PROJ + (size_t)(row0 + ai * 128 + m * 16) * NPROJ + col0;
#pragma unroll
                for (int bj = 0; bj < 2; ++bj) { const f32x4 v0 = acc[ai][bj][m][0], v1 = acc[ai][bj][m][1];
                    u32x4 w; w.x = pk2(v0[0], v0[1]); w.y = pk2(v0[2], v0[3]); w.z = pk2(v1[0], v1[1]); w.w = pk2(v1[2], v1[3]);
                    *(u32x4*)(rowp + bj * 128) = w; } }
    }
};
struct EpiOutProj {
    static constexpr bool PERM = true;
    const float* X; bf16_t* HB;
    __device__ __forceinline__ void operator()(const f32x4 (&acc)[2][2][4][2], const pg8::Unit& u, int wr, int wc, int fr, int fq, const LAS unsigned char*) const {
        const int row0 = u.i0 * 256 + wr * 64 + fr, col0 = u.i1 * 256 + wc * 32 + 8 * fq;
#pragma unroll
        for (int ai = 0; ai < 2; ++ai)
#pragma unroll
            for (int m = 0; m < 4; ++m) { const size_t off = (size_t)(row0 + ai * 128 + m * 16) * D + col0;
#pragma unroll
                for (int bj = 0; bj < 2; ++bj) { const f32x4 x0 = *(const f32x4*)(X + off + bj * 128), x1 = *(const f32x4*)(X + off + bj * 128 + 4);
                    const f32x4 v0 = x0 + acc[ai][bj][m][0], v1 = x1 + acc[ai][bj][m][1];
                    u32x4 w; w.x = pk2(v0[0], v0[1]); w.y = pk2(v0[2], v0[3]); w.z = pk2(v1[0], v1[1]); w.w = pk2(v1[2], v1[3]);
                    *(u32x4*)(HB + off + bj * 128) = w; }
                asm volatile("" ::: "memory"); }
    }
};

constexpr int LDS_MOE_TAB = 131072;
template <bool GATHER, int NT  , int NROWS  >
struct MoeSched {
    const unsigned* cnt; const i32x4* ENT; const char* A; const char* Bt; LAS unsigned char* lds; int lo, hi, G, c, tot;
    __device__ __forceinline__ int cnt_s(int e) const { return __builtin_amdgcn_readfirstlane((int)cnt[e]); }
    __device__ __forceinline__ int tab(int i) const { return __builtin_amdgcn_readfirstlane(*(volatile LAS int*)(lds + LDS_MOE_TAB + 4 * i)); }
    __device__ __forceinline__ void init_tot(int tid) {
        if (tid == 0) { int t = 0; for (int e = lo; e < hi; ++e) { const int ce = (int)cnt[e], te = (ce + 255) >> 8; *(volatile LAS int*)(lds + LDS_MOE_TAB + 4 * (e - lo)) = t; *(volatile LAS int*)(lds + LDS_MOE_TAB + 4 * (64 + e - lo)) = te;
                *(volatile LAS int*)(lds + LDS_MOE_TAB + 4 * (128 + e - lo)) = ce; t += te; }
            *(volatile LAS int*)(lds + LDS_MOE_TAB + 4 * (hi - lo)) = t; }
        __syncthreads();
        tot = tab(hi - lo) * NT;
        for (int i = tid; i * G + c < tot && i < 64; i += 512) { int e, m, n, hb, ce; locate(i * G + c, e, m, n, hb, ce);
            *(LAS i32x4*)(lds + LDS_MOE_TAB + 1024 + 32 * i) = (i32x4){e, m, n, hb}; *(LAS int*)(lds + LDS_MOE_TAB + 1024 + 32 * i + 16) = ce; }
        __syncthreads();
    }
    __device__ __forceinline__ void locate(int L, int& e, int& m, int& n, int& hb, int& ce) const {
        int W; { const int q = tot / 8, r = tot % 8, xcd = L % 8, off = L / 8; W = (xcd < r ? xcd * (q + 1) : r * (q + 1) + (xcd - r) * q) + off; }
        int a = 0, b = hi - lo;
        while (b - a > 1) { const int mm = (a + b) >> 1; if (*(volatile LAS int*)(lds + LDS_MOE_TAB + 4 * mm) * NT <= W) a = mm; else b = mm; }
        const int pre = *(volatile LAS int*)(lds + LDS_MOE_TAB + 4 * a), te = *(volatile LAS int*)(lds + LDS_MOE_TAB + 4 * (64 + a)); W -= pre * NT;
        constexpr int nig = 8 * NT; const int gid = W / nig, fm = gid * 8, gsz = (te - fm) < 8 ? (te - fm) : 8; int j = W - gid * nig; n = 0;
        while (j >= gsz) { j -= gsz; ++n; }
        e = lo + a; m = fm + j; hb = pre * 256; ce = *(volatile LAS int*)(lds + LDS_MOE_TAB + 4 * (128 + a));
    }
    __device__ __forceinline__ bool next(int i, pg8::Unit& u) const {
        if (i * G + c >= tot) return false;
        const i32x4 d = *(volatile LAS i32x4*)(lds + LDS_MOE_TAB + 1024 + 32 * i); const int ce = *(volatile LAS int*)(lds + LDS_MOE_TAB + 1024 + 32 * i + 16);
        u.i0 = __builtin_amdgcn_readfirstlane(d.x); u.i1 = __builtin_amdgcn_readfirstlane(d.y); u.i2 = __builtin_amdgcn_readfirstlane(d.z); u.i3 = __builtin_amdgcn_readfirstlane(d.w); u.i4 = __builtin_amdgcn_readfirstlane(ce);
        u.b = Bt + ((size_t)u.i0 * NROWS + (size_t)u.i2 * 256) * 1024; u.a = A + (size_t)(u.i3 + u.i1 * 256) * 1024;
        return true;
    }
    static constexpr bool HAS_META = true;
    const float* bias;
    __device__ __forceinline__ void meta_issue(const pg8::Unit& u, unsigned ldsa, int wid, int lane) const {
        if (wid < 4) { const unsigned voff = (unsigned)(((unsigned)u.i0 * (unsigned)T + (unsigned)(u.i1 * 256 + 64 * wid + lane)) * 16u); PG8_GLDS1(ldsa + 1024u * (unsigned)wid, (const char*)ENT, voff); }
        else if (wid == 4) { unsigned voff;
            if constexpr (GATHER) voff = (unsigned)((u.i0 * 2048 + (lane < 32 ? 128 * u.i2 + 4 * lane : 1024 + 128 * u.i2 + 4 * (lane - 32))) * 4);
            else voff = (unsigned)((u.i0 * 1024 + 256 * u.i2 + 4 * lane) * 4);
            PG8_GLDS1(ldsa + 4096u, (const char*)bias, voff); }
    }
    __device__ __forceinline__ void goffs_lds(const pg8::Unit& u, int tid, int h, const LAS unsigned char* meta, unsigned& o0, unsigned& o1) const {
        if constexpr (GATHER) { int R0, C0; pg8::stage_rc32(tid * 16, R0, C0);
            const int ce = u.i4, rl = h * 128 + R0, p0 = u.i1 * 256 + rl;
            const int e0 = *(const LAS int*)(meta + 16 * rl), e1 = *(const LAS int*)(meta + 16 * (rl + 64));
            const int t0 = p0 < ce ? e0 : 0, t1 = p0 + 64 < ce ? e1 : 0;
            o0 = (unsigned)t0 * 1024u + 2u * C0; o1 = (unsigned)t1 * 1024u + 2u * C0; }
    }
    __device__ __forceinline__ void goffs(const pg8::Unit& u, int tid, int h, unsigned& o0, unsigned& o1) const {
        if constexpr (GATHER) { int R0, C0; pg8::stage_rc32(tid * 16, R0, C0);
            const int ce = u.i4, p0 = u.i1 * 256 + h * 128 + R0; const i32x4* en = ENT + (size_t)u.i0 * T;
            const int t0 = p0 < ce ? en[p0].x : 0, t1 = p0 + 64 < ce ? en[p0 + 64].x : 0;
            o0 = (unsigned)t0 * 1024u + 2u * C0; o1 = (unsigned)t1 * 1024u + 2u * C0; }
    }
};
struct EpiG1 {
    static constexpr bool PERM = true;
    unsigned char* HID;
    __device__ __forceinline__ void operator()(const pg8::f32x16 (&acc)[2][2][2], const pg8::Unit& u, int wr, int wc, int fr, int fq, const LAS unsigned char* meta) const {
        const int lane = fr + 16 * fq, tr = lane & 31, hb = lane >> 5;
        const int ce = u.i4, hc = u.i2 * 128 + wc * 32 + 16 * hb;
        const LAS float* bl = (const LAS float*)(meta + 4096) + wc * 32 + 16 * hb;
        f32x4 bg[4], bu[4];
#pragma unroll
        for (int q = 0; q < 4; ++q) { bg[q] = *(const LAS f32x4*)(bl + 4 * q); bu[q] = *(const LAS f32x4*)(bl + 128 + 4 * q); }
#pragma unroll
        for (int ai = 0; ai < 2; ++ai)
#pragma unroll
            for (int mb = 0; mb < 2; ++mb) { const int rl = ai * 128 + wr * 64 + mb * 32 + tr, pos = u.i1 * 256 + rl;
                const float r0 = *(const LAS float*)(meta + 16 * rl + 4); const float rstd = pos < ce ? r0 * (1.0f / (SC_H * SC_W)) : 0.f;
                float hv[16];
#pragma unroll
                for (int q = 0; q < 16; ++q) { float g = acc[ai][0][mb][q] * rstd + bg[q >> 2][q & 3], up = acc[ai][1][mb][q] * rstd + bu[q >> 2][q & 3];
                    g = fminf(g, 7.0f); up = fminf(fmaxf(up, -7.0f), 7.0f); hv[q] = (up + 1.0f) * g * sigmoidf_(1.702f * g) * SC_HID; }
                u32x4 w; w.x = pk4_fp8(hv[0], hv[1], hv[2], hv[3]); w.y = pk4_fp8(hv[4], hv[5], hv[6], hv[7]); w.z = pk4_fp8(hv[8], hv[9], hv[10], hv[11]); w.w = pk4_fp8(hv[12], hv[13], hv[14], hv[15]);
                *(u32x4*)(HID + (size_t)(u.i3 + pos) * DFF + hc) = w; }
    }
};
struct EpiG2 {
    static constexpr bool PERM = true;
    unsigned char* OUT01; unsigned char* Y23;
    __device__ __forceinline__ void operator()(const pg8::f32x16 (&acc)[2][2][2], const pg8::Unit& u, int wr, int wc, int fr, int fq, const LAS unsigned char* meta) const {
        const int lane = fr + 16 * fq, tr = lane & 31, hb = lane >> 5;
        const int ce = u.i4, col0 = u.i2 * 256 + wc * 32 + 16 * hb;
        const LAS float* bl = (const LAS float*)(meta + 4096) + wc * 32 + 16 * hb;
        f32x4 b[2][4];
#pragma unroll
        for (int bj = 0; bj < 2; ++bj)
#pragma unroll
            for (int q = 0; q < 4; ++q) b[bj][q] = *(const LAS f32x4*)(bl + bj * 128 + 4 * q);
#pragma unroll
        for (int ai = 0; ai < 2; ++ai)
#pragma unroll
            for (int mb = 0; mb < 2; ++mb) { const int rl = ai * 128 + wr * 64 + mb * 32 + tr;
                const i32x4 v = *(const LAS i32x4*)(meta + 16 * rl);
                if (u.i1 * 256 + rl < ce) { const float gate = __int_as_float(v.w) * SC_Y;
                    unsigned char* dst = (v.z < 2 ? OUT01 + (size_t)v.x * 4096 : Y23 + (size_t)v.x * 2048) + (v.z & 1) * 1024 + col0;
#pragma unroll
                    for (int bj = 0; bj < 2; ++bj) { float y[16];
#pragma unroll
                        for (int q = 0; q < 16; ++q) y[q] = clamp448((acc[ai][bj][mb][q] * (1.0f / (SC_HID * SC_W)) + b[bj][q >> 2][q & 3]) * gate);
                        u32x4 w; w.x = pk4_fp8(y[0], y[1], y[2], y[3]); w.y = pk4_fp8(y[4], y[5], y[6], y[7]); w.z = pk4_fp8(y[8], y[9], y[10], y[11]); w.w = pk4_fp8(y[12], y[13], y[14], y[15]);
                        *(u32x4*)(dst + bj * 128) = w; } } }
    }
};

#define LDS_BARRIER() do { asm volatile("s_waitcnt lgkmcnt(0)" ::: "memory"); __builtin_amdgcn_s_barrier(); asm volatile("" ::: "memory"); } while (0)
constexpr int ML_QS = 0, ML_KS = 17408, ML_VS = 34816, ML_PS = 52224, ML_CT = 61440, ML_DENP = 96256, ML_DI = 96768, ML_SSQP = 97024, ML_NARR = 99072, ML_FLA = 99584, ML_END = 99840;
__device__ __forceinline__ bf16x8 tr_pair(unsigned a0, unsigned a1) {
    u32x2 lo, hi; asm volatile("ds_read_b64_tr_b16 %0, %2\n\tds_read_b64_tr_b16 %1, %3\n\ts_waitcnt lgkmcnt(0)" : "=&v"(lo), "=&v"(hi) : "v"(a0), "v"(a1) : "memory");
    u32x4 r; r.x = lo.x; r.y = lo.y; r.z = hi.x; r.w = hi.y; return __builtin_bit_cast(bf16x8, r);
}
#define TR8(dst, base, OFF0, STEP) do { u32x2 _l[8], _h[8]; \
    asm volatile("ds_read_b64_tr_b16 %0, %16 offset:%17\n\tds_read_b64_tr_b16 %1, %16 offset:%17+1088\n\tds_read_b64_tr_b16 %2, %16 offset:%17+%18\n\tds_read_b64_tr_b16 %3, %16 offset:%17+%18+1088\n\t" \
                 "ds_read_b64_tr_b16 %4, %16 offset:%17+2*%18\n\tds_read_b64_tr_b16 %5, %16 offset:%17+2*%18+1088\n\tds_read_b64_tr_b16 %6, %16 offset:%17+3*%18\n\tds_read_b64_tr_b16 %7, %16 offset:%17+3*%18+1088\n\t" \
                 "ds_read_b64_tr_b16 %8, %16 offset:%17+4*%18\n\tds_read_b64_tr_b16 %9, %16 offset:%17+4*%18+1088\n\tds_read_b64_tr_b16 %10, %16 offset:%17+5*%18\n\tds_read_b64_tr_b16 %11, %16 offset:%17+5*%18+1088\n\t" \
                 "ds_read_b64_tr_b16 %12, %16 offset:%17+6*%18\n\tds_read_b64_tr_b16 %13, %16 offset:%17+6*%18+1088\n\tds_read_b64_tr_b16 %14, %16 offset:%17+7*%18\n\tds_read_b64_tr_b16 %15, %16 offset:%17+7*%18+1088\n\ts_waitcnt lgkmcnt(0)" \
                 : "=&v"(_l[0]), "=&v"(_h[0]), "=&v"(_l[1]), "=&v"(_h[1]), "=&v"(_l[2]), "=&v"(_h[2]), "=&v"(_l[3]), "=&v"(_h[3]), "=&v"(_l[4]), "=&v"(_h[4]), "=&v"(_l[5]), "=&v"(_h[5]), "=&v"(_l[6]), "=&v"(_h[6]), "=&v"(_l[7]), "=&v"(_h[7]) \
                 : "v"(base), "i"(OFF0), "i"(STEP) : "memory"); \
    _Pragma("unroll") for (int _p = 0; _p < 8; ++_p) { u32x4 _r; _r.x = _l[_p].x; _r.y = _l[_p].y; _r.z = _h[_p].x; _r.w = _h[_p].y; dst[_p] = __builtin_bit_cast(bf16x8, _r); } } while (0)
__device__ __forceinline__ float wave_scan_add(float s) {
    s += dpp_x<0x111, 0xf>(s, 0.f); s += dpp_x<0x112, 0xf>(s, 0.f); s += dpp_x<0x114, 0xf>(s, 0.f); s += dpp_x<0x118, 0xf>(s, 0.f);
    s += dpp_x<0x142, 0xa>(s, 0.f); s += dpp_x<0x143, 0xc>(s, 0.f); return s;
}
__device__ __forceinline__ float wave_scan_max(float s) {
    const float ni = -INFINITY;
    s = fmaxf(s, dpp_x<0x111, 0xf>(s, ni)); s = fmaxf(s, dpp_x<0x112, 0xf>(s, ni)); s = fmaxf(s, dpp_x<0x114, 0xf>(s, ni)); s = fmaxf(s, dpp_x<0x118, 0xf>(s, ni));
    s = fmaxf(s, dpp_x<0x142, 0xa>(s, ni)); s = fmaxf(s, dpp_x<0x143, 0xc>(s, ni)); return s;
}
__device__ __forceinline__ void unpack16(const u32x4& a, const u32x4& b, float (&f)[16]) {
    const unsigned w[8] = {a.x, a.y, a.z, a.w, b.x, b.y, b.z, b.w};
#pragma unroll
    for (int i = 0; i < 8; ++i) { f[2 * i] = bflo(w[i]); f[2 * i + 1] = bfhi(w[i]); }
}
template <bool SECOND>
__device__ __forceinline__ void mlstm_phase(const PV& p, LAS unsigned char* lds, int bh) {
    constexpr int c0 = SECOND ? 32 : 0, c1 = c0 + 32;
    const int tid = get_tid(lds);
    const int lane = tid & 63, w = __builtin_amdgcn_readfirstlane(tid >> 6), fr = lane & 15, fq = lane >> 4, tq = (lane & 15) >> 2, tp = lane & 3;
    const int b = bh >> 2, h = bh & 3, srow = tid >> 3, sseg = tid & 7;
    const bf16_t* PROJ = (const bf16_t*)(p.ws() + WS_R2); const float* GATES = (const float*)(p.ws() + WS_GATES); bf16_t* MIX = (bf16_t*)(p.ws() + WS_R1);
    LAS float* DENP = (LAS float*)(lds + ML_DENP); LAS float* DI = (LAS float*)(lds + ML_DI); LAS float* SSQP = (LAS float*)(lds + ML_SSQP); LAS float* NARR = (LAS float*)(lds + ML_NARR);
    const unsigned ldsb = (unsigned)(size_t)lds;
    for (int i = tid; i < 34816 / 16; i += 512) *(LAS u32x4*)(lds + ML_CT + 16 * i) = (u32x4){0u, 0u, 0u, 0u};
    if (tid < 128) NARR[tid] = 0.f;
    f32x4 c3[8];
#pragma unroll
    for (int i = 0; i < 8; ++i) c3[i] = (f32x4){0.f, 0.f, 0.f, 0.f};
    f32x4 nacc = (f32x4){0.f, 0.f, 0.f, 0.f}; float mprev = 0.f; float Gsum = 0.f;
    bf16x8 ones;
#pragma unroll
    for (int jj = 0; jj < 8; ++jj) ones[jj] = (short)0x3F80;
    float ig = GATES[((size_t)b * SEQ + c0 * 64 + lane) * 8 + h], lf = GATES[((size_t)b * SEQ + c0 * 64 + lane) * 8 + 4 + h];
    u32x4 rq0, rq1, rk0, rk1, rv0, rv1;
    u32x2 pend[4]; size_t prow0 = 0; bool have_pend = false;
    { const bf16_t* pr = PROJ + ((size_t)b * SEQ + c0 * 64 + srow) * NPROJ + h * 128 + 16 * sseg;
      rq0 = *(const u32x4*)pr; rq1 = *(const u32x4*)(pr + 8); rk0 = *(const u32x4*)(pr + 512); rk1 = *(const u32x4*)(pr + 520); rv0 = *(const u32x4*)(pr + 1024); rv1 = *(const u32x4*)(pr + 1032); }
    __syncthreads();
    for (int c = c0; c < c1; ++c) {
        const size_t row0 = (size_t)b * SEQ + (size_t)c * 64;
        if (c == 10) GSTAMP(p.ws(), tid, 20);
        u32x2 og[4];
#pragma unroll
        for (int ti = 0; ti < 4; ++ti) og[ti] = *(const u32x2*)(PROJ + (row0 + 16 * ti + fr) * NPROJ + 1536 + h * 128 + 16 * w + 4 * fq);
        const float bc = wave_scan_add(lf), u = ig - bc, cm = wave_scan_max(u);
        const float Mt = fmaxf(cm, mprev), M63 = __builtin_bit_cast(float, __builtin_amdgcn_readlane(__builtin_bit_cast(int, Mt), 63)), bL = __builtin_bit_cast(float, __builtin_amdgcn_readlane(__builtin_bit_cast(int, bc), 63));
        const size_t rown = c + 1 < c1 ? row0 + 64 : row0;
        { ig = GATES[(rown + lane) * 8 + h]; lf = GATES[(rown + lane) * 8 + 4 + h]; }
        const float sq = fexp(M63 - Mt), sk = fexp(u - M63), fl = fexp(-bc - Mt), decay = fexp(mprev - M63);
        mprev = bL + M63;
        if constexpr (SECOND) { if (w == 0) ((float2*)(p.ws() + WS_MLSC))[((size_t)bh * 32 + (c - 32)) * 64 + lane] = make_float2(Mt, bc);
            if (tid == 0) ((float*)(p.ws() + WS_MLSC + MB))[bh * 32 + (c - 32)] = Gsum;
            Gsum += bL; }
        { const float sqv = __shfl(sq, srow), skv = __shfl(sk, srow);
          float f[16]; unpack16(rq0, rq1, f);
          float part = 0.f;
#pragma unroll
          for (int j = 0; j < 16; ++j) { f[j] *= sqv; part += f[j] * NARR[16 * sseg + j]; }
          part += dpp_x<0x101, 0xf>(part, 0.f); part += dpp_x<0x102, 0xf>(part, 0.f); part += dpp_x<0x104, 0xf>(part, 0.f);
          if (sseg == 0) DI[srow] = decay * part;
          if (w == 0) ((LAS float*)(lds + ML_FLA))[lane] = fl;
          u32x4 o0, o1; o0.x = pk2(f[0], f[1]); o0.y = pk2(f[2], f[3]); o0.z = pk2(f[4], f[5]); o0.w = pk2(f[6], f[7]); o1.x = pk2(f[8], f[9]); o1.y = pk2(f[10], f[11]); o1.z = pk2(f[12], f[13]); o1.w = pk2(f[14], f[15]);
          *(LAS u32x4*)(lds + ML_QS + srow * 272 + sseg * 32) = o0; *(LAS u32x4*)(lds + ML_QS + srow * 272 + sseg * 32 + 16) = o1;
          unpack16(rk0, rk1, f);
#pragma unroll
          for (int j = 0; j < 16; ++j) f[j] *= skv;
          o0.x = pk2(f[0], f[1]); o0.y = pk2(f[2], f[3]); o0.z = pk2(f[4], f[5]); o0.w = pk2(f[6], f[7]); o1.x = pk2(f[8], f[9]); o1.y = pk2(f[10], f[11]); o1.z = pk2(f[12], f[13]); o1.w = pk2(f[14], f[15]);
          *(LAS u32x4*)(lds + ML_KS + srow * 272 + sseg * 32) = o0; *(LAS u32x4*)(lds + ML_KS + srow * 272 + sseg * 32 + 16) = o1;
          *(LAS u32x4*)(lds + ML_VS + srow * 272 + sseg * 32) = rv0; *(LAS u32x4*)(lds + ML_VS + srow * 272 + sseg * 32 + 16) = rv1; }
        { const bf16_t* pr = PROJ + (rown + srow) * NPROJ + h * 128 + 16 * sseg;
          rq0 = *(const u32x4*)pr; rq1 = *(const u32x4*)(pr + 8); rk0 = *(const u32x4*)(pr + 512); rk1 = *(const u32x4*)(pr + 520); rv0 = *(const u32x4*)(pr + 1024); rv1 = *(const u32x4*)(pr + 1032); }
        if (c == 10) GSTAMP(p.ws(), tid, 21);
        LDS_BARRIER();
        if (have_pend) {
#pragma unroll
            for (int ti = 0; ti < 4; ++ti) *(u32x2*)(MIX + (prow0 + 16 * ti + fr) * D + h * 128 + 16 * w + 4 * fq) = pend[ti]; }
        if (c == 10) GSTAMP(p.ws(), tid, 22);
        { const int ti = w >> 1; float dsum = 0.f;
          bf16x8 qf[4], kf[2][4];
#pragma unroll
          for (int ks = 0; ks < 4; ++ks) { qf[ks] = *(const LAS bf16x8*)(lds + ML_QS + (16 * ti + fr) * 272 + (32 * ks + 8 * fq) * 2);
#pragma unroll
              for (int jj = 0; jj < 2; ++jj) kf[jj][ks] = *(const LAS bf16x8*)(lds + ML_KS + (16 * (2 * (w & 1) + jj) + fr) * 272 + (32 * ks + 8 * fq) * 2); }
          __builtin_amdgcn_sched_barrier(0);
#pragma unroll
          for (int jj = 0; jj < 2; ++jj) { const int sj = 2 * (w & 1) + jj;
            f32x4 a = (f32x4){0.f, 0.f, 0.f, 0.f};
            if (sj <= ti) {
#pragma unroll
                for (int ks = 0; ks < 4; ++ks) a = __builtin_amdgcn_mfma_f32_16x16x32_bf16(kf[jj][ks], qf[ks], a, 0, 0, 0);
                const int t = 16 * ti + fr, s0 = 16 * sj + 4 * fq;
#pragma unroll
                for (int r = 0; r < 4; ++r) { if (s0 + r > t) a[r] = 0.f; dsum += a[r]; }
            }
            u32x2 pw; pw.x = pk2(a[0], a[1]); pw.y = pk2(a[2], a[3]);
            *(LAS u32x2*)(lds + ML_PS + (16 * ti + fr) * 144 + (16 * sj + 4 * fq) * 2) = pw; }
          dsum += __shfl_xor(dsum, 16); dsum += __shfl_xor(dsum, 32);
          if (fq == 0) DENP[(w & 1) * 64 + 16 * ti + fr] = dsum; }
        if (c == 10) GSTAMP(p.ws(), tid, 23);
        LDS_BARRIER();
        if (c == 10) GSTAMP(p.ws(), tid, 24);
        bf16x8 av[2];
        { u32x2 l0, h0, l1, h1; const unsigned a0 = ldsb + ML_VS + (8 * fq + tq) * 272 + (16 * w + 4 * tp) * 2;
          asm volatile("ds_read_b64_tr_b16 %0, %4\n\tds_read_b64_tr_b16 %1, %4 offset:1088\n\tds_read_b64_tr_b16 %2, %4 offset:8704\n\tds_read_b64_tr_b16 %3, %4 offset:9792\n\ts_waitcnt lgkmcnt(0)"
                       : "=&v"(l0), "=&v"(h0), "=&v"(l1), "=&v"(h1) : "v"(a0) : "memory");
          u32x4 r; r.x = l0.x; r.y = l0.y; r.z = h0.x; r.w = h0.y; av[0] = __builtin_bit_cast(bf16x8, r); r.x = l1.x; r.y = l1.y; r.z = h1.x; r.w = h1.y; av[1] = __builtin_bit_cast(bf16x8, r); }
        bf16x8 ac[4];
#pragma unroll
        for (int ks = 0; ks < 4; ++ks) ac[ks] = *(const LAS bf16x8*)(lds + ML_CT + (16 * w + fr) * 272 + (32 * ks + 8 * fq) * 2);
        float xs[4][4], ssq[4];
#pragma unroll
        for (int hh = 0; hh < 2; ++hh) {
            bf16x8 pb[2][2], qb[2][4]; float dn[2], fv[2];
#pragma unroll
            for (int q = 0; q < 2; ++q) { const int ti = 2 * hh + q, t = 16 * ti + fr;
#pragma unroll
                for (int ks = 0; ks < 2; ++ks) pb[q][ks] = *(const LAS bf16x8*)(lds + ML_PS + t * 144 + (32 * ks + 8 * fq) * 2);
#pragma unroll
                for (int ks = 0; ks < 4; ++ks) qb[q][ks] = *(const LAS bf16x8*)(lds + ML_QS + t * 272 + (32 * ks + 8 * fq) * 2);
                dn[q] = DENP[t] + DENP[64 + t] + DI[t]; fv[q] = ((const LAS float*)(lds + ML_FLA))[t]; }
            __builtin_amdgcn_sched_barrier(0);
#pragma unroll
            for (int q = 0; q < 2; ++q) { const int ti = 2 * hh + q; f32x4 a = (f32x4){0.f, 0.f, 0.f, 0.f}, a2 = (f32x4){0.f, 0.f, 0.f, 0.f};
#pragma unroll
                for (int ks = 0; ks < 2; ++ks) a = __builtin_amdgcn_mfma_f32_16x16x32_bf16(av[ks], pb[q][ks], a, 0, 0, 0);
#pragma unroll
                for (int ks = 0; ks < 4; ++ks) a2 = __builtin_amdgcn_mfma_f32_16x16x32_bf16(ac[ks], qb[q][ks], a2, 0, 0, 0);
                a = a + a2 * decay;
                if constexpr (SECOND) {
                    { u32x2 nw; nw.x = pk2(a[0], a[1]); nw.y = pk2(a[2], a[3]);
                      *(u32x2*)((bf16_t*)(p.ws() + WS_NUML) + ((size_t)bh * 2048 + (size_t)(c - 32) * 64 + 16 * ti + fr) * 128 + 16 * w + 4 * fq) = nw; }
                    if (w == 0 && fq == 0) ((float*)(p.ws() + WS_DENL))[(size_t)bh * 2048 + (c - 32) * 64 + 16 * ti + fr] = dn[q];
                    xs[ti][0] = xs[ti][1] = xs[ti][2] = xs[ti][3] = 0.f; ssq[ti] = 0.f; continue; }
                const float inv = frcp(fmaxf(fabsf(dn[q]), fv[q]));
                xs[ti][0] = sigmoidf_(bflo(og[ti].x)) * a[0] * inv; xs[ti][1] = sigmoidf_(bfhi(og[ti].x)) * a[1] * inv; xs[ti][2] = sigmoidf_(bflo(og[ti].y)) * a[2] * inv; xs[ti][3] = sigmoidf_(bfhi(og[ti].y)) * a[3] * inv;
                ssq[ti] = xs[ti][0] * xs[ti][0] + xs[ti][1] * xs[ti][1] + xs[ti][2] * xs[ti][2] + xs[ti][3] * xs[ti][3]; } }
        if constexpr (!SECOND) {
#pragma unroll
        for (int ti = 0; ti < 4; ++ti) ssq[ti] += __shfl_xor(ssq[ti], 16);
#pragma unroll
        for (int ti = 0; ti < 4; ++ti) ssq[ti] += __shfl_xor(ssq[ti], 32);
        if (fq == 0) {
#pragma unroll
            for (int ti = 0; ti < 4; ++ti) SSQP[w * 64 + 16 * ti + fr] = ssq[ti]; } }
        { const unsigned kb = ldsb + ML_KS + (8 * fq + tq) * 272 + 4 * tp * 2;
          bf16x8 k0[8], k1[8];
          TR8(k0, kb, 0, 32); TR8(k1, kb, 8704, 32);
#pragma unroll
          for (int i = 0; i < 8; ++i) { c3[i] = c3[i] * decay;
              c3[i] = __builtin_amdgcn_mfma_f32_16x16x32_bf16(k0[i], av[0], c3[i], 0, 0, 0); c3[i] = __builtin_amdgcn_mfma_f32_16x16x32_bf16(k1[i], av[1], c3[i], 0, 0, 0);
              if (i == w) { nacc = nacc * decay; nacc = __builtin_amdgcn_mfma_f32_16x16x32_bf16(k0[i], ones, nacc, 0, 0, 0); nacc = __builtin_amdgcn_mfma_f32_16x16x32_bf16(k1[i], ones, nacc, 0, 0, 0); } }
          if (fr == 0) *(LAS f32x4*)(NARR + 16 * w + 4 * fq) = nacc; }
        if (c == 10) GSTAMP(p.ws(), tid, 25);
        LDS_BARRIER();
        if (c == 10) GSTAMP(p.ws(), tid, 26);
        if (c == 11) GSTAMP(p.ws(), tid, 27);
        if constexpr (!SECOND) {
#pragma unroll
        for (int ti = 0; ti < 4; ++ti) { const int t = 16 * ti + fr; float s = 0.f;
#pragma unroll
            for (int ww = 0; ww < 8; ++ww) s += SSQP[ww * 64 + t];
            const float rs = frsq(s * (1.0f / 128.f) + EPS);
            pend[ti].x = pk2(xs[ti][0] * rs, xs[ti][1] * rs); pend[ti].y = pk2(xs[ti][2] * rs, xs[ti][3] * rs); }
        prow0 = row0; have_pend = true; }
#pragma unroll
        for (int i = 0; i < 8; ++i) { u32x2 cw; cw.x = pk2(c3[i][0], c3[i][1]); cw.y = pk2(c3[i][2], c3[i][3]);
            *(LAS u32x2*)(lds + ML_CT + (16 * w + fr) * 272 + (16 * i + 4 * fq) * 2) = cw; }
    }
    if constexpr (!SECOND) {
#pragma unroll
    for (int ti = 0; ti < 4; ++ti) *(u32x2*)(MIX + (prow0 + 16 * ti + fr) * D + h * 128 + 16 * w + 4 * fq) = pend[ti]; }
    __syncthreads();
    if constexpr (!SECOND) {
        unsigned char* st = p.ws() + WS_MLST + (size_t)bh * 40960;
        for (int i = tid; i < 128 * 16; i += 512) { const int row = i >> 4, seg = i & 15; *(u32x4*)(st + row * 256 + seg * 16) = *(const LAS u32x4*)(lds + ML_CT + row * 272 + seg * 16); }
        if (tid < 128) ((float*)(st + 32768))[tid] = NARR[tid];
        if (tid == 0) ((float*)(st + 33280))[0] = mprev;
        asm volatile("s_waitcnt vmcnt(0)" ::: "memory"); __syncthreads();
        if (tid == 0) { __builtin_amdgcn_fence(__ATOMIC_RELEASE, "agent"); asm volatile("s_waitcnt vmcnt(0)" ::: "memory"); (void)xb_add((unsigned*)(p.ws() + WS_CTL) + CW_MLF + bh, 1u); }
    }
}
__device__ __forceinline__ void mlstm_fix(const PV& p, LAS unsigned char* lds, int bh, int cg) {
    const int tid = get_tid(lds);
    const int lane = tid & 63, w = __builtin_amdgcn_readfirstlane(tid >> 6), fr = lane & 15, fq = lane >> 4;
    const int b = bh >> 2, h = bh & 3, srow = tid >> 3, sseg = tid & 7;
    const bf16_t* PROJ = (const bf16_t*)(p.ws() + WS_R2); const float* GATES = (const float*)(p.ws() + WS_GATES); bf16_t* MIX = (bf16_t*)(p.ws() + WS_R1);
    const bf16_t* NUML = (const bf16_t*)(p.ws() + WS_NUML) + (size_t)bh * 2048 * 128; const float* DENL = (const float*)(p.ws() + WS_DENL) + (size_t)bh * 2048;
    const unsigned char* st = p.ws() + WS_MLST + (size_t)bh * 40960;
    LAS float* RT = (LAS float*)(lds + ML_DENP); LAS float* DI = (LAS float*)(lds + ML_DI); LAS float* SSQP = (LAS float*)(lds + ML_SSQP); LAS float* NARR = (LAS float*)(lds + ML_NARR); LAS float* FLA = (LAS float*)(lds + ML_FLA);
    for (int i = tid; i < 128 * 16; i += 512) { const int row = i >> 4, seg = i & 15; *(LAS u32x4*)(lds + ML_CT + row * 272 + seg * 16) = *(const u32x4*)(st + row * 256 + seg * 16); }
    if (tid < 128) NARR[tid] = ((const float*)(st + 32768))[tid];
    const float m_mid = ((const float*)(st + 33280))[0];
    __syncthreads();
    bf16x8 ac[4];
#pragma unroll
    for (int ks = 0; ks < 4; ++ks) ac[ks] = *(const LAS bf16x8*)(lds + ML_CT + (16 * w + fr) * 272 + (32 * ks + 8 * fq) * 2);
    struct FS { u32x4 rq0, rq1; u32x2 og[4]; u32x2 nl[4]; float dl[4]; float2 sc; float gc; } FA, FB;
    const int cb = 32 + 8 * cg, ce = cb + 8;
    auto fs_load_q = [&](FS& X, int cc) { const bf16_t* pr = PROJ + ((size_t)b * SEQ + (size_t)cc * 64 + srow) * NPROJ + h * 128 + 16 * sseg; X.rq0 = *(const u32x4*)pr; X.rq1 = *(const u32x4*)(pr + 8);
        X.sc = ((const float2*)(p.ws() + WS_MLSC))[((size_t)bh * 32 + (cc - 32)) * 64 + lane]; X.gc = ((const float*)(p.ws() + WS_MLSC + MB))[bh * 32 + (cc - 32)]; };
    auto fs_load_o = [&](FS& X, int cc) { const size_t r0 = (size_t)b * SEQ + (size_t)cc * 64;
#pragma unroll
        for (int ti = 0; ti < 4; ++ti) { X.og[ti] = *(const u32x2*)(PROJ + (r0 + 16 * ti + fr) * NPROJ + 1536 + h * 128 + 16 * w + 4 * fq);
            X.nl[ti] = *(const u32x2*)(NUML + ((size_t)(cc - 32) * 64 + 16 * ti + fr) * 128 + 16 * w + 4 * fq); X.dl[ti] = DENL[(cc - 32) * 64 + 16 * ti + fr]; } };
    fs_load_q(FA, cb); fs_load_o(FA, cb); fs_load_q(FB, cb + 1); fs_load_o(FB, cb + 1);
    auto fix_chunk = [&](const int c, FS& X) {
        const size_t row0 = (size_t)b * SEQ + (size_t)c * 64; const int c2 = c + 2 < ce ? c + 2 : ce - 1;
        const float MtL = X.sc.x, bc = X.sc.y, Gc = X.gc;
        const float MtT = fmaxf(MtL, m_mid + Gc);
        const float wt = fexp(m_mid + Gc - MtT), rt = fexp(MtL - MtT), fl = fexp(-bc - MtT);
        { const float wv = __shfl(wt, srow);
          float f[16]; unpack16(X.rq0, X.rq1, f);
          float part = 0.f;
#pragma unroll
          for (int j = 0; j < 16; ++j) { f[j] *= wv; part += f[j] * NARR[16 * sseg + j]; }
          part += dpp_x<0x101, 0xf>(part, 0.f); part += dpp_x<0x102, 0xf>(part, 0.f); part += dpp_x<0x104, 0xf>(part, 0.f);
          if (sseg == 0) DI[srow] = part;
          if (w == 0) { FLA[lane] = fl; RT[lane] = rt; }
          u32x4 o0, o1; o0.x = pk2(f[0], f[1]); o0.y = pk2(f[2], f[3]); o0.z = pk2(f[4], f[5]); o0.w = pk2(f[6], f[7]); o1.x = pk2(f[8], f[9]); o1.y = pk2(f[10], f[11]); o1.z = pk2(f[12], f[13]); o1.w = pk2(f[14], f[15]);
          *(LAS u32x4*)(lds + ML_QS + srow * 272 + sseg * 32) = o0; *(LAS u32x4*)(lds + ML_QS + srow * 272 + sseg * 32 + 16) = o1; }
        fs_load_q(X, c2);
        LDS_BARRIER();
        float xs[4][4], ssq[4];
#pragma unroll
        for (int ti = 0; ti < 4; ++ti) { const int t = 16 * ti + fr; f32x4 a2 = (f32x4){0.f, 0.f, 0.f, 0.f};
#pragma unroll
            for (int ks = 0; ks < 4; ++ks) { const bf16x8 qb = *(const LAS bf16x8*)(lds + ML_QS + t * 272 + (32 * ks + 8 * fq) * 2); a2 = __builtin_amdgcn_mfma_f32_16x16x32_bf16(ac[ks], qb, a2, 0, 0, 0); }
            const float r = RT[t]; const f32x4 nlf = (f32x4){bflo(X.nl[ti].x), bfhi(X.nl[ti].x), bflo(X.nl[ti].y), bfhi(X.nl[ti].y)}; const f32x4 a = nlf * r + a2; const float dn = X.dl[ti] * r + DI[t];
            const float inv = frcp(fmaxf(fabsf(dn), FLA[t]));
            xs[ti][0] = sigmoidf_(bflo(X.og[ti].x)) * a[0] * inv; xs[ti][1] = sigmoidf_(bfhi(X.og[ti].x)) * a[1] * inv; xs[ti][2] = sigmoidf_(bflo(X.og[ti].y)) * a[2] * inv; xs[ti][3] = sigmoidf_(bfhi(X.og[ti].y)) * a[3] * inv;
            ssq[ti] = xs[ti][0] * xs[ti][0] + xs[ti][1] * xs[ti][1] + xs[ti][2] * xs[ti][2] + xs[ti][3] * xs[ti][3]; }
        fs_load_o(X, c2);
#pragma unroll
        for (int ti = 0; ti < 4; ++ti) { ssq[ti] += __shfl_xor(ssq[ti], 16); ssq[ti] += __shfl_xor(ssq[ti], 32); }
        if (fq == 0) {
#pragma unroll
            for (int ti = 0; ti < 4; ++ti) SSQP[w * 64 + 16 * ti + fr] = ssq[ti]; }
        LDS_BARRIER();
#pragma unroll
        for (int ti = 0; ti < 4; ++ti) { const int t = 16 * ti + fr; float s = 0.f;
#pragma unroll
            for (int ww = 0; ww < 8; ++ww) s += SSQP[ww * 64 + t];
            const float rs = frsq(s * (1.0f / 128.f) + EPS);
            u32x2 o; o.x = pk2(xs[ti][0] * rs, xs[ti][1] * rs); o.y = pk2(xs[ti][2] * rs, xs[ti][3] * rs);
            *(u32x2*)(MIX + (row0 + t) * D + h * 128 + 16 * w + 4 * fq) = o; }
        LDS_BARRIER();
    };
    for (int c = cb; c < ce; c += 2) { fix_chunk(c, FA); fix_chunk(c + 1, FB); }
    __syncthreads();
}


constexpr int RL_XC = 0, RL_RG = 34816, RL_OUT = 69632, RL_CW = 104448, RL_CARRY = 114688, RL_SSQP = 116736, RL_END = 124928;
template <int S> __device__ __forceinline__ float dpp_shr(float v, float ident) {
    return __builtin_bit_cast(float, __builtin_amdgcn_update_dpp(__builtin_bit_cast(int, ident), __builtin_bit_cast(int, v), 0x110 + S, 0xf, 0xf, false));
}
__device__ __forceinline__ float row_last(float v) { return __builtin_bit_cast(float, __builtin_amdgcn_update_dpp(0, __builtin_bit_cast(int, v), 0x15F, 0xf, 0xf, false)); }
template <bool FINAL, bool LOCAL = false>
__device__ __forceinline__ void rglru_item(const PV& p, LAS unsigned char* lds, int item) {
    const int tid = get_tid(lds);
    const int lane = tid & 63, w = __builtin_amdgcn_readfirstlane(tid >> 6), fr = lane & 15, fq = lane >> 4, srow = tid >> 3, sseg = tid & 7;
    const int b = item >> 4, chunk = item & 15;
    const bf16_t* PROJ = (const bf16_t*)(p.ws() + WS_R2); bf16_t* MIX = (bf16_t*)(p.ws() + WS_R1); float* SUMM = (float*)(p.ws() + WS_SUMM); const bf16_t* WRI = (const bf16_t*)(p.ws() + WS_WRI);
    LAS float* CW = (LAS float*)(lds + RL_CW); LAS float* CARRY = (LAS float*)(lds + RL_CARRY); LAS float* SSQP = (LAS float*)(lds + RL_SSQP);
    const size_t tok0 = (size_t)b * SEQ + (size_t)chunk * 256;
    if (FINAL) GSTAMP(p.ws(), tid, 0);
    for (int i = tid; i < 2560; i += 512) CW[i] = i < 2048 ? p.in(I_CW)[i] : p.in(I_CB)[i - 2048];
    if (FINAL && !LOCAL) {
        float carry = 0.f;
        for (int cc = 0; cc < chunk; ++cc) { const float2 ab = *(const float2*)(SUMM + ((size_t)(b * 16 + cc) * 512 + tid) * 2); carry = ab.x * carry + ab.y; }
        CARRY[tid] = carry;
        for (int i = tid; i < 2048; i += 512) SSQP[i] = 0.f;
    }
    u32x4 rx[8], rgr[2];
    auto prefetch = [&](int sidx) {
        const int hd = sidx >> 2, step = sidx & 3; const int tl = step * 64 + srow; const size_t tok = tok0 + tl; const int tseq = chunk * 256 + tl;
        const bf16_t* px = PROJ + tok * NPROJ + 2048 + hd * 128 + 16 * sseg;
#pragma unroll
        for (int j = 0; j < 4; ++j) { if (tseq - 3 + j >= 0) { rx[2 * j] = *(const u32x4*)(px + (ptrdiff_t)(j - 3) * NPROJ); rx[2 * j + 1] = *(const u32x4*)(px + (ptrdiff_t)(j - 3) * NPROJ + 8); } else { rx[2 * j] = (u32x4){0u, 0u, 0u, 0u}; rx[2 * j + 1] = (u32x4){0u, 0u, 0u, 0u}; } }
        if (FINAL) { rgr[0] = *(const u32x4*)(px + 512); rgr[1] = *(const u32x4*)(px + 520); }
    };
    prefetch(0);
    __syncthreads();
    if (FINAL) GSTAMP(p.ws(), tid, 1);
    float hc[4], ptot[4], brv[4], biv[4], spv[4];
    bf16x8 br[4], bi[4], bid;
    for (int sidx = 0; sidx < 16; ++sidx) {
        const int hd = sidx >> 2, step = sidx & 3, buf = sidx & 1;
        if (step == 0) {
#pragma unroll
            for (int ks = 0; ks < 4; ++ks) { br[ks] = *(const bf16x8*)(WRI + ((size_t)(hd * 256 + 16 * w + fr) * 128 + 32 * ks + 8 * fq)); bi[ks] = *(const bf16x8*)(WRI + ((size_t)(hd * 256 + 128 + 16 * w + fr) * 128 + 32 * ks + 8 * fq)); }
#pragma unroll
            for (int jj = 0; jj < 8; ++jj) bid[jj] = (8 * fq + jj == 16 * (w & 1) + fr) ? (short)0x3F80 : (short)0;
#pragma unroll
            for (int r = 0; r < 4; ++r) { const int ch = hd * 128 + 16 * w + 4 * fq + r; brv[r] = p.in(I_BR)[ch]; biv[r] = p.in(I_BI)[ch]; spv[r] = log1pf(fexp(-p.in(I_LAM)[ch]));
                hc[r] = (FINAL && !LOCAL) ? CARRY[ch] : 0.f; ptot[r] = 1.f; }
        }
        { float xc[16];
          const LAS f32x4* cb4 = (const LAS f32x4*)(CW + 2048 + hd * 128 + 16 * sseg);
#pragma unroll
          for (int q = 0; q < 4; ++q) { const f32x4 v = cb4[q]; xc[4 * q] = v.x; xc[4 * q + 1] = v.y; xc[4 * q + 2] = v.z; xc[4 * q + 3] = v.w; }
#pragma unroll
          for (int j = 0; j < 4; ++j) { float xf[16]; unpack16(rx[2 * j], rx[2 * j + 1], xf); const LAS f32x4* cw4 = (const LAS f32x4*)(CW + j * 512 + hd * 128 + 16 * sseg);
#pragma unroll
              for (int q = 0; q < 4; ++q) { const f32x4 v = cw4[q]; xc[4 * q] += v.x * xf[4 * q]; xc[4 * q + 1] += v.y * xf[4 * q + 1]; xc[4 * q + 2] += v.z * xf[4 * q + 2]; xc[4 * q + 3] += v.w * xf[4 * q + 3]; } }
          u32x4 o0, o1; o0.x = pk2(xc[0], xc[1]); o0.y = pk2(xc[2], xc[3]); o0.z = pk2(xc[4], xc[5]); o0.w = pk2(xc[6], xc[7]); o1.x = pk2(xc[8], xc[9]); o1.y = pk2(xc[10], xc[11]); o1.z = pk2(xc[12], xc[13]); o1.w = pk2(xc[14], xc[15]);
          *(LAS u32x4*)(lds + RL_XC + buf * 17408 + srow * 272 + sseg * 32) = o0; *(LAS u32x4*)(lds + RL_XC + buf * 17408 + srow * 272 + sseg * 32 + 16) = o1;
          if (FINAL) { *(LAS u32x4*)(lds + RL_RG + buf * 17408 + srow * 272 + sseg * 32) = rgr[0]; *(LAS u32x4*)(lds + RL_RG + buf * 17408 + srow * 272 + sseg * 32 + 16) = rgr[1]; } }
        if (sidx + 1 < 16) prefetch(sidx + 1);
        LDS_BARRIER();
        if (FINAL && sidx > 0) { const int ps = sidx - 1, phd = ps >> 2, pstep = ps & 3, pbuf = ps & 1;
            const u32x4 v0 = *(const LAS u32x4*)(lds + RL_OUT + pbuf * 17408 + srow * 272 + sseg * 32), v1 = *(const LAS u32x4*)(lds + RL_OUT + pbuf * 17408 + srow * 272 + sseg * 32 + 16);
            bf16_t* dst = MIX + (tok0 + pstep * 64 + srow) * D + 512 + phd * 128 + 16 * sseg; *(u32x4*)dst = v0; *(u32x4*)(dst + 8) = v1; }
        const int ksx = w >> 1;
#pragma unroll
        for (int m = 0; m < 4; ++m) {
            f32x4 ar = (f32x4){0.f, 0.f, 0.f, 0.f}, ai = ar, ax = ar, ag = ar;
#pragma unroll
            for (int ks = 0; ks < 4; ++ks) { const bf16x8 a = *(const LAS bf16x8*)(lds + RL_XC + buf * 17408 + (16 * m + fr) * 272 + (32 * ks + 8 * fq) * 2);
                ar = __builtin_amdgcn_mfma_f32_16x16x32_bf16(br[ks], a, ar, 0, 0, 0); ai = __builtin_amdgcn_mfma_f32_16x16x32_bf16(bi[ks], a, ai, 0, 0, 0); }
            { const bf16x8 a = *(const LAS bf16x8*)(lds + RL_XC + buf * 17408 + (16 * m + fr) * 272 + (32 * ksx + 8 * fq) * 2); ax = __builtin_amdgcn_mfma_f32_16x16x32_bf16(bid, a, ax, 0, 0, 0); }
            if (FINAL) { const bf16x8 a = *(const LAS bf16x8*)(lds + RL_RG + buf * 17408 + (16 * m + fr) * 272 + (32 * ksx + 8 * fq) * 2); ag = __builtin_amdgcn_mfma_f32_16x16x32_bf16(bid, a, ag, 0, 0, 0); }
            float P[4], H[4];
#pragma unroll
            for (int rp = 0; rp < 2; ++rp) {
                const f32x2 pr = (f32x2){ar[2 * rp], ar[2 * rp + 1]} + (f32x2){brv[2 * rp], brv[2 * rp + 1]}, pi = (f32x2){ai[2 * rp], ai[2 * rp + 1]} + (f32x2){biv[2 * rp], biv[2 * rp + 1]};
                const f32x2 rr = sig_2(pr), ii = sig_2(pi), a = exp2_2(rr * ((f32x2){spv[2 * rp], spv[2 * rp + 1]} * (-8.0f * 1.4426950408889634f)));
                const f32x2 om = 1.0f - a * a, bx = ii * (f32x2){ax[2 * rp], ax[2 * rp + 1]};
                P[2 * rp] = a.x; P[2 * rp + 1] = a.y; H[2 * rp] = fsqrt(fmaxf(om.x, 0.f)) * bx.x; H[2 * rp + 1] = fsqrt(fmaxf(om.y, 0.f)) * bx.y; }
#define RGL_SCAN_LEVEL(S) asm volatile("s_nop 1\n\t" \
                "v_fmac_f32_dpp %0, %0, %4 row_shr:" #S " row_mask:0xf bank_mask:0xf\n\tv_fmac_f32_dpp %1, %1, %5 row_shr:" #S " row_mask:0xf bank_mask:0xf\n\t" \
                "v_fmac_f32_dpp %2, %2, %6 row_shr:" #S " row_mask:0xf bank_mask:0xf\n\tv_fmac_f32_dpp %3, %3, %7 row_shr:" #S " row_mask:0xf bank_mask:0xf\n\t" \
                "v_mul_f32_dpp %4, %4, %4 row_shr:" #S " row_mask:0xf bank_mask:0xf\n\tv_mul_f32_dpp %5, %5, %5 row_shr:" #S " row_mask:0xf bank_mask:0xf\n\t" \
                "v_mul_f32_dpp %6, %6, %6 row_shr:" #S " row_mask:0xf bank_mask:0xf\n\tv_mul_f32_dpp %7, %7, %7 row_shr:" #S " row_mask:0xf bank_mask:0xf" \
                : "+v"(H[0]), "+v"(H[1]), "+v"(H[2]), "+v"(H[3]), "+v"(P[0]), "+v"(P[1]), "+v"(P[2]), "+v"(P[3]))
            RGL_SCAN_LEVEL(1); RGL_SCAN_LEVEL(2); RGL_SCAN_LEVEL(4); RGL_SCAN_LEVEL(8);
#undef RGL_SCAN_LEVEL
            float gq[4], qq[4]; float ss = 0.f;
#pragma unroll
            for (int rp = 0; rp < 2; ++rp) { const int r = 2 * rp;
                const f32x2 P2 = (f32x2){P[r], P[r + 1]}, hv = (f32x2){H[r], H[r + 1]} + P2 * (f32x2){hc[r], hc[r + 1]};
                if (FINAL) { const f32x2 x = (f32x2){ag[r], ag[r + 1]}; const f32x2 ge = x * sig_2((x + (x * x * x) * 0.044715f) * 1.5957691216057308f);
                    const f32x2 g2 = ge * hv; gq[r] = g2.x; gq[r + 1] = g2.y;
                    if (LOCAL) { const f32x2 q2 = ge * (P2 * (f32x2){ptot[r], ptot[r + 1]}); qq[r] = q2.x; qq[r + 1] = q2.y; } else ss += g2.x * g2.x + g2.y * g2.y; }
                if (!FINAL || LOCAL) { ptot[r] *= row_last(P[r]); ptot[r + 1] *= row_last(P[r + 1]); }
                hc[r] = row_last(hv.x); hc[r + 1] = row_last(hv.y); }
            if (FINAL) {
                u32x2 ow; ow.x = pk2(gq[0], gq[1]); ow.y = pk2(gq[2], gq[3]);
                *(LAS u32x2*)(lds + RL_OUT + buf * 17408 + (16 * m + fr) * 272 + (16 * w + 4 * fq) * 2) = ow;
                if (LOCAL) { u32x2 qw; qw.x = pk2(qq[0], qq[1]); qw.y = pk2(qq[2], qq[3]);
                    *(u32x2*)((bf16_t*)(p.ws() + WS_QB) + (tok0 + step * 64 + 16 * m + fr) * 512 + hd * 128 + 16 * w + 4 * fq) = qw; }
                else { ss += __shfl_xor(ss, 16); ss += __shfl_xor(ss, 32);
                       if (fq == 0) SSQP[w * 256 + step * 64 + 16 * m + fr] += ss; }
            }
        }
        if ((!FINAL || LOCAL) && step == 3 && fr == 0) {
#pragma unroll
            for (int r = 0; r < 4; ++r) *(float2*)(SUMM + ((size_t)(b * 16 + chunk) * 512 + hd * 128 + 16 * w + 4 * fq + r) * 2) = make_float2(ptot[r], hc[r]); }
    }
    if (FINAL) {
        __syncthreads();
        GSTAMP(p.ws(), tid, 2);
        { const int ps = 15, phd = 3, pstep = 3, pbuf = ps & 1;
          const u32x4 v0 = *(const LAS u32x4*)(lds + RL_OUT + pbuf * 17408 + srow * 272 + sseg * 32), v1 = *(const LAS u32x4*)(lds + RL_OUT + pbuf * 17408 + srow * 272 + sseg * 32 + 16);
          bf16_t* dst = MIX + (tok0 + pstep * 64 + srow) * D + 512 + phd * 128 + 16 * sseg; *(u32x4*)dst = v0; *(u32x4*)(dst + 8) = v1; }
        asm volatile("s_waitcnt vmcnt(0)" ::: "memory");
        __syncthreads();
        if (!LOCAL) for (int i = tid; i < 256 * 64; i += 512) { const int tl = i >> 6, c8 = i & 63; float s = 0.f;
#pragma unroll
            for (int ww = 0; ww < 8; ++ww) s += SSQP[ww * 256 + tl];
            const float rs = frsq(s * (1.0f / 512.f) + EPS);
            u32x4* ptr = (u32x4*)(MIX + (tok0 + tl) * D + 512 + c8 * 8); u32x4 v = *ptr;
            v.x = pk2(bflo(v.x) * rs, bfhi(v.x) * rs); v.y = pk2(bflo(v.y) * rs, bfhi(v.y) * rs); v.z = pk2(bflo(v.z) * rs, bfhi(v.z) * rs); v.w = pk2(bflo(v.w) * rs, bfhi(v.w) * rs);
            *ptr = v; }
    }
    __syncthreads();
    if (FINAL) GSTAMP(p.ws(), tid, 3);
}

__device__ __forceinline__ void rglru_fix(const PV& p, LAS unsigned char* lds, int item) {
    const int tid = get_tid(lds), lane = tid & 63, w = __builtin_amdgcn_readfirstlane(tid >> 6);
    const int b = item >> 4, chunk = item & 15;
    bf16_t* MIX = (bf16_t*)(p.ws() + WS_R1); const bf16_t* QB = (const bf16_t*)(p.ws() + WS_QB); const float* SUMM = (const float*)(p.ws() + WS_SUMM);
    LAS float* CARRY = (LAS float*)(lds + RL_CARRY);
    const size_t tok0 = (size_t)b * SEQ + (size_t)chunk * 256;
    GSTAMP(p.ws(), tid, 4);
    { float carry = 0.f;
      for (int cc = 0; cc < chunk; ++cc) { const float2 ab = *(const float2*)(SUMM + ((size_t)(b * 16 + cc) * 512 + tid) * 2); carry = ab.x * carry + ab.y; }
      CARRY[tid] = carry; }
    __syncthreads();
    float c[8];
#pragma unroll
    for (int j = 0; j < 8; ++j) c[j] = CARRY[8 * lane + j];
#pragma unroll 4
    for (int tl = w; tl < 256; tl += 8) {
        u32x4* gp = (u32x4*)(MIX + (tok0 + tl) * D + 512 + 8 * lane);
        const u32x4 g = *gp, q = *(const u32x4*)(QB + (tok0 + tl) * 512 + 8 * lane);
        const unsigned gw[4] = {g.x, g.y, g.z, g.w}, qw[4] = {q.x, q.y, q.z, q.w};
        float v[8]; float s = 0.f;
#pragma unroll
        for (int j = 0; j < 4; ++j) { v[2 * j] = bflo(gw[j]) + bflo(qw[j]) * c[2 * j]; v[2 * j + 1] = bfhi(gw[j]) + bfhi(qw[j]) * c[2 * j + 1]; s += v[2 * j] * v[2 * j] + v[2 * j + 1] * v[2 * j + 1]; }
        const float rs = frsq(wave_sum(s) * (1.0f / 512.f) + EPS);
        u32x4 o; o.x = pk2(v[0] * rs, v[1] * rs); o.y = pk2(v[2] * rs, v[3] * rs); o.z = pk2(v[4] * rs, v[5] * rs); o.w = pk2(v[6] * rs, v[7] * rs);
        *gp = o;
    }
    __syncthreads();
    GSTAMP(p.ws(), tid, 5);
}

constexpr int RT_WH = 0, RT_WL = 66048, RT_SELE = 132096, RT_SELG = RT_SELE + 4096, RT_RSTD = RT_SELG + 4096, RT_HIST = RT_RSTD + 1024, RT_BASE = RT_HIST + 128, RT_LDS = RT_BASE + 128;
template <int N> __device__ __forceinline__ float row_ror_f(float v) { return __builtin_bit_cast(float, __builtin_amdgcn_update_dpp(0, __builtin_bit_cast(int, v), 0x120 + N, 0xf, 0xf, false)); }
template <int N> __device__ __forceinline__ int row_ror_i(int v) { return __builtin_amdgcn_update_dpp(0, v, 0x120 + N, 0xf, 0xf, false); }
__device__ __forceinline__ float row_max16(float v) { v = fmaxf(v, row_ror_f<8>(v)); v = fmaxf(v, row_ror_f<4>(v)); v = fmaxf(v, row_ror_f<2>(v)); v = fmaxf(v, row_ror_f<1>(v)); return v; }
__device__ __forceinline__ int row_min16(int v) { v = min(v, row_ror_i<8>(v)); v = min(v, row_ror_i<4>(v)); v = min(v, row_ror_i<2>(v)); v = min(v, row_ror_i<1>(v)); return v; }
__device__ __forceinline__ void routing_block(const PV& p, LAS unsigned char* lds, int tb) {
    const int tid = get_tid(lds), lane = tid & 63, wave = __builtin_amdgcn_readfirstlane(tid >> 6), fr = lane & 15, fq = lane >> 4;
    LAS int* selE = (LAS int*)(lds + RT_SELE); LAS float* selG = (LAS float*)(lds + RT_SELG);
    LAS float* rstds = (LAS float*)(lds + RT_RSTD); LAS int* hist = (LAS int*)(lds + RT_HIST); LAS int* base = (LAS int*)(lds + RT_BASE);
    { const u32x4* src = (const u32x4*)(p.ws() + WS_WRT);
      for (int i = tid; i < 2 * 32 * 128; i += 512) { const int hl = i >> 12, e = (i >> 7) & 31, c = i & 127; *(LAS u32x4*)(lds + (hl ? RT_WL : RT_WH) + e * 2064 + c * 16) = src[i]; } }
    if (tid < 32) hist[tid] = 0;
    __syncthreads();
    const bf16_t* HB = (const bf16_t*)(p.ws() + WS_HB); unsigned char* HB8 = (unsigned char*)(p.ws() + WS_HB8);
    const size_t tok0 = (size_t)tb * 256 + 32 * wave;
    f32x4 acc[2][2];
#pragma unroll
    for (int m = 0; m < 2; ++m)
#pragma unroll
        for (int hf = 0; hf < 2; ++hf) acc[m][hf] = (f32x4){0.f, 0.f, 0.f, 0.f};
    float ss[2] = {0.f, 0.f};
#pragma unroll 4
    for (int ks = 0; ks < 32; ++ks) {
        bf16x8 ah[2];
#pragma unroll
        for (int m = 0; m < 2; ++m) { const size_t off = (tok0 + 16 * m + fr) * D + 32 * ks + 8 * fq;
            const u32x4 hv = *(const u32x4*)(HB + off);
            const float x0 = bflo(hv.x), x1 = bfhi(hv.x), x2 = bflo(hv.y), x3 = bfhi(hv.y), x4 = bflo(hv.z), x5 = bfhi(hv.z), x6 = bflo(hv.w), x7 = bfhi(hv.w);
            ss[m] += (x0 * x0 + x1 * x1) + (x2 * x2 + x3 * x3) + (x4 * x4 + x5 * x5) + (x6 * x6 + x7 * x7);
            ah[m] = __builtin_bit_cast(bf16x8, hv);
            u32x2 f8; f8.x = pk4_fp8(clamp448(x0 * SC_H), clamp448(x1 * SC_H), clamp448(x2 * SC_H), clamp448(x3 * SC_H)); f8.y = pk4_fp8(clamp448(x4 * SC_H), clamp448(x5 * SC_H), clamp448(x6 * SC_H), clamp448(x7 * SC_H));
            *(u32x2*)(HB8 + off) = f8; }
#pragma unroll
        for (int hf = 0; hf < 2; ++hf) { const bf16x8 bh = *(const LAS bf16x8*)(lds + RT_WH + (16 * hf + fr) * 2064 + (32 * ks + 8 * fq) * 2), bl = *(const LAS bf16x8*)(lds + RT_WL + (16 * hf + fr) * 2064 + (32 * ks + 8 * fq) * 2);
#pragma unroll
            for (int m = 0; m < 2; ++m) { acc[m][hf] = __builtin_amdgcn_mfma_f32_16x16x32_bf16(ah[m], bh, acc[m][hf], 0, 0, 0); acc[m][hf] = __builtin_amdgcn_mfma_f32_16x16x32_bf16(ah[m], bl, acc[m][hf], 0, 0, 0); } }
    }
#pragma unroll
    for (int m = 0; m < 2; ++m) { float s = ss[m]; s += __shfl_xor(s, 16); s += __shfl_xor(s, 32); if (fq == 0) rstds[32 * wave + 16 * m + fr] = frsq(s * (1.0f / D) + EPS); }
    const float rb0 = p.in(I_RB)[fr], rb1 = p.in(I_RB)[16 + fr];
#pragma unroll
    for (int m = 0; m < 2; ++m)
#pragma unroll
        for (int r = 0; r < 4; ++r) { const int tl = 32 * wave + 16 * m + 4 * fq + r; const float rstd = rstds[tl];
            float l0 = acc[m][0][r] * rstd + rb0, l1 = acc[m][1][r] * rstd + rb1;
            float tv[4]; int te[4];
#pragma unroll
            for (int k = 0; k < 4; ++k) { const float mx = row_max16(fmaxf(l0, l1));
                const int cand = l0 == mx ? fr : (l1 == mx ? 16 + fr : 99), sel = row_min16(cand);
                tv[k] = mx; te[k] = sel; if (sel == fr) l0 = -INFINITY; if (sel == 16 + fr) l1 = -INFINITY; }
            const float e1 = fexp(tv[1] - tv[0]), e2 = fexp(tv[2] - tv[0]), e3 = fexp(tv[3] - tv[0]), inv = 1.0f / (1.0f + e1 + e2 + e3);
            if (fr < 4) { const int ee = fr == 0 ? te[0] : fr == 1 ? te[1] : fr == 2 ? te[2] : te[3]; const float gg = (fr == 0 ? 1.0f : fr == 1 ? e1 : fr == 2 ? e2 : e3) * inv;
                selE[tl * 4 + fr] = ee; selG[tl * 4 + fr] = gg; } }
    __syncthreads();
    int myrank[2], mye[2];
#pragma unroll
    for (int q = 0; q < 2; ++q) { const int a = tid + 512 * q; mye[q] = selE[a]; myrank[q] = atomicAdd((int*)(hist + mye[q]), 1); }
    __syncthreads();
    unsigned* ctl = (unsigned*)(p.ws() + WS_CTL);
    if (tid < 32) base[tid] = (int)atomicAdd(ctl + CW_CNT + tid, (unsigned)hist[tid]);
    __syncthreads();
    i32x4* ENT = (i32x4*)(p.ws() + WS_ENT);
#pragma unroll
    for (int q = 0; q < 2; ++q) { const int a = tid + 512 * q, tl = a >> 2, k = a & 3; const int pos = base[mye[q]] + myrank[q];
        i32x4 en; en.x = tb * 256 + tl; en.y = __float_as_int(rstds[tl]); en.z = k; en.w = __float_as_int(selG[a]); ENT[(size_t)mye[q] * T + pos] = en; }
}
__device__ __forceinline__ void routing_phase(const PV& p, LAS unsigned char* lds) {
    for (int tb = blockIdx.x; tb < T / 256; tb += gridDim.x) { routing_block(p, lds, tb); __syncthreads(); }
}

struct Rounds { int es; int nr; __device__ __forceinline__ int lo(int r) const { return r == 0 ? 0 : es; } __device__ __forceinline__ int hi(int r) const { return r == 0 ? es : NE; } };
__device__ __forceinline__ int pad256(int c) { return (c + 255) & ~255; }
__device__ __forceinline__ Rounds make_rounds(const unsigned* cnt) {
    static_assert((long)T * 4 + NE * 255 <= CAP_ROWS, "one round always fits");
    (void)cnt; Rounds R; R.es = NE; R.nr = 1; return R;
}
__device__ __forceinline__ float f8lane(unsigned w, int i) { return i == 0 ? __builtin_amdgcn_cvt_f32_fp8((int)w, 0) : i == 1 ? __builtin_amdgcn_cvt_f32_fp8((int)w, 1) : i == 2 ? __builtin_amdgcn_cvt_f32_fp8((int)w, 2) : __builtin_amdgcn_cvt_f32_fp8((int)w, 3); }
__device__ __forceinline__ void combine_rows(const PV& p, int gw, int ngw, int lane) {
    const bf16_t* HB = (const bf16_t*)(p.ws() + WS_HB); const unsigned char* Y23 = (const unsigned char*)(p.ws() + WS_Y23);
    f32x4 fw[4];
#pragma unroll
    for (int q = 0; q < 4; ++q) fw[q] = *(const f32x4*)(p.in(I_FNW) + 16 * lane + 4 * q);
    for (int m = gw; m < T; m += ngw) {
        float v[16];
        const u32x4 h0 = *(const u32x4*)(HB + (size_t)m * D + 16 * lane), h1 = *(const u32x4*)(HB + (size_t)m * D + 16 * lane + 8);
        const unsigned hw[8] = {h0.x, h0.y, h0.z, h0.w, h1.x, h1.y, h1.z, h1.w};
#pragma unroll
        for (int q = 0; q < 8; ++q) { v[2 * q] = bflo(hw[q]); v[2 * q + 1] = bfhi(hw[q]); }
        float ys[16];
#pragma unroll
        for (int q = 0; q < 16; ++q) ys[q] = 0.f;
#pragma unroll
        for (int k = 0; k < 4; ++k) { const unsigned char* yb = (k < 2 ? (const unsigned char*)p.out() + (size_t)m * 4096 : Y23 + (size_t)m * 2048) + (k & 1) * 1024;
            const u32x4 y = *(const u32x4*)(yb + 16 * lane); const unsigned yw[4] = {y.x, y.y, y.z, y.w};
#pragma unroll
            for (int q = 0; q < 4; ++q) { ys[4 * q] += f8lane(yw[q], 0); ys[4 * q + 1] += f8lane(yw[q], 1); ys[4 * q + 2] += f8lane(yw[q], 2); ys[4 * q + 3] += f8lane(yw[q], 3); } }
        float s = 0.f;
#pragma unroll
        for (int q = 0; q < 16; ++q) { v[q] += ys[q] * (1.0f / SC_Y); s += v[q] * v[q]; }
        const float rstd = frsq(wave_sum(s) * (1.0f / D) + EPS);
        float* o = p.out() + (size_t)m * D + 16 * lane;
#pragma unroll
        for (int q = 0; q < 4; ++q) { f32x4 r; r.x = v[4 * q] * rstd * fw[q].x; r.y = v[4 * q + 1] * rstd * fw[q].y; r.z = v[4 * q + 2] * rstd * fw[q].z; r.w = v[4 * q + 3] * rstd * fw[q].w;
            *(f32x4*)(o + 4 * q) = r; }
    }
}
#ifndef REP_P0
#define REP_P0 1
#endif
#ifndef CONV_CAP
#define CONV_CAP 32
#endif
#ifndef REP_P1
#define REP_P1 1
#endif
#ifndef REP_P2
#define REP_P2 1
#endif
#ifndef REP_P3
#define REP_P3 1
#endif
#ifndef REP_P4
#define REP_P4 1
#endif
#ifndef REP_G1
#define REP_G1 1
#endif
#ifndef REP_G2
#define REP_G2 1
#endif
__global__ void __launch_bounds__(512, 2) fwd(Params kp) {
    extern __shared__ __attribute__((aligned(16))) unsigned char lds_[];
    LAS unsigned char* lds = (LAS unsigned char*)lds_;
    {
        const int t0 = threadIdx.x;
        if (t0 < 22) *(volatile LAS unsigned long long*)(lds + LDS_PTAB_OFF + 8 * t0) = (unsigned long long)(size_t)kp.in[t0];
        if (t0 == 22) *(volatile LAS unsigned long long*)(lds + LDS_PTAB_OFF + 8 * 22) = (unsigned long long)(size_t)kp.out;
        if (t0 == 23) *(volatile LAS unsigned long long*)(lds + LDS_PTAB_OFF + 8 * 23) = (unsigned long long)(size_t)kp.ws;
    }
    unsigned char* ws = kp.ws;
    unsigned* bar = (unsigned*)(ws + WS_CTL) + CW_BAR;
    const PV p{lds};
    {
        const int t0 = threadIdx.x;
        const unsigned slot = (unsigned)__builtin_amdgcn_s_getreg(((6 - 1) << 11) | 4);
        if ((t0 & 63) == 0) *(volatile LAS int*)(lds + LDS_TAB + 4 * slot) = t0 >> 6;
        if (t0 == 0) { *(volatile LAS unsigned*)(lds + LDS_BARST) = 0u; *(volatile LAS unsigned*)(lds + LDS_BARST + 4) = 0u;
            const unsigned x = xb_xcc_id(), rank = xb_add(&bar[XB_XCNT(x)], 1u);
            *(volatile LAS unsigned*)(lds + LDS_BARST + 8) = rank * 8u + x; }
        __syncthreads();
    }
#ifdef PROBE_PH
    volatile LAS unsigned long long* phs = (volatile LAS unsigned long long*)(lds + LDS_TAB - 256); int nph = 0;
#define PH_STAMP() do { if (get_tid(lds) == 0) phs[nph] = __builtin_amdgcn_s_memrealtime(); ++nph; } while (0)
    PH_STAMP();
#define GRID_BAR() do { grid_barrier(bar, lds); PH_STAMP(); } while (0)
#else
#define PH_STAMP() do { } while (0)
#define GRID_BAR() grid_barrier(bar, lds)
#endif
    for (int rep = 0; rep < REP_P0; ++rep) { prep_phase(p, lds);
    GRID_BAR(); }
    int vcu = (int)blockIdx.x;
    { bool even = (gridDim.x % 8u) == 0u;
      for (unsigned j = 0; j < 16; ++j) { const unsigned c = xb_ld(&bar[XB_XCNT(j)]); if (c != (j < 8 ? gridDim.x / 8u : 0u)) even = false; }
      if (even) vcu = (int)*(volatile LAS unsigned*)(lds + LDS_BARST + 8);
      vcu = __builtin_amdgcn_readfirstlane(vcu); }
    for (int rep = 0; rep < REP_P1; ++rep) {
    { DenseSched S; S.o.init(T / 256, NPROJ / 256, gridDim.x, vcu); S.A = (const char*)(ws + WS_R1); S.Bt = (const char*)(ws + WS_WIN); S.pitch = 2 * D; EpiInProj E{(bf16_t*)(ws + WS_R2)};
      pg8::gemm_phase<false, false>(lds, (const char*)(ws + WS_R1), 2 * D, S, E); }
    GRID_BAR(); }
    {
        unsigned* ctl = (unsigned*)(ws + WS_CTL);
        GSTAMP(ws, get_tid(lds), 32);
        if (blockIdx.x < 64) { GSTAMP(ws, get_tid(lds), 30); mlstm_phase<false>(p, lds, blockIdx.x); GSTAMP(ws, get_tid(lds), 31); }
        else if (blockIdx.x < 128) { const int bh = (int)blockIdx.x - 64;
            GSTAMP(ws, get_tid(lds), 34); mlstm_phase<true>(p, lds, bh); GSTAMP(ws, get_tid(lds), 35);
            asm volatile("s_waitcnt vmcnt(0)" ::: "memory"); __syncthreads();
            if (get_tid(lds) == 0) { __builtin_amdgcn_fence(__ATOMIC_RELEASE, "agent"); asm volatile("s_waitcnt vmcnt(0)" ::: "memory"); (void)xb_add(ctl + CW_MLF2 + bh, 1u); } }
        volatile LAS int* qslot = (volatile LAS int*)(lds + LDS_BARST + 12);
        for (;;) {
            const int tid = get_tid(lds);
            if (tid == 0) { int qi; bool held = false;
                const unsigned act = xb_add(ctl + CW_CACT, 1u);
                if (act < (unsigned)CONV_CAP) { const unsigned c = xb_add(ctl + CW_CONV, 1u); if (c < 384u) { qi = 256 + (int)c; held = true; } }
                if (!held) { (void)xb_add(ctl + CW_CACT, 0xFFFFFFFFu);
                    const unsigned m = xb_add(ctl + CW_WORK, 1u);
                    if (m < 256u) qi = (int)m; else if (m < 512u) qi = 640 + (int)(m - 256u); else if (m < 768u) qi = 896 + (int)(m - 512u);
                    else { const unsigned c = xb_add(ctl + CW_CONV, 1u); qi = c < 384u ? 256 + (int)c : 1152; } }
                *qslot = qi | (held ? 0x10000 : 0); }
            __syncthreads();
            const int qv = __builtin_amdgcn_readfirstlane(*qslot), idx = qv & 0xFFFF; const bool cheld = (qv >> 16) != 0;
            __syncthreads();
            if (idx < 256) {
                rglru_item<true, true>(p, lds, idx);
                asm volatile("s_waitcnt vmcnt(0)" ::: "memory"); __syncthreads();
                if (get_tid(lds) == 0) { __builtin_amdgcn_fence(__ATOMIC_RELEASE, "agent"); asm volatile("s_waitcnt vmcnt(0)" ::: "memory"); (void)xb_add(ctl + CW_CNTA + 16 * (idx >> 4), 1u); }
            } else if (idx >= 640 && idx < 896) {
                const int it = idx - 640;
                if (get_tid(lds) == 0) { XB_SPIN(xb_ld(ctl + CW_CNTA + 16 * (it >> 4)) < 16u, bar); __builtin_amdgcn_fence(__ATOMIC_ACQUIRE, "agent"); asm volatile("s_waitcnt vmcnt(0)" ::: "memory"); }
                __syncthreads();
                rglru_fix(p, lds, it);
            } else if (idx < 640) {
                const int ch = idx - 256, wave = get_tid(lds) >> 6, lane = get_tid(lds) & 63;
                LAS float* scr = (LAS float*)(lds + wave * 17408);
                conv_items8_moe(p, ch * 64 + wave * 8, scr, lane);
                __syncthreads();
                if (cheld && get_tid(lds) == 0) (void)xb_add(ctl + CW_CACT, 0xFFFFFFFFu);
            } else if (idx < 512 + 384 + 256) {
                const int it = idx - (512 + 384), bh = it >> 2, cg = it & 3;
                GSTAMP(ws, get_tid(lds), 38);
                if (get_tid(lds) == 0) { XB_SPIN(xb_ld(ctl + CW_MLF + bh) < 1u, bar); XB_SPIN(xb_ld(ctl + CW_MLF2 + bh) < 1u, bar); __builtin_amdgcn_fence(__ATOMIC_ACQUIRE, "agent"); asm volatile("s_waitcnt vmcnt(0)" ::: "memory"); }
                __syncthreads();
                GSTAMP(ws, get_tid(lds), 36); mlstm_fix(p, lds, bh, cg); GSTAMP(ws, get_tid(lds), 37);
            } else break;
        }
        GSTAMP(ws, get_tid(lds), 33);
    }
    GRID_BAR();
    for (int rep = 0; rep < REP_P4; ++rep) {
    { DenseSched S; S.o.init(T / 256, D / 256, gridDim.x, vcu); S.A = (const char*)(ws + WS_R1); S.Bt = (const char*)(ws + WS_WOUT); S.pitch = 2 * D; EpiOutProj E{p.in(I_X), (bf16_t*)(ws + WS_HB)};
      pg8::gemm_phase<false, false>(lds, (const char*)(ws + WS_R1), 2 * D, S, E); }
    GRID_BAR(); }
    routing_phase(p, lds);
    GRID_BAR();
    const unsigned* cnt = (const unsigned*)(ws + WS_CTL) + CW_CNT;
    const Rounds RR = make_rounds(cnt);
    for (int r = 0; r < RR.nr; ++r) {
        for (int rep = 0; rep < REP_G1; ++rep) {
        { MoeSched<true, 8, 2 * DFF> S{cnt, (const i32x4*)(ws + WS_ENT), (const char*)(ws + WS_HB8), (const char*)(ws + WS_WGU), lds, RR.lo(r), RR.hi(r), (int)gridDim.x, vcu, 0, p.in(I_BGU)}; S.init_tot(get_tid(lds));
          EpiG1 E{(unsigned char*)(ws + WS_R2)};
          pg8::gemm_phase<true, true>(lds, (const char*)(ws + WS_HB8), D, S, E, ws, 8); }
        GRID_BAR(); }
        for (int rep = 0; rep < REP_G2; ++rep) {
        { MoeSched<false, 4, D> S{cnt, (const i32x4*)(ws + WS_ENT), (const char*)(ws + WS_R2), (const char*)(ws + WS_WDN), lds, RR.lo(r), RR.hi(r), (int)gridDim.x, vcu, 0, p.in(I_BDN)}; S.init_tot(get_tid(lds));
          EpiG2 E{(unsigned char*)p.out(), (unsigned char*)(ws + WS_Y23)};
          pg8::gemm_phase<true, false>(lds, (const char*)(ws + WS_R2), DFF, S, E, ws, 16); }
        GRID_BAR(); }
    }
    { const int tid = get_tid(lds); combine_rows(p, blockIdx.x * 8 + (tid >> 6), gridDim.x * 8, tid & 63); }
#ifdef PROBE_G
    if (blockIdx.x == PROBE_BLK && get_tid(lds) == 0) {
        const volatile unsigned long long* st = (const volatile unsigned long long*)(ws + WS_CTL + 40960);
        const unsigned long long ticks = (st[PROBE_I + PROBE_SPAN] - st[PROBE_I]) * PROBE_MUL;
        const unsigned long long t0 = __builtin_amdgcn_s_memrealtime();
        while (__builtin_amdgcn_s_memrealtime() - t0 < ticks) __builtin_amdgcn_s_sleep(8);
    }
#endif
#ifdef PROBE_PH
    PH_STAMP();
    if (vcu == 0 && get_tid(lds) == 0) {
        const unsigned long long ticks = (phs[PROBE_PH + 1] - phs[PROBE_PH]) * PROBE_MUL;
        const unsigned long long t0 = __builtin_amdgcn_s_memrealtime();
        while (__builtin_amdgcn_s_memrealtime() - t0 < ticks) __builtin_amdgcn_s_sleep(8);
    }
#endif
}

extern "C" void kernel_launch(void* const* d_in, const int* in_sizes, int n_in, void* d_out, int out_size, void* d_ws, size_t ws_size, hipStream_t stream) {
    static int grid = 0;
    if (grid == 0) {
        if (n_in != 22 || ws_size < WS_END) { fprintf(stderr, "kernel_launch: unexpected n_in %d / ws_size %zu (need %zu)\n", n_in, ws_size, (size_t)WS_END); grid = -1; return; }
        int dev = 0, cus = 0, per_cu = 0;
        (void)hipGetDevice(&dev); (void)hipDeviceGetAttribute(&cus, hipDeviceAttributeMultiprocessorCount, dev);
        (void)hipFuncSetAttribute((const void*)fwd, hipFuncAttributeMaxDynamicSharedMemorySize, LDS_BYTES);
        (void)hipOccupancyMaxActiveBlocksPerMultiprocessor(&per_cu, (const void*)fwd, 512, LDS_BYTES);
        if (per_cu < 1) { fprintf(stderr, "kernel_launch: occupancy query says %d blocks/CU\n", per_cu); per_cu = 1; }
        grid = cus * per_cu;
        fprintf(stderr, "kernel_launch: grid %d (cus %d x %d)\n", grid, cus, per_cu);
    }
    if (grid < 0) return;
    Params p{};
    for (int i = 0; i < 22; ++i) p.in[i] = (const float*)d_in[i];
    p.out = (float*)d_out; p.ws = (unsigned char*)d_ws;
    (void)hipMemsetAsync((unsigned char*)d_ws + WS_CTL, 0, 65536, stream);
    void* args[] = {&p};
    hipError_t e = hipLaunchCooperativeKernel((const void*)fwd, dim3(grid), dim3(512), args, LDS_BYTES, stream);
    if (e != hipSuccess) fprintf(stderr, "kernel_launch: cooperative launch failed: %s (grid %d)\n", hipGetErrorString(e), grid);
}
```
